# Optimizing an MI355X kernel written in HIP

```python
import math
import jax, jax.numpy as jnp
from jax import lax
import numpy as np

D_MODEL = 1024
BATCH = 2
SEQ = 8192
DEPTH = 2

R_HEAD_DIM = 64
R_HEADS = D_MODEL // R_HEAD_DIM
R_WIDTH = R_HEADS * R_HEAD_DIM
DECAY_LORA = 64
ICLR_LORA = 64
VRES_LORA = 32
GN_EPS = 64e-5
A_HEAD_DIM = 64
A_HEADS_PER_GROUP = 8
DILATION_GROUPS = ((128, 1), (512, 4), (2048, 16))
N_GROUPS = 3
A_HEADS = N_GROUPS * A_HEADS_PER_GROUP
A_QK_WIDTH = A_HEADS * A_HEAD_DIM
A_OUT_WIDTH = A_HEADS_PER_GROUP * A_HEAD_DIM
BLK = 128
NUM_BUCKETS = 32
MAX_DISTANCE = 2048
N_BRANCHES = 2
PROJ_WIDTH = 4 * R_WIDTH + 3 * A_QK_WIDTH + A_OUT_WIDTH + N_BRANCHES * D_MODEL
RMS_EPS = 1e-6
NEG_INF = -1e30

kernel_name = "rwkv7_dilated_attn_gated_hybrid"


def rmsnorm(x, g):
    xf = x.astype(jnp.float32)
    y = xf * lax.rsqrt(jnp.mean(xf * xf, axis=-1, keepdims=True) + RMS_EPS)
    return (y * g).astype(x.dtype)


def token_shift(t):
    return jnp.pad(t, ((0, 0), (1, 0), (0, 0)))[:, :-1]


def t5_bucket(dist):
    max_exact = NUM_BUCKETS // 2
    safe = np.maximum(dist, 1).astype(np.float32)
    large = max_exact + (np.log(safe / max_exact) / math.log(MAX_DISTANCE / max_exact)
                         * (NUM_BUCKETS - max_exact)).astype(np.int32)
    large = np.minimum(large, NUM_BUCKETS - 1)
    return np.where(dist < max_exact, dist, large).astype(np.int32)


def dilated_window_attention(q, k, v, bias_table, window, dilation):
    B, S, H, E = q.shape
    span = window // dilation
    L = S // dilation
    nb = -(-L // BLK)
    Lp = nb * BLK

    def to_blocks(t):
        t = t.reshape(B, L, dilation, H, E).transpose(0, 2, 3, 1, 4)
        t = jnp.pad(t, ((0, 0), (0, 0), (0, 0), (0, Lp - L), (0, 0)))
        return t.reshape(B, dilation, H, nb, BLK, E)

    def with_prev(t):
        prev = jnp.pad(t[:, :, :, :-1], ((0, 0), (0, 0), (0, 0), (1, 0), (0, 0), (0, 0)))
        return jnp.concatenate([prev, t], axis=4)

    qb = to_blocks(q)
    kw = with_prev(to_blocks(k))
    vw = with_prev(to_blocks(v))

    qi = np.arange(BLK)[:, None]
    ki = np.arange(2 * BLK)[None, :]
    delta = qi + BLK - ki
    band = (delta >= 0) & (delta <= span)
    not_first = np.arange(nb)[:, None, None] > 0
    mask = band[None] & (not_first | (ki >= BLK)[None])
    bucket = t5_bucket(np.maximum(delta, 0) * dilation)
    bias = jnp.take(bias_table, bucket, axis=0).astype(jnp.float32).transpose(2, 0, 1)

    logits = jnp.einsum('bdhnqe,bdhnke->bdhnqk', qb, kw) / math.sqrt(E) + bias[None, None, :, None]
    logits = jnp.where(mask, logits, NEG_INF)
    m = jnp.max(logits, axis=-1, keepdims=True)
    p = jnp.exp(logits - m)
    den = jnp.sum(p, axis=-1, keepdims=True)
    o = jnp.einsum('bdhnqk,bdhnke->bdhnqe', p, vw) / den
    lse = (m + jnp.log(den))[..., 0]

    def from_blocks(t):
        t = t.reshape((B, dilation, H, Lp) + t.shape[5:])[:, :, :, :L]
        t = jnp.moveaxis(t, 3, 1)
        return t.reshape((B, S, H) + t.shape[4:])

    return from_blocks(o), from_blocks(lse)


def rwkv7_scan(r, decay, k, v, neg_kk, kk_a):
    B, S, H, N = r.shape
    xs = tuple(jnp.moveaxis(t, 1, 0) for t in (r, decay, k, v, neg_kk, kk_a))

    def step(state, inp):
        r_t, w_t, k_t, v_t, a_t, b_t = inp
        sa = jnp.einsum('bhij,bhj->bhi', state, a_t)
        state = (state * w_t[:, :, None, :] + sa[..., None] * b_t[:, :, None, :]
                 + v_t[..., None] * k_t[:, :, None, :])
        y = jnp.einsum('bhij,bhj->bhi', state, r_t)
        return state, y

    _, y = lax.scan(step, jnp.zeros((B, H, N, N), jnp.float32), xs)
    return jnp.moveaxis(y, 0, 1)


def rwkv7_time_mix(h, p_r, p_k, p_v, mu_rkv, mu_wa, w0, w1, w2, a0, a1, a2,
                   k_k, k_a, r_k, ln_g, ln_b, v_first, vres):
    B, S, _ = h.shape
    f32 = jnp.float32
    h = h.astype(f32)

    def lerp(t, mu):
        return t + (token_shift(t) - t) * mu

    r = lerp(p_r.astype(f32), mu_rkv[0])
    k = lerp(p_k.astype(f32), mu_rkv[1])
    v = lerp(p_v.astype(f32), mu_rkv[2])
    xw = lerp(h, mu_wa[0])
    xa = lerp(h, mu_wa[1])
    w = -jax.nn.softplus(-(w0 + jnp.tanh(xw @ w1) @ w2)) - 0.5
    decay = jnp.exp(-jnp.exp(w))
    a = jax.nn.sigmoid(a0 + (xa @ a1) @ a2)
    if vres is None:
        v_first = v
    else:
        mu_v, v0, v1, v2 = vres
        xv = lerp(h, mu_v)
        v = v + (v_first - v) * jax.nn.sigmoid(v0 + (xv @ v1) @ v2)

    def heads(t):
        return t.reshape(B, S, R_HEADS, R_HEAD_DIM)

    kk = heads(k * k_k)
    kk = kk * lax.rsqrt(jnp.maximum(jnp.sum(kk * kk, axis=-1, keepdims=True), 1e-24))
    k = k * (1.0 + (a - 1.0) * k_a)
    r, k, v, decay, a = heads(r), heads(k), heads(v), heads(decay), heads(a)

    y = rwkv7_scan(r, decay, k, v, -kk, kk * a)
    mean = jnp.mean(y, axis=-1, keepdims=True)
    var = jnp.mean(jnp.square(y - mean), axis=-1, keepdims=True)
    y = ((y - mean) * lax.rsqrt(var + GN_EPS)).reshape(B, S, R_WIDTH) * ln_g + ln_b
    bonus = (jnp.sum(r * k * r_k, axis=-1, keepdims=True) * v).reshape(B, S, R_WIDTH)
    return y + bonus, v_first


def setup_inputs(seed: int = 0) -> dict:
    key = jax.random.key(seed)
    ks = iter(jax.random.split(key, 32))

    def nrm(shape, scale):
        return jax.random.normal(next(ks), shape, jnp.float32) * scale

    def uni(shape, lo, hi):
        return jax.random.uniform(next(ks), shape, jnp.float32, lo, hi)

    D, L = D_MODEL, DEPTH
    return {
        "x": nrm((BATCH, SEQ, D), 1.0),
        "c": nrm((BATCH, D), 1.0),
        "norm_g": 1.0 + nrm((L, D), 0.02),
        "ada_w": nrm((L, D, 3 * D), 0.5 * D ** -0.5),
        "ada_b": nrm((L, 3 * D), 0.02),
        "w_in": nrm((L, D, PROJ_WIDTH), D ** -0.5),
        "rwkv_mu_rkv": uni((L, 3, R_WIDTH), 0.0, 1.0),
        "rwkv_mu_wa": uni((L, 2, D), 0.0, 1.0),
        "rwkv_w0": uni((L, R_WIDTH), -6.5, -1.5),
        "rwkv_w1": nrm((L, D, DECAY_LORA), D ** -0.5),
        "rwkv_w2": nrm((L, DECAY_LORA, R_WIDTH), 0.5 * DECAY_LORA ** -0.5),
        "rwkv_a0": nrm((L, R_WIDTH), 0.5),
        "rwkv_a1": nrm((L, D, ICLR_LORA), D ** -0.5),
        "rwkv_a2": nrm((L, ICLR_LORA, R_WIDTH), ICLR_LORA ** -0.5),
        "rwkv_k_k": 0.85 + nrm((L, R_WIDTH), 0.05),
        "rwkv_k_a": 1.0 + nrm((L, R_WIDTH), 0.05),
        "rwkv_r_k": nrm((L, R_HEADS, R_HEAD_DIM), 0.1),
        "rwkv_ln_g": 1.0 + nrm((L, R_WIDTH), 0.02),
        "rwkv_ln_b": nrm((L, R_WIDTH), 0.02),
        "rwkv_mu_v": uni((L - 1, D), 0.0, 1.0),
        "rwkv_v0": nrm((L - 1, R_WIDTH), 0.5),
        "rwkv_v1": nrm((L - 1, D, VRES_LORA), D ** -0.5),
        "rwkv_v2": nrm((L - 1, VRES_LORA, R_WIDTH), VRES_LORA ** -0.5),
        "w_branch_a": nrm((L, R_WIDTH, D), R_WIDTH ** -0.5),
        "w_branch_b": nrm((L, A_OUT_WIDTH, D), A_OUT_WIDTH ** -0.5),
        "w_out": nrm((L, D, D), D ** -0.5),
        "rel_bias": nrm((NUM_BUCKETS, A_HEADS), 0.5),
        "final_g": 1.0 + nrm((D,), 0.02),
    }


def reference(x, c, norm_g, ada_w, ada_b, w_in, rwkv_mu_rkv, rwkv_mu_wa, rwkv_w0, rwkv_w1,
              rwkv_w2, rwkv_a0, rwkv_a1, rwkv_a2, rwkv_k_k, rwkv_k_a, rwkv_r_k, rwkv_ln_g,
              rwkv_ln_b, rwkv_mu_v, rwkv_v0, rwkv_v1, rwkv_v2, w_branch_a, w_branch_b, w_out,
              rel_bias, final_g):
    B, S, _ = x.shape
    f32 = jnp.float32
    widths = [R_WIDTH] * 4 + [A_QK_WIDTH] * 3 + [A_OUT_WIDTH] + [D_MODEL]
    split_points = [int(s) for s in np.cumsum(widths)]
    v_first = None
    for i in range(DEPTH):
        mod = jax.nn.silu(c) @ ada_w[i] + ada_b[i]
        shift, scale, gate = jnp.split(mod, 3, axis=-1)
        h = rmsnorm(x, norm_g[i]) * (1.0 + scale[:, None]) + shift[:, None]

        proj = h @ w_in[i]
        p_r, p_k, p_v, g_a, q, k, v, g_b, m_a, m_b = jnp.split(proj, split_points, axis=-1)

        vres = None if i == 0 else (rwkv_mu_v[i - 1], rwkv_v0[i - 1], rwkv_v1[i - 1], rwkv_v2[i - 1])
        y_a, v_first = rwkv7_time_mix(h, p_r, p_k, p_v, rwkv_mu_rkv[i], rwkv_mu_wa[i], rwkv_w0[i],
                                      rwkv_w1[i], rwkv_w2[i], rwkv_a0[i], rwkv_a1[i], rwkv_a2[i],
                                      rwkv_k_k[i], rwkv_k_a[i], rwkv_r_k[i], rwkv_ln_g[i],
                                      rwkv_ln_b[i], v_first, vres)
        y_a = y_a * jax.nn.silu(g_a.astype(f32))

        qg = q.astype(f32).reshape(B, S, N_GROUPS, A_HEADS_PER_GROUP, A_HEAD_DIM)
        kg = k.astype(f32).reshape(B, S, N_GROUPS, A_HEADS_PER_GROUP, A_HEAD_DIM)
        vg = v.astype(f32).reshape(B, S, N_GROUPS, A_HEADS_PER_GROUP, A_HEAD_DIM)
        outs, lses = [], []
        for g, (win, dil) in enumerate(DILATION_GROUPS):
            o_g, l_g = dilated_window_attention(
                qg[:, :, g], kg[:, :, g], vg[:, :, g],
                rel_bias[:, g * A_HEADS_PER_GROUP:(g + 1) * A_HEADS_PER_GROUP], win, dil)
            outs.append(o_g)
            lses.append(l_g)
        wts = jax.nn.softmax(jnp.stack(lses, axis=0), axis=0)
        y_b = jnp.sum(wts[..., None] * jnp.stack(outs, axis=0), axis=0).reshape(B, S, A_OUT_WIDTH)
        y_b = y_b * jax.nn.silu(g_b.astype(f32))

        merged = (jax.nn.sigmoid(m_a.astype(f32)) * (y_a @ w_branch_a[i])
                  + jax.nn.sigmoid(m_b.astype(f32)) * (y_b @ w_branch_b[i]))
        out = merged @ w_out[i]
        x = (x + gate[:, None] * out).astype(x.dtype)
    return rmsnorm(x, final_g)
```

```cpp
#include <hip/hip_runtime.h>
#include <hip/hip_cooperative_groups.h>
#include <cstdio>
#include <cstdint>
namespace cg = cooperative_groups;
namespace pg8 {
#define PG8_LAS __attribute__((address_space(3)))
typedef unsigned short bf16_t;
typedef short bf16x8 __attribute__((ext_vector_type(8)));
typedef float f32x4 __attribute__((ext_vector_type(4)));
typedef unsigned u32x4 __attribute__((ext_vector_type(4)));
constexpr int BM = 256, BK = 64, HALF = 128, HTB = HALF * BK * 2  , STAGE_BYTES = 8 * HTB, NXCD = 8, WGM = 8;

__host__ __device__ __forceinline__ int lds_byte(int r, int c) { const int st = (r >> 4) * 2 + (c >> 5), rr = r & 15, cc = c & 31, ob = rr * 64 + cc * 2; return st * 1024 + (ob ^ (((ob >> 9) & 1) << 5)); }
__host__ __device__ __forceinline__ void stage_rc(int b, int& R, int& C) { const int st = b / 1024, sb = b % 1024, swz = sb ^ (((sb >> 9) & 1) << 5); R = (st >> 1) * 16 + swz / 64; C = (st & 1) * 32 + (swz % 64) / 2; }
__host__ __device__ __forceinline__ int perm32(int rho) { const int n = rho >> 4, i = rho & 15; return 8 * (i >> 2) + 4 * n + (i & 3); }

struct Unit { int pm, pn; };
struct Gemm { const bf16_t* A; const bf16_t* Bt; int M, N, K; };

struct StaticOrder {
    int nM, nN, nwg, G, c;
    __host__ __device__ void init(int M, int N, int G_, int c_) { nM = M / BM; nN = N / BM; nwg = nM * nN; G = G_; c = c_; }
    __host__ __device__ bool next(int i, Unit& u) const {
        const long L = (long)i * G + c; if (L >= nwg) return false;
        int wgid = (int)L; { const int q = nwg / NXCD, r = nwg % NXCD, xcd = wgid % NXCD, off = wgid / NXCD; wgid = (xcd < r ? xcd * (q + 1) : r * (q + 1) + (xcd - r) * q) + off; }
        const int nig = WGM * nN, gid = wgid / nig, fm = gid * WGM, gsz = (nM - fm) < WGM ? (nM - fm) : WGM;
        u.pm = fm + ((wgid % nig) % gsz); u.pn = (wgid % nig) / gsz; return true;
    }
    __device__ __forceinline__ void a_ready(const Unit&) const {}
    __device__ __forceinline__ void done(const Unit&) const {}
};

__device__ __forceinline__ unsigned cvt_pk_bf16(float lo, float hi) { unsigned r; asm volatile("v_cvt_pk_bf16_f32 %0, %1, %2" : "=v"(r) : "v"(lo), "v"(hi)); return r; }
typedef float f32x2 __attribute__((ext_vector_type(2)));
template <class Epi, class Sched, bool ALIGN_EPI = false, bool SP2 = false>
__device__ __forceinline__ void gemm_phase(PG8_LAS unsigned char* lds, const Gemm g, const Sched& S, const Epi& E) {
    int tid_ = threadIdx.x; asm volatile("" : "+v"(tid_));
    const int tid = tid_, wid = __builtin_amdgcn_readfirstlane(tid >> 6), lane = tid & 63, wr = wid >> 2, wc = wid & 3, fr = lane & 15, fq = lane >> 4;
    const int K = g.K, nt = K / BK;
    unsigned voffA[2], voffB[2];
#pragma unroll
    for (int i = 0; i < 2; ++i) { int R, C; stage_rc(tid * 16 + i * 8192, R, C); const int Rb = Epi::PERM ? ((R & ~31) + perm32(R & 31)) : R;
        voffA[i] = (unsigned)(R * K + C) * 2u; voffB[i] = (unsigned)(Rb * K + C) * 2u; }
    const size_t kstep = (size_t)(BK * 2);
    const size_t hstep = (size_t)HALF * K * 2;
    const size_t tstep = 2 * hstep;
    const unsigned ldsw = (unsigned)wid * 1024u;
    const int aoff = lds_byte(wr * 64 + fr, fq * 8), boff = lds_byte(wc * 32 + fr, fq * 8);
#define PG8_SA(b, h) (((b) * 2 + (h)) * HTB)
#define PG8_SB(b, h) ((4 + (b) * 2 + (h)) * HTB)
#define PG8_STAGE(bufoff, gbase, voff) do { _Pragma("unroll") for (int _i = 0; _i < 2; ++_i) \
        __builtin_amdgcn_global_load_lds((const unsigned*)((const char*)(gbase) + (voff)[_i]), (PG8_LAS unsigned*)(lds + (bufoff) + ldsw + _i * 8192), 16, 0, 0); } while (0)
#define PG8_LDA(dst, b, h) do { _Pragma("unroll") for (int m = 0; m < 4; ++m) _Pragma("unroll") for (int k = 0; k < 2; ++k) dst[m][k] = *(const PG8_LAS bf16x8*)(lds + PG8_SA(b, h) + aoff + m * 2048 + k * 1024); } while (0)
#define PG8_LDB(dst, b, h) do { _Pragma("unroll") for (int n = 0; n < 2; ++n) _Pragma("unroll") for (int k = 0; k < 2; ++k) dst[n][k] = *(const PG8_LAS bf16x8*)(lds + PG8_SB(b, h) + boff + n * 2048 + k * 1024); } while (0)
#define PG8_MMA(ai, bj, At, Bt) do { __builtin_amdgcn_s_setprio(1); _Pragma("unroll") for (int m = 0; m < 4; ++m) _Pragma("unroll") for (int n = 0; n < 2; ++n) _Pragma("unroll") for (int k = 0; k < 2; ++k) \
        acc[ai][bj][m][n] = __builtin_amdgcn_mfma_f32_16x16x32_bf16(Bt[n][k], At[m][k], acc[ai][bj][m][n], 0, 0, 0); __builtin_amdgcn_s_setprio(0); } while (0)
#define PG8_WAIT_V(n) asm volatile("s_waitcnt vmcnt(" #n ")" ::: "memory")
#define PG8_WAIT_L(n) asm volatile("s_waitcnt lgkmcnt(" #n ")" ::: "memory")
#define PG8_BAR __builtin_amdgcn_s_barrier()
#define PG8_SCHED __builtin_amdgcn_sched_barrier(0)
    Unit cur, nxt; int ui = 0;
    if (!S.next(0, cur)) return;
    f32x4 acc[2][2][4][2];
#pragma unroll
    for (int a = 0; a < 2; ++a)
#pragma unroll
        for (int b = 0; b < 2; ++b)
#pragma unroll
            for (int m = 0; m < 4; ++m)
#pragma unroll
                for (int n = 0; n < 2; ++n) acc[a][b][m][n] = (f32x4){0.f, 0.f, 0.f, 0.f};
    bf16x8 At[4][2], B0[2][2], B1[2][2];
    const char* cA = (const char*)g.A + (size_t)cur.pm * tstep; const char* cB = (const char*)g.Bt + (size_t)cur.pn * tstep;
    S.a_ready(cur);
    if constexpr (SP2) {
        PG8_STAGE(PG8_SB(0, 0), cB, voffB); PG8_STAGE(PG8_SB(0, 1), cB + hstep, voffB); PG8_STAGE(PG8_SA(0, 0), cA, voffA); PG8_STAGE(PG8_SA(0, 1), cA + hstep, voffA);
        if (wr == 1) PG8_BAR;
        PG8_WAIT_V(2); PG8_BAR;
        PG8_STAGE(PG8_SB(1, 0), cB + kstep, voffB); PG8_STAGE(PG8_SA(1, 0), cA + kstep, voffA); PG8_STAGE(PG8_SB(1, 1), cB + hstep + kstep, voffB);
        PG8_WAIT_V(6); PG8_BAR;
    } else {
        PG8_STAGE(PG8_SB(0, 0), cB, voffB); PG8_STAGE(PG8_SA(0, 0), cA, voffA); PG8_STAGE(PG8_SB(0, 1), cB + hstep, voffB); PG8_STAGE(PG8_SA(0, 1), cA + hstep, voffA);
        if (wr == 1) PG8_BAR;
        PG8_WAIT_V(4); PG8_BAR;
        PG8_STAGE(PG8_SB(1, 0), cB + kstep, voffB); PG8_STAGE(PG8_SA(1, 0), cA + kstep, voffA); PG8_STAGE(PG8_SB(1, 1), cB + hstep + kstep, voffB);
        PG8_WAIT_V(6); PG8_BAR;
    }
    for (;;) {
        const bool has_next = S.next(ui + 1, nxt);
        const char* nA = has_next ? (const char*)g.A + (size_t)nxt.pm * tstep : cA; const char* nB = has_next ? (const char*)g.Bt + (size_t)nxt.pn * tstep : cB;
        for (int t = 0; t < nt; t += 2) {
            const bool last = (t == nt - 2);
            const char* a1 = cA + (size_t)(t + 1) * kstep;
            const char* a2 = last ? nA : cA + (size_t)(t + 2) * kstep; const char* b2 = last ? nB : cB + (size_t)(t + 2) * kstep;
            const char* a3 = a2 + kstep; const char* b3 = b2 + kstep;
            if (last && has_next) S.a_ready(nxt);
            if constexpr (SP2) {
            PG8_LDB(B0, 0, 0); PG8_LDB(B1, 0, 1); PG8_SCHED; PG8_LDA(At, 0, 0); PG8_STAGE(PG8_SA(1, 1), a1 + hstep, voffA);
            PG8_WAIT_V(8); PG8_WAIT_L(0); PG8_BAR; PG8_MMA(0, 0, At, B0); PG8_MMA(0, 1, At, B1); PG8_BAR; PG8_SCHED;
            PG8_LDA(At, 0, 1); PG8_STAGE(PG8_SB(0, 0), b2, voffB); PG8_STAGE(PG8_SB(0, 1), b2 + hstep, voffB); PG8_STAGE(PG8_SA(0, 0), a2, voffA);
            PG8_WAIT_V(8); PG8_WAIT_L(0); PG8_BAR; PG8_MMA(1, 0, At, B0); PG8_MMA(1, 1, At, B1); PG8_BAR; PG8_SCHED;
            PG8_LDB(B0, 1, 0); PG8_LDB(B1, 1, 1); PG8_SCHED; PG8_LDA(At, 1, 0); PG8_STAGE(PG8_SA(0, 1), a2 + hstep, voffA);
            PG8_WAIT_V(8); PG8_WAIT_L(0); PG8_BAR; PG8_MMA(0, 0, At, B0); PG8_MMA(0, 1, At, B1); PG8_BAR; PG8_SCHED;
            PG8_LDA(At, 1, 1); PG8_STAGE(PG8_SB(1, 0), b3, voffB); PG8_STAGE(PG8_SB(1, 1), b3 + hstep, voffB); PG8_STAGE(PG8_SA(1, 0), a3, voffA);
            PG8_WAIT_V(8); PG8_WAIT_L(0); PG8_BAR; PG8_MMA(1, 0, At, B0); PG8_MMA(1, 1, At, B1); PG8_BAR; PG8_SCHED;
            } else {
            PG8_LDB(B0, 0, 0); PG8_SCHED; PG8_LDA(At, 0, 0); PG8_STAGE(PG8_SA(1, 1), a1 + hstep, voffA);
            PG8_WAIT_L(8); PG8_BAR; PG8_WAIT_L(0); PG8_MMA(0, 0, At, B0); PG8_BAR; PG8_SCHED;
            PG8_LDB(B1, 0, 1); PG8_STAGE(PG8_SB(0, 0), b2, voffB);
            PG8_BAR; PG8_WAIT_L(0); PG8_MMA(0, 1, At, B1); PG8_BAR;
            PG8_LDA(At, 0, 1); PG8_STAGE(PG8_SA(0, 0), a2, voffA);
            PG8_BAR; PG8_WAIT_L(0); PG8_MMA(1, 0, At, B0); PG8_BAR; PG8_SCHED;
            PG8_STAGE(PG8_SB(0, 1), b2 + hstep, voffB);
            PG8_WAIT_V(6); PG8_BAR; PG8_MMA(1, 1, At, B1); PG8_BAR;
            PG8_LDB(B0, 1, 0); PG8_SCHED; PG8_LDA(At, 1, 0); PG8_STAGE(PG8_SA(0, 1), a2 + hstep, voffA);
            PG8_WAIT_L(8); PG8_BAR; PG8_WAIT_L(0); PG8_MMA(0, 0, At, B0); PG8_BAR; PG8_SCHED;
            PG8_LDB(B1, 1, 1); PG8_STAGE(PG8_SB(1, 0), b3, voffB);
            PG8_BAR; PG8_WAIT_L(0); PG8_MMA(0, 1, At, B1); PG8_BAR;
            PG8_LDA(At, 1, 1); PG8_STAGE(PG8_SA(1, 0), a3, voffA);
            PG8_BAR; PG8_WAIT_L(0); PG8_MMA(1, 0, At, B0); PG8_BAR; PG8_SCHED;
            PG8_STAGE(PG8_SB(1, 1), b3 + hstep, voffB);
            PG8_WAIT_V(6); PG8_BAR; PG8_MMA(1, 1, At, B1); PG8_BAR;
            }
        }
        if constexpr (ALIGN_EPI) { if (wr == 0) PG8_BAR; }
        if constexpr (!Epi::AFTER_DRAIN) { E(acc, cur, wr, wc, fr, fq); S.done(cur); }
        if (!has_next) break;
#pragma unroll
        for (int a = 0; a < 2; ++a)
#pragma unroll
            for (int b = 0; b < 2; ++b)
#pragma unroll
                for (int m = 0; m < 4; ++m)
#pragma unroll
                    for (int n = 0; n < 2; ++n) acc[a][b][m][n] = (f32x4){0.f, 0.f, 0.f, 0.f};
        cur = nxt; cA = nA; cB = nB; ++ui;
        if constexpr (ALIGN_EPI) { if (wr == 1) PG8_BAR; }
    }
    PG8_WAIT_V(0);
    if constexpr (!ALIGN_EPI) { if (wr == 0) PG8_BAR; }
    PG8_BAR;
    if constexpr (Epi::AFTER_DRAIN) { E.fused(acc, cur, wr, wc, fr, fq, lds, wid, lane); S.done(cur); }
#undef PG8_SA
#undef PG8_SB
#undef PG8_STAGE
#undef PG8_LDA
#undef PG8_LDB
#undef PG8_MMA
#undef PG8_WAIT_V
#undef PG8_WAIT_L
#undef PG8_BAR
#undef PG8_SCHED
}
}
namespace pg8 {
__device__ __forceinline__ float ep_bflo(unsigned w) { return __uint_as_float(w << 16); }
__device__ __forceinline__ float ep_bfhi(unsigned w) { return __uint_as_float(w & 0xffff0000u); }
__device__ __forceinline__ float ep_sigmoid(float x) { return 1.f / (1.f + __expf(-x)); }
struct EpiStore {
    static constexpr bool PERM = true, AFTER_DRAIN = false;
    bf16_t* O; int ldc;
    __device__ __forceinline__ void operator()(const f32x4 (&acc)[2][2][4][2], const Unit& u, int wr, int wc, int fr, int fq) const {
        const int row0 = u.pm * BM + wr * 64 + fr, col0 = u.pn * BM + wc * 32 + 8 * fq;
#pragma unroll
        for (int ai = 0; ai < 2; ++ai)
#pragma unroll
            for (int m = 0; m < 4; ++m) { bf16_t* rowp = O + (size_t)(row0 + ai * HALF + m * 16) * ldc + col0;
#pragma unroll
                for (int bj = 0; bj < 2; ++bj) { const f32x4 v0 = acc[ai][bj][m][0], v1 = acc[ai][bj][m][1]; u32x4 w;
                    w.x = cvt_pk_bf16(v0[0], v0[1]); w.y = cvt_pk_bf16(v0[2], v0[3]); w.z = cvt_pk_bf16(v1[0], v1[1]); w.w = cvt_pk_bf16(v1[2], v1[3]);
                    *(u32x4*)(rowp + bj * HALF) = w; } }
    }
};
struct EpiGates {
    static constexpr bool PERM = true, AFTER_DRAIN = false;
    bf16_t* YA; bf16_t* YB; bf16_t* MG;
    __device__ __forceinline__ void operator()(const f32x4 (&acc)[2][2][4][2], const Unit& u, int wr, int wc, int fr, int fq) const {
        const int colt = u.pn * BM; int mode, ld, cb; bf16_t* P;
        if (colt < 1024) { mode = 0; P = YA; ld = 1024; cb = colt; } else if (colt < 1536) { mode = 1; P = YB; ld = 512; cb = colt - 1024; } else { mode = 2; P = MG; ld = 2048; cb = colt - 1536; }
        const int row0 = u.pm * BM + wr * 64 + fr, col0 = cb + wc * 32 + 8 * fq;
#pragma unroll
        for (int ai = 0; ai < 2; ++ai)
#pragma unroll
            for (int m = 0; m < 4; ++m) { bf16_t* rowp = P + (size_t)(row0 + ai * HALF + m * 16) * ld + col0;
#pragma unroll
                for (int bj = 0; bj < 2; ++bj) { const f32x4 v0 = acc[ai][bj][m][0], v1 = acc[ai][bj][m][1]; float g[8] = {v0[0], v0[1], v0[2], v0[3], v1[0], v1[1], v1[2], v1[3]};
                    u32x4 w;
                    if (mode == 2) {
#pragma unroll
                        for (int e = 0; e < 8; ++e) g[e] = ep_sigmoid(g[e]);
                    } else {
                        const u32x4 y = *(const u32x4*)(rowp + bj * HALF);
                        const float yv[8] = {ep_bflo(y.x), ep_bfhi(y.x), ep_bflo(y.y), ep_bfhi(y.y), ep_bflo(y.z), ep_bfhi(y.z), ep_bflo(y.w), ep_bfhi(y.w)};
#pragma unroll
                        for (int e = 0; e < 8; ++e) g[e] = yv[e] * g[e] * ep_sigmoid(g[e]);
                    }
                    w.x = cvt_pk_bf16(g[0], g[1]); w.y = cvt_pk_bf16(g[2], g[3]); w.z = cvt_pk_bf16(g[4], g[5]); w.w = cvt_pk_bf16(g[6], g[7]);
                    *(u32x4*)(rowp + bj * HALF) = w; } }
    }
};
template <bool SECOND> struct EpiMerge {
    static constexpr bool PERM = true, AFTER_DRAIN = false;
    bf16_t* MERGED; const bf16_t* MG;
    __device__ __forceinline__ void operator()(const f32x4 (&acc)[2][2][4][2], const Unit& u, int wr, int wc, int fr, int fq) const {
        const int row0 = u.pm * BM + wr * 64 + fr, col0 = u.pn * BM + wc * 32 + 8 * fq;
#pragma unroll
        for (int ai = 0; ai < 2; ++ai)
#pragma unroll
            for (int m = 0; m < 4; ++m) { const size_t r = (size_t)(row0 + ai * HALF + m * 16);
#pragma unroll
                for (int bj = 0; bj < 2; ++bj) { const f32x4 v0 = acc[ai][bj][m][0], v1 = acc[ai][bj][m][1]; float g[8] = {v0[0], v0[1], v0[2], v0[3], v1[0], v1[1], v1[2], v1[3]};
                    const int c = col0 + bj * HALF;
                    const u32x4 s = *(const u32x4*)(MG + r * 2048 + (SECOND ? 1024 : 0) + c);
                    const float sv[8] = {ep_bflo(s.x), ep_bfhi(s.x), ep_bflo(s.y), ep_bfhi(s.y), ep_bflo(s.z), ep_bfhi(s.z), ep_bflo(s.w), ep_bfhi(s.w)};
                    bf16_t* dst = MERGED + r * 1024 + c;
                    if (SECOND) { const u32x4 p = *(const u32x4*)dst;
                        const float pv[8] = {ep_bflo(p.x), ep_bfhi(p.x), ep_bflo(p.y), ep_bfhi(p.y), ep_bflo(p.z), ep_bfhi(p.z), ep_bflo(p.w), ep_bfhi(p.w)};
#pragma unroll
                        for (int e = 0; e < 8; ++e) g[e] = pv[e] + sv[e] * g[e];
                    } else {
#pragma unroll
                        for (int e = 0; e < 8; ++e) g[e] = sv[e] * g[e];
                    }
                    u32x4 w; w.x = cvt_pk_bf16(g[0], g[1]); w.y = cvt_pk_bf16(g[2], g[3]); w.z = cvt_pk_bf16(g[4], g[5]); w.w = cvt_pk_bf16(g[6], g[7]);
                    *(u32x4*)dst = w; } }
    }
};
struct EpiResid {
    static constexpr bool PERM = false, AFTER_DRAIN = false;
    const float* xin; float* xout; const float* gate;
    __device__ __forceinline__ void operator()(const f32x4 (&acc)[2][2][4][2], const Unit& u, int wr, int wc, int fr, int fq) const {
        const int b = (u.pm * BM) / 8192; const float* gp = gate + b * 3072;
        const int row0 = u.pm * BM + wr * 64 + fr, col0 = u.pn * BM + wc * 32 + 4 * fq;
#pragma unroll
        for (int bj = 0; bj < 2; ++bj)
#pragma unroll
            for (int n = 0; n < 2; ++n) { const int c = col0 + bj * HALF + n * 16; const f32x4 gv = *(const f32x4*)(gp + c);
#pragma unroll
                for (int ai = 0; ai < 2; ++ai)
#pragma unroll
                    for (int m = 0; m < 4; ++m) { const size_t off = (size_t)(row0 + ai * HALF + m * 16) * 1024 + c;
                        const f32x4 xi = *(const f32x4*)(xin + off); *(f32x4*)(xout + off) = xi + gv * acc[ai][bj][m][n]; } }
    }
};
}
constexpr int BATCH = 2, SEQ = 8192, DM = 1024, MROWS = BATCH * SEQ, PROJW = 11264;
constexpr int NQKV = 4608, NA = 3584, NG = 3584, NLORA = 320;
constexpr size_t MiB = 1u << 20;
constexpr size_t WS_CTL = 0, WS_MOD = 1 * MiB;
constexpr size_t WS_WQKV = 2 * MiB, WS_WA = 20 * MiB, WS_WG = 34 * MiB, WS_WBA = 48 * MiB, WS_WBB = 52 * MiB, WS_WO = 54 * MiB;
constexpr size_t WS_VFIRST = 58 * MiB, WS_XN = 90 * MiB, WS_YB = 122 * MiB;
constexpr size_t WS_QKV = 138 * MiB, WS_PA = 138 * MiB, WS_YA = 250 * MiB, WS_MG = 138 * MiB, WS_MERGED = 202 * MiB, WS_SC = 282 * MiB;
constexpr int LDS_BYTES = 147456;
constexpr int NTHREADS = 512, NWAVES = 8;
#define LAS __attribute__((address_space(3)))
typedef unsigned short bf16;
typedef float f32x4 __attribute__((ext_vector_type(4)));
typedef unsigned u32x4 __attribute__((ext_vector_type(4)));
typedef unsigned u32x2 __attribute__((ext_vector_type(2)));

__device__ const unsigned char T5BUCKET[3][132] = {
 {0,1,2,3,4,5,6,7,8,9,10,11,12,13,14,15,16,16,16,16,16,16,17,17,17,17,17,17,17,17,18,18,18,18,18,18,18,18,18,18,19,19,19,19,19,19,19,19,19,19,19,19,19,19,20,20,20,20,20,20,20,20,20,20,20,20,20,20,20,20,20,20,20,21,21,21,21,21,21,21,21,21,21,21,21,21,21,21,21,21,21,21,21,21,21,21,21,21,21,22,22,22,22,22,22,22,22,22,22,22,22,22,22,22,22,22,22,22,22,22,22,22,22,22,22,22,22,22,22,0,0,0},
 {0,4,8,12,16,16,17,17,18,18,19,19,19,19,20,20,20,20,20,21,21,21,21,21,21,22,22,22,22,22,22,22,22,22,23,23,23,23,23,23,23,23,23,23,23,23,24,24,24,24,24,24,24,24,24,24,24,24,24,24,24,24,25,25,25,25,25,25,25,25,25,25,25,25,25,25,25,25,25,25,25,25,25,26,26,26,26,26,26,26,26,26,26,26,26,26,26,26,26,26,26,26,26,26,26,26,26,26,26,26,26,26,26,27,27,27,27,27,27,27,27,27,27,27,27,27,27,27,27,0,0,0},
 {0,16,18,19,20,21,21,22,22,23,23,23,24,24,24,24,25,25,25,25,25,26,26,26,26,26,26,26,26,27,27,27,27,27,27,27,27,27,27,28,28,28,28,28,28,28,28,28,28,28,28,28,29,29,29,29,29,29,29,29,29,29,29,29,29,29,29,29,29,29,30,30,30,30,30,30,30,30,30,30,30,30,30,30,30,30,30,30,30,30,30,30,30,30,30,31,31,31,31,31,31,31,31,31,31,31,31,31,31,31,31,31,31,31,31,31,31,31,31,31,31,31,31,31,31,31,31,31,31,0,0,0}};

__device__ __forceinline__ unsigned f2bf(float f) { unsigned u = __builtin_bit_cast(unsigned, f); return (u + 0x7fffu + ((u >> 16) & 1u)) >> 16; }
__device__ __forceinline__ unsigned pk2(float lo, float hi) { return f2bf(lo) | (f2bf(hi) << 16); }
__device__ __forceinline__ float bflo(unsigned w) { return __uint_as_float(w << 16); }
__device__ __forceinline__ float bfhi(unsigned w) { return __uint_as_float(w & 0xffff0000u); }
__device__ __forceinline__ float bf2f(bf16 h) { return __uint_as_float(((unsigned)h) << 16); }
__device__ __forceinline__ float wave_sum(float v) {
#pragma unroll
    for (int o = 1; o < 64; o <<= 1) v += __shfl_xor(v, o);
    return v;
}
__device__ __forceinline__ float wave_max(float v) {
#pragma unroll
    for (int o = 1; o < 64; o <<= 1) v = fmaxf(v, __shfl_xor(v, o));
    return v;
}
__device__ __forceinline__ float sigmoidf_(float x) { return 1.f / (1.f + __expf(-x)); }
__device__ __forceinline__ float siluf_(float x) { return x / (1.f + __expf(-x)); }

struct Args { const float* in[28]; float* out; unsigned char* ws; };
typedef const __attribute__((address_space(4))) Args* KArgs;
struct Frame {
    LAS unsigned char* lds;
    int tid, lane, wave, G, bid;
    const float* in[28]; float* out; unsigned char* ws;
};
__device__ __forceinline__ void make_frame(Frame& F, KArgs ka, unsigned char* lds) {
    asm volatile("" : "+s"(ka));
    int t = threadIdx.x; asm volatile("" : "+v"(t));
    F.lds = (LAS unsigned char*)lds; F.tid = t; F.lane = t & 63; F.wave = __builtin_amdgcn_readfirstlane(t >> 6); F.G = gridDim.x; F.bid = blockIdx.x;
#pragma unroll
    for (int i = 0; i < 28; ++i) F.in[i] = ka->in[i];
    F.out = ka->out; F.ws = ka->ws;
}
__device__ __forceinline__ void p0_mod(Frame& F) {
    const float* c = F.in[1]; const float* ada_w = F.in[3]; const float* ada_b = F.in[4];
    float* mod = (float*)(F.ws + WS_MOD);
    LAS float* red = (LAS float*)F.lds;
    const int col = F.tid & 31, kg = F.tid >> 5;
    for (int ch = F.bid; ch < 192; ch += F.G) {
        const int l = ch / 96, n = (ch % 96) * 32 + col;
        const float* W = ada_w + (size_t)l * 1024 * 3072 + n;
        float a0 = 0.f, a1 = 0.f;
        for (int i = 0; i < 64; ++i) { const int k = kg + 16 * i; const float w = W[(size_t)k * 3072]; a0 += siluf_(c[k]) * w; a1 += siluf_(c[1024 + k]) * w; }
        red[kg * 32 + col] = a0; red[512 + kg * 32 + col] = a1;
        __syncthreads();
        if (F.tid < 64) { const int b = F.tid >> 5; float s = 0.f;
            for (int g = 0; g < 16; ++g) s += red[b * 512 + g * 32 + col];
            mod[(size_t)(l * 2 + b) * 3072 + n] = s + ada_b[l * 3072 + n]; }
        __syncthreads();
    }
}
__device__ __forceinline__ void transpose_item(const float* W, int ldw, int col0, int K, int ncols, bf16* WT, LAS float* scr, int item, int lane) {
    const int nblk = ncols / 32, kb = item / nblk, nb = item % nblk, k0 = 64 * kb, n0 = 32 * nb;
#pragma unroll 8
    for (int i = 0; i < 32; ++i) { const int kk = 2 * i + (lane >> 5); scr[kk * 33 + (lane & 31)] = W[(size_t)(k0 + kk) * ldw + col0 + n0 + (lane & 31)]; }
    asm volatile("s_waitcnt lgkmcnt(0)" ::: "memory");
    const int c = lane & 7;
#pragma unroll
    for (int j = 0; j < 4; ++j) { const int n = (lane >> 3) + 8 * j; const LAS float* s = scr + (8 * c) * 33 + n;
        u32x4 o; o.x = pk2(s[0 * 33], s[1 * 33]); o.y = pk2(s[2 * 33], s[3 * 33]); o.z = pk2(s[4 * 33], s[5 * 33]); o.w = pk2(s[6 * 33], s[7 * 33]);
        *(u32x4*)(WT + (size_t)(n0 + n) * K + k0 + 8 * c) = o; }
    asm volatile("s_waitcnt lgkmcnt(0)" ::: "memory");
}
__device__ __forceinline__ void p0_weights(Frame& F) {
    LAS float* scr = (LAS float*)(F.lds + 16384 + F.wave * 16384);
    const int gw = F.bid * NWAVES + F.wave, NGW = F.G * NWAVES;
    constexpr int I_QKV = 16 * 144, I_A = 16 * 96, I_GA = 16 * 32, I_GB = 16 * 16, I_M = 16 * 64, I_BA = 16 * 32, I_BB = 8 * 32, I_O = 16 * 32;
    constexpr int PER_L = I_QKV + I_A + I_GA + I_GB + I_M + I_BA + I_BB + I_O;
    for (int it = gw; it < 2 * PER_L; it += NGW) {
        const int l = it / PER_L; int r = it % PER_L;
        const float* win = F.in[5] + (size_t)l * 1024 * PROJW;
        bf16* wqkv = (bf16*)(F.ws + WS_WQKV) + (size_t)l * NQKV * 1024;
        bf16* wa = (bf16*)(F.ws + WS_WA) + (size_t)l * NA * 1024;
        bf16* wg = (bf16*)(F.ws + WS_WG) + (size_t)l * NG * 1024;
        if (r < I_QKV) { transpose_item(win, PROJW, 4096, 1024, 4608, wqkv, scr, r, F.lane); continue; } r -= I_QKV;
        if (r < I_A) { transpose_item(win, PROJW, 0, 1024, 3072, wa, scr, r, F.lane); continue; } r -= I_A;
        if (r < I_GA) { transpose_item(win, PROJW, 3072, 1024, 1024, wg, scr, r, F.lane); continue; } r -= I_GA;
        if (r < I_GB) { transpose_item(win, PROJW, 8704, 1024, 512, wg + (size_t)1024 * 1024, scr, r, F.lane); continue; } r -= I_GB;
        if (r < I_M) { transpose_item(win, PROJW, 9216, 1024, 2048, wg + (size_t)1536 * 1024, scr, r, F.lane); continue; } r -= I_M;
        if (r < I_BA) { transpose_item(F.in[23] + (size_t)l * 1024 * 1024, 1024, 0, 1024, 1024, (bf16*)(F.ws + WS_WBA) + (size_t)l * 1024 * 1024, scr, r, F.lane); continue; } r -= I_BA;
        if (r < I_BB) { transpose_item(F.in[24] + (size_t)l * 512 * 1024, 1024, 0, 512, 1024, (bf16*)(F.ws + WS_WBB) + (size_t)l * 1024 * 512, scr, r, F.lane); continue; } r -= I_BB;
        transpose_item(F.in[25] + (size_t)l * 1024 * 1024, 1024, 0, 1024, 1024, (bf16*)(F.ws + WS_WO) + (size_t)l * 1024 * 1024, scr, r, F.lane);
    }
    const size_t gt = (size_t)F.bid * NTHREADS + F.tid, NGT = (size_t)F.G * NTHREADS;
    for (size_t e = gt; e < (size_t)2 * 512 * 1024; e += NGT) {
        const int l = (int)(e / (512 * 1024)), n = (int)((e / 1024) % 512), k = (int)(e % 1024);
        const float muw = F.in[7][(size_t)(l * 2 + 0) * 1024 + k], mua = F.in[7][(size_t)(l * 2 + 1) * 1024 + k];
        float v = 0.f;
        if (n < 64) v = F.in[9][((size_t)l * 1024 + k) * 64 + n] * (1.f - muw);
        else if (n < 128) v = F.in[9][((size_t)l * 1024 + k) * 64 + (n - 64)] * muw;
        else if (n < 192) v = F.in[12][((size_t)l * 1024 + k) * 64 + (n - 128)] * (1.f - mua);
        else if (n < 256) v = F.in[12][((size_t)l * 1024 + k) * 64 + (n - 192)] * mua;
        else if (n < 320 && l == 1) { const float muv = F.in[19][k]; const int m = (n - 256) & 31; const float w = F.in[21][(size_t)k * 32 + m]; v = (n < 288) ? w * (1.f - muv) : w * muv; }
        ((bf16*)(F.ws + WS_WA))[((size_t)l * NA + 3072 + n) * 1024 + k] = (bf16)f2bf(v);
    }
}
__device__ __forceinline__ void phase_modnorm(Frame& F, int l, const float* xin) {
    const float* mod = (const float*)(F.ws + WS_MOD) + (size_t)l * 2 * 3072;
    const float* g = F.in[2] + l * 1024;
    bf16* XN = (bf16*)(F.ws + WS_XN);
    const int gw = F.bid * NWAVES + F.wave, NGW = F.G * NWAVES;
    for (int m = gw; m < MROWS; m += NGW) {
        const int b = m / SEQ; const f32x4* xr = (const f32x4*)(xin + (size_t)m * 1024) + F.lane;
        f32x4 v[4]; float s = 0.f;
#pragma unroll
        for (int j = 0; j < 4; ++j) { v[j] = xr[64 * j]; s += (v[j].x * v[j].x + v[j].y * v[j].y) + (v[j].z * v[j].z + v[j].w * v[j].w); }
        const float rs = 1.f / sqrtf(wave_sum(s) * (1.f / 1024.f) + 1e-6f);
        u32x2* o = (u32x2*)(XN + (size_t)m * 1024) + F.lane;
#pragma unroll
        for (int j = 0; j < 4; ++j) { const int c = 4 * F.lane + 256 * j;
            const f32x4 gg = *(const f32x4*)(g + c), sh = *(const f32x4*)(mod + b * 3072 + c), sc = *(const f32x4*)(mod + b * 3072 + 1024 + c);
            const f32x4 h = v[j] * rs * gg * (sc + 1.f) + sh; u32x2 w; w.x = pk2(h.x, h.y); w.y = pk2(h.z, h.w); o[64 * j] = w; }
    }
}
__device__ __forceinline__ void phase_final(Frame& F) {
    const float* g = F.in[27]; const int gw = F.bid * NWAVES + F.wave, NGW = F.G * NWAVES;
    for (int m = gw; m < MROWS; m += NGW) {
        f32x4* xr = (f32x4*)(F.out + (size_t)m * 1024) + F.lane; f32x4 v[4]; float s = 0.f;
#pragma unroll
        for (int j = 0; j < 4; ++j) { v[j] = xr[64 * j]; s += (v[j].x * v[j].x + v[j].y * v[j].y) + (v[j].z * v[j].z + v[j].w * v[j].w); }
        const float rs = 1.f / sqrtf(wave_sum(s) * (1.f / 1024.f) + 1e-6f);
#pragma unroll
        for (int j = 0; j < 4; ++j) { const f32x4 gg = *(const f32x4*)(g + 4 * F.lane + 256 * j); xr[64 * j] = v[j] * rs * gg; }
    }
}
__device__ __forceinline__ void phase_attn_naive(Frame& F) {
    const bf16* QKV = (const bf16*)(F.ws + WS_QKV); bf16* YB = (bf16*)(F.ws + WS_YB); const float* rel_bias = F.in[26];
    LAS float* QS = (LAS float*)(F.lds) + F.wave * 640;
    LAS float* PS = QS + 192;
    const int gw = F.bid * NWAVES + F.wave, NGW = F.G * NWAVES, lane = F.lane;
    for (int it = gw; it < MROWS * 8; it += NGW) {
        const int row = it >> 3, h = it & 7, b = row / SEQ, t = row % SEQ;
        const bf16* qrow = QKV + (size_t)row * NQKV;
#pragma unroll
        for (int g = 0; g < 3; ++g) QS[g * 64 + lane] = bf2f(qrow[g * 512 + h * 64 + lane]) * 0.125f;
        __builtin_amdgcn_wave_barrier();
        float sc[3][3]; float mx = -1e30f;
#pragma unroll
        for (int g = 0; g < 3; ++g) { const int dil = (g == 0) ? 1 : (g == 1 ? 4 : 16);
#pragma unroll
            for (int jj = 0; jj < 3; ++jj) { const int j = lane + 64 * jj; const int tk = t - j * dil; float s = -1e30f;
                if (j <= 128 && tk >= 0) {
                    const u32x4* kp = (const u32x4*)(QKV + (size_t)(b * SEQ + tk) * NQKV + 1536 + g * 512 + h * 64);
                    float a = 0.f;
#pragma unroll
                    for (int c8 = 0; c8 < 8; ++c8) { const u32x4 kv = kp[c8]; const LAS float* q = QS + g * 64 + c8 * 8;
                        a += q[0] * bflo(kv.x) + q[1] * bfhi(kv.x) + q[2] * bflo(kv.y) + q[3] * bfhi(kv.y) + q[4] * bflo(kv.z) + q[5] * bfhi(kv.z) + q[6] * bflo(kv.w) + q[7] * bfhi(kv.w); }
                    s = a + rel_bias[(int)T5BUCKET[g][j] * 24 + g * 8 + h];
                }
                sc[g][jj] = s; mx = fmaxf(mx, s); } }
        mx = wave_max(mx);
        float den = 0.f;
#pragma unroll
        for (int g = 0; g < 3; ++g)
#pragma unroll
            for (int jj = 0; jj < 3; ++jj) { const int j = lane + 64 * jj; const float p = (sc[g][jj] > -1e29f) ? __expf(sc[g][jj] - mx) : 0.f; den += p; if (j <= 128) PS[g * 132 + j] = p; }
        den = wave_sum(den);
        __builtin_amdgcn_wave_barrier();
        float o = 0.f;
#pragma unroll
        for (int g = 0; g < 3; ++g) { const int dil = (g == 0) ? 1 : (g == 1 ? 4 : 16); const int jmax = min(128, t / dil);
            const bf16* vp = QKV + (size_t)(b * SEQ + t) * NQKV + 3072 + g * 512 + h * 64 + lane;
            for (int j = 0; j <= jmax; ++j) o += PS[g * 132 + j] * bf2f(vp[-(ptrdiff_t)j * dil * NQKV]); }
        YB[(size_t)row * 512 + h * 64 + lane] = (bf16)f2bf(o / den);
        __builtin_amdgcn_wave_barrier();
    }
}
__device__ __forceinline__ float softplusf_(float x) { return fmaxf(x, 0.f) + log1pf(__expf(-fabsf(x))); }
__device__ __forceinline__ void phase_rwkv_naive(Frame& F, int l) {
    if (F.bid >= 32) return;
    constexpr int TB = 16;
    const int b = F.bid >> 4, h = F.bid & 15, tid = F.tid, lane = F.lane, wave = F.wave;
    const bf16* PA = (const bf16*)(F.ws + WS_PA); bf16* YA = (bf16*)(F.ws + WS_YA); bf16* VF = (bf16*)(F.ws + WS_VFIRST);
    LAS float* L = (LAS float*)F.lds;
    LAS float* W2s = L; LAS float* A2s = L + 4096; LAS float* V2s = L + 8192; LAS float* CV = L + 10240;
    LAS float* PRs = L + 11264; LAS float* PKs = PRs + 17 * 64; LAS float* PVs = PKs + 17 * 64; LAS float* LOs = PVs + 17 * 64;
    LAS float* LWs = LOs + 17 * 320; LAS float* LAs = LWs + TB * 64; LAS float* LVs = LAs + TB * 64;
    LAS float* Rs = LVs + TB * 32; LAS float* Ws = Rs + TB * 64; LAS float* Ks = Ws + TB * 64; LAS float* Vs = Ks + TB * 64; LAS float* As = Vs + TB * 64; LAS float* Bs = As + TB * 64;
    LAS float* RKs = Bs + TB * 64; LAS float* Ys = RKs + TB;
    for (int e = tid; e < 4096; e += NTHREADS) { const int m = e >> 6, j = e & 63;
        W2s[e] = F.in[10][((size_t)l * 64 + m) * 1024 + h * 64 + j]; A2s[e] = F.in[13][((size_t)l * 64 + m) * 1024 + h * 64 + j];
        if (m < 32) V2s[e] = (l == 1) ? F.in[22][(size_t)m * 1024 + h * 64 + j] : 0.f; }
    if (tid < 64) { const int c = h * 64 + tid;
        CV[0 * 64 + tid] = F.in[8][l * 1024 + c];  CV[1 * 64 + tid] = F.in[11][l * 1024 + c]; CV[2 * 64 + tid] = (l == 1) ? F.in[20][c] : 0.f;
        CV[3 * 64 + tid] = F.in[14][l * 1024 + c]; CV[4 * 64 + tid] = F.in[15][l * 1024 + c]; CV[5 * 64 + tid] = F.in[16][l * 1024 + c];
        CV[6 * 64 + tid] = F.in[17][l * 1024 + c]; CV[7 * 64 + tid] = F.in[18][l * 1024 + c];
        CV[8 * 64 + tid] = F.in[6][(size_t)(l * 3 + 0) * 1024 + c]; CV[9 * 64 + tid] = F.in[6][(size_t)(l * 3 + 1) * 1024 + c]; CV[10 * 64 + tid] = F.in[6][(size_t)(l * 3 + 2) * 1024 + c]; }
    float S[16];
#pragma unroll
    for (int q = 0; q < 16; ++q) S[q] = 0.f;
    __syncthreads();
    for (int t0 = 0; t0 < SEQ; t0 += TB) {
        for (int e = tid; e < 17 * 512; e += NTHREADS) { const int rr = e >> 9, cc = e & 511, t = t0 - 1 + rr; float v = 0.f;
            if (t >= 0) { const int gc = (cc < 192) ? ((cc >> 6) * 1024 + h * 64 + (cc & 63)) : (3072 + cc - 192); v = bf2f(PA[(size_t)(b * SEQ + t) * NA + gc]); }
            if (cc < 64) PRs[rr * 64 + cc] = v; else if (cc < 128) PKs[rr * 64 + cc - 64] = v; else if (cc < 192) PVs[rr * 64 + cc - 128] = v; else LOs[rr * 320 + cc - 192] = v; }
        __syncthreads();
        for (int e = tid; e < TB * 160; e += NTHREADS) { const int tl = e / 160, m = e % 160; const LAS float* cur = LOs + (tl + 1) * 320; const LAS float* prv = LOs + tl * 320;
            if (m < 64) LWs[tl * 64 + m] = tanhf(cur[m] + prv[64 + m]);
            else if (m < 128) LAs[tl * 64 + m - 64] = cur[128 + m - 64] + prv[192 + m - 64];
            else LVs[tl * 32 + m - 128] = cur[256 + m - 128] + prv[288 + m - 128]; }
        __syncthreads();
        for (int tl = wave; tl < TB; tl += NWAVES) { const int j = lane; const size_t row = (size_t)(b * SEQ + t0 + tl);
            float wpre = CV[j], apre = CV[64 + j], vpre = CV[128 + j];
            for (int m = 0; m < 64; ++m) { wpre += LWs[tl * 64 + m] * W2s[m * 64 + j]; apre += LAs[tl * 64 + m] * A2s[m * 64 + j]; }
            for (int m = 0; m < 32; ++m) vpre += LVs[tl * 32 + m] * V2s[m * 64 + j];
            const float pr = PRs[(tl + 1) * 64 + j], prp = PRs[tl * 64 + j], pk = PKs[(tl + 1) * 64 + j], pkp = PKs[tl * 64 + j], pv = PVs[(tl + 1) * 64 + j], pvp = PVs[tl * 64 + j];
            const float r = pr + (prp - pr) * CV[8 * 64 + j], k = pk + (pkp - pk) * CV[9 * 64 + j]; float v = pv + (pvp - pv) * CV[10 * 64 + j];
            const float w = -softplusf_(-wpre) - 0.5f; const float decay = __expf(-__expf(w)); const float asig = sigmoidf_(apre);
            if (l == 0) VF[row * 1024 + h * 64 + j] = (bf16)f2bf(v); else { const float vf = bf2f(VF[row * 1024 + h * 64 + j]); v = v + (vf - v) * sigmoidf_(vpre); }
            const float kk = k * CV[3 * 64 + j]; const float ss = wave_sum(kk * kk); const float kkn = kk * (1.f / sqrtf(fmaxf(ss, 1e-24f)));
            const float k2 = k * (1.f + (asig - 1.f) * CV[4 * 64 + j]);
            const float rk = wave_sum(r * k2 * CV[5 * 64 + j]);
            Rs[tl * 64 + j] = r; Ws[tl * 64 + j] = decay; Ks[tl * 64 + j] = k2; Vs[tl * 64 + j] = v; As[tl * 64 + j] = -kkn; Bs[tl * 64 + j] = kkn * asig;
            if (lane == 0) RKs[tl] = rk; }
        __syncthreads();
        if (wave < 4) { const int i = wave * 16 + (lane >> 2), jq = lane & 3;
            for (int tl = 0; tl < TB; ++tl) { const int o = tl * 64 + jq * 16; const float vi = Vs[tl * 64 + i];
                float sa = 0.f;
#pragma unroll
                for (int q = 0; q < 16; ++q) sa += S[q] * As[o + q];
                sa += __shfl_xor(sa, 1); sa += __shfl_xor(sa, 2);
                float y = 0.f;
#pragma unroll
                for (int q = 0; q < 16; ++q) { S[q] = S[q] * Ws[o + q] + sa * Bs[o + q] + vi * Ks[o + q]; y += S[q] * Rs[o + q]; }
                y += __shfl_xor(y, 1); y += __shfl_xor(y, 2);
                if (jq == 0) Ys[tl * 64 + i] = y; } }
        __syncthreads();
        for (int tl = wave; tl < TB; tl += NWAVES) { const int i = lane; const size_t row = (size_t)(b * SEQ + t0 + tl);
            const float y = Ys[tl * 64 + i]; const float mean = wave_sum(y) * (1.f / 64.f); const float d = y - mean; const float var = wave_sum(d * d) * (1.f / 64.f);
            const float o = d * (1.f / sqrtf(var + 64e-5f)) * CV[6 * 64 + i] + CV[7 * 64 + i] + RKs[tl] * Vs[tl * 64 + i];
            YA[row * 1024 + h * 64 + i] = (bf16)f2bf(o); }
    }
}
#define GEMM_LDS ((PG8_LAS unsigned char*)F.lds)
template <class Epi> __device__ __forceinline__ void run_gemm(Frame& F, const bf16* A, const bf16* Bt, int N, int K, const Epi& E) {
    pg8::Gemm g{A, Bt, MROWS, N, K}; pg8::StaticOrder S; S.init(MROWS, N, F.G, F.bid);
    pg8::gemm_phase<Epi, pg8::StaticOrder, true, true>(GEMM_LDS, g, S, E);
}
__global__ void __launch_bounds__(NTHREADS, 2) fwd_kernel(Args a) {
    extern __shared__ __attribute__((aligned(16))) unsigned char lds[];
    cg::grid_group grid = cg::this_grid();
    const KArgs ka = (KArgs)__builtin_amdgcn_kernarg_segment_ptr();
    { Frame F; make_frame(F, ka, lds); p0_mod(F); p0_weights(F); }
    grid.sync();
    for (int l = 0; l < 2; ++l) {
        { Frame F; make_frame(F, ka, lds); phase_modnorm(F, l, (l == 0) ? F.in[0] : F.out); }
        grid.sync();
        { Frame F; make_frame(F, ka, lds); run_gemm(F, (const bf16*)(F.ws + WS_XN), (const bf16*)(F.ws + WS_WQKV) + (size_t)l * NQKV * 1024, NQKV, 1024, pg8::EpiStore{(bf16*)(F.ws + WS_QKV), NQKV}); }
        grid.sync();
        { Frame F; make_frame(F, ka, lds); phase_attn_naive(F); }
        grid.sync();
        { Frame F; make_frame(F, ka, lds); run_gemm(F, (const bf16*)(F.ws + WS_XN), (const bf16*)(F.ws + WS_WA) + (size_t)l * NA * 1024, NA, 1024, pg8::EpiStore{(bf16*)(F.ws + WS_PA), NA}); }
        grid.sync();
        { Frame F; make_frame(F, ka, lds); phase_rwkv_naive(F, l); }
        grid.sync();
        { Frame F; make_frame(F, ka, lds); run_gemm(F, (const bf16*)(F.ws + WS_XN), (const bf16*)(F.ws + WS_WG) + (size_t)l * NG * 1024, NG, 1024, pg8::EpiGates{(bf16*)(F.ws + WS_YA), (bf16*)(F.ws + WS_YB), (bf16*)(F.ws + WS_MG)}); }
        grid.sync();
        { Frame F; make_frame(F, ka, lds); run_gemm(F, (const bf16*)(F.ws + WS_YA), (const bf16*)(F.ws + WS_WBA) + (size_t)l * 1024 * 1024, 1024, 1024, pg8::EpiMerge<false>{(bf16*)(F.ws + WS_MERGED), (const bf16*)(F.ws + WS_MG)}); }
        { Frame F; make_frame(F, ka, lds); run_gemm(F, (const bf16*)(F.ws + WS_YB), (const bf16*)(F.ws + WS_WBB) + (size_t)l * 1024 * 512, 1024, 512, pg8::EpiMerge<true>{(bf16*)(F.ws + WS_MERGED), (const bf16*)(F.ws + WS_MG)}); }
        grid.sync();
        { Frame F; make_frame(F, ka, lds); run_gemm(F, (const bf16*)(F.ws + WS_MERGED), (const bf16*)(F.ws + WS_WO) + (size_t)l * 1024 * 1024, 1024, 1024,
              pg8::EpiResid{(l == 0) ? F.in[0] : F.out, F.out, (const float*)(F.ws + WS_MOD) + (size_t)l * 2 * 3072 + 2048}); }
        grid.sync();
    }
    { Frame F; make_frame(F, ka, lds); phase_final(F); }
}
extern "C" void kernel_launch(void* const* d_in, const int* in_sizes, int n_in, void* d_out, int out_size, void* d_ws, size_t ws_size, hipStream_t stream) {
    static int grid = 0;
    if (grid == 0) {
        int dev = 0, cus = 0, per_cu = 0;
        (void)hipGetDevice(&dev); (void)hipDeviceGetAttribute(&cus, hipDeviceAttributeMultiprocessorCount, dev);
        (void)hipFuncSetAttribute((const void*)fwd_kernel, hipFuncAttributeMaxDynamicSharedMemorySize, LDS_BYTES);
        (void)hipOccupancyMaxActiveBlocksPerMultiprocessor(&per_cu, (const void*)fwd_kernel, NTHREADS, LDS_BYTES);
        if (n_in != 28 || out_size != MROWS * DM || ws_size < (size_t)352 * MiB || per_cu < 1) { fprintf(stderr, "kernel_launch: unexpected problem (n_in %d out %d ws %zu per_cu %d)\n", n_in, out_size, ws_size, per_cu); }
        grid = cus;
        (void)hipGetLastError();
    }
    Args a{};
    for (int i = 0; i < 28; ++i) a.in[i] = (const float*)d_in[i];
    a.out = (float*)d_out; a.ws = (unsigned char*)d_ws;
    void* args[] = {&a};
    hipError_t e = hipLaunchCooperativeKernel((void*)fwd_kernel, dim3(grid), dim3(NTHREADS), args, LDS_BYTES, stream);
    if (e != hipSuccess) fprintf(stderr, "cooperative launch failed: %s (grid %d)\n", hipGetErrorString(e), grid);
}
```

```cpp
#include <hip/hip_runtime.h>
#include <hip/hip_cooperative_groups.h>
#include <cstdio>
#include <cstdint>
namespace cg = cooperative_groups;
namespace pg8 {
#define PG8_LAS __attribute__((address_space(3)))
typedef unsigned short bf16_t;
typedef short bf16x8 __attribute__((ext_vector_type(8)));
typedef float f32x4 __attribute__((ext_vector_type(4)));
typedef unsigned u32x4 __attribute__((ext_vector_type(4)));
constexpr int BM = 256, BK = 64, HALF = 128, HTB = HALF * BK * 2  , STAGE_BYTES = 8 * HTB, NXCD = 8, WGM = 8;

__host__ __device__ __forceinline__ int lds_byte(int r, int c) { const int st = (r >> 4) * 2 + (c >> 5), rr = r & 15, cc = c & 31, ob = rr * 64 + cc * 2; return st * 1024 + (ob ^ (((ob >> 9) & 1) << 5)); }
__host__ __device__ __forceinline__ void stage_rc(int b, int& R, int& C) { const int st = b / 1024, sb = b % 1024, swz = sb ^ (((sb >> 9) & 1) << 5); R = (st >> 1) * 16 + swz / 64; C = (st & 1) * 32 + (swz % 64) / 2; }
__host__ __device__ __forceinline__ int perm32(int rho) { const int n = rho >> 4, i = rho & 15; return 8 * (i >> 2) + 4 * n + (i & 3); }

struct Unit { int pm, pn; };
struct Gemm { const bf16_t* A; const bf16_t* Bt; int M, N, K; };

struct StaticOrder {
    int nM, nN, nwg, G, c;
    __host__ __device__ void init(int M, int N, int G_, int c_) { nM = M / BM; nN = N / BM; nwg = nM * nN; G = G_; c = c_; }
    __host__ __device__ bool next(int i, Unit& u) const {
        const long L = (long)i * G + c; if (L >= nwg) return false;
        int wgid = (int)L; { const int q = nwg / NXCD, r = nwg % NXCD, xcd = wgid % NXCD, off = wgid / NXCD; wgid = (xcd < r ? xcd * (q + 1) : r * (q + 1) + (xcd - r) * q) + off; }
        const int nig = WGM * nN, gid = wgid / nig, fm = gid * WGM, gsz = (nM - fm) < WGM ? (nM - fm) : WGM;
        u.pm = fm + ((wgid % nig) % gsz); u.pn = (wgid % nig) / gsz; return true;
    }
    __device__ __forceinline__ void a_ready(const Unit&) const {}
    __device__ __forceinline__ void done(const Unit&) const {}
};

__device__ __forceinline__ unsigned cvt_pk_bf16(float lo, float hi) { unsigned r; asm volatile("v_cvt_pk_bf16_f32 %0, %1, %2" : "=v"(r) : "v"(lo), "v"(hi)); return r; }
typedef float f32x2 __attribute__((ext_vector_type(2)));
template <class Epi, class Sched, bool ALIGN_EPI = false, bool SP2 = false>
__device__ __forceinline__ void gemm_phase(PG8_LAS unsigned char* lds, const Gemm g, const Sched& S, const Epi& E) {
    int tid_ = threadIdx.x; asm volatile("" : "+v"(tid_));
    const int tid = tid_, wid = __builtin_amdgcn_readfirstlane(tid >> 6), lane = tid & 63, wr = wid >> 2, wc = wid & 3, fr = lane & 15, fq = lane >> 4;
    const int K = g.K, nt = K / BK;
    unsigned voffA[2], voffB[2];
#pragma unroll
    for (int i = 0; i < 2; ++i) { int R, C; stage_rc(tid * 16 + i * 8192, R, C); const int Rb = Epi::PERM ? ((R & ~31) + perm32(R & 31)) : R;
        voffA[i] = (unsigned)(R * K + C) * 2u; voffB[i] = (unsigned)(Rb * K + C) * 2u; }
    const size_t kstep = (size_t)(BK * 2);
    const size_t hstep = (size_t)HALF * K * 2;
    const size_t tstep = 2 * hstep;
    const unsigned ldsw = (unsigned)wid * 1024u;
    const int aoff = lds_byte(wr * 64 + fr, fq * 8), boff = lds_byte(wc * 32 + fr, fq * 8);
#define PG8_SA(b, h) (((b) * 2 + (h)) * HTB)
#define PG8_SB(b, h) ((4 + (b) * 2 + (h)) * HTB)
#define PG8_STAGE(bufoff, gbase, voff) do { _Pragma("unroll") for (int _i = 0; _i < 2; ++_i) \
        __builtin_amdgcn_global_load_lds((const unsigned*)((const char*)(gbase) + (voff)[_i]), (PG8_LAS unsigned*)(lds + (bufoff) + ldsw + _i * 8192), 16, 0, 0); } while (0)
#define PG8_LDA(dst, b, h) do { _Pragma("unroll") for (int m = 0; m < 4; ++m) _Pragma("unroll") for (int k = 0; k < 2; ++k) dst[m][k] = *(const PG8_LAS bf16x8*)(lds + PG8_SA(b, h) + aoff + m * 2048 + k * 1024); } while (0)
#define PG8_LDB(dst, b, h) do { _Pragma("unroll") for (int n = 0; n < 2; ++n) _Pragma("unroll") for (int k = 0; k < 2; ++k) dst[n][k] = *(const PG8_LAS bf16x8*)(lds + PG8_SB(b, h) + boff + n * 2048 + k * 1024); } while (0)
#define PG8_MMA(ai, bj, At, Bt) do { __builtin_amdgcn_s_setprio(1); _Pragma("unroll") for (int m = 0; m < 4; ++m) _Pragma("unroll") for (int n = 0; n < 2; ++n) _Pragma("unroll") for (int k = 0; k < 2; ++k) \
        acc[ai][bj][m][n] = __builtin_amdgcn_mfma_f32_16x16x32_bf16(Bt[n][k], At[m][k], acc[ai][bj][m][n], 0, 0, 0); __builtin_amdgcn_s_setprio(0); } while (0)
#define PG8_WAIT_V(n) asm volatile("s_waitcnt vmcnt(" #n ")" ::: "memory")
#define PG8_WAIT_L(n) asm volatile("s_waitcnt lgkmcnt(" #n ")" ::: "memory")
#define PG8_BAR __builtin_amdgcn_s_barrier()
#define PG8_SCHED __builtin_amdgcn_sched_barrier(0)
    Unit cur, nxt; int ui = 0;
    if (!S.next(0, cur)) return;
    f32x4 acc[2][2][4][2];
#pragma unroll
    for (int a = 0; a < 2; ++a)
#pragma unroll
        for (int b = 0; b < 2; ++b)
#pragma unroll
            for (int m = 0; m < 4; ++m)
#pragma unroll
                for (int n = 0; n < 2; ++n) acc[a][b][m][n] = (f32x4){0.f, 0.f, 0.f, 0.f};
    bf16x8 At[4][2], B0[2][2], B1[2][2];
    const char* cA = (const char*)g.A + (size_t)cur.pm * tstep; const char* cB = (const char*)g.Bt + (size_t)cur.pn * tstep;
    S.a_ready(cur);
    if constexpr (SP2) {
        PG8_STAGE(PG8_SB(0, 0), cB, voffB); PG8_STAGE(PG8_SB(0, 1), cB + hstep, voffB); PG8_STAGE(PG8_SA(0, 0), cA, voffA); PG8_STAGE(PG8_SA(0, 1), cA + hstep, voffA);
        if (wr == 1) PG8_BAR;
        PG8_WAIT_V(2); PG8_BAR;
        PG8_STAGE(PG8_SB(1, 0), cB + kstep, voffB); PG8_STAGE(PG8_SA(1, 0), cA + kstep, voffA); PG8_STAGE(PG8_SB(1, 1), cB + hstep + kstep, voffB);
        PG8_WAIT_V(6); PG8_BAR;
    } else {
        PG8_STAGE(PG8_SB(0, 0), cB, voffB); PG8_STAGE(PG8_SA(0, 0), cA, voffA); PG8_STAGE(PG8_SB(0, 1), cB + hstep, voffB); PG8_STAGE(PG8_SA(0, 1), cA + hstep, voffA);
        if (wr == 1) PG8_BAR;
        PG8_WAIT_V(4); PG8_BAR;
        PG8_STAGE(PG8_SB(1, 0), cB + kstep, voffB); PG8_STAGE(PG8_SA(1, 0), cA + kstep, voffA); PG8_STAGE(PG8_SB(1, 1), cB + hstep + kstep, voffB);
        PG8_WAIT_V(6); PG8_BAR;
    }
    for (;;) {
        const bool has_next = S.next(ui + 1, nxt);
        const char* nA = has_next ? (const char*)g.A + (size_t)nxt.pm * tstep : cA; const char* nB = has_next ? (const char*)g.Bt + (size_t)nxt.pn * tstep : cB;
        for (int t = 0; t < nt; t += 2) {
            const bool last = (t == nt - 2);
            const char* a1 = cA + (size_t)(t + 1) * kstep;
            const char* a2 = last ? nA : cA + (size_t)(t + 2) * kstep; const char* b2 = last ? nB : cB + (size_t)(t + 2) * kstep;
            const char* a3 = a2 + kstep; const char* b3 = b2 + kstep;
            if (last && has_next) S.a_ready(nxt);
            if constexpr (SP2) {
            PG8_LDB(B0, 0, 0); PG8_LDB(B1, 0, 1); PG8_SCHED; PG8_LDA(At, 0, 0); PG8_STAGE(PG8_SA(1, 1), a1 + hstep, voffA);
            PG8_WAIT_V(8); PG8_WAIT_L(0); PG8_BAR; PG8_MMA(0, 0, At, B0); PG8_MMA(0, 1, At, B1); PG8_BAR; PG8_SCHED;
            PG8_LDA(At, 0, 1); PG8_STAGE(PG8_SB(0, 0), b2, voffB); PG8_STAGE(PG8_SB(0, 1), b2 + hstep, voffB); PG8_STAGE(PG8_SA(0, 0), a2, voffA);
            PG8_WAIT_V(8); PG8_WAIT_L(0); PG8_BAR; PG8_MMA(1, 0, At, B0); PG8_MMA(1, 1, At, B1); PG8_BAR; PG8_SCHED;
            PG8_LDB(B0, 1, 0); PG8_LDB(B1, 1, 1); PG8_SCHED; PG8_LDA(At, 1, 0); PG8_STAGE(PG8_SA(0, 1), a2 + hstep, voffA);
            PG8_WAIT_V(8); PG8_WAIT_L(0); PG8_BAR; PG8_MMA(0, 0, At, B0); PG8_MMA(0, 1, At, B1); PG8_BAR; PG8_SCHED;
            PG8_LDA(At, 1, 1); PG8_STAGE(PG8_SB(1, 0), b3, voffB); PG8_STAGE(PG8_SB(1, 1), b3 + hstep, voffB); PG8_STAGE(PG8_SA(1, 0), a3, voffA);
            PG8_WAIT_V(8); PG8_WAIT_L(0); PG8_BAR; PG8_MMA(1, 0, At, B0); PG8_MMA(1, 1, At, B1); PG8_BAR; PG8_SCHED;
            } else {
            PG8_LDB(B0, 0, 0); PG8_SCHED; PG8_LDA(At, 0, 0); PG8_STAGE(PG8_SA(1, 1), a1 + hstep, voffA);
            PG8_WAIT_L(8); PG8_BAR; PG8_WAIT_L(0); PG8_MMA(0, 0, At, B0); PG8_BAR; PG8_SCHED;
            PG8_LDB(B1, 0, 1); PG8_STAGE(PG8_SB(0, 0), b2, voffB);
            PG8_BAR; PG8_WAIT_L(0); PG8_MMA(0, 1, At, B1); PG8_BAR;
            PG8_LDA(At, 0, 1); PG8_STAGE(PG8_SA(0, 0), a2, voffA);
            PG8_BAR; PG8_WAIT_L(0); PG8_MMA(1, 0, At, B0); PG8_BAR; PG8_SCHED;
            PG8_STAGE(PG8_SB(0, 1), b2 + hstep, voffB);
            PG8_WAIT_V(6); PG8_BAR; PG8_MMA(1, 1, At, B1); PG8_BAR;
            PG8_LDB(B0, 1, 0); PG8_SCHED; PG8_LDA(At, 1, 0); PG8_STAGE(PG8_SA(0, 1), a2 + hstep, voffA);
            PG8_WAIT_L(8); PG8_BAR; PG8_WAIT_L(0); PG8_MMA(0, 0, At, B0); PG8_BAR; PG8_SCHED;
            PG8_LDB(B1, 1, 1); PG8_STAGE(PG8_SB(1, 0), b3, voffB);
            PG8_BAR; PG8_WAIT_L(0); PG8_MMA(0, 1, At, B1); PG8_BAR;
            PG8_LDA(At, 1, 1); PG8_STAGE(PG8_SA(1, 0), a3, voffA);
            PG8_BAR; PG8_WAIT_L(0); PG8_MMA(1, 0, At, B0); PG8_BAR; PG8_SCHED;
            PG8_STAGE(PG8_SB(1, 1), b3 + hstep, voffB);
            PG8_WAIT_V(6); PG8_BAR; PG8_MMA(1, 1, At, B1); PG8_BAR;
            }
        }
        if constexpr (ALIGN_EPI) { if (wr == 0) PG8_BAR; }
        if constexpr (!Epi::AFTER_DRAIN) { E(acc, cur, wr, wc, fr, fq); S.done(cur); }
        if (!has_next) break;
#pragma unroll
        for (int a = 0; a < 2; ++a)
#pragma unroll
            for (int b = 0; b < 2; ++b)
#pragma unroll
                for (int m = 0; m < 4; ++m)
#pragma unroll
                    for (int n = 0; n < 2; ++n) acc[a][b][m][n] = (f32x4){0.f, 0.f, 0.f, 0.f};
        cur = nxt; cA = nA; cB = nB; ++ui;
        if constexpr (ALIGN_EPI) { if (wr == 1) PG8_BAR; }
    }
    PG8_WAIT_V(0);
    if constexpr (!ALIGN_EPI) { if (wr == 0) PG8_BAR; }
    PG8_BAR;
    if constexpr (Epi::AFTER_DRAIN) { E.fused(acc, cur, wr, wc, fr, fq, lds, wid, lane); S.done(cur); }
#undef PG8_SA
#undef PG8_SB
#undef PG8_STAGE
#undef PG8_LDA
#undef PG8_LDB
#undef PG8_MMA
#undef PG8_WAIT_V
#undef PG8_WAIT_L
#undef PG8_BAR
#undef PG8_SCHED
}
}
namespace pg8 {
__device__ __forceinline__ float ep_bflo(unsigned w) { return __uint_as_float(w << 16); }
__device__ __forceinline__ float ep_bfhi(unsigned w) { return __uint_as_float(w & 0xffff0000u); }
__device__ __forceinline__ float ep_sigmoid(float x) { return 1.f / (1.f + __expf(-x)); }
struct EpiStore {
    static constexpr bool PERM = true, AFTER_DRAIN = false;
    bf16_t* O; int ldc;
    __device__ __forceinline__ void operator()(const f32x4 (&acc)[2][2][4][2], const Unit& u, int wr, int wc, int fr, int fq) const {
        const int row0 = u.pm * BM + wr * 64 + fr, col0 = u.pn * BM + wc * 32 + 8 * fq;
#pragma unroll
        for (int ai = 0; ai < 2; ++ai)
#pragma unroll
            for (int m = 0; m < 4; ++m) { bf16_t* rowp = O + (size_t)(row0 + ai * HALF + m * 16) * ldc + col0;
#pragma unroll
                for (int bj = 0; bj < 2; ++bj) { const f32x4 v0 = acc[ai][bj][m][0], v1 = acc[ai][bj][m][1]; u32x4 w;
                    w.x = cvt_pk_bf16(v0[0], v0[1]); w.y = cvt_pk_bf16(v0[2], v0[3]); w.z = cvt_pk_bf16(v1[0], v1[1]); w.w = cvt_pk_bf16(v1[2], v1[3]);
                    *(u32x4*)(rowp + bj * HALF) = w; } }
    }
};
struct EpiGates {
    static constexpr bool PERM = true, AFTER_DRAIN = false;
    bf16_t* YA; bf16_t* YB; bf16_t* MG;
    __device__ __forceinline__ void operator()(const f32x4 (&acc)[2][2][4][2], const Unit& u, int wr, int wc, int fr, int fq) const {
        const int colt = u.pn * BM; int mode, ld, cb; bf16_t* P;
        if (colt < 1024) { mode = 0; P = YA; ld = 1024; cb = colt; } else if (colt < 1536) { mode = 1; P = YB; ld = 512; cb = colt - 1024; } else { mode = 2; P = MG; ld = 2048; cb = colt - 1536; }
        const int row0 = u.pm * BM + wr * 64 + fr, col0 = cb + wc * 32 + 8 * fq;
#pragma unroll
        for (int ai = 0; ai < 2; ++ai)
#pragma unroll
            for (int m = 0; m < 4; ++m) { bf16_t* rowp = P + (size_t)(row0 + ai * HALF + m * 16) * ld + col0;
#pragma unroll
                for (int bj = 0; bj < 2; ++bj) { const f32x4 v0 = acc[ai][bj][m][0], v1 = acc[ai][bj][m][1]; float g[8] = {v0[0], v0[1], v0[2], v0[3], v1[0], v1[1], v1[2], v1[3]};
                    u32x4 w;
                    if (mode == 2) {
#pragma unroll
                        for (int e = 0; e < 8; ++e) g[e] = ep_sigmoid(g[e]);
                    } else {
                        const u32x4 y = *(const u32x4*)(rowp + bj * HALF);
                        const float yv[8] = {ep_bflo(y.x), ep_bfhi(y.x), ep_bflo(y.y), ep_bfhi(y.y), ep_bflo(y.z), ep_bfhi(y.z), ep_bflo(y.w), ep_bfhi(y.w)};
#pragma unroll
                        for (int e = 0; e < 8; ++e) g[e] = yv[e] * g[e] * ep_sigmoid(g[e]);
                    }
                    w.x = cvt_pk_bf16(g[0], g[1]); w.y = cvt_pk_bf16(g[2], g[3]); w.z = cvt_pk_bf16(g[4], g[5]); w.w = cvt_pk_bf16(g[6], g[7]);
                    *(u32x4*)(rowp + bj * HALF) = w; } }
    }
};
template <bool SECOND> struct EpiMerge {
    static constexpr bool PERM = true, AFTER_DRAIN = false;
    bf16_t* MERGED; const bf16_t* MG;
    __device__ __forceinline__ void operator()(const f32x4 (&acc)[2][2][4][2], const Unit& u, int wr, int wc, int fr, int fq) const {
        const int row0 = u.pm * BM + wr * 64 + fr, col0 = u.pn * BM + wc * 32 + 8 * fq;
#pragma unroll
        for (int ai = 0; ai < 2; ++ai)
#pragma unroll
            for (int m = 0; m < 4; ++m) { const size_t r = (size_t)(row0 + ai * HALF + m * 16);
#pragma unroll
                for (int bj = 0; bj < 2; ++bj) { const f32x4 v0 = acc[ai][bj][m][0], v1 = acc[ai][bj][m][1]; float g[8] = {v0[0], v0[1], v0[2], v0[3], v1[0], v1[1], v1[2], v1[3]};
                    const int c = col0 + bj * HALF;
                    const u32x4 s = *(const u32x4*)(MG + r * 2048 + (SECOND ? 1024 : 0) + c);
                    const float sv[8] = {ep_bflo(s.x), ep_bfhi(s.x), ep_bflo(s.y), ep_bfhi(s.y), ep_bflo(s.z), ep_bfhi(s.z), ep_bflo(s.w), ep_bfhi(s.w)};
                    bf16_t* dst = MERGED + r * 1024 + c;
                    if (SECOND) { const u32x4 p = *(const u32x4*)dst;
                        const float pv[8] = {ep_bflo(p.x), ep_bfhi(p.x), ep_bflo(p.y), ep_bfhi(p.y), ep_bflo(p.z), ep_bfhi(p.z), ep_bflo(p.w), ep_bfhi(p.w)};
#pragma unroll
                        for (int e = 0; e < 8; ++e) g[e] = pv[e] + sv[e] * g[e];
                    } else {
#pragma unroll
                        for (int e = 0; e < 8; ++e) g[e] = sv[e] * g[e];
                    }
                    u32x4 w; w.x = cvt_pk_bf16(g[0], g[1]); w.y = cvt_pk_bf16(g[2], g[3]); w.z = cvt_pk_bf16(g[4], g[5]); w.w = cvt_pk_bf16(g[6], g[7]);
                    *(u32x4*)dst = w; } }
    }
};
struct EpiResid {
    static constexpr bool PERM = false, AFTER_DRAIN = false;
    const float* xin; float* xout; const float* gate;
    __device__ __forceinline__ void operator()(const f32x4 (&acc)[2][2][4][2], const Unit& u, int wr, int wc, int fr, int fq) const {
        const int b = (u.pm * BM) / 8192; const float* gp = gate + b * 3072;
        const int row0 = u.pm * BM + wr * 64 + fr, col0 = u.pn * BM + wc * 32 + 4 * fq;
#pragma unroll
        for (int bj = 0; bj < 2; ++bj)
#pragma unroll
            for (int n = 0; n < 2; ++n) { const int c = col0 + bj * HALF + n * 16; const f32x4 gv = *(const f32x4*)(gp + c);
#pragma unroll
                for (int ai = 0; ai < 2; ++ai)
#pragma unroll
                    for (int m = 0; m < 4; ++m) { const size_t off = (size_t)(row0 + ai * HALF + m * 16) * 1024 + c;
                        const f32x4 xi = *(const f32x4*)(xin + off); *(f32x4*)(xout + off) = xi + gv * acc[ai][bj][m][n]; } }
    }
};
}
constexpr int BATCH = 2, SEQ = 8192, DM = 1024, MROWS = BATCH * SEQ, PROJW = 11264;
constexpr int NQKV = 4608, NA = 3584, NG = 3584, NLORA = 320;
constexpr size_t MiB = 1u << 20;
constexpr size_t WS_CTL = 0, WS_MOD = 1 * MiB;
constexpr size_t WS_WQKV = 2 * MiB, WS_WA = 20 * MiB, WS_WG = 34 * MiB, WS_WBA = 48 * MiB, WS_WBB = 52 * MiB, WS_WO = 54 * MiB;
constexpr size_t WS_VFIRST = 58 * MiB, WS_XN = 90 * MiB, WS_YB = 122 * MiB;
constexpr size_t WS_QKV = 138 * MiB, WS_PA = 138 * MiB, WS_YA = 250 * MiB, WS_MG = 138 * MiB, WS_MERGED = 202 * MiB, WS_SC = 282 * MiB;
constexpr int LDS_BYTES = 147456;
constexpr int NTHREADS = 512, NWAVES = 8;
#define LAS __attribute__((address_space(3)))
typedef unsigned short bf16;
typedef float f32x4 __attribute__((ext_vector_type(4)));
typedef unsigned u32x4 __attribute__((ext_vector_type(4)));
typedef unsigned u32x2 __attribute__((ext_vector_type(2)));

__device__ const unsigned char T5BUCKET[3][132] = {
 {0,1,2,3,4,5,6,7,8,9,10,11,12,13,14,15,16,16,16,16,16,16,17,17,17,17,17,17,17,17,18,18,18,18,18,18,18,18,18,18,19,19,19,19,19,19,19,19,19,19,19,19,19,19,20,20,20,20,20,20,20,20,20,20,20,20,20,20,20,20,20,20,20,21,21,21,21,21,21,21,21,21,21,21,21,21,21,21,21,21,21,21,21,21,21,21,21,21,21,22,22,22,22,22,22,22,22,22,22,22,22,22,22,22,22,22,22,22,22,22,22,22,22,22,22,22,22,22,22,0,0,0},
 {0,4,8,12,16,16,17,17,18,18,19,19,19,19,20,20,20,20,20,21,21,21,21,21,21,22,22,22,22,22,22,22,22,22,23,23,23,23,23,23,23,23,23,23,23,23,24,24,24,24,24,24,24,24,24,24,24,24,24,24,24,24,25,25,25,25,25,25,25,25,25,25,25,25,25,25,25,25,25,25,25,25,25,26,26,26,26,26,26,26,26,26,26,26,26,26,26,26,26,26,26,26,26,26,26,26,26,26,26,26,26,26,26,27,27,27,27,27,27,27,27,27,27,27,27,27,27,27,27,0,0,0},
 {0,16,18,19,20,21,21,22,22,23,23,23,24,24,24,24,25,25,25,25,25,26,26,26,26,26,26,26,26,27,27,27,27,27,27,27,27,27,27,28,28,28,28,28,28,28,28,28,28,28,28,28,29,29,29,29,29,29,29,29,29,29,29,29,29,29,29,29,29,29,30,30,30,30,30,30,30,30,30,30,30,30,30,30,30,30,30,30,30,30,30,30,30,30,30,31,31,31,31,31,31,31,31,31,31,31,31,31,31,31,31,31,31,31,31,31,31,31,31,31,31,31,31,31,31,31,31,31,31,0,0,0}};

__device__ __forceinline__ unsigned f2bf(float f) { unsigned u = __builtin_bit_cast(unsigned, f); return (u + 0x7fffu + ((u >> 16) & 1u)) >> 16; }
__device__ __forceinline__ unsigned pk2(float lo, float hi) { return f2bf(lo) | (f2bf(hi) << 16); }
__device__ __forceinline__ float bflo(unsigned w) { return __uint_as_float(w << 16); }
__device__ __forceinline__ float bfhi(unsigned w) { return __uint_as_float(w & 0xffff0000u); }
__device__ __forceinline__ float bf2f(bf16 h) { return __uint_as_float(((unsigned)h) << 16); }
__device__ __forceinline__ float wave_sum(float v) {
#pragma unroll
    for (int o = 1; o < 64; o <<= 1) v += __shfl_xor(v, o);
    return v;
}
__device__ __forceinline__ float wave_max(float v) {
#pragma unroll
    for (int o = 1; o < 64; o <<= 1) v = fmaxf(v, __shfl_xor(v, o));
    return v;
}
__device__ __forceinline__ float sigmoidf_(float x) { return 1.f / (1.f + __expf(-x)); }
__device__ __forceinline__ float siluf_(float x) { return x / (1.f + __expf(-x)); }

struct Args { const float* in[28]; float* out; unsigned char* ws; };
typedef const __attribute__((address_space(4))) Args* KArgs;
struct Frame {
    LAS unsigned char* lds;
    int tid, lane, wave, G, bid;
    const float* in[28]; float* out; unsigned char* ws;
};
__device__ __forceinline__ void make_frame(Frame& F, KArgs ka, unsigned char* lds) {
    asm volatile("" : "+s"(ka));
    int t = threadIdx.x; asm volatile("" : "+v"(t));
    F.lds = (LAS unsigned char*)lds; F.tid = t; F.lane = t & 63; F.wave = __builtin_amdgcn_readfirstlane(t >> 6); F.G = gridDim.x; F.bid = blockIdx.x;
#pragma unroll
    for (int i = 0; i < 28; ++i) F.in[i] = ka->in[i];
    F.out = ka->out; F.ws = ka->ws;
}
__device__ __forceinline__ void p0_mod(Frame& F) {
    const float* c = F.in[1]; const float* ada_w = F.in[3]; const float* ada_b = F.in[4];
    float* mod = (float*)(F.ws + WS_MOD);
    LAS float* red = (LAS float*)F.lds;
    const int col = F.tid & 31, kg = F.tid >> 5;
    for (int ch = F.bid; ch < 192; ch += F.G) {
        const int l = ch / 96, n = (ch % 96) * 32 + col;
        const float* W = ada_w + (size_t)l * 1024 * 3072 + n;
        float a0 = 0.f, a1 = 0.f;
        for (int i = 0; i < 64; ++i) { const int k = kg + 16 * i; const float w = W[(size_t)k * 3072]; a0 += siluf_(c[k]) * w; a1 += siluf_(c[1024 + k]) * w; }
        red[kg * 32 + col] = a0; red[512 + kg * 32 + col] = a1;
        __syncthreads();
        if (F.tid < 64) { const int b = F.tid >> 5; float s = 0.f;
            for (int g = 0; g < 16; ++g) s += red[b * 512 + g * 32 + col];
            mod[(size_t)(l * 2 + b) * 3072 + n] = s + ada_b[l * 3072 + n]; }
        __syncthreads();
    }
}
__device__ __forceinline__ void transpose_item(const float* W, int ldw, int col0, int K, int ncols, bf16* WT, LAS float* scr, int item, int lane) {
    const int nblk = ncols / 32, kb = item / nblk, nb = item % nblk, k0 = 64 * kb, n0 = 32 * nb;
#pragma unroll 8
    for (int i = 0; i < 32; ++i) { const int kk = 2 * i + (lane >> 5); scr[kk * 33 + (lane & 31)] = W[(size_t)(k0 + kk) * ldw + col0 + n0 + (lane & 31)]; }
    asm volatile("s_waitcnt lgkmcnt(0)" ::: "memory");
    const int c = lane & 7;
#pragma unroll
    for (int j = 0; j < 4; ++j) { const int n = (lane >> 3) + 8 * j; const LAS float* s = scr + (8 * c) * 33 + n;
        u32x4 o; o.x = pk2(s[0 * 33], s[1 * 33]); o.y = pk2(s[2 * 33], s[3 * 33]); o.z = pk2(s[4 * 33], s[5 * 33]); o.w = pk2(s[6 * 33], s[7 * 33]);
        *(u32x4*)(WT + (size_t)(n0 + n) * K + k0 + 8 * c) = o; }
    asm volatile("s_waitcnt lgkmcnt(0)" ::: "memory");
}
__device__ __forceinline__ void p0_weights(Frame& F) {
    LAS float* scr = (LAS float*)(F.lds + 16384 + F.wave * 16384);
    const int gw = F.bid * NWAVES + F.wave, NGW = F.G * NWAVES;
    constexpr int I_QKV = 16 * 144, I_A = 16 * 96, I_GA = 16 * 32, I_GB = 16 * 16, I_M = 16 * 64, I_BA = 16 * 32, I_BB = 8 * 32, I_O = 16 * 32;
    constexpr int PER_L = I_QKV + I_A + I_GA + I_GB + I_M + I_BA + I_BB + I_O;
    for (int it = gw; it < 2 * PER_L; it += NGW) {
        const int l = it / PER_L; int r = it % PER_L;
        const float* win = F.in[5] + (size_t)l * 1024 * PROJW;
        bf16* wqkv = (bf16*)(F.ws + WS_WQKV) + (size_t)l * NQKV * 1024;
        bf16* wa = (bf16*)(F.ws + WS_WA) + (size_t)l * NA * 1024;
        bf16* wg = (bf16*)(F.ws + WS_WG) + (size_t)l * NG * 1024;
        if (r < I_QKV) { transpose_item(win, PROJW, 4096, 1024, 4608, wqkv, scr, r, F.lane); continue; } r -= I_QKV;
        if (r < I_A) { transpose_item(win, PROJW, 0, 1024, 3072, wa, scr, r, F.lane); continue; } r -= I_A;
        if (r < I_GA) { transpose_item(win, PROJW, 3072, 1024, 1024, wg, scr, r, F.lane); continue; } r -= I_GA;
        if (r < I_GB) { transpose_item(win, PROJW, 8704, 1024, 512, wg + (size_t)1024 * 1024, scr, r, F.lane); continue; } r -= I_GB;
        if (r < I_M) { transpose_item(win, PROJW, 9216, 1024, 2048, wg + (size_t)1536 * 1024, scr, r, F.lane); continue; } r -= I_M;
        if (r < I_BA) { transpose_item(F.in[23] + (size_t)l * 1024 * 1024, 1024, 0, 1024, 1024, (bf16*)(F.ws + WS_WBA) + (size_t)l * 1024 * 1024, scr, r, F.lane); continue; } r -= I_BA;
        if (r < I_BB) { transpose_item(F.in[24] + (size_t)l * 512 * 1024, 1024, 0, 512, 1024, (bf16*)(F.ws + WS_WBB) + (size_t)l * 1024 * 512, scr, r, F.lane); continue; } r -= I_BB;
        transpose_item(F.in[25] + (size_t)l * 1024 * 1024, 1024, 0, 1024, 1024, (bf16*)(F.ws + WS_WO) + (size_t)l * 1024 * 1024, scr, r, F.lane);
    }
    const size_t gt = (size_t)F.bid * NTHREADS + F.tid, NGT = (size_t)F.G * NTHREADS;
    for (size_t e = gt; e < (size_t)2 * 512 * 1024; e += NGT) {
        const int l = (int)(e / (512 * 1024)), n = (int)((e / 1024) % 512), k = (int)(e % 1024);
        const float muw = F.in[7][(size_t)(l * 2 + 0) * 1024 + k], mua = F.in[7][(size_t)(l * 2 + 1) * 1024 + k];
        float v = 0.f;
        if (n < 64) v = F.in[9][((size_t)l * 1024 + k) * 64 + n] * (1.f - muw);
        else if (n < 128) v = F.in[9][((size_t)l * 1024 + k) * 64 + (n - 64)] * muw;
        else if (n < 192) v = F.in[12][((size_t)l * 1024 + k) * 64 + (n - 128)] * (1.f - mua);
        else if (n < 256) v = F.in[12][((size_t)l * 1024 + k) * 64 + (n - 192)] * mua;
        else if (n < 320 && l == 1) { const float muv = F.in[19][k]; const int m = (n - 256) & 31; const float w = F.in[21][(size_t)k * 32 + m]; v = (n < 288) ? w * (1.f - muv) : w * muv; }
        ((bf16*)(F.ws + WS_WA))[((size_t)l * NA + 3072 + n) * 1024 + k] = (bf16)f2bf(v);
    }
}
__device__ __forceinline__ void phase_modnorm(Frame& F, int l, const float* xin) {
    const float* mod = (const float*)(F.ws + WS_MOD) + (size_t)l * 2 * 3072;
    const float* g = F.in[2] + l * 1024;
    bf16* XN = (bf16*)(F.ws + WS_XN);
    const int gw = F.bid * NWAVES + F.wave, NGW = F.G * NWAVES;
    for (int m = gw; m < MROWS; m += NGW) {
        const int b = m / SEQ; const f32x4* xr = (const f32x4*)(xin + (size_t)m * 1024) + F.lane;
        f32x4 v[4]; float s = 0.f;
#pragma unroll
        for (int j = 0; j < 4; ++j) { v[j] = xr[64 * j]; s += (v[j].x * v[j].x + v[j].y * v[j].y) + (v[j].z * v[j].z + v[j].w * v[j].w); }
        const float rs = 1.f / sqrtf(wave_sum(s) * (1.f / 1024.f) + 1e-6f);
        u32x2* o = (u32x2*)(XN + (size_t)m * 1024) + F.lane;
#pragma unroll
        for (int j = 0; j < 4; ++j) { const int c = 4 * F.lane + 256 * j;
            const f32x4 gg = *(const f32x4*)(g + c), sh = *(const f32x4*)(mod + b * 3072 + c), sc = *(const f32x4*)(mod + b * 3072 + 1024 + c);
            const f32x4 h = v[j] * rs * gg * (sc + 1.f) + sh; u32x2 w; w.x = pk2(h.x, h.y); w.y = pk2(h.z, h.w); o[64 * j] = w; }
    }
}
__device__ __forceinline__ void phase_final(Frame& F) {
    const float* g = F.in[27]; const int gw = F.bid * NWAVES + F.wave, NGW = F.G * NWAVES;
    for (int m = gw; m < MROWS; m += NGW) {
        f32x4* xr = (f32x4*)(F.out + (size_t)m * 1024) + F.lane; f32x4 v[4]; float s = 0.f;
#pragma unroll
        for (int j = 0; j < 4; ++j) { v[j] = xr[64 * j]; s += (v[j].x * v[j].x + v[j].y * v[j].y) + (v[j].z * v[j].z + v[j].w * v[j].w); }
        const float rs = 1.f / sqrtf(wave_sum(s) * (1.f / 1024.f) + 1e-6f);
#pragma unroll
        for (int j = 0; j < 4; ++j) { const f32x4 gg = *(const f32x4*)(g + 4 * F.lane + 256 * j); xr[64 * j] = v[j] * rs * gg; }
    }
}
__device__ __forceinline__ void phase_attn_naive(Frame& F) {
    const bf16* QKV = (const bf16*)(F.ws + WS_QKV); bf16* YB = (bf16*)(F.ws + WS_YB); const float* rel_bias = F.in[26];
    LAS float* QS = (LAS float*)(F.lds) + F.wave * 640;
    LAS float* PS = QS + 192;
    const int gw = F.bid * NWAVES + F.wave, NGW = F.G * NWAVES, lane = F.lane;
    for (int it = gw; it < MROWS * 8; it += NGW) {
        const int row = it >> 3, h = it & 7, b = row / SEQ, t = row % SEQ;
        const bf16* qrow = QKV + (size_t)row * NQKV;
#pragma unroll
        for (int g = 0; g < 3; ++g) QS[g * 64 + lane] = bf2f(qrow[g * 512 + h * 64 + lane]) * 0.125f;
        __builtin_amdgcn_wave_barrier();
        float sc[3][3]; float mx = -1e30f;
#pragma unroll
        for (int g = 0; g < 3; ++g) { const int dil = (g == 0) ? 1 : (g == 1 ? 4 : 16);
#pragma unroll
            for (int jj = 0; jj < 3; ++jj) { const int j = lane + 64 * jj; const int tk = t - j * dil; float s = -1e30f;
                if (j <= 128 && tk >= 0) {
                    const u32x4* kp = (const u32x4*)(QKV + (size_t)(b * SEQ + tk) * NQKV + 1536 + g * 512 + h * 64);
                    float a = 0.f;
#pragma unroll
                    for (int c8 = 0; c8 < 8; ++c8) { const u32x4 kv = kp[c8]; const LAS float* q = QS + g * 64 + c8 * 8;
                        a += q[0] * bflo(kv.x) + q[1] * bfhi(kv.x) + q[2] * bflo(kv.y) + q[3] * bfhi(kv.y) + q[4] * bflo(kv.z) + q[5] * bfhi(kv.z) + q[6] * bflo(kv.w) + q[7] * bfhi(kv.w); }
                    s = a + rel_bias[(int)T5BUCKET[g][j] * 24 + g * 8 + h];
                }
                sc[g][jj] = s; mx = fmaxf(mx, s); } }
        mx = wave_max(mx);
        float den = 0.f;
#pragma unroll
        for (int g = 0; g < 3; ++g)
#pragma unroll
            for (int jj = 0; jj < 3; ++jj) { const int j = lane + 64 * jj; const float p = (sc[g][jj] > -1e29f) ? __expf(sc[g][jj] - mx) : 0.f; den += p; if (j <= 128) PS[g * 132 + j] = p; }
        den = wave_sum(den);
        __builtin_amdgcn_wave_barrier();
        float o = 0.f;
#pragma unroll
        for (int g = 0; g < 3; ++g) { const int dil = (g == 0) ? 1 : (g == 1 ? 4 : 16); const int jmax = min(128, t / dil);
            const bf16* vp = QKV + (size_t)(b * SEQ + t) * NQKV + 3072 + g * 512 + h * 64 + lane;
            for (int j = 0; j <= jmax; ++j) o += PS[g * 132 + j] * bf2f(vp[-(ptrdiff_t)j * dil * NQKV]); }
        YB[(size_t)row * 512 + h * 64 + lane] = (bf16)f2bf(o / den);
        __builtin_amdgcn_wave_barrier();
    }
}
__device__ __forceinline__ float softplusf_(float x) { return fmaxf(x, 0.f) + log1pf(__expf(-fabsf(x))); }
__device__ __forceinline__ void phase_rwkv_naive(Frame& F, int l) {
    if (F.bid >= 32) return;
    constexpr int TB = 16;
    const int b = F.bid >> 4, h = F.bid & 15, tid = F.tid, lane = F.lane, wave = F.wave;
    const bf16* PA = (const bf16*)(F.ws + WS_PA); bf16* YA = (bf16*)(F.ws + WS_YA); bf16* VF = (bf16*)(F.ws + WS_VFIRST);
    LAS float* L = (LAS float*)F.lds;
    LAS float* W2s = L; LAS float* A2s = L + 4096; LAS float* V2s = L + 8192; LAS float* CV = L + 10240;
    LAS float* PRs = L + 11264; LAS float* PKs = PRs + 17 * 64; LAS float* PVs = PKs + 17 * 64; LAS float* LOs = PVs + 17 * 64;
    LAS float* LWs = LOs + 17 * 320; LAS float* LAs = LWs + TB * 64; LAS float* LVs = LAs + TB * 64;
    LAS float* Rs = LVs + TB * 32; LAS float* Ws = Rs + TB * 64; LAS float* Ks = Ws + TB * 64; LAS float* Vs = Ks + TB * 64; LAS float* As = Vs + TB * 64; LAS float* Bs = As + TB * 64;
    LAS float* RKs = Bs + TB * 64; LAS float* Ys = RKs + TB;
    for (int e = tid; e < 4096; e += NTHREADS) { const int m = e >> 6, j = e & 63;
        W2s[e] = F.in[10][((size_t)l * 64 + m) * 1024 + h * 64 + j]; A2s[e] = F.in[13][((size_t)l * 64 + m) * 1024 + h * 64 + j];
        if (m < 32) V2s[e] = (l == 1) ? F.in[22][(size_t)m * 1024 + h * 64 + j] : 0.f; }
    if (tid < 64) { const int c = h * 64 + tid;
        CV[0 * 64 + tid] = F.in[8][l * 1024 + c];  CV[1 * 64 + tid] = F.in[11][l * 1024 + c]; CV[2 * 64 + tid] = (l == 1) ? F.in[20][c] : 0.f;
        CV[3 * 64 + tid] = F.in[14][l * 1024 + c]; CV[4 * 64 + tid] = F.in[15][l * 1024 + c]; CV[5 * 64 + tid] = F.in[16][l * 1024 + c];
        CV[6 * 64 + tid] = F.in[17][l * 1024 + c]; CV[7 * 64 + tid] = F.in[18][l * 1024 + c];
        CV[8 * 64 + tid] = F.in[6][(size_t)(l * 3 + 0) * 1024 + c]; CV[9 * 64 + tid] = F.in[6][(size_t)(l * 3 + 1) * 1024 + c]; CV[10 * 64 + tid] = F.in[6][(size_t)(l * 3 + 2) * 1024 + c]; }
    float S[16];
#pragma unroll
    for (int q = 0; q < 16; ++q) S[q] = 0.f;
    __syncthreads();
    for (int t0 = 0; t0 < SEQ; t0 += TB) {
        for (int e = tid; e < 17 * 512; e += NTHREADS) { const int rr = e >> 9, cc = e & 511, t = t0 - 1 + rr; float v = 0.f;
            if (t >= 0) { const int gc = (cc < 192) ? ((cc >> 6) * 1024 + h * 64 + (cc & 63)) : (3072 + cc - 192); v = bf2f(PA[(size_t)(b * SEQ + t) * NA + gc]); }
            if (cc < 64) PRs[rr * 64 + cc] = v; else if (cc < 128) PKs[rr * 64 + cc - 64] = v; else if (cc < 192) PVs[rr * 64 + cc - 128] = v; else LOs[rr * 320 + cc - 192] = v; }
        __syncthreads();
        for (int e = tid; e < TB * 160; e += NTHREADS) { const int tl = e / 160, m = e % 160; const LAS float* cur = LOs + (tl + 1) * 320; const LAS float* prv = LOs + tl * 320;
            if (m < 64) LWs[tl * 64 + m] = tanhf(cur[m] + prv[64 + m]);
            else if (m < 128) LAs[tl * 64 + m - 64] = cur[128 + m - 64] + prv[192 + m - 64];
            else LVs[tl * 32 + m - 128] = cur[256 + m - 128] + prv[288 + m - 128]; }
        __syncthreads();
        for (int tl = wave; tl < TB; tl += NWAVES) { const int j = lane; const size_t row = (size_t)(b * SEQ + t0 + tl);
            float wpre = CV[j], apre = CV[64 + j], vpre = CV[128 + j];
            for (int m = 0; m < 64; ++m) { wpre += LWs[tl * 64 + m] * W2s[m * 64 + j]; apre += LAs[tl * 64 + m] * A2s[m * 64 + j]; }
            for (int m = 0; m < 32; ++m) vpre += LVs[tl * 32 + m] * V2s[m * 64 + j];
            const float pr = PRs[(tl + 1) * 64 + j], prp = PRs[tl * 64 + j], pk = PKs[(tl + 1) * 64 + j], pkp = PKs[tl * 64 + j], pv = PVs[(tl + 1) * 64 + j], pvp = PVs[tl * 64 + j];
            const float r = pr + (prp - pr) * CV[8 * 64 + j], k = pk + (pkp - pk) * CV[9 * 64 + j]; float v = pv + (pvp - pv) * CV[10 * 64 + j];
            const float w = -softplusf_(-wpre) - 0.5f; const float decay = __expf(-__expf(w)); const float asig = sigmoidf_(apre);
            if (l == 0) VF[row * 1024 + h * 64 + j] = (bf16)f2bf(v); else { const float vf = bf2f(VF[row * 1024 + h * 64 + j]); v = v + (vf - v) * sigmoidf_(vpre); }
            const float kk = k * CV[3 * 64 + j]; const float ss = wave_sum(kk * kk); const float kkn = kk * (1.f / sqrtf(fmaxf(ss, 1e-24f)));
            const float k2 = k * (1.f + (asig - 1.f) * CV[4 * 64 + j]);
            const float rk = wave_sum(r * k2 * CV[5 * 64 + j]);
            Rs[tl * 64 + j] = r; Ws[tl * 64 + j] = decay; Ks[tl * 64 + j] = k2; Vs[tl * 64 + j] = v; As[tl * 64 + j] = -kkn; Bs[tl * 64 + j] = kkn * asig;
            if (lane == 0) RKs[tl] = rk; }
        __syncthreads();
        if (wave < 4) { const int i = wave * 16 + (lane >> 2), jq = lane & 3;
            for (int tl = 0; tl < TB; ++tl) { const int o = tl * 64 + jq * 16; const float vi = Vs[tl * 64 + i];
                float sa = 0.f;
#pragma unroll
                for (int q = 0; q < 16; ++q) sa += S[q] * As[o + q];
                sa += __shfl_xor(sa, 1); sa += __shfl_xor(sa, 2);
                float y = 0.f;
#pragma unroll
                for (int q = 0; q < 16; ++q) { S[q] = S[q] * Ws[o + q] + sa * Bs[o + q] + vi * Ks[o + q]; y += S[q] * Rs[o + q]; }
                y += __shfl_xor(y, 1); y += __shfl_xor(y, 2);
                if (jq == 0) Ys[tl * 64 + i] = y; } }
        __syncthreads();
        for (int tl = wave; tl < TB; tl += NWAVES) { const int i = lane; const size_t row = (size_t)(b * SEQ + t0 + tl);
            const float y = Ys[tl * 64 + i]; const float mean = wave_sum(y) * (1.f / 64.f); const float d = y - mean; const float var = wave_sum(d * d) * (1.f / 64.f);
            const float o = d * (1.f / sqrtf(var + 64e-5f)) * CV[6 * 64 + i] + CV[7 * 64 + i] + RKs[tl] * Vs[tl * 64 + i];
            YA[row * 1024 + h * 64 + i] = (bf16)f2bf(o); }
    }
}
typedef short bf16x8 __attribute__((ext_vector_type(8)));
typedef short s16x4 __attribute__((ext_vector_type(4)));
typedef short v4i16_t __attribute__((ext_vector_type(4)));
constexpr int RC = 32, RLS = 256, RNSC = SEQ / RLS, RNCH = RLS / RC, RITEMS = BATCH * 16 * RNSC;
constexpr int AST = 72;
constexpr int MST = 40;
constexpr int OFF_RAWH = 0, OFF_RAWL = 12800, OFF_MK = 12800, OFF_QB = 15360, OFF_QK = 17920, OFF_YS = 20480;
constexpr int OFF_LW = 34048, OFF_LA = OFF_LW + 4608, OFF_LV = OFF_LA + 4608;
constexpr int OFF_W2T = 45824, OFF_A2T = OFF_W2T + 9216, OFF_V2T = OFF_A2T + 9216;
constexpr int OFF_CV = 69376, OFF_GAM = 72192, OFF_RK = 72448;
constexpr int OFF_PRE = 72576, OFF_U = 72576, OFF_T = OFF_U + 8704;
constexpr int OFF_LWG = 97664, OFF_ARR = 105856;
constexpr int PRE_ST = 196, U_ST = 68, T_ST = 36, YS_ST = 68;
enum { AR_RT = 0, AR_AT, AR_BT, AR_KT, AR_BH, AR_KH, AR_V, AR_W };
static_assert(OFF_ARR + 8 * 32 * AST * 2 <= LDS_BYTES, "rwkv LDS map");
#define ARR(k) (F.lds + OFF_ARR + (k) * (32 * AST * 2))

__device__ __forceinline__ bf16x8 ld_b128(const LAS unsigned char* p) { return *(const LAS bf16x8*)p; }
__device__ __forceinline__ s16x4 ld_b64(const LAS unsigned char* p) { return *(const LAS s16x4*)p; }
__device__ __forceinline__ s16x4 ld_tr(const LAS unsigned char* p) { return __builtin_bit_cast(s16x4, __builtin_amdgcn_ds_read_tr16_b64_v4i16((LAS v4i16_t*)p)); }
__device__ __forceinline__ bf16x8 cat8(s16x4 a, s16x4 b) { return (bf16x8){a[0], a[1], a[2], a[3], b[0], b[1], b[2], b[3]}; }
__device__ __forceinline__ bf16x8 pack8(f32x4 a, f32x4 b) { u32x4 w; w.x = pk2(a[0], a[1]); w.y = pk2(a[2], a[3]); w.z = pk2(b[0], b[1]); w.w = pk2(b[2], b[3]); return __builtin_bit_cast(bf16x8, w); }
#define MFMA16(a, b, c) __builtin_amdgcn_mfma_f32_16x16x32_bf16((a), (b), (c), 0, 0, 0)
__device__ __forceinline__ void st_bf(LAS unsigned char* base, int idx, float v) { ((LAS bf16*)base)[idx] = (bf16)f2bf(v); }

template <int PASS> __device__ __forceinline__ void rwkv_pass(Frame& F, int l) {
    const int tid = F.tid, lane = F.lane, wave = F.wave, g = lane >> 4, c = lane & 15;
    const bf16* PA = (const bf16*)(F.ws + WS_PA); bf16* YA = (bf16*)(F.ws + WS_YA); bf16* VF = (bf16*)(F.ws + WS_VFIRST);
    float* PD = (float*)(F.ws + WS_SC); float* SST = (float*)(F.ws + WS_SC + 32 * MiB);
    LAS float* CV = (LAS float*)(F.lds + OFF_CV); LAS float* GAM = (LAS float*)(F.lds + OFF_GAM); LAS float* RK = (LAS float*)(F.lds + OFF_RK);
    LAS float* PRE = (LAS float*)(F.lds + OFF_PRE); LAS float* Us = (LAS float*)(F.lds + OFF_U); LAS float* Ts = (LAS float*)(F.lds + OFF_T);
    LAS float* LWG = (LAS float*)(F.lds + OFF_LWG); LAS float* YS = (LAS float*)(F.lds + OFF_YS);
    LAS bf16* RAWH = (LAS bf16*)(F.lds + OFF_RAWH); LAS bf16* RAWL = (LAS bf16*)(F.lds + OFF_RAWL);
    for (int it = F.bid; it < RITEMS; it += F.G) {
        const int b = it / (16 * RNSC), h = (it / RNSC) % 16, sc = it % RNSC;
        __syncthreads();
        for (int e = tid; e < 4096; e += NTHREADS) { const int m = e >> 6, j = e & 63;
            st_bf(F.lds + OFF_W2T, j * AST + m, F.in[10][((size_t)l * 64 + m) * 1024 + h * 64 + j]);
            st_bf(F.lds + OFF_A2T, j * AST + m, F.in[13][((size_t)l * 64 + m) * 1024 + h * 64 + j]);
            if (m < 32) st_bf(F.lds + OFF_V2T, j * MST + m, (l == 1) ? F.in[22][(size_t)m * 1024 + h * 64 + j] : 0.f); }
        if (tid < 64) { const int cc = h * 64 + tid;
            CV[0 * 64 + tid] = F.in[8][l * 1024 + cc];  CV[1 * 64 + tid] = F.in[11][l * 1024 + cc]; CV[2 * 64 + tid] = (l == 1) ? F.in[20][cc] : 0.f;
            CV[3 * 64 + tid] = F.in[14][l * 1024 + cc]; CV[4 * 64 + tid] = F.in[15][l * 1024 + cc]; CV[5 * 64 + tid] = F.in[16][l * 1024 + cc];
            CV[6 * 64 + tid] = F.in[17][l * 1024 + cc]; CV[7 * 64 + tid] = F.in[18][l * 1024 + cc];
            CV[8 * 64 + tid] = F.in[6][(size_t)(l * 3 + 0) * 1024 + cc]; CV[9 * 64 + tid] = F.in[6][(size_t)(l * 3 + 1) * 1024 + cc]; CV[10 * 64 + tid] = F.in[6][(size_t)(l * 3 + 2) * 1024 + cc]; }
        f32x4 X[4];
#pragma unroll
        for (int jt = 0; jt < 4; ++jt) X[jt] = (f32x4){0.f, 0.f, 0.f, 0.f};
        if (PASS == 1) { if (wave >= 4) {
#pragma unroll
                for (int jt = 0; jt < 4; ++jt)
#pragma unroll
                    for (int r = 0; r < 4; ++r) X[jt][r] = (16 * jt + 4 * g + r == 16 * (wave - 4) + c) ? 1.f : 0.f; } }
        else if (wave < 4) { const float* s0 = SST + (size_t)it * 4096;
#pragma unroll
            for (int jt = 0; jt < 4; ++jt)
#pragma unroll
                for (int r = 0; r < 4; ++r) X[jt][r] = s0[(16 * jt + 4 * g + r) * 64 + 16 * wave + c]; }
        for (int ch = 0; ch < RNCH; ++ch) {
            const int t0 = sc * RLS + ch * RC;
            __syncthreads();
            for (int e = tid; e < 33 * 64; e += NTHREADS) { const int rr = e >> 6, k = e & 63, t = t0 - 1 + rr; u32x4 v = (u32x4){0u, 0u, 0u, 0u};
                const int gc = (k < 24) ? ((k >> 3) * 1024 + h * 64 + (k & 7) * 8) : (3072 + (k - 24) * 8);
                if (t >= 0) v = *(const u32x4*)(PA + (size_t)(b * SEQ + t) * NA + gc);
                if (k < 24) *(LAS u32x4*)(RAWH + rr * 192 + k * 8) = v; else *(LAS u32x4*)(RAWL + rr * 320 + (k - 24) * 8) = v; }
            __syncthreads();
            for (int e = tid; e < 32 * 160; e += NTHREADS) { const int tl = e / 160, m = e % 160; const LAS bf16* cur = RAWL + (tl + 1) * 320; const LAS bf16* prv = RAWL + tl * 320;
                if (m < 64) st_bf(F.lds + OFF_LW, tl * AST + m, tanhf(bf2f(cur[m]) + bf2f(prv[64 + m])));
                else if (m < 128) st_bf(F.lds + OFF_LA, tl * AST + (m - 64), bf2f(cur[128 + m - 64]) + bf2f(prv[192 + m - 64]));
                else st_bf(F.lds + OFF_LV, tl * MST + (m - 128), bf2f(cur[256 + m - 128]) + bf2f(prv[288 + m - 128])); }
            __syncthreads();
#pragma unroll
            for (int q = 0; q < 3; ++q) { const int tile = wave * 3 + q, tt = tile / 12, nt = tile % 12, mat = nt >> 2, jt = nt & 3;
                f32x4 acc = (f32x4){0.f, 0.f, 0.f, 0.f};
                if (mat < 2) { const LAS unsigned char* Ab = F.lds + (mat == 0 ? OFF_LW : OFF_LA) + ((16 * tt + c) * AST + 8 * g) * 2; const LAS unsigned char* Bb = F.lds + (mat == 0 ? OFF_W2T : OFF_A2T) + ((16 * jt + c) * AST + 8 * g) * 2;
                    acc = MFMA16(ld_b128(Ab), ld_b128(Bb), acc); acc = MFMA16(ld_b128(Ab + 64), ld_b128(Bb + 64), acc); }
                else { const LAS unsigned char* Ab = F.lds + OFF_LV + ((16 * tt + c) * MST + 8 * g) * 2; const LAS unsigned char* Bb = F.lds + OFF_V2T + ((16 * jt + c) * MST + 8 * g) * 2;
                    acc = MFMA16(ld_b128(Ab), ld_b128(Bb), acc); }
#pragma unroll
                for (int r = 0; r < 4; ++r) PRE[(16 * tt + 4 * g + r) * PRE_ST + 16 * nt + c] = acc[r]; }
            __syncthreads();
            for (int e = tid; e < 32 * 64; e += NTHREADS) { const int t = e >> 6, j = e & 63; const float wpre = PRE[t * PRE_ST + j] + CV[j];
                const float w = -softplusf_(-wpre) - 0.5f; LWG[t * 64 + j] = -__expf(w); }
            __syncthreads();
            if (tid < 64) { float a = 0.f;
#pragma unroll 8
                for (int t = 0; t < 32; ++t) { a += LWG[t * 64 + tid]; LWG[t * 64 + tid] = a; }
                GAM[tid] = __expf(a); }
            __syncthreads();
            for (int tl = wave; tl < 32; tl += NWAVES) { const int j = lane; const size_t row = (size_t)(b * SEQ + t0 + tl);
                const float apre = PRE[tl * PRE_ST + 64 + j] + CV[64 + j], vpre = PRE[tl * PRE_ST + 128 + j] + CV[128 + j];
                const float pr = bf2f(RAWH[(tl + 1) * 192 + j]), prp = bf2f(RAWH[tl * 192 + j]), pk = bf2f(RAWH[(tl + 1) * 192 + 64 + j]), pkp = bf2f(RAWH[tl * 192 + 64 + j]);
                const float pv = bf2f(RAWH[(tl + 1) * 192 + 128 + j]), pvp = bf2f(RAWH[tl * 192 + 128 + j]);
                const float r = pr + (prp - pr) * CV[8 * 64 + j], k = pk + (pkp - pk) * CV[9 * 64 + j]; float v = pv + (pvp - pv) * CV[10 * 64 + j];
                const float asig = sigmoidf_(apre);
                if (l == 0) { if (PASS == 1) VF[row * 1024 + h * 64 + j] = (bf16)f2bf(v); } else { const float vf = bf2f(VF[row * 1024 + h * 64 + j]); v = v + (vf - v) * sigmoidf_(vpre); }
                const float kk = k * CV[3 * 64 + j]; const float ss = wave_sum(kk * kk); const float kkn = kk * (1.f / sqrtf(fmaxf(ss, 1e-24f)));
                const float k2 = k * (1.f + (asig - 1.f) * CV[4 * 64 + j]); const float av = -kkn, bv = kkn * asig;
                const float gt = LWG[tl * 64 + j], gp = (tl > 0) ? LWG[(tl - 1) * 64 + j] : 0.f, gC = LWG[31 * 64 + j];
                const float eg = __expf(gt), egp = __expf(gp), einv = __expf(-gt), eh = __expf(gC - gt);
                const int o = tl * AST + j;
                st_bf(ARR(AR_AT), o, av * egp); st_bf(ARR(AR_BT), o, bv * einv); st_bf(ARR(AR_KT), o, k2 * einv); st_bf(ARR(AR_BH), o, bv * eh); st_bf(ARR(AR_KH), o, k2 * eh); st_bf(ARR(AR_V), o, v);
                if (PASS == 3) { st_bf(ARR(AR_RT), o, r * eg); const float rk = wave_sum(r * k2 * CV[5 * 64 + j]); if (lane == 0) RK[tl] = rk; } }
            __syncthreads();
#pragma unroll
            for (int q = 0; q < 2; ++q) { const int tile = wave * 2 + q, rt = tile >> 2, ct = tile & 3, tt = rt & 1, st = ct & 1;
                if (PASS == 1 && rt >= 2) continue;
                f32x4 acc = (f32x4){0.f, 0.f, 0.f, 0.f};
                if (st <= tt) { const LAS unsigned char* Ab = ARR(rt < 2 ? AR_AT : AR_RT) + ((16 * tt + c) * AST + 8 * g) * 2; const LAS unsigned char* Bb = ARR(ct < 2 ? AR_BT : AR_KT) + ((16 * st + c) * AST + 8 * g) * 2;
                    acc = MFMA16(ld_b128(Ab), ld_b128(Bb), acc); acc = MFMA16(ld_b128(Ab + 64), ld_b128(Bb + 64), acc); }
                const int s = 16 * st + c;
#pragma unroll
                for (int r = 0; r < 4; ++r) { const int t = 16 * tt + 4 * g + r; const bool keep = (rt < 2) ? (s < t) : (s <= t); const float v = keep ? acc[r] : 0.f;
                    if (rt < 2 && ct < 2) Ts[t * T_ST + s] = v; else st_bf(F.lds + (rt < 2 ? OFF_MK : (ct < 2 ? OFF_QB : OFF_QK)), t * MST + s, v); } }
            __syncthreads();
            { const int tt = wave >> 2, itl = wave & 3;
              const bf16x8 a = ld_b128(F.lds + OFF_MK + ((16 * tt + c) * MST + 8 * g) * 2);
              const int q = c >> 2, p = c & 3;
              const LAS unsigned char* vb = ARR(AR_V) + ((8 * g + q) * AST + 16 * itl + 4 * p) * 2;
              const bf16x8 bfr = cat8(ld_tr(vb), ld_tr(vb + 4 * AST * 2));
              f32x4 acc = (f32x4){0.f, 0.f, 0.f, 0.f}; acc = MFMA16(a, bfr, acc);
#pragma unroll
              for (int r = 0; r < 4; ++r) Us[(16 * tt + 4 * g + r) * U_ST + 16 * itl + c] = acc[r]; }
            __syncthreads();
            if (wave < 2) { float x[32];
#pragma unroll
                for (int t = 0; t < 32; ++t) { float a = (wave == 0) ? bf2f(((const LAS bf16*)ARR(AR_AT))[t * AST + lane]) : Us[t * U_ST + lane];
#pragma unroll
                    for (int s4 = 0; s4 < (t + 3) / 4; ++s4) { const f32x4 tv = *(const LAS f32x4*)(Ts + t * T_ST + 4 * s4);
#pragma unroll
                        for (int e = 0; e < 4; ++e) if (4 * s4 + e < t) a += tv[e] * x[4 * s4 + e]; }
                    x[t] = a;
                    if (wave == 0) st_bf(ARR(AR_W), t * AST + lane, a); else Us[t * U_ST + lane] = a; } }
            __syncthreads();
            const bool active = (PASS == 1) ? true : (wave < 4);
            const bool inhom = (PASS == 1) ? (wave < 4) : true;
            const int cw = wave & 3;
            if (active) {
                bf16x8 xf[2];
                xf[0] = pack8(X[0], X[1]); xf[1] = pack8(X[2], X[3]);
                f32x4 Z[2];
#pragma unroll
                for (int tt = 0; tt < 2; ++tt) { f32x4 z = (f32x4){0.f, 0.f, 0.f, 0.f};
                    if (inhom) {
#pragma unroll
                        for (int r = 0; r < 4; ++r) z[r] = Us[(16 * tt + 4 * g + r) * U_ST + 16 * cw + c]; }
#pragma unroll
                    for (int ks = 0; ks < 2; ++ks) { const LAS unsigned char* wb = ARR(AR_W) + ((16 * tt + c) * AST + 32 * ks + 4 * g) * 2;
                        z = MFMA16(cat8(ld_b64(wb), ld_b64(wb + 32)), xf[ks], z); }
                    Z[tt] = z; }
                const bf16x8 zf = pack8(Z[0], Z[1]);
                bf16x8 vf = zf;
                if (inhom) { const int q = c >> 2, p = c & 3; const LAS unsigned char* vb = ARR(AR_V) + ((4 * g + q) * AST + 16 * cw + 4 * p) * 2; vf = cat8(ld_tr(vb), ld_tr(vb + 16 * AST * 2)); }
                if (PASS == 3) {
#pragma unroll
                    for (int tt = 0; tt < 2; ++tt) { f32x4 y = (f32x4){0.f, 0.f, 0.f, 0.f};
#pragma unroll
                        for (int ks = 0; ks < 2; ++ks) { const LAS unsigned char* rb = ARR(AR_RT) + ((16 * tt + c) * AST + 32 * ks + 4 * g) * 2;
                            y = MFMA16(cat8(ld_b64(rb), ld_b64(rb + 32)), xf[ks], y); }
                        const LAS unsigned char* qb = F.lds + OFF_QB + ((16 * tt + c) * MST + 4 * g) * 2; const LAS unsigned char* qk = F.lds + OFF_QK + ((16 * tt + c) * MST + 4 * g) * 2;
                        y = MFMA16(cat8(ld_b64(qb), ld_b64(qb + 32)), zf, y);
                        y = MFMA16(cat8(ld_b64(qk), ld_b64(qk + 32)), vf, y);
#pragma unroll
                        for (int r = 0; r < 4; ++r) YS[(16 * tt + 4 * g + r) * YS_ST + 16 * cw + c] = y[r]; } }
                { const int q = c >> 2, p = c & 3;
#pragma unroll
                  for (int jt = 0; jt < 4; ++jt) { f32x4 xn;
#pragma unroll
                      for (int r = 0; r < 4; ++r) xn[r] = X[jt][r] * GAM[16 * jt + 4 * g + r];
                      const LAS unsigned char* bb = ARR(AR_BH) + ((4 * g + q) * AST + 16 * jt + 4 * p) * 2;
                      xn = MFMA16(cat8(ld_tr(bb), ld_tr(bb + 16 * AST * 2)), zf, xn);
                      if (inhom) { const LAS unsigned char* kb = ARR(AR_KH) + ((4 * g + q) * AST + 16 * jt + 4 * p) * 2; xn = MFMA16(cat8(ld_tr(kb), ld_tr(kb + 16 * AST * 2)), vf, xn); }
                      X[jt] = xn; } }
            }
            if (PASS == 3) {
                __syncthreads();
                for (int tl = wave; tl < 32; tl += NWAVES) { const int i = lane; const size_t row = (size_t)(b * SEQ + t0 + tl);
                    const float y = YS[tl * YS_ST + i]; const float mean = wave_sum(y) * (1.f / 64.f); const float d = y - mean; const float var = wave_sum(d * d) * (1.f / 64.f);
                    const float o = d * (1.f / sqrtf(var + 64e-5f)) * CV[6 * 64 + i] + CV[7 * 64 + i] + RK[tl] * bf2f(((const LAS bf16*)ARR(AR_V))[tl * AST + i]);
                    YA[row * 1024 + h * 64 + i] = (bf16)f2bf(o); }
            }
        }
        if (PASS == 1) { float* pd = PD + (size_t)it * 8192;
#pragma unroll
            for (int jt = 0; jt < 4; ++jt)
#pragma unroll
                for (int r = 0; r < 4; ++r) pd[(16 * jt + 4 * g + r) * 128 + 16 * wave + c] = X[jt][r]; }
    }
}
__device__ __forceinline__ void rwkv_pass2(Frame& F) {
    if (F.bid >= 32) return;
    const float* PD = (const float*)(F.ws + WS_SC); float* SST = (float*)(F.ws + WS_SC + 32 * MiB);
    LAS float* S = (LAS float*)F.lds;
    const int tid = F.tid, j = tid >> 3, i0 = (tid & 7) * 8;
    float s[8];
#pragma unroll
    for (int e = 0; e < 8; ++e) s[e] = 0.f;
    for (int sc = 0; sc < RNSC; ++sc) { const size_t it = (size_t)F.bid * RNSC + sc;
        float* so = SST + it * 4096 + j * 64 + i0;
        *(f32x4*)so = (f32x4){s[0], s[1], s[2], s[3]}; *(f32x4*)(so + 4) = (f32x4){s[4], s[5], s[6], s[7]};
        __syncthreads();
        *(LAS f32x4*)(S + j * 68 + i0) = (f32x4){s[0], s[1], s[2], s[3]}; *(LAS f32x4*)(S + j * 68 + i0 + 4) = (f32x4){s[4], s[5], s[6], s[7]};
        __syncthreads();
        const float* pd = PD + it * 8192 + j * 128;
        const f32x4 d0 = *(const f32x4*)(pd + i0), d1 = *(const f32x4*)(pd + i0 + 4);
        float a[8] = {d0[0], d0[1], d0[2], d0[3], d1[0], d1[1], d1[2], d1[3]};
#pragma unroll 4
        for (int q = 0; q < 16; ++q) { const f32x4 pv = *(const f32x4*)(pd + 64 + 4 * q);
#pragma unroll
            for (int e = 0; e < 4; ++e) { const f32x4 s0 = *(const LAS f32x4*)(S + (4 * q + e) * 68 + i0), s1 = *(const LAS f32x4*)(S + (4 * q + e) * 68 + i0 + 4);
                a[0] += pv[e] * s0[0]; a[1] += pv[e] * s0[1]; a[2] += pv[e] * s0[2]; a[3] += pv[e] * s0[3]; a[4] += pv[e] * s1[0]; a[5] += pv[e] * s1[1]; a[6] += pv[e] * s1[2]; a[7] += pv[e] * s1[3]; } }
#pragma unroll
        for (int e = 0; e < 8; ++e) s[e] = a[e];
    }
}
#define GEMM_LDS ((PG8_LAS unsigned char*)F.lds)
template <class Epi> __device__ __forceinline__ void run_gemm(Frame& F, const bf16* A, const bf16* Bt, int N, int K, const Epi& E) {
    pg8::Gemm g{A, Bt, MROWS, N, K}; pg8::StaticOrder S; S.init(MROWS, N, F.G, F.bid);
    pg8::gemm_phase<Epi, pg8::StaticOrder, true, true>(GEMM_LDS, g, S, E);
}
__global__ void __launch_bounds__(NTHREADS, 2) fwd_kernel(Args a) {
    extern __shared__ __attribute__((aligned(16))) unsigned char lds[];
    cg::grid_group grid = cg::this_grid();
    const KArgs ka = (KArgs)__builtin_amdgcn_kernarg_segment_ptr();
    { Frame F; make_frame(F, ka, lds); p0_mod(F); p0_weights(F); }
    grid.sync();
    for (int l = 0; l < 2; ++l) {
        { Frame F; make_frame(F, ka, lds); phase_modnorm(F, l, (l == 0) ? F.in[0] : F.out); }
        grid.sync();
        { Frame F; make_frame(F, ka, lds); run_gemm(F, (const bf16*)(F.ws + WS_XN), (const bf16*)(F.ws + WS_WQKV) + (size_t)l * NQKV * 1024, NQKV, 1024, pg8::EpiStore{(bf16*)(F.ws + WS_QKV), NQKV}); }
        grid.sync();
        { Frame F; make_frame(F, ka, lds); phase_attn_naive(F); }
        grid.sync();
        { Frame F; make_frame(F, ka, lds); run_gemm(F, (const bf16*)(F.ws + WS_XN), (const bf16*)(F.ws + WS_WA) + (size_t)l * NA * 1024, NA, 1024, pg8::EpiStore{(bf16*)(F.ws + WS_PA), NA}); }
        grid.sync();
#ifdef RWKV_NAIVE
        { Frame F; make_frame(F, ka, lds); phase_rwkv_naive(F, l); }
        grid.sync();
#else
        { Frame F; make_frame(F, ka, lds); rwkv_pass<1>(F, l); }
        grid.sync();
        { Frame F; make_frame(F, ka, lds); rwkv_pass2(F); }
        grid.sync();
        { Frame F; make_frame(F, ka, lds); rwkv_pass<3>(F, l); }
        grid.sync();
#endif
        { Frame F; make_frame(F, ka, lds); run_gemm(F, (const bf16*)(F.ws + WS_XN), (const bf16*)(F.ws + WS_WG) + (size_t)l * NG * 1024, NG, 1024, pg8::EpiGates{(bf16*)(F.ws + WS_YA), (bf16*)(F.ws + WS_YB), (bf16*)(F.ws + WS_MG)}); }
        grid.sync();
        { Frame F; make_frame(F, ka, lds); run_gemm(F, (const bf16*)(F.ws + WS_YA), (const bf16*)(F.ws + WS_WBA) + (size_t)l * 1024 * 1024, 1024, 1024, pg8::EpiMerge<false>{(bf16*)(F.ws + WS_MERGED), (const bf16*)(F.ws + WS_MG)}); }
        { Frame F; make_frame(F, ka, lds); run_gemm(F, (const bf16*)(F.ws + WS_YB), (const bf16*)(F.ws + WS_WBB) + (size_t)l * 1024 * 512, 1024, 512, pg8::EpiMerge<true>{(bf16*)(F.ws + WS_MERGED), (const bf16*)(F.ws + WS_MG)}); }
        grid.sync();
        { Frame F; make_frame(F, ka, lds); run_gemm(F, (const bf16*)(F.ws + WS_MERGED), (const bf16*)(F.ws + WS_WO) + (size_t)l * 1024 * 1024, 1024, 1024,
              pg8::EpiResid{(l == 0) ? F.in[0] : F.out, F.out, (const float*)(F.ws + WS_MOD) + (size_t)l * 2 * 3072 + 2048}); }
        grid.sync();
    }
    { Frame F; make_frame(F, ka, lds); phase_final(F); }
}
extern "C" void kernel_launch(void* const* d_in, const int* in_sizes, int n_in, void* d_out, int out_size, void* d_ws, size_t ws_size, hipStream_t stream) {
    static int grid = 0;
    if (grid == 0) {
        int dev = 0, cus = 0, per_cu = 0;
        (void)hipGetDevice(&dev); (void)hipDeviceGetAttribute(&cus, hipDeviceAttributeMultiprocessorCount, dev);
        (void)hipFuncSetAttribute((const void*)fwd_kernel, hipFuncAttributeMaxDynamicSharedMemorySize, LDS_BYTES);
        (void)hipOccupancyMaxActiveBlocksPerMultiprocessor(&per_cu, (const void*)fwd_kernel, NTHREADS, LDS_BYTES);
        if (n_in != 28 || out_size != MROWS * DM || ws_size < (size_t)352 * MiB || per_cu < 1) { fprintf(stderr, "kernel_launch: unexpected problem (n_in %d out %d ws %zu per_cu %d)\n", n_in, out_size, ws_size, per_cu); }
        grid = cus;
        (void)hipGetLastError();
    }
    Args a{};
    for (int i = 0; i < 28; ++i) a.in[i] = (const float*)d_in[i];
    a.out = (float*)d_out; a.ws = (unsigned char*)d_ws;
    void* args[] = {&a};
    hipError_t e = hipLaunchCooperativeKernel((void*)fwd_kernel, dim3(grid), dim3(NTHREADS), args, LDS_BYTES, stream);
    if (e != hipSuccess) fprintf(stderr, "cooperative launch failed: %s (grid %d)\n", hipGetErrorString(e), grid);
}
```

```cpp
#include <hip/hip_runtime.h>
#include <hip/hip_cooperative_groups.h>
#include <cstdio>
#include <cstdint>
namespace cg = cooperative_groups;
namespace pg8 {
#define PG8_LAS __attribute__((address_space(3)))
typedef unsigned short bf16_t;
typedef short bf16x8 __attribute__((ext_vector_type(8)));
typedef float f32x4 __attribute__((ext_vector_type(4)));
typedef unsigned u32x4 __attribute__((ext_vector_type(4)));
constexpr int BM = 256, BK = 64, HALF = 128, HTB = HALF * BK * 2  , STAGE_BYTES = 8 * HTB, NXCD = 8, WGM = 8;

__host__ __device__ __forceinline__ int lds_byte(int r, int c) { const int st = (r >> 4) * 2 + (c >> 5), rr = r & 15, cc = c & 31, ob = rr * 64 + cc * 2; return st * 1024 + (ob ^ (((ob >> 9) & 1) << 5)); }
__host__ __device__ __forceinline__ void stage_rc(int b, int& R, int& C) { const int st = b / 1024, sb = b % 1024, swz = sb ^ (((sb >> 9) & 1) << 5); R = (st >> 1) * 16 + swz / 64; C = (st & 1) * 32 + (swz % 64) / 2; }
__host__ __device__ __forceinline__ int perm32(int rho) { const int n = rho >> 4, i = rho & 15; return 8 * (i >> 2) + 4 * n + (i & 3); }

struct Unit { int pm, pn; };
struct Gemm { const bf16_t* A; const bf16_t* Bt; int M, N, K; };

struct StaticOrder {
    int nM, nN, nwg, G, c;
    __host__ __device__ void init(int M, int N, int G_, int c_) { nM = M / BM; nN = N / BM; nwg = nM * nN; G = G_; c = c_; }
    __host__ __device__ bool next(int i, Unit& u) const {
        const long L = (long)i * G + c; if (L >= nwg) return false;
        int wgid = (int)L; { const int q = nwg / NXCD, r = nwg % NXCD, xcd = wgid % NXCD, off = wgid / NXCD; wgid = (xcd < r ? xcd * (q + 1) : r * (q + 1) + (xcd - r) * q) + off; }
        const int nig = WGM * nN, gid = wgid / nig, fm = gid * WGM, gsz = (nM - fm) < WGM ? (nM - fm) : WGM;
        u.pm = fm + ((wgid % nig) % gsz); u.pn = (wgid % nig) / gsz; return true;
    }
    __device__ __forceinline__ void a_ready(const Unit&) const {}
    __device__ __forceinline__ void done(const Unit&) const {}
};

__device__ __forceinline__ unsigned cvt_pk_bf16(float lo, float hi) { unsigned r; asm volatile("v_cvt_pk_bf16_f32 %0, %1, %2" : "=v"(r) : "v"(lo), "v"(hi)); return r; }
typedef float f32x2 __attribute__((ext_vector_type(2)));
template <class Epi, class Sched, bool ALIGN_EPI = false, bool SP2 = false>
__device__ __forceinline__ void gemm_phase(PG8_LAS unsigned char* lds, const Gemm g, const Sched& S, const Epi& E) {
    int tid_ = threadIdx.x; asm volatile("" : "+v"(tid_));
    const int tid = tid_, wid = __builtin_amdgcn_readfirstlane(tid >> 6), lane = tid & 63, wr = wid >> 2, wc = wid & 3, fr = lane & 15, fq = lane >> 4;
    const int K = g.K, nt = K / BK;
    unsigned voffA[2], voffB[2];
#pragma unroll
    for (int i = 0; i < 2; ++i) { int R, C; stage_rc(tid * 16 + i * 8192, R, C); const int Rb = Epi::PERM ? ((R & ~31) + perm32(R & 31)) : R;
        voffA[i] = (unsigned)(R * K + C) * 2u; voffB[i] = (unsigned)(Rb * K + C) * 2u; }
    const size_t kstep = (size_t)(BK * 2);
    const size_t hstep = (size_t)HALF * K * 2;
    const size_t tstep = 2 * hstep;
    const unsigned ldsw = (unsigned)wid * 1024u;
    const int aoff = lds_byte(wr * 64 + fr, fq * 8), boff = lds_byte(wc * 32 + fr, fq * 8);
#define PG8_SA(b, h) (((b) * 2 + (h)) * HTB)
#define PG8_SB(b, h) ((4 + (b) * 2 + (h)) * HTB)
#define PG8_STAGE(bufoff, gbase, voff) do { _Pragma("unroll") for (int _i = 0; _i < 2; ++_i) \
        __builtin_amdgcn_global_load_lds((const unsigned*)((const char*)(gbase) + (voff)[_i]), (PG8_LAS unsigned*)(lds + (bufoff) + ldsw + _i * 8192), 16, 0, 0); } while (0)
#define PG8_LDA(dst, b, h) do { _Pragma("unroll") for (int m = 0; m < 4; ++m) _Pragma("unroll") for (int k = 0; k < 2; ++k) dst[m][k] = *(const PG8_LAS bf16x8*)(lds + PG8_SA(b, h) + aoff + m * 2048 + k * 1024); } while (0)
#define PG8_LDB(dst, b, h) do { _Pragma("unroll") for (int n = 0; n < 2; ++n) _Pragma("unroll") for (int k = 0; k < 2; ++k) dst[n][k] = *(const PG8_LAS bf16x8*)(lds + PG8_SB(b, h) + boff + n * 2048 + k * 1024); } while (0)
#define PG8_MMA(ai, bj, At, Bt) do { __builtin_amdgcn_s_setprio(1); _Pragma("unroll") for (int m = 0; m < 4; ++m) _Pragma("unroll") for (int n = 0; n < 2; ++n) _Pragma("unroll") for (int k = 0; k < 2; ++k) \
        acc[ai][bj][m][n] = __builtin_amdgcn_mfma_f32_16x16x32_bf16(Bt[n][k], At[m][k], acc[ai][bj][m][n], 0, 0, 0); __builtin_amdgcn_s_setprio(0); } while (0)
#define PG8_WAIT_V(n) asm volatile("s_waitcnt vmcnt(" #n ")" ::: "memory")
#define PG8_WAIT_L(n) asm volatile("s_waitcnt lgkmcnt(" #n ")" ::: "memory")
#define PG8_BAR __builtin_amdgcn_s_barrier()
#define PG8_SCHED __builtin_amdgcn_sched_barrier(0)
    Unit cur, nxt; int ui = 0;
    if (!S.next(0, cur)) return;
    f32x4 acc[2][2][4][2];
#pragma unroll
    for (int a = 0; a < 2; ++a)
#pragma unroll
        for (int b = 0; b < 2; ++b)
#pragma unroll
            for (int m = 0; m < 4; ++m)
#pragma unroll
                for (int n = 0; n < 2; ++n) acc[a][b][m][n] = (f32x4){0.f, 0.f, 0.f, 0.f};
    bf16x8 At[4][2], B0[2][2], B1[2][2];
    const char* cA = (const char*)g.A + (size_t)cur.pm * tstep; const char* cB = (const char*)g.Bt + (size_t)cur.pn * tstep;
    S.a_ready(cur);
    if constexpr (SP2) {
        PG8_STAGE(PG8_SB(0, 0), cB, voffB); PG8_STAGE(PG8_SB(0, 1), cB + hstep, voffB); PG8_STAGE(PG8_SA(0, 0), cA, voffA); PG8_STAGE(PG8_SA(0, 1), cA + hstep, voffA);
        if (wr == 1) PG8_BAR;
        PG8_WAIT_V(2); PG8_BAR;
        PG8_STAGE(PG8_SB(1, 0), cB + kstep, voffB); PG8_STAGE(PG8_SA(1, 0), cA + kstep, voffA); PG8_STAGE(PG8_SB(1, 1), cB + hstep + kstep, voffB);
        PG8_WAIT_V(6); PG8_BAR;
    } else {
        PG8_STAGE(PG8_SB(0, 0), cB, voffB); PG8_STAGE(PG8_SA(0, 0), cA, voffA); PG8_STAGE(PG8_SB(0, 1), cB + hstep, voffB); PG8_STAGE(PG8_SA(0, 1), cA + hstep, voffA);
        if (wr == 1) PG8_BAR;
        PG8_WAIT_V(4); PG8_BAR;
        PG8_STAGE(PG8_SB(1, 0), cB + kstep, voffB); PG8_STAGE(PG8_SA(1, 0), cA + kstep, voffA); PG8_STAGE(PG8_SB(1, 1), cB + hstep + kstep, voffB);
        PG8_WAIT_V(6); PG8_BAR;
    }
    for (;;) {
        const bool has_next = S.next(ui + 1, nxt);
        const char* nA = has_next ? (const char*)g.A + (size_t)nxt.pm * tstep : cA; const char* nB = has_next ? (const char*)g.Bt + (size_t)nxt.pn * tstep : cB;
        for (int t = 0; t < nt; t += 2) {
            const bool last = (t == nt - 2);
            const char* a1 = cA + (size_t)(t + 1) * kstep;
            const char* a2 = last ? nA : cA + (size_t)(t + 2) * kstep; const char* b2 = last ? nB : cB + (size_t)(t + 2) * kstep;
            const char* a3 = a2 + kstep; const char* b3 = b2 + kstep;
            if (last && has_next) S.a_ready(nxt);
            if constexpr (SP2) {
            PG8_LDB(B0, 0, 0); PG8_LDB(B1, 0, 1); PG8_SCHED; PG8_LDA(At, 0, 0); PG8_STAGE(PG8_SA(1, 1), a1 + hstep, voffA);
            PG8_WAIT_V(8); PG8_WAIT_L(0); PG8_BAR; PG8_MMA(0, 0, At, B0); PG8_MMA(0, 1, At, B1); PG8_BAR; PG8_SCHED;
            PG8_LDA(At, 0, 1); PG8_STAGE(PG8_SB(0, 0), b2, voffB); PG8_STAGE(PG8_SB(0, 1), b2 + hstep, voffB); PG8_STAGE(PG8_SA(0, 0), a2, voffA);
            PG8_WAIT_V(8); PG8_WAIT_L(0); PG8_BAR; PG8_MMA(1, 0, At, B0); PG8_MMA(1, 1, At, B1); PG8_BAR; PG8_SCHED;
            PG8_LDB(B0, 1, 0); PG8_LDB(B1, 1, 1); PG8_SCHED; PG8_LDA(At, 1, 0); PG8_STAGE(PG8_SA(0, 1), a2 + hstep, voffA);
            PG8_WAIT_V(8); PG8_WAIT_L(0); PG8_BAR; PG8_MMA(0, 0, At, B0); PG8_MMA(0, 1, At, B1); PG8_BAR; PG8_SCHED;
            PG8_LDA(At, 1, 1); PG8_STAGE(PG8_SB(1, 0), b3, voffB); PG8_STAGE(PG8_SB(1, 1), b3 + hstep, voffB); PG8_STAGE(PG8_SA(1, 0), a3, voffA);
            PG8_WAIT_V(8); PG8_WAIT_L(0); PG8_BAR; PG8_MMA(1, 0, At, B0); PG8_MMA(1, 1, At, B1); PG8_BAR; PG8_SCHED;
            } else {
            PG8_LDB(B0, 0, 0); PG8_SCHED; PG8_LDA(At, 0, 0); PG8_STAGE(PG8_SA(1, 1), a1 + hstep, voffA);
            PG8_WAIT_L(8); PG8_BAR; PG8_WAIT_L(0); PG8_MMA(0, 0, At, B0); PG8_BAR; PG8_SCHED;
            PG8_LDB(B1, 0, 1); PG8_STAGE(PG8_SB(0, 0), b2, voffB);
            PG8_BAR; PG8_WAIT_L(0); PG8_MMA(0, 1, At, B1); PG8_BAR;
            PG8_LDA(At, 0, 1); PG8_STAGE(PG8_SA(0, 0), a2, voffA);
            PG8_BAR; PG8_WAIT_L(0); PG8_MMA(1, 0, At, B0); PG8_BAR; PG8_SCHED;
            PG8_STAGE(PG8_SB(0, 1), b2 + hstep, voffB);
            PG8_WAIT_V(6); PG8_BAR; PG8_MMA(1, 1, At, B1); PG8_BAR;
            PG8_LDB(B0, 1, 0); PG8_SCHED; PG8_LDA(At, 1, 0); PG8_STAGE(PG8_SA(0, 1), a2 + hstep, voffA);
            PG8_WAIT_L(8); PG8_BAR; PG8_WAIT_L(0); PG8_MMA(0, 0, At, B0); PG8_BAR; PG8_SCHED;
            PG8_LDB(B1, 1, 1); PG8_STAGE(PG8_SB(1, 0), b3, voffB);
            PG8_BAR; PG8_WAIT_L(0); PG8_MMA(0, 1, At, B1); PG8_BAR;
            PG8_LDA(At, 1, 1); PG8_STAGE(PG8_SA(1, 0), a3, voffA);
            PG8_BAR; PG8_WAIT_L(0); PG8_MMA(1, 0, At, B0); PG8_BAR; PG8_SCHED;
            PG8_STAGE(PG8_SB(1, 1), b3 + hstep, voffB);
            PG8_WAIT_V(6); PG8_BAR; PG8_MMA(1, 1, At, B1); PG8_BAR;
            }
        }
        if constexpr (ALIGN_EPI) { if (wr == 0) PG8_BAR; }
        if constexpr (!Epi::AFTER_DRAIN) { E(acc, cur, wr, wc, fr, fq); S.done(cur); }
        if (!has_next) break;
#pragma unroll
        for (int a = 0; a < 2; ++a)
#pragma unroll
            for (int b = 0; b < 2; ++b)
#pragma unroll
                for (int m = 0; m < 4; ++m)
#pragma unroll
                    for (int n = 0; n < 2; ++n) acc[a][b][m][n] = (f32x4){0.f, 0.f, 0.f, 0.f};
        cur = nxt; cA = nA; cB = nB; ++ui;
        if constexpr (ALIGN_EPI) { if (wr == 1) PG8_BAR; }
    }
    PG8_WAIT_V(0);
    if constexpr (!ALIGN_EPI) { if (wr == 0) PG8_BAR; }
    PG8_BAR;
    if constexpr (Epi::AFTER_DRAIN) { E.fused(acc, cur, wr, wc, fr, fq, lds, wid, lane); S.done(cur); }
#undef PG8_SA
#undef PG8_SB
#undef PG8_STAGE
#undef PG8_LDA
#undef PG8_LDB
#undef PG8_MMA
#undef PG8_WAIT_V
#undef PG8_WAIT_L
#undef PG8_BAR
#undef PG8_SCHED
}
}
namespace pg8 {
__device__ __forceinline__ float ep_bflo(unsigned w) { return __uint_as_float(w << 16); }
__device__ __forceinline__ float ep_bfhi(unsigned w) { return __uint_as_float(w & 0xffff0000u); }
__device__ __forceinline__ float ep_sigmoid(float x) { return 1.f / (1.f + __expf(-x)); }
struct EpiStore {
    static constexpr bool PERM = true, AFTER_DRAIN = false;
    bf16_t* O; int ldc;
    __device__ __forceinline__ void operator()(const f32x4 (&acc)[2][2][4][2], const Unit& u, int wr, int wc, int fr, int fq) const {
        const int row0 = u.pm * BM + wr * 64 + fr, col0 = u.pn * BM + wc * 32 + 8 * fq;
#pragma unroll
        for (int ai = 0; ai < 2; ++ai)
#pragma unroll
            for (int m = 0; m < 4; ++m) { bf16_t* rowp = O + (size_t)(row0 + ai * HALF + m * 16) * ldc + col0;
#pragma unroll
                for (int bj = 0; bj < 2; ++bj) { const f32x4 v0 = acc[ai][bj][m][0], v1 = acc[ai][bj][m][1]; u32x4 w;
                    w.x = cvt_pk_bf16(v0[0], v0[1]); w.y = cvt_pk_bf16(v0[2], v0[3]); w.z = cvt_pk_bf16(v1[0], v1[1]); w.w = cvt_pk_bf16(v1[2], v1[3]);
                    *(u32x4*)(rowp + bj * HALF) = w; } }
    }
};
struct EpiGates {
    static constexpr bool PERM = true, AFTER_DRAIN = false;
    bf16_t* YA; bf16_t* YB; bf16_t* MG;
    __device__ __forceinline__ void operator()(const f32x4 (&acc)[2][2][4][2], const Unit& u, int wr, int wc, int fr, int fq) const {
        const int colt = u.pn * BM; int mode, ld, cb; bf16_t* P;
        if (colt < 1024) { mode = 0; P = YA; ld = 1024; cb = colt; } else if (colt < 1536) { mode = 1; P = YB; ld = 512; cb = colt - 1024; } else { mode = 2; P = MG; ld = 2048; cb = colt - 1536; }
        const int row0 = u.pm * BM + wr * 64 + fr, col0 = cb + wc * 32 + 8 * fq;
#pragma unroll
        for (int ai = 0; ai < 2; ++ai)
#pragma unroll
            for (int m = 0; m < 4; ++m) { bf16_t* rowp = P + (size_t)(row0 + ai * HALF + m * 16) * ld + col0;
#pragma unroll
                for (int bj = 0; bj < 2; ++bj) { const f32x4 v0 = acc[ai][bj][m][0], v1 = acc[ai][bj][m][1]; float g[8] = {v0[0], v0[1], v0[2], v0[3], v1[0], v1[1], v1[2], v1[3]};
                    u32x4 w;
                    if (mode == 2) {
#pragma unroll
                        for (int e = 0; e < 8; ++e) g[e] = ep_sigmoid(g[e]);
                    } else {
                        const u32x4 y = *(const u32x4*)(rowp + bj * HALF);
                        const float yv[8] = {ep_bflo(y.x), ep_bfhi(y.x), ep_bflo(y.y), ep_bfhi(y.y), ep_bflo(y.z), ep_bfhi(y.z), ep_bflo(y.w), ep_bfhi(y.w)};
#pragma unroll
                        for (int e = 0; e < 8; ++e) g[e] = yv[e] * g[e] * ep_sigmoid(g[e]);
                    }
                    w.x = cvt_pk_bf16(g[0], g[1]); w.y = cvt_pk_bf16(g[2], g[3]); w.z = cvt_pk_bf16(g[4], g[5]); w.w = cvt_pk_bf16(g[6], g[7]);
                    *(u32x4*)(rowp + bj * HALF) = w; } }
    }
};
template <bool SECOND> struct EpiMerge {
    static constexpr bool PERM = true, AFTER_DRAIN = false;
    bf16_t* MERGED; const bf16_t* MG;
    __device__ __forceinline__ void operator()(const f32x4 (&acc)[2][2][4][2], const Unit& u, int wr, int wc, int fr, int fq) const {
        const int row0 = u.pm * BM + wr * 64 + fr, col0 = u.pn * BM + wc * 32 + 8 * fq;
#pragma unroll
        for (int ai = 0; ai < 2; ++ai)
#pragma unroll
            for (int m = 0; m < 4; ++m) { const size_t r = (size_t)(row0 + ai * HALF + m * 16);
#pragma unroll
                for (int bj = 0; bj < 2; ++bj) { const f32x4 v0 = acc[ai][bj][m][0], v1 = acc[ai][bj][m][1]; float g[8] = {v0[0], v0[1], v0[2], v0[3], v1[0], v1[1], v1[2], v1[3]};
                    const int c = col0 + bj * HALF;
                    const u32x4 s = *(const u32x4*)(MG + r * 2048 + (SECOND ? 1024 : 0) + c);
                    const float sv[8] = {ep_bflo(s.x), ep_bfhi(s.x), ep_bflo(s.y), ep_bfhi(s.y), ep_bflo(s.z), ep_bfhi(s.z), ep_bflo(s.w), ep_bfhi(s.w)};
                    bf16_t* dst = MERGED + r * 1024 + c;
                    if (SECOND) { const u32x4 p = *(const u32x4*)dst;
                        const float pv[8] = {ep_bflo(p.x), ep_bfhi(p.x), ep_bflo(p.y), ep_bfhi(p.y), ep_bflo(p.z), ep_bfhi(p.z), ep_bflo(p.w), ep_bfhi(p.w)};
#pragma unroll
                        for (int e = 0; e < 8; ++e) g[e] = pv[e] + sv[e] * g[e];
                    } else {
#pragma unroll
                        for (int e = 0; e < 8; ++e) g[e] = sv[e] * g[e];
                    }
                    u32x4 w; w.x = cvt_pk_bf16(g[0], g[1]); w.y = cvt_pk_bf16(g[2], g[3]); w.z = cvt_pk_bf16(g[4], g[5]); w.w = cvt_pk_bf16(g[6], g[7]);
                    *(u32x4*)dst = w; } }
    }
};
struct EpiResid {
    static constexpr bool PERM = false, AFTER_DRAIN = false;
    const float* xin; float* xout; const float* gate;
    __device__ __forceinline__ void operator()(const f32x4 (&acc)[2][2][4][2], const Unit& u, int wr, int wc, int fr, int fq) const {
        const int b = (u.pm * BM) / 8192; const float* gp = gate + b * 3072;
        const int row0 = u.pm * BM + wr * 64 + fr, col0 = u.pn * BM + wc * 32 + 4 * fq;
#pragma unroll
        for (int bj = 0; bj < 2; ++bj)
#pragma unroll
            for (int n = 0; n < 2; ++n) { const int c = col0 + bj * HALF + n * 16; const f32x4 gv = *(const f32x4*)(gp + c);
#pragma unroll
                for (int ai = 0; ai < 2; ++ai)
#pragma unroll
                    for (int m = 0; m < 4; ++m) { const size_t off = (size_t)(row0 + ai * HALF + m * 16) * 1024 + c;
                        const f32x4 xi = *(const f32x4*)(xin + off); *(f32x4*)(xout + off) = xi + gv * acc[ai][bj][m][n]; } }
    }
};
}
constexpr int BATCH = 2, SEQ = 8192, DM = 1024, MROWS = BATCH * SEQ, PROJW = 11264;
constexpr int NQKV = 4608, NA = 3584, NG = 3584, NLORA = 320;
constexpr size_t MiB = 1u << 20;
constexpr size_t WS_CTL = 0, WS_MOD = 1 * MiB;
constexpr size_t WS_WQKV = 2 * MiB, WS_WA = 20 * MiB, WS_WG = 34 * MiB, WS_WBA = 48 * MiB, WS_WBB = 52 * MiB, WS_WO = 54 * MiB;
constexpr size_t WS_VFIRST = 58 * MiB, WS_XN = 90 * MiB, WS_YB = 122 * MiB;
constexpr size_t WS_QKV = 138 * MiB, WS_PA = 138 * MiB, WS_YA = 250 * MiB, WS_MG = 138 * MiB, WS_MERGED = 202 * MiB, WS_SC = 282 * MiB;
constexpr int LDS_BYTES = 147456;
constexpr int NTHREADS = 512, NWAVES = 8;
#define LAS __attribute__((address_space(3)))
typedef unsigned short bf16;
typedef float f32x4 __attribute__((ext_vector_type(4)));
typedef unsigned u32x4 __attribute__((ext_vector_type(4)));
typedef unsigned u32x2 __attribute__((ext_vector_type(2)));

__device__ const unsigned char T5BUCKET[3][132] = {
 {0,1,2,3,4,5,6,7,8,9,10,11,12,13,14,15,16,16,16,16,16,16,17,17,17,17,17,17,17,17,18,18,18,18,18,18,18,18,18,18,19,19,19,19,19,19,19,19,19,19,19,19,19,19,20,20,20,20,20,20,20,20,20,20,20,20,20,20,20,20,20,20,20,21,21,21,21,21,21,21,21,21,21,21,21,21,21,21,21,21,21,21,21,21,21,21,21,21,21,22,22,22,22,22,22,22,22,22,22,22,22,22,22,22,22,22,22,22,22,22,22,22,22,22,22,22,22,22,22,0,0,0},
 {0,4,8,12,16,16,17,17,18,18,19,19,19,19,20,20,20,20,20,21,21,21,21,21,21,22,22,22,22,22,22,22,22,22,23,23,23,23,23,23,23,23,23,23,23,23,24,24,24,24,24,24,24,24,24,24,24,24,24,24,24,24,25,25,25,25,25,25,25,25,25,25,25,25,25,25,25,25,25,25,25,25,25,26,26,26,26,26,26,26,26,26,26,26,26,26,26,26,26,26,26,26,26,26,26,26,26,26,26,26,26,26,26,27,27,27,27,27,27,27,27,27,27,27,27,27,27,27,27,0,0,0},
 {0,16,18,19,20,21,21,22,22,23,23,23,24,24,24,24,25,25,25,25,25,26,26,26,26,26,26,26,26,27,27,27,27,27,27,27,27,27,27,28,28,28,28,28,28,28,28,28,28,28,28,28,29,29,29,29,29,29,29,29,29,29,29,29,29,29,29,29,29,29,30,30,30,30,30,30,30,30,30,30,30,30,30,30,30,30,30,30,30,30,30,30,30,30,30,31,31,31,31,31,31,31,31,31,31,31,31,31,31,31,31,31,31,31,31,31,31,31,31,31,31,31,31,31,31,31,31,31,31,0,0,0}};

__device__ __forceinline__ unsigned f2bf(float f) { unsigned u = __builtin_bit_cast(unsigned, f); return (u + 0x7fffu + ((u >> 16) & 1u)) >> 16; }
__device__ __forceinline__ unsigned pk2(float lo, float hi) { return f2bf(lo) | (f2bf(hi) << 16); }
__device__ __forceinline__ float bflo(unsigned w) { return __uint_as_float(w << 16); }
__device__ __forceinline__ float bfhi(unsigned w) { return __uint_as_float(w & 0xffff0000u); }
__device__ __forceinline__ float bf2f(bf16 h) { return __uint_as_float(((unsigned)h) << 16); }
__device__ __forceinline__ float wave_sum(float v) {
#pragma unroll
    for (int o = 1; o < 64; o <<= 1) v += __shfl_xor(v, o);
    return v;
}
__device__ __forceinline__ float wave_max(float v) {
#pragma unroll
    for (int o = 1; o < 64; o <<= 1) v = fmaxf(v, __shfl_xor(v, o));
    return v;
}
__device__ __forceinline__ float sigmoidf_(float x) { return 1.f / (1.f + __expf(-x)); }
__device__ __forceinline__ float siluf_(float x) { return x / (1.f + __expf(-x)); }

struct Args { const float* in[28]; float* out; unsigned char* ws; };
typedef const __attribute__((address_space(4))) Args* KArgs;
struct Frame {
    LAS unsigned char* lds;
    int tid, lane, wave, G, bid;
    const float* in[28]; float* out; unsigned char* ws;
};
__device__ __forceinline__ void make_frame(Frame& F, KArgs ka, unsigned char* lds) {
    asm volatile("" : "+s"(ka));
    int t = threadIdx.x; asm volatile("" : "+v"(t));
    F.lds = (LAS unsigned char*)lds; F.tid = t; F.lane = t & 63; F.wave = __builtin_amdgcn_readfirstlane(t >> 6); F.G = gridDim.x; F.bid = blockIdx.x;
#pragma unroll
    for (int i = 0; i < 28; ++i) F.in[i] = ka->in[i];
    F.out = ka->out; F.ws = ka->ws;
}
__device__ __forceinline__ void p0_mod(Frame& F) {
    const float* c = F.in[1]; const float* ada_w = F.in[3]; const float* ada_b = F.in[4];
    float* mod = (float*)(F.ws + WS_MOD);
    LAS float* red = (LAS float*)F.lds;
    const int col = F.tid & 31, kg = F.tid >> 5;
    for (int ch = F.bid; ch < 192; ch += F.G) {
        const int l = ch / 96, n = (ch % 96) * 32 + col;
        const float* W = ada_w + (size_t)l * 1024 * 3072 + n;
        float a0 = 0.f, a1 = 0.f;
        for (int i = 0; i < 64; ++i) { const int k = kg + 16 * i; const float w = W[(size_t)k * 3072]; a0 += siluf_(c[k]) * w; a1 += siluf_(c[1024 + k]) * w; }
        red[kg * 32 + col] = a0; red[512 + kg * 32 + col] = a1;
        __syncthreads();
        if (F.tid < 64) { const int b = F.tid >> 5; float s = 0.f;
            for (int g = 0; g < 16; ++g) s += red[b * 512 + g * 32 + col];
            mod[(size_t)(l * 2 + b) * 3072 + n] = s + ada_b[l * 3072 + n]; }
        __syncthreads();
    }
}
__device__ __forceinline__ void transpose_item(const float* W, int ldw, int col0, int K, int ncols, bf16* WT, LAS float* scr, int item, int lane) {
    const int nblk = ncols / 32, kb = item / nblk, nb = item % nblk, k0 = 64 * kb, n0 = 32 * nb;
#pragma unroll 8
    for (int i = 0; i < 32; ++i) { const int kk = 2 * i + (lane >> 5); scr[kk * 33 + (lane & 31)] = W[(size_t)(k0 + kk) * ldw + col0 + n0 + (lane & 31)]; }
    asm volatile("s_waitcnt lgkmcnt(0)" ::: "memory");
    const int c = lane & 7;
#pragma unroll
    for (int j = 0; j < 4; ++j) { const int n = (lane >> 3) + 8 * j; const LAS float* s = scr + (8 * c) * 33 + n;
        u32x4 o; o.x = pk2(s[0 * 33], s[1 * 33]); o.y = pk2(s[2 * 33], s[3 * 33]); o.z = pk2(s[4 * 33], s[5 * 33]); o.w = pk2(s[6 * 33], s[7 * 33]);
        *(u32x4*)(WT + (size_t)(n0 + n) * K + k0 + 8 * c) = o; }
    asm volatile("s_waitcnt lgkmcnt(0)" ::: "memory");
}
__device__ __forceinline__ void p0_weights(Frame& F) {
    LAS float* scr = (LAS float*)(F.lds + 16384 + F.wave * 16384);
    const int gw = F.bid * NWAVES + F.wave, NGW = F.G * NWAVES;
    constexpr int I_QKV = 16 * 144, I_A = 16 * 96, I_GA = 16 * 32, I_GB = 16 * 16, I_M = 16 * 64, I_BA = 16 * 32, I_BB = 8 * 32, I_O = 16 * 32;
    constexpr int PER_L = I_QKV + I_A + I_GA + I_GB + I_M + I_BA + I_BB + I_O;
    for (int it = gw; it < 2 * PER_L; it += NGW) {
        const int l = it / PER_L; int r = it % PER_L;
        const float* win = F.in[5] + (size_t)l * 1024 * PROJW;
        bf16* wqkv = (bf16*)(F.ws + WS_WQKV) + (size_t)l * NQKV * 1024;
        bf16* wa = (bf16*)(F.ws + WS_WA) + (size_t)l * NA * 1024;
        bf16* wg = (bf16*)(F.ws + WS_WG) + (size_t)l * NG * 1024;
        if (r < I_QKV) { transpose_item(win, PROJW, 4096, 1024, 4608, wqkv, scr, r, F.lane); continue; } r -= I_QKV;
        if (r < I_A) { transpose_item(win, PROJW, 0, 1024, 3072, wa, scr, r, F.lane); continue; } r -= I_A;
        if (r < I_GA) { transpose_item(win, PROJW, 3072, 1024, 1024, wg, scr, r, F.lane); continue; } r -= I_GA;
        if (r < I_GB) { transpose_item(win, PROJW, 8704, 1024, 512, wg + (size_t)1024 * 1024, scr, r, F.lane); continue; } r -= I_GB;
        if (r < I_M) { transpose_item(win, PROJW, 9216, 1024, 2048, wg + (size_t)1536 * 1024, scr, r, F.lane); continue; } r -= I_M;
        if (r < I_BA) { transpose_item(F.in[23] + (size_t)l * 1024 * 1024, 1024, 0, 1024, 1024, (bf16*)(F.ws + WS_WBA) + (size_t)l * 1024 * 1024, scr, r, F.lane); continue; } r -= I_BA;
        if (r < I_BB) { transpose_item(F.in[24] + (size_t)l * 512 * 1024, 1024, 0, 512, 1024, (bf16*)(F.ws + WS_WBB) + (size_t)l * 1024 * 512, scr, r, F.lane); continue; } r -= I_BB;
        transpose_item(F.in[25] + (size_t)l * 1024 * 1024, 1024, 0, 1024, 1024, (bf16*)(F.ws + WS_WO) + (size_t)l * 1024 * 1024, scr, r, F.lane);
    }
    const size_t gt = (size_t)F.bid * NTHREADS + F.tid, NGT = (size_t)F.G * NTHREADS;
    for (size_t e = gt; e < (size_t)2 * 512 * 1024; e += NGT) {
        const int l = (int)(e / (512 * 1024)), n = (int)((e / 1024) % 512), k = (int)(e % 1024);
        const float muw = F.in[7][(size_t)(l * 2 + 0) * 1024 + k], mua = F.in[7][(size_t)(l * 2 + 1) * 1024 + k];
        float v = 0.f;
        if (n < 64) v = F.in[9][((size_t)l * 1024 + k) * 64 + n] * (1.f - muw);
        else if (n < 128) v = F.in[9][((size_t)l * 1024 + k) * 64 + (n - 64)] * muw;
        else if (n < 192) v = F.in[12][((size_t)l * 1024 + k) * 64 + (n - 128)] * (1.f - mua);
        else if (n < 256) v = F.in[12][((size_t)l * 1024 + k) * 64 + (n - 192)] * mua;
        else if (n < 320 && l == 1) { const float muv = F.in[19][k]; const int m = (n - 256) & 31; const float w = F.in[21][(size_t)k * 32 + m]; v = (n < 288) ? w * (1.f - muv) : w * muv; }
        ((bf16*)(F.ws + WS_WA))[((size_t)l * NA + 3072 + n) * 1024 + k] = (bf16)f2bf(v);
    }
}
__device__ __forceinline__ void phase_modnorm(Frame& F, int l, const float* xin) {
    const float* mod = (const float*)(F.ws + WS_MOD) + (size_t)l * 2 * 3072;
    const float* g = F.in[2] + l * 1024;
    bf16* XN = (bf16*)(F.ws + WS_XN);
    const int gw = F.bid * NWAVES + F.wave, NGW = F.G * NWAVES;
    for (int m = gw; m < MROWS; m += NGW) {
        const int b = m / SEQ; const f32x4* xr = (const f32x4*)(xin + (size_t)m * 1024) + F.lane;
        f32x4 v[4]; float s = 0.f;
#pragma unroll
        for (int j = 0; j < 4; ++j) { v[j] = xr[64 * j]; s += (v[j].x * v[j].x + v[j].y * v[j].y) + (v[j].z * v[j].z + v[j].w * v[j].w); }
        const float rs = 1.f / sqrtf(wave_sum(s) * (1.f / 1024.f) + 1e-6f);
        u32x2* o = (u32x2*)(XN + (size_t)m * 1024) + F.lane;
#pragma unroll
        for (int j = 0; j < 4; ++j) { const int c = 4 * F.lane + 256 * j;
            const f32x4 gg = *(const f32x4*)(g + c), sh = *(const f32x4*)(mod + b * 3072 + c), sc = *(const f32x4*)(mod + b * 3072 + 1024 + c);
            const f32x4 h = v[j] * rs * gg * (sc + 1.f) + sh; u32x2 w; w.x = pk2(h.x, h.y); w.y = pk2(h.z, h.w); o[64 * j] = w; }
    }
}
__device__ __forceinline__ void phase_final(Frame& F) {
    const float* g = F.in[27]; const int gw = F.bid * NWAVES + F.wave, NGW = F.G * NWAVES;
    for (int m = gw; m < MROWS; m += NGW) {
        f32x4* xr = (f32x4*)(F.out + (size_t)m * 1024) + F.lane; f32x4 v[4]; float s = 0.f;
#pragma unroll
        for (int j = 0; j < 4; ++j) { v[j] = xr[64 * j]; s += (v[j].x * v[j].x + v[j].y * v[j].y) + (v[j].z * v[j].z + v[j].w * v[j].w); }
        const float rs = 1.f / sqrtf(wave_sum(s) * (1.f / 1024.f) + 1e-6f);
#pragma unroll
        for (int j = 0; j < 4; ++j) { const f32x4 gg = *(const f32x4*)(g + 4 * F.lane + 256 * j); xr[64 * j] = v[j] * rs * gg; }
    }
}
__device__ __forceinline__ void phase_attn_naive(Frame& F) {
    const bf16* QKV = (const bf16*)(F.ws + WS_QKV); bf16* YB = (bf16*)(F.ws + WS_YB); const float* rel_bias = F.in[26];
    LAS float* QS = (LAS float*)(F.lds) + F.wave * 640;
    LAS float* PS = QS + 192;
    const int gw = F.bid * NWAVES + F.wave, NGW = F.G * NWAVES, lane = F.lane;
    for (int it = gw; it < MROWS * 8; it += NGW) {
        const int row = it >> 3, h = it & 7, b = row / SEQ, t = row % SEQ;
        const bf16* qrow = QKV + (size_t)row * NQKV;
#pragma unroll
        for (int g = 0; g < 3; ++g) QS[g * 64 + lane] = bf2f(qrow[g * 512 + h * 64 + lane]) * 0.125f;
        __builtin_amdgcn_wave_barrier();
        float sc[3][3]; float mx = -1e30f;
#pragma unroll
        for (int g = 0; g < 3; ++g) { const int dil = (g == 0) ? 1 : (g == 1 ? 4 : 16);
#pragma unroll
            for (int jj = 0; jj < 3; ++jj) { const int j = lane + 64 * jj; const int tk = t - j * dil; float s = -1e30f;
                if (j <= 128 && tk >= 0) {
                    const u32x4* kp = (const u32x4*)(QKV + (size_t)(b * SEQ + tk) * NQKV + 1536 + g * 512 + h * 64);
                    float a = 0.f;
#pragma unroll
                    for (int c8 = 0; c8 < 8; ++c8) { const u32x4 kv = kp[c8]; const LAS float* q = QS + g * 64 + c8 * 8;
                        a += q[0] * bflo(kv.x) + q[1] * bfhi(kv.x) + q[2] * bflo(kv.y) + q[3] * bfhi(kv.y) + q[4] * bflo(kv.z) + q[5] * bfhi(kv.z) + q[6] * bflo(kv.w) + q[7] * bfhi(kv.w); }
                    s = a + rel_bias[(int)T5BUCKET[g][j] * 24 + g * 8 + h];
                }
                sc[g][jj] = s; mx = fmaxf(mx, s); } }
        mx = wave_max(mx);
        float den = 0.f;
#pragma unroll
        for (int g = 0; g < 3; ++g)
#pragma unroll
            for (int jj = 0; jj < 3; ++jj) { const int j = lane + 64 * jj; const float p = (sc[g][jj] > -1e29f) ? __expf(sc[g][jj] - mx) : 0.f; den += p; if (j <= 128) PS[g * 132 + j] = p; }
        den = wave_sum(den);
        __builtin_amdgcn_wave_barrier();
        float o = 0.f;
#pragma unroll
        for (int g = 0; g < 3; ++g) { const int dil = (g == 0) ? 1 : (g == 1 ? 4 : 16); const int jmax = min(128, t / dil);
            const bf16* vp = QKV + (size_t)(b * SEQ + t) * NQKV + 3072 + g * 512 + h * 64 + lane;
            for (int j = 0; j <= jmax; ++j) o += PS[g * 132 + j] * bf2f(vp[-(ptrdiff_t)j * dil * NQKV]); }
        YB[(size_t)row * 512 + h * 64 + lane] = (bf16)f2bf(o / den);
        __builtin_amdgcn_wave_barrier();
    }
}
__device__ __forceinline__ float softplusf_(float x) { return fmaxf(x, 0.f) + log1pf(__expf(-fabsf(x))); }
__device__ __forceinline__ void phase_rwkv_naive(Frame& F, int l) {
    if (F.bid >= 32) return;
    constexpr int TB = 16;
    const int b = F.bid >> 4, h = F.bid & 15, tid = F.tid, lane = F.lane, wave = F.wave;
    const bf16* PA = (const bf16*)(F.ws + WS_PA); bf16* YA = (bf16*)(F.ws + WS_YA); bf16* VF = (bf16*)(F.ws + WS_VFIRST);
    LAS float* L = (LAS float*)F.lds;
    LAS float* W2s = L; LAS float* A2s = L + 4096; LAS float* V2s = L + 8192; LAS float* CV = L + 10240;
    LAS float* PRs = L + 11264; LAS float* PKs = PRs + 17 * 64; LAS float* PVs = PKs + 17 * 64; LAS float* LOs = PVs + 17 * 64;
    LAS float* LWs = LOs + 17 * 320; LAS float* LAs = LWs + TB * 64; LAS float* LVs = LAs + TB * 64;
    LAS float* Rs = LVs + TB * 32; LAS float* Ws = Rs + TB * 64; LAS float* Ks = Ws + TB * 64; LAS float* Vs = Ks + TB * 64; LAS float* As = Vs + TB * 64; LAS float* Bs = As + TB * 64;
    LAS float* RKs = Bs + TB * 64; LAS float* Ys = RKs + TB;
    for (int e = tid; e < 4096; e += NTHREADS) { const int m = e >> 6, j = e & 63;
        W2s[e] = F.in[10][((size_t)l * 64 + m) * 1024 + h * 64 + j]; A2s[e] = F.in[13][((size_t)l * 64 + m) * 1024 + h * 64 + j];
        if (m < 32) V2s[e] = (l == 1) ? F.in[22][(size_t)m * 1024 + h * 64 + j] : 0.f; }
    if (tid < 64) { const int c = h * 64 + tid;
        CV[0 * 64 + tid] = F.in[8][l * 1024 + c];  CV[1 * 64 + tid] = F.in[11][l * 1024 + c]; CV[2 * 64 + tid] = (l == 1) ? F.in[20][c] : 0.f;
        CV[3 * 64 + tid] = F.in[14][l * 1024 + c]; CV[4 * 64 + tid] = F.in[15][l * 1024 + c]; CV[5 * 64 + tid] = F.in[16][l * 1024 + c];
        CV[6 * 64 + tid] = F.in[17][l * 1024 + c]; CV[7 * 64 + tid] = F.in[18][l * 1024 + c];
        CV[8 * 64 + tid] = F.in[6][(size_t)(l * 3 + 0) * 1024 + c]; CV[9 * 64 + tid] = F.in[6][(size_t)(l * 3 + 1) * 1024 + c]; CV[10 * 64 + tid] = F.in[6][(size_t)(l * 3 + 2) * 1024 + c]; }
    float S[16];
#pragma unroll
    for (int q = 0; q < 16; ++q) S[q] = 0.f;
    __syncthreads();
    for (int t0 = 0; t0 < SEQ; t0 += TB) {
        for (int e = tid; e < 17 * 512; e += NTHREADS) { const int rr = e >> 9, cc = e & 511, t = t0 - 1 + rr; float v = 0.f;
            if (t >= 0) { const int gc = (cc < 192) ? ((cc >> 6) * 1024 + h * 64 + (cc & 63)) : (3072 + cc - 192); v = bf2f(PA[(size_t)(b * SEQ + t) * NA + gc]); }
            if (cc < 64) PRs[rr * 64 + cc] = v; else if (cc < 128) PKs[rr * 64 + cc - 64] = v; else if (cc < 192) PVs[rr * 64 + cc - 128] = v; else LOs[rr * 320 + cc - 192] = v; }
        __syncthreads();
        for (int e = tid; e < TB * 160; e += NTHREADS) { const int tl = e / 160, m = e % 160; const LAS float* cur = LOs + (tl + 1) * 320; const LAS float* prv = LOs + tl * 320;
            if (m < 64) LWs[tl * 64 + m] = tanhf(cur[m] + prv[64 + m]);
            else if (m < 128) LAs[tl * 64 + m - 64] = cur[128 + m - 64] + prv[192 + m - 64];
            else LVs[tl * 32 + m - 128] = cur[256 + m - 128] + prv[288 + m - 128]; }
        __syncthreads();
        for (int tl = wave; tl < TB; tl += NWAVES) { const int j = lane; const size_t row = (size_t)(b * SEQ + t0 + tl);
            float wpre = CV[j], apre = CV[64 + j], vpre = CV[128 + j];
            for (int m = 0; m < 64; ++m) { wpre += LWs[tl * 64 + m] * W2s[m * 64 + j]; apre += LAs[tl * 64 + m] * A2s[m * 64 + j]; }
            for (int m = 0; m < 32; ++m) vpre += LVs[tl * 32 + m] * V2s[m * 64 + j];
            const float pr = PRs[(tl + 1) * 64 + j], prp = PRs[tl * 64 + j], pk = PKs[(tl + 1) * 64 + j], pkp = PKs[tl * 64 + j], pv = PVs[(tl + 1) * 64 + j], pvp = PVs[tl * 64 + j];
            const float r = pr + (prp - pr) * CV[8 * 64 + j], k = pk + (pkp - pk) * CV[9 * 64 + j]; float v = pv + (pvp - pv) * CV[10 * 64 + j];
            const float w = -softplusf_(-wpre) - 0.5f; const float decay = __expf(-__expf(w)); const float asig = sigmoidf_(apre);
            if (l == 0) VF[row * 1024 + h * 64 + j] = (bf16)f2bf(v); else { const float vf = bf2f(VF[row * 1024 + h * 64 + j]); v = v + (vf - v) * sigmoidf_(vpre); }
            const float kk = k * CV[3 * 64 + j]; const float ss = wave_sum(kk * kk); const float kkn = kk * (1.f / sqrtf(fmaxf(ss, 1e-24f)));
            const float k2 = k * (1.f + (asig - 1.f) * CV[4 * 64 + j]);
            const float rk = wave_sum(r * k2 * CV[5 * 64 + j]);
            Rs[tl * 64 + j] = r; Ws[tl * 64 + j] = decay; Ks[tl * 64 + j] = k2; Vs[tl * 64 + j] = v; As[tl * 64 + j] = -kkn; Bs[tl * 64 + j] = kkn * asig;
            if (lane == 0) RKs[tl] = rk; }
        __syncthreads();
        if (wave < 4) { const int i = wave * 16 + (lane >> 2), jq = lane & 3;
            for (int tl = 0; tl < TB; ++tl) { const int o = tl * 64 + jq * 16; const float vi = Vs[tl * 64 + i];
                float sa = 0.f;
#pragma unroll
                for (int q = 0; q < 16; ++q) sa += S[q] * As[o + q];
                sa += __shfl_xor(sa, 1); sa += __shfl_xor(sa, 2);
                float y = 0.f;
#pragma unroll
                for (int q = 0; q < 16; ++q) { S[q] = S[q] * Ws[o + q] + sa * Bs[o + q] + vi * Ks[o + q]; y += S[q] * Rs[o + q]; }
                y += __shfl_xor(y, 1); y += __shfl_xor(y, 2);
                if (jq == 0) Ys[tl * 64 + i] = y; } }
        __syncthreads();
        for (int tl = wave; tl < TB; tl += NWAVES) { const int i = lane; const size_t row = (size_t)(b * SEQ + t0 + tl);
            const float y = Ys[tl * 64 + i]; const float mean = wave_sum(y) * (1.f / 64.f); const float d = y - mean; const float var = wave_sum(d * d) * (1.f / 64.f);
            const float o = d * (1.f / sqrtf(var + 64e-5f)) * CV[6 * 64 + i] + CV[7 * 64 + i] + RKs[tl] * Vs[tl * 64 + i];
            YA[row * 1024 + h * 64 + i] = (bf16)f2bf(o); }
    }
}
typedef short bf16x8 __attribute__((ext_vector_type(8)));
typedef short s16x4 __attribute__((ext_vector_type(4)));
typedef short v4i16_t __attribute__((ext_vector_type(4)));
constexpr int RC = 32, RLS = 256, RNSC = SEQ / RLS, RNCH = RLS / RC, RITEMS = BATCH * 16 * RNSC;
constexpr int AST = 72;
constexpr int MST = 40;
constexpr int OFF_RAWH = 0, OFF_RAWL = 12800, OFF_MK = 12800, OFF_QB = 15360, OFF_QK = 17920, OFF_YS = 20480;
constexpr int OFF_LW = 34048, OFF_LA = OFF_LW + 4608, OFF_LV = OFF_LA + 4608;
constexpr int OFF_W2T = 45824, OFF_A2T = OFF_W2T + 9216, OFF_V2T = OFF_A2T + 9216;
constexpr int OFF_CV = 69376, OFF_GAM = 72192, OFF_RK = 72448;
constexpr int OFF_PRE = 72576, OFF_U = 72576, OFF_T = OFF_U + 8704;
constexpr int OFF_LWG = 97664, OFF_ARR = 105856;
constexpr int PRE_ST = 196, U_ST = 68, T_ST = 36, YS_ST = 68;
enum { AR_RT = 0, AR_AT, AR_BT, AR_KT, AR_BH, AR_KH, AR_V, AR_W };
static_assert(OFF_ARR + 8 * 32 * AST * 2 <= LDS_BYTES, "rwkv LDS map");
#define ARR(k) (F.lds + OFF_ARR + (k) * (32 * AST * 2))

__device__ __forceinline__ bf16x8 ld_b128(const LAS unsigned char* p) { return *(const LAS bf16x8*)p; }
__device__ __forceinline__ s16x4 ld_b64(const LAS unsigned char* p) { return *(const LAS s16x4*)p; }
__device__ __forceinline__ s16x4 ld_tr(const LAS unsigned char* p) { return __builtin_bit_cast(s16x4, __builtin_amdgcn_ds_read_tr16_b64_v4i16((LAS v4i16_t*)p)); }
__device__ __forceinline__ bf16x8 cat8(s16x4 a, s16x4 b) { return (bf16x8){a[0], a[1], a[2], a[3], b[0], b[1], b[2], b[3]}; }
__device__ __forceinline__ bf16x8 pack8(f32x4 a, f32x4 b) { u32x4 w; w.x = pk2(a[0], a[1]); w.y = pk2(a[2], a[3]); w.z = pk2(b[0], b[1]); w.w = pk2(b[2], b[3]); return __builtin_bit_cast(bf16x8, w); }
#define MFMA16(a, b, c) __builtin_amdgcn_mfma_f32_16x16x32_bf16((a), (b), (c), 0, 0, 0)
__device__ __forceinline__ void st_bf(LAS unsigned char* base, int idx, float v) { ((LAS bf16*)base)[idx] = (bf16)f2bf(v); }

template <int PASS> __device__ __forceinline__ void rwkv_pass(Frame& F, int l) {
    const int tid = F.tid, lane = F.lane, wave = F.wave, g = lane >> 4, c = lane & 15;
    const bf16* PA = (const bf16*)(F.ws + WS_PA); bf16* YA = (bf16*)(F.ws + WS_YA); bf16* VF = (bf16*)(F.ws + WS_VFIRST);
    float* PD = (float*)(F.ws + WS_SC); float* SST = (float*)(F.ws + WS_SC + 32 * MiB);
    LAS float* CV = (LAS float*)(F.lds + OFF_CV); LAS float* GAM = (LAS float*)(F.lds + OFF_GAM); LAS float* RK = (LAS float*)(F.lds + OFF_RK);
    LAS float* PRE = (LAS float*)(F.lds + OFF_PRE); LAS float* Us = (LAS float*)(F.lds + OFF_U); LAS float* Ts = (LAS float*)(F.lds + OFF_T);
    LAS float* LWG = (LAS float*)(F.lds + OFF_LWG); LAS float* YS = (LAS float*)(F.lds + OFF_YS);
    LAS bf16* RAWH = (LAS bf16*)(F.lds + OFF_RAWH); LAS bf16* RAWL = (LAS bf16*)(F.lds + OFF_RAWL);
    for (int it = F.bid; it < RITEMS; it += F.G) {
        const int b = it / (16 * RNSC), h = (it / RNSC) % 16, sc = it % RNSC;
        __syncthreads();
        for (int e = tid; e < 4096; e += NTHREADS) { const int m = e >> 6, j = e & 63;
            st_bf(F.lds + OFF_W2T, j * AST + m, F.in[10][((size_t)l * 64 + m) * 1024 + h * 64 + j]);
            st_bf(F.lds + OFF_A2T, j * AST + m, F.in[13][((size_t)l * 64 + m) * 1024 + h * 64 + j]);
            if (m < 32) st_bf(F.lds + OFF_V2T, j * MST + m, (l == 1) ? F.in[22][(size_t)m * 1024 + h * 64 + j] : 0.f); }
        if (tid < 64) { const int cc = h * 64 + tid;
            CV[0 * 64 + tid] = F.in[8][l * 1024 + cc];  CV[1 * 64 + tid] = F.in[11][l * 1024 + cc]; CV[2 * 64 + tid] = (l == 1) ? F.in[20][cc] : 0.f;
            CV[3 * 64 + tid] = F.in[14][l * 1024 + cc]; CV[4 * 64 + tid] = F.in[15][l * 1024 + cc]; CV[5 * 64 + tid] = F.in[16][l * 1024 + cc];
            CV[6 * 64 + tid] = F.in[17][l * 1024 + cc]; CV[7 * 64 + tid] = F.in[18][l * 1024 + cc];
            CV[8 * 64 + tid] = F.in[6][(size_t)(l * 3 + 0) * 1024 + cc]; CV[9 * 64 + tid] = F.in[6][(size_t)(l * 3 + 1) * 1024 + cc]; CV[10 * 64 + tid] = F.in[6][(size_t)(l * 3 + 2) * 1024 + cc]; }
        f32x4 X[4];
#pragma unroll
        for (int jt = 0; jt < 4; ++jt) X[jt] = (f32x4){0.f, 0.f, 0.f, 0.f};
        if (PASS == 1) { if (wave >= 4) {
#pragma unroll
                for (int jt = 0; jt < 4; ++jt)
#pragma unroll
                    for (int r = 0; r < 4; ++r) X[jt][r] = (16 * jt + 4 * g + r == 16 * (wave - 4) + c) ? 1.f : 0.f; } }
        else if (wave < 4) { const float* s0 = SST + (size_t)it * 4096;
#pragma unroll
            for (int jt = 0; jt < 4; ++jt)
#pragma unroll
                for (int r = 0; r < 4; ++r) X[jt][r] = s0[(16 * jt + 4 * g + r) * 64 + 16 * wave + c]; }
        for (int ch = 0; ch < RNCH; ++ch) {
            const int t0 = sc * RLS + ch * RC;
            __syncthreads();
            for (int e = tid; e < 33 * 64; e += NTHREADS) { const int rr = e >> 6, k = e & 63, t = t0 - 1 + rr; u32x4 v = (u32x4){0u, 0u, 0u, 0u};
                const int gc = (k < 24) ? ((k >> 3) * 1024 + h * 64 + (k & 7) * 8) : (3072 + (k - 24) * 8);
                if (t >= 0) v = *(const u32x4*)(PA + (size_t)(b * SEQ + t) * NA + gc);
                if (k < 24) *(LAS u32x4*)(RAWH + rr * 192 + k * 8) = v; else *(LAS u32x4*)(RAWL + rr * 320 + (k - 24) * 8) = v; }
            __syncthreads();
            for (int e = tid; e < 32 * 160; e += NTHREADS) { const int tl = e / 160, m = e % 160; const LAS bf16* cur = RAWL + (tl + 1) * 320; const LAS bf16* prv = RAWL + tl * 320;
                if (m < 64) st_bf(F.lds + OFF_LW, tl * AST + m, tanhf(bf2f(cur[m]) + bf2f(prv[64 + m])));
                else if (m < 128) st_bf(F.lds + OFF_LA, tl * AST + (m - 64), bf2f(cur[128 + m - 64]) + bf2f(prv[192 + m - 64]));
                else st_bf(F.lds + OFF_LV, tl * MST + (m - 128), bf2f(cur[256 + m - 128]) + bf2f(prv[288 + m - 128])); }
            __syncthreads();
#pragma unroll
            for (int q = 0; q < 3; ++q) { const int tile = wave * 3 + q, tt = tile / 12, nt = tile % 12, mat = nt >> 2, jt = nt & 3;
                f32x4 acc = (f32x4){0.f, 0.f, 0.f, 0.f};
                if (mat < 2) { const LAS unsigned char* Ab = F.lds + (mat == 0 ? OFF_LW : OFF_LA) + ((16 * tt + c) * AST + 8 * g) * 2; const LAS unsigned char* Bb = F.lds + (mat == 0 ? OFF_W2T : OFF_A2T) + ((16 * jt + c) * AST + 8 * g) * 2;
                    acc = MFMA16(ld_b128(Ab), ld_b128(Bb), acc); acc = MFMA16(ld_b128(Ab + 64), ld_b128(Bb + 64), acc); }
                else { const LAS unsigned char* Ab = F.lds + OFF_LV + ((16 * tt + c) * MST + 8 * g) * 2; const LAS unsigned char* Bb = F.lds + OFF_V2T + ((16 * jt + c) * MST + 8 * g) * 2;
                    acc = MFMA16(ld_b128(Ab), ld_b128(Bb), acc); }
#pragma unroll
                for (int r = 0; r < 4; ++r) PRE[(16 * tt + 4 * g + r) * PRE_ST + 16 * nt + c] = acc[r]; }
            __syncthreads();
            for (int e = tid; e < 32 * 64; e += NTHREADS) { const int t = e >> 6, j = e & 63; const float wpre = PRE[t * PRE_ST + j] + CV[j];
                const float w = -softplusf_(-wpre) - 0.5f; LWG[t * 64 + j] = -__expf(w); }
            __syncthreads();
            if (tid < 64) { float a = 0.f;
#pragma unroll 8
                for (int t = 0; t < 32; ++t) { a += LWG[t * 64 + tid]; LWG[t * 64 + tid] = a; }
                GAM[tid] = __expf(a); }
            __syncthreads();
            for (int tl = wave; tl < 32; tl += NWAVES) { const int j = lane; const size_t row = (size_t)(b * SEQ + t0 + tl);
                const float apre = PRE[tl * PRE_ST + 64 + j] + CV[64 + j], vpre = PRE[tl * PRE_ST + 128 + j] + CV[128 + j];
                const float pr = bf2f(RAWH[(tl + 1) * 192 + j]), prp = bf2f(RAWH[tl * 192 + j]), pk = bf2f(RAWH[(tl + 1) * 192 + 64 + j]), pkp = bf2f(RAWH[tl * 192 + 64 + j]);
                const float pv = bf2f(RAWH[(tl + 1) * 192 + 128 + j]), pvp = bf2f(RAWH[tl * 192 + 128 + j]);
                const float r = pr + (prp - pr) * CV[8 * 64 + j], k = pk + (pkp - pk) * CV[9 * 64 + j]; float v = pv + (pvp - pv) * CV[10 * 64 + j];
                const float asig = sigmoidf_(apre);
                if (l == 0) { if (PASS == 1) VF[row * 1024 + h * 64 + j] = (bf16)f2bf(v); } else { const float vf = bf2f(VF[row * 1024 + h * 64 + j]); v = v + (vf - v) * sigmoidf_(vpre); }
                const float kk = k * CV[3 * 64 + j]; const float ss = wave_sum(kk * kk); const float kkn = kk * (1.f / sqrtf(fmaxf(ss, 1e-24f)));
                const float k2 = k * (1.f + (asig - 1.f) * CV[4 * 64 + j]); const float av = -kkn, bv = kkn * asig;
                const float gt = LWG[tl * 64 + j], gp = (tl > 0) ? LWG[(tl - 1) * 64 + j] : 0.f, gC = LWG[31 * 64 + j];
                const float eg = __expf(gt), egp = __expf(gp), einv = __expf(-gt), eh = __expf(gC - gt);
                const int o = tl * AST + j;
                st_bf(ARR(AR_AT), o, av * egp); st_bf(ARR(AR_BT), o, bv * einv); st_bf(ARR(AR_KT), o, k2 * einv); st_bf(ARR(AR_BH), o, bv * eh); st_bf(ARR(AR_KH), o, k2 * eh); st_bf(ARR(AR_V), o, v);
                if (PASS == 3) { st_bf(ARR(AR_RT), o, r * eg); const float rk = wave_sum(r * k2 * CV[5 * 64 + j]); if (lane == 0) RK[tl] = rk; } }
            __syncthreads();
#pragma unroll
            for (int q = 0; q < 2; ++q) { const int tile = wave * 2 + q, rt = tile >> 2, ct = tile & 3, tt = rt & 1, st = ct & 1;
                if (PASS == 1 && rt >= 2) continue;
                f32x4 acc = (f32x4){0.f, 0.f, 0.f, 0.f};
                if (st <= tt) { const LAS unsigned char* Ab = ARR(rt < 2 ? AR_AT : AR_RT) + ((16 * tt + c) * AST + 8 * g) * 2; const LAS unsigned char* Bb = ARR(ct < 2 ? AR_BT : AR_KT) + ((16 * st + c) * AST + 8 * g) * 2;
                    acc = MFMA16(ld_b128(Ab), ld_b128(Bb), acc); acc = MFMA16(ld_b128(Ab + 64), ld_b128(Bb + 64), acc); }
                const int s = 16 * st + c;
#pragma unroll
                for (int r = 0; r < 4; ++r) { const int t = 16 * tt + 4 * g + r; const bool keep = (rt < 2) ? (s < t) : (s <= t); const float v = keep ? acc[r] : 0.f;
                    if (rt < 2 && ct < 2) Ts[t * T_ST + s] = v; else st_bf(F.lds + (rt < 2 ? OFF_MK : (ct < 2 ? OFF_QB : OFF_QK)), t * MST + s, v); } }
            __syncthreads();
            { const int tt = wave >> 2, itl = wave & 3;
              const bf16x8 a = ld_b128(F.lds + OFF_MK + ((16 * tt + c) * MST + 8 * g) * 2);
              const int q = c >> 2, p = c & 3;
              const LAS unsigned char* vb = ARR(AR_V) + ((8 * g + q) * AST + 16 * itl + 4 * p) * 2;
              const bf16x8 bfr = cat8(ld_tr(vb), ld_tr(vb + 4 * AST * 2));
              f32x4 acc = (f32x4){0.f, 0.f, 0.f, 0.f}; acc = MFMA16(a, bfr, acc);
#pragma unroll
              for (int r = 0; r < 4; ++r) Us[(16 * tt + 4 * g + r) * U_ST + 16 * itl + c] = acc[r]; }
            __syncthreads();
            if (wave < 2) { float x[32];
#pragma unroll
                for (int t = 0; t < 32; ++t) { float a = (wave == 0) ? bf2f(((const LAS bf16*)ARR(AR_AT))[t * AST + lane]) : Us[t * U_ST + lane];
#pragma unroll
                    for (int s4 = 0; s4 < (t + 3) / 4; ++s4) { const f32x4 tv = *(const LAS f32x4*)(Ts + t * T_ST + 4 * s4);
#pragma unroll
                        for (int e = 0; e < 4; ++e) if (4 * s4 + e < t) a += tv[e] * x[4 * s4 + e]; }
                    x[t] = a;
                    if (wave == 0) st_bf(ARR(AR_W), t * AST + lane, a); else Us[t * U_ST + lane] = a; } }
            __syncthreads();
            const bool active = (PASS == 1) ? true : (wave < 4);
            const bool inhom = (PASS == 1) ? (wave < 4) : true;
            const int cw = wave & 3;
            if (active) {
                bf16x8 xf[2];
                xf[0] = pack8(X[0], X[1]); xf[1] = pack8(X[2], X[3]);
                f32x4 Z[2];
#pragma unroll
                for (int tt = 0; tt < 2; ++tt) { f32x4 z = (f32x4){0.f, 0.f, 0.f, 0.f};
                    if (inhom) {
#pragma unroll
                        for (int r = 0; r < 4; ++r) z[r] = Us[(16 * tt + 4 * g + r) * U_ST + 16 * cw + c]; }
#pragma unroll
                    for (int ks = 0; ks < 2; ++ks) { const LAS unsigned char* wb = ARR(AR_W) + ((16 * tt + c) * AST + 32 * ks + 4 * g) * 2;
                        z = MFMA16(cat8(ld_b64(wb), ld_b64(wb + 32)), xf[ks], z); }
                    Z[tt] = z; }
                const bf16x8 zf = pack8(Z[0], Z[1]);
                bf16x8 vf = zf;
                if (inhom) { const int q = c >> 2, p = c & 3; const LAS unsigned char* vb = ARR(AR_V) + ((4 * g + q) * AST + 16 * cw + 4 * p) * 2; vf = cat8(ld_tr(vb), ld_tr(vb + 16 * AST * 2)); }
                if (PASS == 3) {
#pragma unroll
                    for (int tt = 0; tt < 2; ++tt) { f32x4 y = (f32x4){0.f, 0.f, 0.f, 0.f};
#pragma unroll
                        for (int ks = 0; ks < 2; ++ks) { const LAS unsigned char* rb = ARR(AR_RT) + ((16 * tt + c) * AST + 32 * ks + 4 * g) * 2;
                            y = MFMA16(cat8(ld_b64(rb), ld_b64(rb + 32)), xf[ks], y); }
                        const LAS unsigned char* qb = F.lds + OFF_QB + ((16 * tt + c) * MST + 4 * g) * 2; const LAS unsigned char* qk = F.lds + OFF_QK + ((16 * tt + c) * MST + 4 * g) * 2;
                        y = MFMA16(cat8(ld_b64(qb), ld_b64(qb + 32)), zf, y);
                        y = MFMA16(cat8(ld_b64(qk), ld_b64(qk + 32)), vf, y);
#pragma unroll
                        for (int r = 0; r < 4; ++r) YS[(16 * tt + 4 * g + r) * YS_ST + 16 * cw + c] = y[r]; } }
                { const int q = c >> 2, p = c & 3;
#pragma unroll
                  for (int jt = 0; jt < 4; ++jt) { f32x4 xn;
#pragma unroll
                      for (int r = 0; r < 4; ++r) xn[r] = X[jt][r] * GAM[16 * jt + 4 * g + r];
                      const LAS unsigned char* bb = ARR(AR_BH) + ((4 * g + q) * AST + 16 * jt + 4 * p) * 2;
                      xn = MFMA16(cat8(ld_tr(bb), ld_tr(bb + 16 * AST * 2)), zf, xn);
                      if (inhom) { const LAS unsigned char* kb = ARR(AR_KH) + ((4 * g + q) * AST + 16 * jt + 4 * p) * 2; xn = MFMA16(cat8(ld_tr(kb), ld_tr(kb + 16 * AST * 2)), vf, xn); }
                      X[jt] = xn; } }
            }
            if (PASS == 3) {
                __syncthreads();
                for (int tl = wave; tl < 32; tl += NWAVES) { const int i = lane; const size_t row = (size_t)(b * SEQ + t0 + tl);
                    const float y = YS[tl * YS_ST + i]; const float mean = wave_sum(y) * (1.f / 64.f); const float d = y - mean; const float var = wave_sum(d * d) * (1.f / 64.f);
                    const float o = d * (1.f / sqrtf(var + 64e-5f)) * CV[6 * 64 + i] + CV[7 * 64 + i] + RK[tl] * bf2f(((const LAS bf16*)ARR(AR_V))[tl * AST + i]);
                    YA[row * 1024 + h * 64 + i] = (bf16)f2bf(o); }
            }
        }
        if (PASS == 1) { float* pd = PD + (size_t)it * 8192;
#pragma unroll
            for (int jt = 0; jt < 4; ++jt)
#pragma unroll
                for (int r = 0; r < 4; ++r) pd[(16 * jt + 4 * g + r) * 128 + 16 * wave + c] = X[jt][r]; }
    }
}
__device__ __forceinline__ void rwkv_pass2(Frame& F) {
    if (F.bid >= 32) return;
    const float* PD = (const float*)(F.ws + WS_SC); float* SST = (float*)(F.ws + WS_SC + 32 * MiB);
    LAS float* S = (LAS float*)F.lds;
    const int tid = F.tid, j = tid >> 3, i0 = (tid & 7) * 8;
    float s[8];
#pragma unroll
    for (int e = 0; e < 8; ++e) s[e] = 0.f;
    for (int sc = 0; sc < RNSC; ++sc) { const size_t it = (size_t)F.bid * RNSC + sc;
        float* so = SST + it * 4096 + j * 64 + i0;
        *(f32x4*)so = (f32x4){s[0], s[1], s[2], s[3]}; *(f32x4*)(so + 4) = (f32x4){s[4], s[5], s[6], s[7]};
        __syncthreads();
        *(LAS f32x4*)(S + j * 68 + i0) = (f32x4){s[0], s[1], s[2], s[3]}; *(LAS f32x4*)(S + j * 68 + i0 + 4) = (f32x4){s[4], s[5], s[6], s[7]};
        __syncthreads();
        const float* pd = PD + it * 8192 + j * 128;
        const f32x4 d0 = *(const f32x4*)(pd + i0), d1 = *(const f32x4*)(pd + i0 + 4);
        float a[8] = {d0[0], d0[1], d0[2], d0[3], d1[0], d1[1], d1[2], d1[3]};
#pragma unroll 4
        for (int q = 0; q < 16; ++q) { const f32x4 pv = *(const f32x4*)(pd + 64 + 4 * q);
#pragma unroll
            for (int e = 0; e < 4; ++e) { const f32x4 s0 = *(const LAS f32x4*)(S + (4 * q + e) * 68 + i0), s1 = *(const LAS f32x4*)(S + (4 * q + e) * 68 + i0 + 4);
                a[0] += pv[e] * s0[0]; a[1] += pv[e] * s0[1]; a[2] += pv[e] * s0[2]; a[3] += pv[e] * s0[3]; a[4] += pv[e] * s1[0]; a[5] += pv[e] * s1[1]; a[6] += pv[e] * s1[2]; a[7] += pv[e] * s1[3]; } }
#pragma unroll
        for (int e = 0; e < 8; ++e) s[e] = a[e];
    }
}
constexpr size_t WS_LSE = 330 * MiB;
constexpr int AT_KS = 0, AT_VS = 36864, AT_BIAS = 76032, KVST = 72;
__device__ __forceinline__ void phase_attn_mfma(Frame& F) {
    bf16* QKV = (bf16*)(F.ws + WS_QKV); float* LSE = (float*)(F.ws + WS_LSE); const float* rel_bias = F.in[26];
    const int tid = F.tid, lane = F.lane, w = F.wave, g = lane >> 4, c = lane & 15, q4 = c >> 2, p4 = c & 3;
    LAS float* BIAS = (LAS float*)(F.lds + AT_BIAS);
    for (int e = tid; e < 16 * KVST / 2; e += NTHREADS) ((LAS unsigned*)(F.lds + AT_VS + 256 * KVST * 2))[e] = 0u;
    for (int u = F.bid; u < 3072; u += F.G) {
        const int blk = u & 63, h = (u >> 6) & 7, bg = u >> 9, gatt = bg % 3, b = bg / 3;
        const int dil = (gatt == 0) ? 1 : (gatt == 1 ? 4 : 16), nblk = 64 / dil, r = blk / nblk, n = blk % nblk;
        __syncthreads();
        if (tid < 129) BIAS[tid] = rel_bias[(int)T5BUCKET[gatt][tid] * 24 + gatt * 8 + h];
        for (int e = tid; e < 4096; e += NTHREADS) { const int which = e >> 11, rowi = (e >> 3) & 255, chn = e & 7; const int lk = 128 * n - 128 + rowi; u32x4 v = (u32x4){0u, 0u, 0u, 0u};
            if (lk >= 0) v = *(const u32x4*)(QKV + (size_t)(b * SEQ + lk * dil + r) * NQKV + 1536 + which * 1536 + gatt * 512 + h * 64 + chn * 8);
            *(LAS u32x4*)(F.lds + (which ? AT_VS : AT_KS) + (rowi * KVST + chn * 8) * 2) = v; }
        const size_t qrow = (size_t)(b * SEQ + (128 * n + 16 * w + c) * dil + r);
        bf16x8 qf[2];
#pragma unroll
        for (int ks = 0; ks < 2; ++ks) { const u32x4 v = *(const u32x4*)(QKV + qrow * NQKV + gatt * 512 + h * 64 + 32 * ks + 8 * g); u32x4 o;
            o.x = pk2(bflo(v.x) * 0.125f, bfhi(v.x) * 0.125f); o.y = pk2(bflo(v.y) * 0.125f, bfhi(v.y) * 0.125f); o.z = pk2(bflo(v.z) * 0.125f, bfhi(v.z) * 0.125f); o.w = pk2(bflo(v.w) * 0.125f, bfhi(v.w) * 0.125f);
            qf[ks] = __builtin_bit_cast(bf16x8, o); }
        __syncthreads();
        f32x4 S[9];
#pragma unroll
        for (int j = 0; j < 9; ++j) { const LAS unsigned char* kb = F.lds + AT_KS + ((16 * (w + j) + c) * KVST + 8 * g) * 2;
            f32x4 a = (f32x4){0.f, 0.f, 0.f, 0.f}; a = MFMA16(ld_b128(kb), qf[0], a); a = MFMA16(ld_b128(kb + 64), qf[1], a); S[j] = a; }
        float mx = -1e30f;
#pragma unroll
        for (int j = 0; j < 9; ++j)
#pragma unroll
            for (int rr = 0; rr < 4; ++rr) { const int delta = 128 - 16 * j + c - 4 * g - rr, ki = 16 * (w + j) + 4 * g + rr;
                const bool valid = (delta >= 0) && (delta <= 128) && (n > 0 || ki >= 128);
                const float s = valid ? S[j][rr] + BIAS[valid ? delta : 0] : -1e30f; S[j][rr] = s; mx = fmaxf(mx, s); }
        mx = fmaxf(mx, __shfl_xor(mx, 16)); mx = fmaxf(mx, __shfl_xor(mx, 32));
        float lsum = 0.f;
#pragma unroll
        for (int j = 0; j < 9; ++j)
#pragma unroll
            for (int rr = 0; rr < 4; ++rr) { const float p = (S[j][rr] > -1e29f) ? __expf(S[j][rr] - mx) : 0.f; S[j][rr] = p; lsum += p; }
        lsum += __shfl_xor(lsum, 16); lsum += __shfl_xor(lsum, 32);
        f32x4 O[4];
#pragma unroll
        for (int dt = 0; dt < 4; ++dt) O[dt] = (f32x4){0.f, 0.f, 0.f, 0.f};
#pragma unroll
        for (int m5 = 0; m5 < 5; ++m5) { const f32x4 z4 = (f32x4){0.f, 0.f, 0.f, 0.f};
            const bf16x8 pf = pack8(S[2 * m5], (2 * m5 + 1 < 9) ? S[(2 * m5 + 1 < 9) ? 2 * m5 + 1 : 0] : z4);
            const LAS unsigned char* vb = F.lds + AT_VS + ((16 * (w + 2 * m5) + 4 * g + q4) * KVST + 4 * p4) * 2;
#pragma unroll
            for (int dt = 0; dt < 4; ++dt) O[dt] = MFMA16(pf, cat8(ld_tr(vb + dt * 32), ld_tr(vb + dt * 32 + 16 * KVST * 2)), O[dt]); }
        const float linv = 1.f / lsum;
        if (g == 0) LSE[qrow * 24 + gatt * 8 + h] = mx + __logf(lsum);
#pragma unroll
        for (int rr = 0; rr < 4; ++rr) { const float li = __shfl(linv, 4 * g + rr);
            bf16* op = QKV + (size_t)(b * SEQ + (128 * n + 16 * w + 4 * g + rr) * dil + r) * NQKV + gatt * 512 + h * 64 + c;
#pragma unroll
            for (int dt = 0; dt < 4; ++dt) op[16 * dt] = (bf16)f2bf(O[dt][rr] * li); }
    }
}
__device__ __forceinline__ void phase_attn_merge(Frame& F) {
    const bf16* QKV = (const bf16*)(F.ws + WS_QKV); const float* LSE = (const float*)(F.ws + WS_LSE); bf16* YB = (bf16*)(F.ws + WS_YB);
    const size_t gt = (size_t)F.bid * NTHREADS + F.tid, NGT = (size_t)F.G * NTHREADS;
    for (size_t e = gt; e < (size_t)MROWS * 64; e += NGT) { const size_t row = e >> 6; const int h = (int)(e >> 3) & 7, d8 = (int)e & 7;
        const float l0 = LSE[row * 24 + h], l1 = LSE[row * 24 + 8 + h], l2 = LSE[row * 24 + 16 + h]; const float m = fmaxf(l0, fmaxf(l1, l2));
        float w0 = __expf(l0 - m), w1 = __expf(l1 - m), w2 = __expf(l2 - m); const float inv = 1.f / (w0 + w1 + w2); w0 *= inv; w1 *= inv; w2 *= inv;
        const bf16* qp = QKV + row * NQKV + h * 64 + d8 * 8;
        const u32x4 a = *(const u32x4*)qp, bq = *(const u32x4*)(qp + 512), cq = *(const u32x4*)(qp + 1024); u32x4 o;
        o.x = pk2(w0 * bflo(a.x) + w1 * bflo(bq.x) + w2 * bflo(cq.x), w0 * bfhi(a.x) + w1 * bfhi(bq.x) + w2 * bfhi(cq.x));
        o.y = pk2(w0 * bflo(a.y) + w1 * bflo(bq.y) + w2 * bflo(cq.y), w0 * bfhi(a.y) + w1 * bfhi(bq.y) + w2 * bfhi(cq.y));
        o.z = pk2(w0 * bflo(a.z) + w1 * bflo(bq.z) + w2 * bflo(cq.z), w0 * bfhi(a.z) + w1 * bfhi(bq.z) + w2 * bfhi(cq.z));
        o.w = pk2(w0 * bflo(a.w) + w1 * bflo(bq.w) + w2 * bflo(cq.w), w0 * bfhi(a.w) + w1 * bfhi(bq.w) + w2 * bfhi(cq.w));
        *(u32x4*)(YB + row * 512 + h * 64 + d8 * 8) = o; }
}
#define GEMM_LDS ((PG8_LAS unsigned char*)F.lds)
template <class Epi> __device__ __forceinline__ void run_gemm(Frame& F, const bf16* A, const bf16* Bt, int N, int K, const Epi& E) {
    pg8::Gemm g{A, Bt, MROWS, N, K}; pg8::StaticOrder S; S.init(MROWS, N, F.G, F.bid);
    pg8::gemm_phase<Epi, pg8::StaticOrder, true, true>(GEMM_LDS, g, S, E);
}
__global__ void __launch_bounds__(NTHREADS, 2) fwd_kernel(Args a) {
    extern __shared__ __attribute__((aligned(16))) unsigned char lds[];
    cg::grid_group grid = cg::this_grid();
    const KArgs ka = (KArgs)__builtin_amdgcn_kernarg_segment_ptr();
    { Frame F; make_frame(F, ka, lds); p0_mod(F); p0_weights(F); }
    grid.sync();
    for (int l = 0; l < 2; ++l) {
        { Frame F; make_frame(F, ka, lds); phase_modnorm(F, l, (l == 0) ? F.in[0] : F.out); }
        grid.sync();
        { Frame F; make_frame(F, ka, lds); run_gemm(F, (const bf16*)(F.ws + WS_XN), (const bf16*)(F.ws + WS_WQKV) + (size_t)l * NQKV * 1024, NQKV, 1024, pg8::EpiStore{(bf16*)(F.ws + WS_QKV), NQKV}); }
        grid.sync();
#ifdef ATTN_NAIVE
        { Frame F; make_frame(F, ka, lds); phase_attn_naive(F); }
        grid.sync();
#else
        { Frame F; make_frame(F, ka, lds); phase_attn_mfma(F); }
        grid.sync();
        { Frame F; make_frame(F, ka, lds); phase_attn_merge(F); }
        grid.sync();
#endif
        { Frame F; make_frame(F, ka, lds); run_gemm(F, (const bf16*)(F.ws + WS_XN), (const bf16*)(F.ws + WS_WA) + (size_t)l * NA * 1024, NA, 1024, pg8::EpiStore{(bf16*)(F.ws + WS_PA), NA}); }
        grid.sync();
#ifdef RWKV_NAIVE
        { Frame F; make_frame(F, ka, lds); phase_rwkv_naive(F, l); }
        grid.sync();
#else
        { Frame F; make_frame(F, ka, lds); rwkv_pass<1>(F, l); }
        grid.sync();
        { Frame F; make_frame(F, ka, lds); rwkv_pass2(F); }
        grid.sync();
        { Frame F; make_frame(F, ka, lds); rwkv_pass<3>(F, l); }
        grid.sync();
#endif
        { Frame F; make_frame(F, ka, lds); run_gemm(F, (const bf16*)(F.ws + WS_XN), (const bf16*)(F.ws + WS_WG) + (size_t)l * NG * 1024, NG, 1024, pg8::EpiGates{(bf16*)(F.ws + WS_YA), (bf16*)(F.ws + WS_YB), (bf16*)(F.ws + WS_MG)}); }
        grid.sync();
        { Frame F; make_frame(F, ka, lds); run_gemm(F, (const bf16*)(F.ws + WS_YA), (const bf16*)(F.ws + WS_WBA) + (size_t)l * 1024 * 1024, 1024, 1024, pg8::EpiMerge<false>{(bf16*)(F.ws + WS_MERGED), (const bf16*)(F.ws + WS_MG)}); }
        { Frame F; make_frame(F, ka, lds); run_gemm(F, (const bf16*)(F.ws + WS_YB), (const bf16*)(F.ws + WS_WBB) + (size_t)l * 1024 * 512, 1024, 512, pg8::EpiMerge<true>{(bf16*)(F.ws + WS_MERGED), (const bf16*)(F.ws + WS_MG)}); }
        grid.sync();
        { Frame F; make_frame(F, ka, lds); run_gemm(F, (const bf16*)(F.ws + WS_MERGED), (const bf16*)(F.ws + WS_WO) + (size_t)l * 1024 * 1024, 1024, 1024,
              pg8::EpiResid{(l == 0) ? F.in[0] : F.out, F.out, (const float*)(F.ws + WS_MOD) + (size_t)l * 2 * 3072 + 2048}); }
        grid.sync();
    }
    { Frame F; make_frame(F, ka, lds); phase_final(F); }
}
extern "C" void kernel_launch(void* const* d_in, const int* in_sizes, int n_in, void* d_out, int out_size, void* d_ws, size_t ws_size, hipStream_t stream) {
    static int grid = 0;
    if (grid == 0) {
        int dev = 0, cus = 0, per_cu = 0;
        (void)hipGetDevice(&dev); (void)hipDeviceGetAttribute(&cus, hipDeviceAttributeMultiprocessorCount, dev);
        (void)hipFuncSetAttribute((const void*)fwd_kernel, hipFuncAttributeMaxDynamicSharedMemorySize, LDS_BYTES);
        (void)hipOccupancyMaxActiveBlocksPerMultiprocessor(&per_cu, (const void*)fwd_kernel, NTHREADS, LDS_BYTES);
        if (n_in != 28 || out_size != MROWS * DM || ws_size < (size_t)352 * MiB || per_cu < 1) { fprintf(stderr, "kernel_launch: unexpected problem (n_in %d out %d ws %zu per_cu %d)\n", n_in, out_size, ws_size, per_cu); }
        grid = cus;
        (void)hipGetLastError();
    }
    Args a{};
    for (int i = 0; i < 28; ++i) a.in[i] = (const float*)d_in[i];
    a.out = (float*)d_out; a.ws = (unsigned char*)d_ws;
    void* args[] = {&a};
    hipError_t e = hipLaunchCooperativeKernel((void*)fwd_kernel, dim3(grid), dim3(NTHREADS), args, LDS_BYTES, stream);
    if (e != hipSuccess) fprintf(stderr, "cooperative launch failed: %s (grid %d)\n", hipGetErrorString(e), grid);
}
```

```cpp
#include <hip/hip_runtime.h>
#include <hip/hip_cooperative_groups.h>
#include <cstdio>
#include <cstdint>
namespace cg = cooperative_groups;
namespace pg8 {
#define PG8_LAS __attribute__((address_space(3)))
typedef unsigned short bf16_t;
typedef short bf16x8 __attribute__((ext_vector_type(8)));
typedef float f32x4 __attribute__((ext_vector_type(4)));
typedef unsigned u32x4 __attribute__((ext_vector_type(4)));
constexpr int BM = 256, BK = 64, HALF = 128, HTB = HALF * BK * 2  , STAGE_BYTES = 8 * HTB, NXCD = 8, WGM = 8;

__host__ __device__ __forceinline__ int lds_byte(int r, int c) { const int st = (r >> 4) * 2 + (c >> 5), rr = r & 15, cc = c & 31, ob = rr * 64 + cc * 2; return st * 1024 + (ob ^ (((ob >> 9) & 1) << 5)); }
__host__ __device__ __forceinline__ void stage_rc(int b, int& R, int& C) { const int st = b / 1024, sb = b % 1024, swz = sb ^ (((sb >> 9) & 1) << 5); R = (st >> 1) * 16 + swz / 64; C = (st & 1) * 32 + (swz % 64) / 2; }
__host__ __device__ __forceinline__ int perm32(int rho) { const int n = rho >> 4, i = rho & 15; return 8 * (i >> 2) + 4 * n + (i & 3); }

struct Unit { int pm, pn; };
struct Gemm { const bf16_t* A; const bf16_t* Bt; int M, N, K; };

struct StaticOrder {
    int nM, nN, nwg, G, c;
    __host__ __device__ void init(int M, int N, int G_, int c_) { nM = M / BM; nN = N / BM; nwg = nM * nN; G = G_; c = c_; }
    __host__ __device__ bool next(int i, Unit& u) const {
        const long L = (long)i * G + c; if (L >= nwg) return false;
        int wgid = (int)L; { const int q = nwg / NXCD, r = nwg % NXCD, xcd = wgid % NXCD, off = wgid / NXCD; wgid = (xcd < r ? xcd * (q + 1) : r * (q + 1) + (xcd - r) * q) + off; }
        const int nig = WGM * nN, gid = wgid / nig, fm = gid * WGM, gsz = (nM - fm) < WGM ? (nM - fm) : WGM;
        u.pm = fm + ((wgid % nig) % gsz); u.pn = (wgid % nig) / gsz; return true;
    }
    __device__ __forceinline__ void a_ready(const Unit&) const {}
    __device__ __forceinline__ void done(const Unit&) const {}
};

__device__ __forceinline__ unsigned cvt_pk_bf16(float lo, float hi) { unsigned r; asm volatile("v_cvt_pk_bf16_f32 %0, %1, %2" : "=v"(r) : "v"(lo), "v"(hi)); return r; }
typedef float f32x2 __attribute__((ext_vector_type(2)));
template <class Epi, class Sched, bool ALIGN_EPI = false, bool SP2 = false>
__device__ __forceinline__ void gemm_phase(PG8_LAS unsigned char* lds, const Gemm g, const Sched& S, const Epi& E) {
    int tid_ = threadIdx.x; asm volatile("" : "+v"(tid_));
    const int tid = tid_, wid = __builtin_amdgcn_readfirstlane(tid >> 6), lane = tid & 63, wr = wid >> 2, wc = wid & 3, fr = lane & 15, fq = lane >> 4;
    const int K = g.K, nt = K / BK;
    unsigned voffA[2], voffB[2];
#pragma unroll
    for (int i = 0; i < 2; ++i) { int R, C; stage_rc(tid * 16 + i * 8192, R, C); const int Rb = Epi::PERM ? ((R & ~31) + perm32(R & 31)) : R;
        voffA[i] = (unsigned)(R * K + C) * 2u; voffB[i] = (unsigned)(Rb * K + C) * 2u; }
    const size_t kstep = (size_t)(BK * 2);
    const size_t hstep = (size_t)HALF * K * 2;
    const size_t tstep = 2 * hstep;
    const unsigned ldsw = (unsigned)wid * 1024u;
    const int aoff = lds_byte(wr * 64 + fr, fq * 8), boff = lds_byte(wc * 32 + fr, fq * 8);
#define PG8_SA(b, h) (((b) * 2 + (h)) * HTB)
#define PG8_SB(b, h) ((4 + (b) * 2 + (h)) * HTB)
#define PG8_STAGE(bufoff, gbase, voff) do { _Pragma("unroll") for (int _i = 0; _i < 2; ++_i) \
        __builtin_amdgcn_global_load_lds((const unsigned*)((const char*)(gbase) + (voff)[_i]), (PG8_LAS unsigned*)(lds + (bufoff) + ldsw + _i * 8192), 16, 0, 0); } while (0)
#define PG8_LDA(dst, b, h) do { _Pragma("unroll") for (int m = 0; m < 4; ++m) _Pragma("unroll") for (int k = 0; k < 2; ++k) dst[m][k] = *(const PG8_LAS bf16x8*)(lds + PG8_SA(b, h) + aoff + m * 2048 + k * 1024); } while (0)
#define PG8_LDB(dst, b, h) do { _Pragma("unroll") for (int n = 0; n < 2; ++n) _Pragma("unroll") for (int k = 0; k < 2; ++k) dst[n][k] = *(const PG8_LAS bf16x8*)(lds + PG8_SB(b, h) + boff + n * 2048 + k * 1024); } while (0)
#define PG8_MMA(ai, bj, At, Bt) do { __builtin_amdgcn_s_setprio(1); _Pragma("unroll") for (int m = 0; m < 4; ++m) _Pragma("unroll") for (int n = 0; n < 2; ++n) _Pragma("unroll") for (int k = 0; k < 2; ++k) \
        acc[ai][bj][m][n] = __builtin_amdgcn_mfma_f32_16x16x32_bf16(Bt[n][k], At[m][k], acc[ai][bj][m][n], 0, 0, 0); __builtin_amdgcn_s_setprio(0); } while (0)
#define PG8_WAIT_V(n) asm volatile("s_waitcnt vmcnt(" #n ")" ::: "memory")
#define PG8_WAIT_L(n) asm volatile("s_waitcnt lgkmcnt(" #n ")" ::: "memory")
#define PG8_BAR __builtin_amdgcn_s_barrier()
#define PG8_SCHED __builtin_amdgcn_sched_barrier(0)
    Unit cur, nxt; int ui = 0;
    if (!S.next(0, cur)) return;
    f32x4 acc[2][2][4][2];
#pragma unroll
    for (int a = 0; a < 2; ++a)
#pragma unroll
        for (int b = 0; b < 2; ++b)
#pragma unroll
            for (int m = 0; m < 4; ++m)
#pragma unroll
                for (int n = 0; n < 2; ++n) acc[a][b][m][n] = (f32x4){0.f, 0.f, 0.f, 0.f};
    bf16x8 At[4][2], B0[2][2], B1[2][2];
    const char* cA = (const char*)g.A + (size_t)cur.pm * tstep; const char* cB = (const char*)g.Bt + (size_t)cur.pn * tstep;
    S.a_ready(cur);
    if constexpr (SP2) {
        PG8_STAGE(PG8_SB(0, 0), cB, voffB); PG8_STAGE(PG8_SB(0, 1), cB + hstep, voffB); PG8_STAGE(PG8_SA(0, 0), cA, voffA); PG8_STAGE(PG8_SA(0, 1), cA + hstep, voffA);
        if (wr == 1) PG8_BAR;
        PG8_WAIT_V(2); PG8_BAR;
        PG8_STAGE(PG8_SB(1, 0), cB + kstep, voffB); PG8_STAGE(PG8_SA(1, 0), cA + kstep, voffA); PG8_STAGE(PG8_SB(1, 1), cB + hstep + kstep, voffB);
        PG8_WAIT_V(6); PG8_BAR;
    } else {
        PG8_STAGE(PG8_SB(0, 0), cB, voffB); PG8_STAGE(PG8_SA(0, 0), cA, voffA); PG8_STAGE(PG8_SB(0, 1), cB + hstep, voffB); PG8_STAGE(PG8_SA(0, 1), cA + hstep, voffA);
        if (wr == 1) PG8_BAR;
        PG8_WAIT_V(4); PG8_BAR;
        PG8_STAGE(PG8_SB(1, 0), cB + kstep, voffB); PG8_STAGE(PG8_SA(1, 0), cA + kstep, voffA); PG8_STAGE(PG8_SB(1, 1), cB + hstep + kstep, voffB);
        PG8_WAIT_V(6); PG8_BAR;
    }
    for (;;) {
        const bool has_next = S.next(ui + 1, nxt);
        const char* nA = has_next ? (const char*)g.A + (size_t)nxt.pm * tstep : cA; const char* nB = has_next ? (const char*)g.Bt + (size_t)nxt.pn * tstep : cB;
        for (int t = 0; t < nt; t += 2) {
            const bool last = (t == nt - 2);
            const char* a1 = cA + (size_t)(t + 1) * kstep;
            const char* a2 = last ? nA : cA + (size_t)(t + 2) * kstep; const char* b2 = last ? nB : cB + (size_t)(t + 2) * kstep;
            const char* a3 = a2 + kstep; const char* b3 = b2 + kstep;
            if (last && has_next) S.a_ready(nxt);
            if constexpr (SP2) {
            PG8_LDB(B0, 0, 0); PG8_LDB(B1, 0, 1); PG8_SCHED; PG8_LDA(At, 0, 0); PG8_STAGE(PG8_SA(1, 1), a1 + hstep, voffA);
            PG8_WAIT_V(8); PG8_WAIT_L(0); PG8_BAR; PG8_MMA(0, 0, At, B0); PG8_MMA(0, 1, At, B1); PG8_BAR; PG8_SCHED;
            PG8_LDA(At, 0, 1); PG8_STAGE(PG8_SB(0, 0), b2, voffB); PG8_STAGE(PG8_SB(0, 1), b2 + hstep, voffB); PG8_STAGE(PG8_SA(0, 0), a2, voffA);
            PG8_WAIT_V(8); PG8_WAIT_L(0); PG8_BAR; PG8_MMA(1, 0, At, B0); PG8_MMA(1, 1, At, B1); PG8_BAR; PG8_SCHED;
            PG8_LDB(B0, 1, 0); PG8_LDB(B1, 1, 1); PG8_SCHED; PG8_LDA(At, 1, 0); PG8_STAGE(PG8_SA(0, 1), a2 + hstep, voffA);
            PG8_WAIT_V(8); PG8_WAIT_L(0); PG8_BAR; PG8_MMA(0, 0, At, B0); PG8_MMA(0, 1, At, B1); PG8_BAR; PG8_SCHED;
            PG8_LDA(At, 1, 1); PG8_STAGE(PG8_SB(1, 0), b3, voffB); PG8_STAGE(PG8_SB(1, 1), b3 + hstep, voffB); PG8_STAGE(PG8_SA(1, 0), a3, voffA);
            PG8_WAIT_V(8); PG8_WAIT_L(0); PG8_BAR; PG8_MMA(1, 0, At, B0); PG8_MMA(1, 1, At, B1); PG8_BAR; PG8_SCHED;
            } else {
            PG8_LDB(B0, 0, 0); PG8_SCHED; PG8_LDA(At, 0, 0); PG8_STAGE(PG8_SA(1, 1), a1 + hstep, voffA);
            PG8_WAIT_L(8); PG8_BAR; PG8_WAIT_L(0); PG8_MMA(0, 0, At, B0); PG8_BAR; PG8_SCHED;
            PG8_LDB(B1, 0, 1); PG8_STAGE(PG8_SB(0, 0), b2, voffB);
            PG8_BAR; PG8_WAIT_L(0); PG8_MMA(0, 1, At, B1); PG8_BAR;
            PG8_LDA(At, 0, 1); PG8_STAGE(PG8_SA(0, 0), a2, voffA);
            PG8_BAR; PG8_WAIT_L(0); PG8_MMA(1, 0, At, B0); PG8_BAR; PG8_SCHED;
            PG8_STAGE(PG8_SB(0, 1), b2 + hstep, voffB);
            PG8_WAIT_V(6); PG8_BAR; PG8_MMA(1, 1, At, B1); PG8_BAR;
            PG8_LDB(B0, 1, 0); PG8_SCHED; PG8_LDA(At, 1, 0); PG8_STAGE(PG8_SA(0, 1), a2 + hstep, voffA);
            PG8_WAIT_L(8); PG8_BAR; PG8_WAIT_L(0); PG8_MMA(0, 0, At, B0); PG8_BAR; PG8_SCHED;
            PG8_LDB(B1, 1, 1); PG8_STAGE(PG8_SB(1, 0), b3, voffB);
            PG8_BAR; PG8_WAIT_L(0); PG8_MMA(0, 1, At, B1); PG8_BAR;
            PG8_LDA(At, 1, 1); PG8_STAGE(PG8_SA(1, 0), a3, voffA);
            PG8_BAR; PG8_WAIT_L(0); PG8_MMA(1, 0, At, B0); PG8_BAR; PG8_SCHED;
            PG8_STAGE(PG8_SB(1, 1), b3 + hstep, voffB);
            PG8_WAIT_V(6); PG8_BAR; PG8_MMA(1, 1, At, B1); PG8_BAR;
            }
        }
        if constexpr (ALIGN_EPI) { if (wr == 0) PG8_BAR; }
        if constexpr (!Epi::AFTER_DRAIN) { E(acc, cur, wr, wc, fr, fq); S.done(cur); }
        if (!has_next) break;
#pragma unroll
        for (int a = 0; a < 2; ++a)
#pragma unroll
            for (int b = 0; b < 2; ++b)
#pragma unroll
                for (int m = 0; m < 4; ++m)
#pragma unroll
                    for (int n = 0; n < 2; ++n) acc[a][b][m][n] = (f32x4){0.f, 0.f, 0.f, 0.f};
        cur = nxt; cA = nA; cB = nB; ++ui;
        if constexpr (ALIGN_EPI) { if (wr == 1) PG8_BAR; }
    }
    PG8_WAIT_V(0);
    if constexpr (!ALIGN_EPI) { if (wr == 0) PG8_BAR; }
    PG8_BAR;
    if constexpr (Epi::AFTER_DRAIN) { E.fused(acc, cur, wr, wc, fr, fq, lds, wid, lane); S.done(cur); }
#undef PG8_SA
#undef PG8_SB
#undef PG8_STAGE
#undef PG8_LDA
#undef PG8_LDB
#undef PG8_MMA
#undef PG8_WAIT_V
#undef PG8_WAIT_L
#undef PG8_BAR
#undef PG8_SCHED
}
}
namespace pg8 {
__device__ __forceinline__ float ep_bflo(unsigned w) { return __uint_as_float(w << 16); }
__device__ __forceinline__ float ep_bfhi(unsigned w) { return __uint_as_float(w & 0xffff0000u); }
__device__ __forceinline__ float ep_sigmoid(float x) { return 1.f / (1.f + __expf(-x)); }
struct EpiStore {
    static constexpr bool PERM = true, AFTER_DRAIN = false;
    bf16_t* O; int ldc;
    __device__ __forceinline__ void operator()(const f32x4 (&acc)[2][2][4][2], const Unit& u, int wr, int wc, int fr, int fq) const {
        const int row0 = u.pm * BM + wr * 64 + fr, col0 = u.pn * BM + wc * 32 + 8 * fq;
#pragma unroll
        for (int ai = 0; ai < 2; ++ai)
#pragma unroll
            for (int m = 0; m < 4; ++m) { bf16_t* rowp = O + (size_t)(row0 + ai * HALF + m * 16) * ldc + col0;
#pragma unroll
                for (int bj = 0; bj < 2; ++bj) { const f32x4 v0 = acc[ai][bj][m][0], v1 = acc[ai][bj][m][1]; u32x4 w;
                    w.x = cvt_pk_bf16(v0[0], v0[1]); w.y = cvt_pk_bf16(v0[2], v0[3]); w.z = cvt_pk_bf16(v1[0], v1[1]); w.w = cvt_pk_bf16(v1[2], v1[3]);
                    *(u32x4*)(rowp + bj * HALF) = w; } }
    }
};
struct EpiGates {
    static constexpr bool PERM = true, AFTER_DRAIN = false;
    bf16_t* YA; bf16_t* YB; bf16_t* MG;
    __device__ __forceinline__ void operator()(const f32x4 (&acc)[2][2][4][2], const Unit& u, int wr, int wc, int fr, int fq) const {
        const int colt = u.pn * BM; int mode, ld, cb; bf16_t* P;
        if (colt < 1024) { mode = 0; P = YA; ld = 1024; cb = colt; } else if (colt < 1536) { mode = 1; P = YB; ld = 512; cb = colt - 1024; } else { mode = 2; P = MG; ld = 2048; cb = colt - 1536; }
        const int row0 = u.pm * BM + wr * 64 + fr, col0 = cb + wc * 32 + 8 * fq;
#pragma unroll
        for (int ai = 0; ai < 2; ++ai)
#pragma unroll
            for (int m = 0; m < 4; ++m) { bf16_t* rowp = P + (size_t)(row0 + ai * HALF + m * 16) * ld + col0;
#pragma unroll
                for (int bj = 0; bj < 2; ++bj) { const f32x4 v0 = acc[ai][bj][m][0], v1 = acc[ai][bj][m][1]; float g[8] = {v0[0], v0[1], v0[2], v0[3], v1[0], v1[1], v1[2], v1[3]};
                    u32x4 w;
                    if (mode == 2) {
#pragma unroll
                        for (int e = 0; e < 8; ++e) g[e] = ep_sigmoid(g[e]);
                    } else {
                        const u32x4 y = *(const u32x4*)(rowp + bj * HALF);
                        const float yv[8] = {ep_bflo(y.x), ep_bfhi(y.x), ep_bflo(y.y), ep_bfhi(y.y), ep_bflo(y.z), ep_bfhi(y.z), ep_bflo(y.w), ep_bfhi(y.w)};
#pragma unroll
                        for (int e = 0; e < 8; ++e) g[e] = yv[e] * g[e] * ep_sigmoid(g[e]);
                    }
                    w.x = cvt_pk_bf16(g[0], g[1]); w.y = cvt_pk_bf16(g[2], g[3]); w.z = cvt_pk_bf16(g[4], g[5]); w.w = cvt_pk_bf16(g[6], g[7]);
                    *(u32x4*)(rowp + bj * HALF) = w; } }
    }
};
template <bool SECOND> struct EpiMerge {
    static constexpr bool PERM = true, AFTER_DRAIN = false;
    bf16_t* MERGED; const bf16_t* MG;
    __device__ __forceinline__ void operator()(const f32x4 (&acc)[2][2][4][2], const Unit& u, int wr, int wc, int fr, int fq) const {
        const int row0 = u.pm * BM + wr * 64 + fr, col0 = u.pn * BM + wc * 32 + 8 * fq;
#pragma unroll
        for (int ai = 0; ai < 2; ++ai)
#pragma unroll
            for (int m = 0; m < 4; ++m) { const size_t r = (size_t)(row0 + ai * HALF + m * 16);
#pragma unroll
                for (int bj = 0; bj < 2; ++bj) { const f32x4 v0 = acc[ai][bj][m][0], v1 = acc[ai][bj][m][1]; float g[8] = {v0[0], v0[1], v0[2], v0[3], v1[0], v1[1], v1[2], v1[3]};
                    const int c = col0 + bj * HALF;
                    const u32x4 s = *(const u32x4*)(MG + r * 2048 + (SECOND ? 1024 : 0) + c);
                    const float sv[8] = {ep_bflo(s.x), ep_bfhi(s.x), ep_bflo(s.y), ep_bfhi(s.y), ep_bflo(s.z), ep_bfhi(s.z), ep_bflo(s.w), ep_bfhi(s.w)};
                    bf16_t* dst = MERGED + r * 1024 + c;
                    if (SECOND) { const u32x4 p = *(const u32x4*)dst;
                        const float pv[8] = {ep_bflo(p.x), ep_bfhi(p.x), ep_bflo(p.y), ep_bfhi(p.y), ep_bflo(p.z), ep_bfhi(p.z), ep_bflo(p.w), ep_bfhi(p.w)};
#pragma unroll
                        for (int e = 0; e < 8; ++e) g[e] = pv[e] + sv[e] * g[e];
                    } else {
#pragma unroll
                        for (int e = 0; e < 8; ++e) g[e] = sv[e] * g[e];
                    }
                    u32x4 w; w.x = cvt_pk_bf16(g[0], g[1]); w.y = cvt_pk_bf16(g[2], g[3]); w.z = cvt_pk_bf16(g[4], g[5]); w.w = cvt_pk_bf16(g[6], g[7]);
                    *(u32x4*)dst = w; } }
    }
};
struct EpiResid {
    static constexpr bool PERM = false, AFTER_DRAIN = false;
    const float* xin; float* xout; const float* gate;
    __device__ __forceinline__ void operator()(const f32x4 (&acc)[2][2][4][2], const Unit& u, int wr, int wc, int fr, int fq) const {
        const int b = (u.pm * BM) / 8192; const float* gp = gate + b * 3072;
        const int row0 = u.pm * BM + wr * 64 + fr, col0 = u.pn * BM + wc * 32 + 4 * fq;
#pragma unroll
        for (int bj = 0; bj < 2; ++bj)
#pragma unroll
            for (int n = 0; n < 2; ++n) { const int c = col0 + bj * HALF + n * 16; const f32x4 gv = *(const f32x4*)(gp + c);
#pragma unroll
                for (int ai = 0; ai < 2; ++ai)
#pragma unroll
                    for (int m = 0; m < 4; ++m) { const size_t off = (size_t)(row0 + ai * HALF + m * 16) * 1024 + c;
                        const f32x4 xi = *(const f32x4*)(xin + off); *(f32x4*)(xout + off) = xi + gv * acc[ai][bj][m][n]; } }
    }
};
}
constexpr int BATCH = 2, SEQ = 8192, DM = 1024, MROWS = BATCH * SEQ, PROJW = 11264;
constexpr int NQKV = 4608, NA = 3584, NG = 3584, NLORA = 320;
constexpr size_t MiB = 1u << 20;
constexpr size_t WS_CTL = 0, WS_MOD = 1 * MiB;
constexpr size_t WS_WQKV = 2 * MiB, WS_WA = 20 * MiB, WS_WG = 34 * MiB, WS_WBA = 48 * MiB, WS_WBB = 52 * MiB, WS_WO = 54 * MiB;
constexpr size_t WS_VFIRST = 58 * MiB, WS_XN = 90 * MiB, WS_YB = 122 * MiB;
constexpr size_t WS_QKV = 138 * MiB, WS_PA = 138 * MiB, WS_YA = 250 * MiB, WS_MG = 138 * MiB, WS_MERGED = 202 * MiB, WS_SC = 282 * MiB;
constexpr int LDS_BYTES = 147456;
constexpr int NTHREADS = 512, NWAVES = 8;
#define LAS __attribute__((address_space(3)))
typedef unsigned short bf16;
typedef float f32x4 __attribute__((ext_vector_type(4)));
typedef unsigned u32x4 __attribute__((ext_vector_type(4)));
typedef unsigned u32x2 __attribute__((ext_vector_type(2)));

__device__ const unsigned char T5BUCKET[3][132] = {
 {0,1,2,3,4,5,6,7,8,9,10,11,12,13,14,15,16,16,16,16,16,16,17,17,17,17,17,17,17,17,18,18,18,18,18,18,18,18,18,18,19,19,19,19,19,19,19,19,19,19,19,19,19,19,20,20,20,20,20,20,20,20,20,20,20,20,20,20,20,20,20,20,20,21,21,21,21,21,21,21,21,21,21,21,21,21,21,21,21,21,21,21,21,21,21,21,21,21,21,22,22,22,22,22,22,22,22,22,22,22,22,22,22,22,22,22,22,22,22,22,22,22,22,22,22,22,22,22,22,0,0,0},
 {0,4,8,12,16,16,17,17,18,18,19,19,19,19,20,20,20,20,20,21,21,21,21,21,21,22,22,22,22,22,22,22,22,22,23,23,23,23,23,23,23,23,23,23,23,23,24,24,24,24,24,24,24,24,24,24,24,24,24,24,24,24,25,25,25,25,25,25,25,25,25,25,25,25,25,25,25,25,25,25,25,25,25,26,26,26,26,26,26,26,26,26,26,26,26,26,26,26,26,26,26,26,26,26,26,26,26,26,26,26,26,26,26,27,27,27,27,27,27,27,27,27,27,27,27,27,27,27,27,0,0,0},
 {0,16,18,19,20,21,21,22,22,23,23,23,24,24,24,24,25,25,25,25,25,26,26,26,26,26,26,26,26,27,27,27,27,27,27,27,27,27,27,28,28,28,28,28,28,28,28,28,28,28,28,28,29,29,29,29,29,29,29,29,29,29,29,29,29,29,29,29,29,29,30,30,30,30,30,30,30,30,30,30,30,30,30,30,30,30,30,30,30,30,30,30,30,30,30,31,31,31,31,31,31,31,31,31,31,31,31,31,31,31,31,31,31,31,31,31,31,31,31,31,31,31,31,31,31,31,31,31,31,0,0,0}};

__device__ __forceinline__ unsigned f2bf(float f) { unsigned u = __builtin_bit_cast(unsigned, f); return (u + 0x7fffu + ((u >> 16) & 1u)) >> 16; }
__device__ __forceinline__ unsigned pk2(float lo, float hi) { return f2bf(lo) | (f2bf(hi) << 16); }
__device__ __forceinline__ float bflo(unsigned w) { return __uint_as_float(w << 16); }
__device__ __forceinline__ float bfhi(unsigned w) { return __uint_as_float(w & 0xffff0000u); }
__device__ __forceinline__ float bf2f(bf16 h) { return __uint_as_float(((unsigned)h) << 16); }
__device__ __forceinline__ float wave_sum(float v) {
#pragma unroll
    for (int o = 1; o < 64; o <<= 1) v += __shfl_xor(v, o);
    return v;
}
__device__ __forceinline__ float wave_max(float v) {
#pragma unroll
    for (int o = 1; o < 64; o <<= 1) v = fmaxf(v, __shfl_xor(v, o));
    return v;
}
__device__ __forceinline__ float sigmoidf_(float x) { return 1.f / (1.f + __expf(-x)); }
__device__ __forceinline__ float siluf_(float x) { return x / (1.f + __expf(-x)); }

struct Args { const float* in[28]; float* out; unsigned char* ws; };
typedef const __attribute__((address_space(4))) Args* KArgs;
struct Frame {
    LAS unsigned char* lds;
    int tid, lane, wave, G, bid;
    const float* in[28]; float* out; unsigned char* ws;
};
__device__ __forceinline__ void make_frame(Frame& F, KArgs ka, unsigned char* lds) {
    asm volatile("" : "+s"(ka));
    int t = threadIdx.x; asm volatile("" : "+v"(t));
    F.lds = (LAS unsigned char*)lds; F.tid = t; F.lane = t & 63; F.wave = __builtin_amdgcn_readfirstlane(t >> 6); F.G = gridDim.x; F.bid = blockIdx.x;
#pragma unroll
    for (int i = 0; i < 28; ++i) F.in[i] = ka->in[i];
    F.out = ka->out; F.ws = ka->ws;
}
#define XB_TMO      128
#define XB_XCNT(j)  (256  + 64 * (j))
#define XB_XSUB(j)  (1280 + 64 * (j))
#define XB_XGEN(j)  (2304 + 64 * (j))
#define XB_TOP      3328
#define XB_TOPGEN   3392
#define XCD_BAR_WORDS 3456
#define XB_SPIN_CAP (1u << 18)

__device__ __forceinline__ unsigned xb_ld(unsigned* p)              { return __hip_atomic_load(p, __ATOMIC_RELAXED, __HIP_MEMORY_SCOPE_AGENT); }
__device__ __forceinline__ unsigned xb_add(unsigned* p, unsigned v) { return __hip_atomic_fetch_add(p, v, __ATOMIC_RELAXED, __HIP_MEMORY_SCOPE_AGENT); }
__device__ __forceinline__ unsigned xb_xcc_id() { return (unsigned)__builtin_amdgcn_s_getreg((3 << 11) | 20) & 0xFu; }
#define XB_SPIN(cond, bar) do { unsigned _sp = 0; while (cond) { __builtin_amdgcn_s_sleep(1); \
    if ((++_sp & 255u) == 0u) { if (xb_ld(&(bar)[XB_TMO])) break; if (_sp > XB_SPIN_CAP) { atomicAdd(&(bar)[XB_TMO], 1u); break; } } } } while (0)

struct XcdBarrier {
    unsigned* bar; unsigned x;
    volatile LAS unsigned* st;
};

__device__ __forceinline__ XcdBarrier xcd_barrier_post(unsigned* bar, volatile LAS unsigned* st) {
    XcdBarrier b; b.bar = bar; b.x = xb_xcc_id(); b.st = st;
    if (threadIdx.x == 0) (void)xb_add(&bar[XB_XCNT(b.x)], 1u);
    return b;
}
__device__ __forceinline__ void xcd_barrier_complete(unsigned* bar, unsigned x, unsigned& nloc, unsigned& nx) {
    const unsigned G = gridDim.x * gridDim.y * gridDim.z;
    unsigned sum, cnt, mine, sp = 0u;
    for (;;) {
        sum = 0u; cnt = 0u; mine = 0u;
#pragma unroll
        for (unsigned j = 0; j < 16; ++j) { const unsigned c = xb_ld(&bar[XB_XCNT(j)]); sum += c; cnt += (c > 0u) ? 1u : 0u; mine = (j == x) ? c : mine; }
        if (sum == G) break;
        __builtin_amdgcn_s_sleep(1);
        if ((++sp & 255u) == 0u) { if (xb_ld(&bar[XB_TMO])) break; if (sp > XB_SPIN_CAP) { atomicAdd(&bar[XB_TMO], 1u); break; } }
    }
    nloc = mine > 0u ? mine : 1u; nx = cnt > 0u ? cnt : 1u;
}

__device__ __forceinline__ void xcd_barrier(const XcdBarrier& b) {
    asm volatile("s_waitcnt vmcnt(0)" ::: "memory");
    __syncthreads();
    if (threadIdx.x == 0) {
        unsigned* bar = b.bar;
        __builtin_amdgcn_s_waitcnt(0);
        unsigned nloc = b.st[0], nx = b.st[1];
        if (nloc == 0u) { xcd_barrier_complete(bar, b.x, nloc, nx); b.st[0] = nloc; b.st[1] = nx; }
        const unsigned old = xb_add(&bar[XB_XSUB(b.x)], 1u);
        const unsigned gen = old / nloc;
        if (old + 1u == (gen + 1u) * nloc) {
            __builtin_amdgcn_fence(__ATOMIC_RELEASE, "agent");
            asm volatile("s_waitcnt vmcnt(0)" ::: "memory");
            const unsigned og = xb_add(&bar[XB_TOP], 1u);
            const unsigned tg = og / nx;
            if (og + 1u == (tg + 1u) * nx) xb_add(&bar[XB_TOPGEN], 1u);
            else XB_SPIN(xb_ld(&bar[XB_TOPGEN]) == tg, bar);
            __builtin_amdgcn_fence(__ATOMIC_ACQUIRE, "agent");
            xb_add(&bar[XB_XGEN(b.x)], 1u);
            asm volatile("s_waitcnt vmcnt(0)" ::: "memory");
        } else {
            XB_SPIN(xb_ld(&bar[XB_XGEN(b.x)]) == gen, bar);
            __builtin_amdgcn_fence(__ATOMIC_ACQUIRE, "agent");
            asm volatile("s_waitcnt vmcnt(0)" ::: "memory");
        }
    }
    __syncthreads();
}
__device__ __forceinline__ void p0_mod(Frame& F) {
    const float* c = F.in[1]; const float* ada_w = F.in[3]; const float* ada_b = F.in[4];
    float* mod = (float*)(F.ws + WS_MOD);
    LAS float* red = (LAS float*)F.lds;
    const int col = F.tid & 31, kg = F.tid >> 5;
    for (int ch = F.bid; ch < 192; ch += F.G) {
        const int l = ch / 96, n = (ch % 96) * 32 + col;
        const float* W = ada_w + (size_t)l * 1024 * 3072 + n;
        float a0 = 0.f, a1 = 0.f;
        for (int i = 0; i < 64; ++i) { const int k = kg + 16 * i; const float w = W[(size_t)k * 3072]; a0 += siluf_(c[k]) * w; a1 += siluf_(c[1024 + k]) * w; }
        red[kg * 32 + col] = a0; red[512 + kg * 32 + col] = a1;
        __syncthreads();
        if (F.tid < 64) { const int b = F.tid >> 5; float s = 0.f;
            for (int g = 0; g < 16; ++g) s += red[b * 512 + g * 32 + col];
            mod[(size_t)(l * 2 + b) * 3072 + n] = s + ada_b[l * 3072 + n]; }
        __syncthreads();
    }
}
__device__ __forceinline__ void transpose_item(const float* W, int ldw, int col0, int K, int ncols, bf16* WT, LAS float* scr, int item, int lane) {
    const int nblk = ncols / 32, kb = item / nblk, nb = item % nblk, k0 = 64 * kb, n0 = 32 * nb;
#pragma unroll 8
    for (int i = 0; i < 32; ++i) { const int kk = 2 * i + (lane >> 5); scr[kk * 33 + (lane & 31)] = W[(size_t)(k0 + kk) * ldw + col0 + n0 + (lane & 31)]; }
    asm volatile("s_waitcnt lgkmcnt(0)" ::: "memory");
    const int c = lane & 7;
#pragma unroll
    for (int j = 0; j < 4; ++j) { const int n = (lane >> 3) + 8 * j; const LAS float* s = scr + (8 * c) * 33 + n;
        u32x4 o; o.x = pk2(s[0 * 33], s[1 * 33]); o.y = pk2(s[2 * 33], s[3 * 33]); o.z = pk2(s[4 * 33], s[5 * 33]); o.w = pk2(s[6 * 33], s[7 * 33]);
        *(u32x4*)(WT + (size_t)(n0 + n) * K + k0 + 8 * c) = o; }
    asm volatile("s_waitcnt lgkmcnt(0)" ::: "memory");
}
__device__ __forceinline__ void p0_weights(Frame& F) {
    LAS float* scr = (LAS float*)(F.lds + 16384 + F.wave * 16384);
    const int gw = F.bid * NWAVES + F.wave, NGW = F.G * NWAVES;
    constexpr int I_QKV = 16 * 144, I_A = 16 * 96, I_GA = 16 * 32, I_GB = 16 * 16, I_M = 16 * 64, I_BA = 16 * 32, I_BB = 8 * 32, I_O = 16 * 32;
    constexpr int PER_L = I_QKV + I_A + I_GA + I_GB + I_M + I_BA + I_BB + I_O;
    for (int it = gw; it < 2 * PER_L; it += NGW) {
        const int l = it / PER_L; int r = it % PER_L;
        const float* win = F.in[5] + (size_t)l * 1024 * PROJW;
        bf16* wqkv = (bf16*)(F.ws + WS_WQKV) + (size_t)l * NQKV * 1024;
        bf16* wa = (bf16*)(F.ws + WS_WA) + (size_t)l * NA * 1024;
        bf16* wg = (bf16*)(F.ws + WS_WG) + (size_t)l * NG * 1024;
        if (r < I_QKV) { transpose_item(win, PROJW, 4096, 1024, 4608, wqkv, scr, r, F.lane); continue; } r -= I_QKV;
        if (r < I_A) { transpose_item(win, PROJW, 0, 1024, 3072, wa, scr, r, F.lane); continue; } r -= I_A;
        if (r < I_GA) { transpose_item(win, PROJW, 3072, 1024, 1024, wg, scr, r, F.lane); continue; } r -= I_GA;
        if (r < I_GB) { transpose_item(win, PROJW, 8704, 1024, 512, wg + (size_t)1024 * 1024, scr, r, F.lane); continue; } r -= I_GB;
        if (r < I_M) { transpose_item(win, PROJW, 9216, 1024, 2048, wg + (size_t)1536 * 1024, scr, r, F.lane); continue; } r -= I_M;
        if (r < I_BA) { transpose_item(F.in[23] + (size_t)l * 1024 * 1024, 1024, 0, 1024, 1024, (bf16*)(F.ws + WS_WBA) + (size_t)l * 1024 * 1024, scr, r, F.lane); continue; } r -= I_BA;
        if (r < I_BB) { transpose_item(F.in[24] + (size_t)l * 512 * 1024, 1024, 0, 512, 1024, (bf16*)(F.ws + WS_WBB) + (size_t)l * 1024 * 512, scr, r, F.lane); continue; } r -= I_BB;
        transpose_item(F.in[25] + (size_t)l * 1024 * 1024, 1024, 0, 1024, 1024, (bf16*)(F.ws + WS_WO) + (size_t)l * 1024 * 1024, scr, r, F.lane);
    }
    const size_t gt = (size_t)F.bid * NTHREADS + F.tid, NGT = (size_t)F.G * NTHREADS;
    for (size_t e = gt; e < (size_t)2 * 512 * 1024; e += NGT) {
        const int l = (int)(e / (512 * 1024)), n = (int)((e / 1024) % 512), k = (int)(e % 1024);
        const float muw = F.in[7][(size_t)(l * 2 + 0) * 1024 + k], mua = F.in[7][(size_t)(l * 2 + 1) * 1024 + k];
        float v = 0.f;
        if (n < 64) v = F.in[9][((size_t)l * 1024 + k) * 64 + n] * (1.f - muw);
        else if (n < 128) v = F.in[9][((size_t)l * 1024 + k) * 64 + (n - 64)] * muw;
        else if (n < 192) v = F.in[12][((size_t)l * 1024 + k) * 64 + (n - 128)] * (1.f - mua);
        else if (n < 256) v = F.in[12][((size_t)l * 1024 + k) * 64 + (n - 192)] * mua;
        else if (n < 320 && l == 1) { const float muv = F.in[19][k]; const int m = (n - 256) & 31; const float w = F.in[21][(size_t)k * 32 + m]; v = (n < 288) ? w * (1.f - muv) : w * muv; }
        ((bf16*)(F.ws + WS_WA))[((size_t)l * NA + 3072 + n) * 1024 + k] = (bf16)f2bf(v);
    }
}
__device__ __forceinline__ void phase_modnorm(Frame& F, int l, const float* xin) {
    const float* mod = (const float*)(F.ws + WS_MOD) + (size_t)l * 2 * 3072;
    const float* g = F.in[2] + l * 1024;
    bf16* XN = (bf16*)(F.ws + WS_XN);
    const int gw = F.bid * NWAVES + F.wave, NGW = F.G * NWAVES;
    for (int m = gw; m < MROWS; m += NGW) {
        const int b = m / SEQ; const f32x4* xr = (const f32x4*)(xin + (size_t)m * 1024) + F.lane;
        f32x4 v[4]; float s = 0.f;
#pragma unroll
        for (int j = 0; j < 4; ++j) { v[j] = xr[64 * j]; s += (v[j].x * v[j].x + v[j].y * v[j].y) + (v[j].z * v[j].z + v[j].w * v[j].w); }
        const float rs = 1.f / sqrtf(wave_sum(s) * (1.f / 1024.f) + 1e-6f);
        u32x2* o = (u32x2*)(XN + (size_t)m * 1024) + F.lane;
#pragma unroll
        for (int j = 0; j < 4; ++j) { const int c = 4 * F.lane + 256 * j;
            const f32x4 gg = *(const f32x4*)(g + c), sh = *(const f32x4*)(mod + b * 3072 + c), sc = *(const f32x4*)(mod + b * 3072 + 1024 + c);
            const f32x4 h = v[j] * rs * gg * (sc + 1.f) + sh; u32x2 w; w.x = pk2(h.x, h.y); w.y = pk2(h.z, h.w); o[64 * j] = w; }
    }
}
__device__ __forceinline__ void phase_final(Frame& F) {
    const float* g = F.in[27]; const int gw = F.bid * NWAVES + F.wave, NGW = F.G * NWAVES;
    for (int m = gw; m < MROWS; m += NGW) {
        f32x4* xr = (f32x4*)(F.out + (size_t)m * 1024) + F.lane; f32x4 v[4]; float s = 0.f;
#pragma unroll
        for (int j = 0; j < 4; ++j) { v[j] = xr[64 * j]; s += (v[j].x * v[j].x + v[j].y * v[j].y) + (v[j].z * v[j].z + v[j].w * v[j].w); }
        const float rs = 1.f / sqrtf(wave_sum(s) * (1.f / 1024.f) + 1e-6f);
#pragma unroll
        for (int j = 0; j < 4; ++j) { const f32x4 gg = *(const f32x4*)(g + 4 * F.lane + 256 * j); xr[64 * j] = v[j] * rs * gg; }
    }
}
__device__ __forceinline__ void phase_attn_naive(Frame& F) {
    const bf16* QKV = (const bf16*)(F.ws + WS_QKV); bf16* YB = (bf16*)(F.ws + WS_YB); const float* rel_bias = F.in[26];
    LAS float* QS = (LAS float*)(F.lds) + F.wave * 640;
    LAS float* PS = QS + 192;
    const int gw = F.bid * NWAVES + F.wave, NGW = F.G * NWAVES, lane = F.lane;
    for (int it = gw; it < MROWS * 8; it += NGW) {
        const int row = it >> 3, h = it & 7, b = row / SEQ, t = row % SEQ;
        const bf16* qrow = QKV + (size_t)row * NQKV;
#pragma unroll
        for (int g = 0; g < 3; ++g) QS[g * 64 + lane] = bf2f(qrow[g * 512 + h * 64 + lane]) * 0.125f;
        __builtin_amdgcn_wave_barrier();
        float sc[3][3]; float mx = -1e30f;
#pragma unroll
        for (int g = 0; g < 3; ++g) { const int dil = (g == 0) ? 1 : (g == 1 ? 4 : 16);
#pragma unroll
            for (int jj = 0; jj < 3; ++jj) { const int j = lane + 64 * jj; const int tk = t - j * dil; float s = -1e30f;
                if (j <= 128 && tk >= 0) {
                    const u32x4* kp = (const u32x4*)(QKV + (size_t)(b * SEQ + tk) * NQKV + 1536 + g * 512 + h * 64);
                    float a = 0.f;
#pragma unroll
                    for (int c8 = 0; c8 < 8; ++c8) { const u32x4 kv = kp[c8]; const LAS float* q = QS + g * 64 + c8 * 8;
                        a += q[0] * bflo(kv.x) + q[1] * bfhi(kv.x) + q[2] * bflo(kv.y) + q[3] * bfhi(kv.y) + q[4] * bflo(kv.z) + q[5] * bfhi(kv.z) + q[6] * bflo(kv.w) + q[7] * bfhi(kv.w); }
                    s = a + rel_bias[(int)T5BUCKET[g][j] * 24 + g * 8 + h];
                }
                sc[g][jj] = s; mx = fmaxf(mx, s); } }
        mx = wave_max(mx);
        float den = 0.f;
#pragma unroll
        for (int g = 0; g < 3; ++g)
#pragma unroll
            for (int jj = 0; jj < 3; ++jj) { const int j = lane + 64 * jj; const float p = (sc[g][jj] > -1e29f) ? __expf(sc[g][jj] - mx) : 0.f; den += p; if (j <= 128) PS[g * 132 + j] = p; }
        den = wave_sum(den);
        __builtin_amdgcn_wave_barrier();
        float o = 0.f;
#pragma unroll
        for (int g = 0; g < 3; ++g) { const int dil = (g == 0) ? 1 : (g == 1 ? 4 : 16); const int jmax = min(128, t / dil);
            const bf16* vp = QKV + (size_t)(b * SEQ + t) * NQKV + 3072 + g * 512 + h * 64 + lane;
            for (int j = 0; j <= jmax; ++j) o += PS[g * 132 + j] * bf2f(vp[-(ptrdiff_t)j * dil * NQKV]); }
        YB[(size_t)row * 512 + h * 64 + lane] = (bf16)f2bf(o / den);
        __builtin_amdgcn_wave_barrier();
    }
}
__device__ __forceinline__ float softplusf_(float x) { return fmaxf(x, 0.f) + log1pf(__expf(-fabsf(x))); }
__device__ __forceinline__ void phase_rwkv_naive(Frame& F, int l) {
    if (F.bid >= 32) return;
    constexpr int TB = 16;
    const int b = F.bid >> 4, h = F.bid & 15, tid = F.tid, lane = F.lane, wave = F.wave;
    const bf16* PA = (const bf16*)(F.ws + WS_PA); bf16* YA = (bf16*)(F.ws + WS_YA); bf16* VF = (bf16*)(F.ws + WS_VFIRST);
    LAS float* L = (LAS float*)F.lds;
    LAS float* W2s = L; LAS float* A2s = L + 4096; LAS float* V2s = L + 8192; LAS float* CV = L + 10240;
    LAS float* PRs = L + 11264; LAS float* PKs = PRs + 17 * 64; LAS float* PVs = PKs + 17 * 64; LAS float* LOs = PVs + 17 * 64;
    LAS float* LWs = LOs + 17 * 320; LAS float* LAs = LWs + TB * 64; LAS float* LVs = LAs + TB * 64;
    LAS float* Rs = LVs + TB * 32; LAS float* Ws = Rs + TB * 64; LAS float* Ks = Ws + TB * 64; LAS float* Vs = Ks + TB * 64; LAS float* As = Vs + TB * 64; LAS float* Bs = As + TB * 64;
    LAS float* RKs = Bs + TB * 64; LAS float* Ys = RKs + TB;
    for (int e = tid; e < 4096; e += NTHREADS) { const int m = e >> 6, j = e & 63;
        W2s[e] = F.in[10][((size_t)l * 64 + m) * 1024 + h * 64 + j]; A2s[e] = F.in[13][((size_t)l * 64 + m) * 1024 + h * 64 + j];
        if (m < 32) V2s[e] = (l == 1) ? F.in[22][(size_t)m * 1024 + h * 64 + j] : 0.f; }
    if (tid < 64) { const int c = h * 64 + tid;
        CV[0 * 64 + tid] = F.in[8][l * 1024 + c];  CV[1 * 64 + tid] = F.in[11][l * 1024 + c]; CV[2 * 64 + tid] = (l == 1) ? F.in[20][c] : 0.f;
        CV[3 * 64 + tid] = F.in[14][l * 1024 + c]; CV[4 * 64 + tid] = F.in[15][l * 1024 + c]; CV[5 * 64 + tid] = F.in[16][l * 1024 + c];
        CV[6 * 64 + tid] = F.in[17][l * 1024 + c]; CV[7 * 64 + tid] = F.in[18][l * 1024 + c];
        CV[8 * 64 + tid] = F.in[6][(size_t)(l * 3 + 0) * 1024 + c]; CV[9 * 64 + tid] = F.in[6][(size_t)(l * 3 + 1) * 1024 + c]; CV[10 * 64 + tid] = F.in[6][(size_t)(l * 3 + 2) * 1024 + c]; }
    float S[16];
#pragma unroll
    for (int q = 0; q < 16; ++q) S[q] = 0.f;
    __syncthreads();
    for (int t0 = 0; t0 < SEQ; t0 += TB) {
        for (int e = tid; e < 17 * 512; e += NTHREADS) { const int rr = e >> 9, cc = e & 511, t = t0 - 1 + rr; float v = 0.f;
            if (t >= 0) { const int gc = (cc < 192) ? ((cc >> 6) * 1024 + h * 64 + (cc & 63)) : (3072 + cc - 192); v = bf2f(PA[(size_t)(b * SEQ + t) * NA + gc]); }
            if (cc < 64) PRs[rr * 64 + cc] = v; else if (cc < 128) PKs[rr * 64 + cc - 64] = v; else if (cc < 192) PVs[rr * 64 + cc - 128] = v; else LOs[rr * 320 + cc - 192] = v; }
        __syncthreads();
        for (int e = tid; e < TB * 160; e += NTHREADS) { const int tl = e / 160, m = e % 160; const LAS float* cur = LOs + (tl + 1) * 320; const LAS float* prv = LOs + tl * 320;
            if (m < 64) LWs[tl * 64 + m] = tanhf(cur[m] + prv[64 + m]);
            else if (m < 128) LAs[tl * 64 + m - 64] = cur[128 + m - 64] + prv[192 + m - 64];
            else LVs[tl * 32 + m - 128] = cur[256 + m - 128] + prv[288 + m - 128]; }
        __syncthreads();
        for (int tl = wave; tl < TB; tl += NWAVES) { const int j = lane; const size_t row = (size_t)(b * SEQ + t0 + tl);
            float wpre = CV[j], apre = CV[64 + j], vpre = CV[128 + j];
            for (int m = 0; m < 64; ++m) { wpre += LWs[tl * 64 + m] * W2s[m * 64 + j]; apre += LAs[tl * 64 + m] * A2s[m * 64 + j]; }
            for (int m = 0; m < 32; ++m) vpre += LVs[tl * 32 + m] * V2s[m * 64 + j];
            const float pr = PRs[(tl + 1) * 64 + j], prp = PRs[tl * 64 + j], pk = PKs[(tl + 1) * 64 + j], pkp = PKs[tl * 64 + j], pv = PVs[(tl + 1) * 64 + j], pvp = PVs[tl * 64 + j];
            const float r = pr + (prp - pr) * CV[8 * 64 + j], k = pk + (pkp - pk) * CV[9 * 64 + j]; float v = pv + (pvp - pv) * CV[10 * 64 + j];
            const float w = -softplusf_(-wpre) - 0.5f; const float decay = __expf(-__expf(w)); const float asig = sigmoidf_(apre);
            if (l == 0) VF[row * 1024 + h * 64 + j] = (bf16)f2bf(v); else { const float vf = bf2f(VF[row * 1024 + h * 64 + j]); v = v + (vf - v) * sigmoidf_(vpre); }
            const float kk = k * CV[3 * 64 + j]; const float ss = wave_sum(kk * kk); const float kkn = kk * (1.f / sqrtf(fmaxf(ss, 1e-24f)));
            const float k2 = k * (1.f + (asig - 1.f) * CV[4 * 64 + j]);
            const float rk = wave_sum(r * k2 * CV[5 * 64 + j]);
            Rs[tl * 64 + j] = r; Ws[tl * 64 + j] = decay; Ks[tl * 64 + j] = k2; Vs[tl * 64 + j] = v; As[tl * 64 + j] = -kkn; Bs[tl * 64 + j] = kkn * asig;
            if (lane == 0) RKs[tl] = rk; }
        __syncthreads();
        if (wave < 4) { const int i = wave * 16 + (lane >> 2), jq = lane & 3;
            for (int tl = 0; tl < TB; ++tl) { const int o = tl * 64 + jq * 16; const float vi = Vs[tl * 64 + i];
                float sa = 0.f;
#pragma unroll
                for (int q = 0; q < 16; ++q) sa += S[q] * As[o + q];
                sa += __shfl_xor(sa, 1); sa += __shfl_xor(sa, 2);
                float y = 0.f;
#pragma unroll
                for (int q = 0; q < 16; ++q) { S[q] = S[q] * Ws[o + q] + sa * Bs[o + q] + vi * Ks[o + q]; y += S[q] * Rs[o + q]; }
                y += __shfl_xor(y, 1); y += __shfl_xor(y, 2);
                if (jq == 0) Ys[tl * 64 + i] = y; } }
        __syncthreads();
        for (int tl = wave; tl < TB; tl += NWAVES) { const int i = lane; const size_t row = (size_t)(b * SEQ + t0 + tl);
            const float y = Ys[tl * 64 + i]; const float mean = wave_sum(y) * (1.f / 64.f); const float d = y - mean; const float var = wave_sum(d * d) * (1.f / 64.f);
            const float o = d * (1.f / sqrtf(var + 64e-5f)) * CV[6 * 64 + i] + CV[7 * 64 + i] + RKs[tl] * Vs[tl * 64 + i];
            YA[row * 1024 + h * 64 + i] = (bf16)f2bf(o); }
    }
}
typedef short bf16x8 __attribute__((ext_vector_type(8)));
typedef short s16x4 __attribute__((ext_vector_type(4)));
typedef short v4i16_t __attribute__((ext_vector_type(4)));
constexpr int RC = 32, RLS = 256, RNSC = SEQ / RLS, RNCH = RLS / RC, RITEMS = BATCH * 16 * RNSC;
constexpr int AST = 72;
constexpr int MST = 40;
constexpr int OFF_RAWH = 0, OFF_RAWL = 12800, OFF_MK = 12800, OFF_QB = 15360, OFF_QK = 17920, OFF_YS = 20480;
constexpr int OFF_LW = 34048, OFF_LA = OFF_LW + 4608, OFF_LV = OFF_LA + 4608;
constexpr int OFF_W2T = 45824, OFF_A2T = OFF_W2T + 9216, OFF_V2T = OFF_A2T + 9216;
constexpr int OFF_CV = 69376, OFF_GAM = 72192, OFF_RK = 72448;
constexpr int OFF_PRE = 72576, OFF_U = 72576, OFF_T = OFF_U + 8704;
constexpr int OFF_LWG = 97664, OFF_ARR = 105856;
constexpr int PRE_ST = 196, U_ST = 68, T_ST = 36, YS_ST = 68;
enum { AR_RT = 0, AR_AT, AR_BT, AR_KT, AR_BH, AR_KH, AR_V, AR_W };
static_assert(OFF_ARR + 8 * 32 * AST * 2 <= LDS_BYTES, "rwkv LDS map");
#define ARR(k) (F.lds + OFF_ARR + (k) * (32 * AST * 2))

__device__ __forceinline__ bf16x8 ld_b128(const LAS unsigned char* p) { return *(const LAS bf16x8*)p; }
__device__ __forceinline__ s16x4 ld_b64(const LAS unsigned char* p) { return *(const LAS s16x4*)p; }
__device__ __forceinline__ s16x4 ld_tr(const LAS unsigned char* p) { return __builtin_bit_cast(s16x4, __builtin_amdgcn_ds_read_tr16_b64_v4i16((LAS v4i16_t*)p)); }
__device__ __forceinline__ bf16x8 cat8(s16x4 a, s16x4 b) { return (bf16x8){a[0], a[1], a[2], a[3], b[0], b[1], b[2], b[3]}; }
__device__ __forceinline__ bf16x8 pack8(f32x4 a, f32x4 b) { u32x4 w; w.x = pk2(a[0], a[1]); w.y = pk2(a[2], a[3]); w.z = pk2(b[0], b[1]); w.w = pk2(b[2], b[3]); return __builtin_bit_cast(bf16x8, w); }
#define MFMA16(a, b, c) __builtin_amdgcn_mfma_f32_16x16x32_bf16((a), (b), (c), 0, 0, 0)
__device__ __forceinline__ void st_bf(LAS unsigned char* base, int idx, float v) { ((LAS bf16*)base)[idx] = (bf16)f2bf(v); }

template <int PASS> __device__ __forceinline__ void rwkv_pass(Frame& F, int l) {
    const int tid = F.tid, lane = F.lane, wave = F.wave, g = lane >> 4, c = lane & 15;
    const bf16* PA = (const bf16*)(F.ws + WS_PA); bf16* YA = (bf16*)(F.ws + WS_YA); bf16* VF = (bf16*)(F.ws + WS_VFIRST);
    float* PD = (float*)(F.ws + WS_SC); float* SST = (float*)(F.ws + WS_SC + 32 * MiB);
    LAS float* CV = (LAS float*)(F.lds + OFF_CV); LAS float* GAM = (LAS float*)(F.lds + OFF_GAM); LAS float* RK = (LAS float*)(F.lds + OFF_RK);
    LAS float* PRE = (LAS float*)(F.lds + OFF_PRE); LAS float* Us = (LAS float*)(F.lds + OFF_U); LAS float* Ts = (LAS float*)(F.lds + OFF_T);
    LAS float* LWG = (LAS float*)(F.lds + OFF_LWG); LAS float* YS = (LAS float*)(F.lds + OFF_YS);
    LAS bf16* RAWH = (LAS bf16*)(F.lds + OFF_RAWH); LAS bf16* RAWL = (LAS bf16*)(F.lds + OFF_RAWL);
    for (int it = F.bid; it < RITEMS; it += F.G) {
        const int b = it / (16 * RNSC), h = (it / RNSC) % 16, sc = it % RNSC;
        __syncthreads();
        for (int e = tid; e < 4096; e += NTHREADS) { const int m = e >> 6, j = e & 63;
            st_bf(F.lds + OFF_W2T, j * AST + m, F.in[10][((size_t)l * 64 + m) * 1024 + h * 64 + j]);
            st_bf(F.lds + OFF_A2T, j * AST + m, F.in[13][((size_t)l * 64 + m) * 1024 + h * 64 + j]);
            if (m < 32) st_bf(F.lds + OFF_V2T, j * MST + m, (l == 1) ? F.in[22][(size_t)m * 1024 + h * 64 + j] : 0.f); }
        if (tid < 64) { const int cc = h * 64 + tid;
            CV[0 * 64 + tid] = F.in[8][l * 1024 + cc];  CV[1 * 64 + tid] = F.in[11][l * 1024 + cc]; CV[2 * 64 + tid] = (l == 1) ? F.in[20][cc] : 0.f;
            CV[3 * 64 + tid] = F.in[14][l * 1024 + cc]; CV[4 * 64 + tid] = F.in[15][l * 1024 + cc]; CV[5 * 64 + tid] = F.in[16][l * 1024 + cc];
            CV[6 * 64 + tid] = F.in[17][l * 1024 + cc]; CV[7 * 64 + tid] = F.in[18][l * 1024 + cc];
            CV[8 * 64 + tid] = F.in[6][(size_t)(l * 3 + 0) * 1024 + cc]; CV[9 * 64 + tid] = F.in[6][(size_t)(l * 3 + 1) * 1024 + cc]; CV[10 * 64 + tid] = F.in[6][(size_t)(l * 3 + 2) * 1024 + cc]; }
        f32x4 X[4];
#pragma unroll
        for (int jt = 0; jt < 4; ++jt) X[jt] = (f32x4){0.f, 0.f, 0.f, 0.f};
        if (PASS == 1) { if (wave >= 4) {
#pragma unroll
                for (int jt = 0; jt < 4; ++jt)
#pragma unroll
                    for (int r = 0; r < 4; ++r) X[jt][r] = (16 * jt + 4 * g + r == 16 * (wave - 4) + c) ? 1.f : 0.f; } }
        else if (wave < 4) { const float* s0 = SST + (size_t)it * 4096;
#pragma unroll
            for (int jt = 0; jt < 4; ++jt)
#pragma unroll
                for (int r = 0; r < 4; ++r) X[jt][r] = s0[(16 * jt + 4 * g + r) * 64 + 16 * wave + c]; }
        for (int ch = 0; ch < RNCH; ++ch) {
            const int t0 = sc * RLS + ch * RC;
            __syncthreads();
            for (int e = tid; e < 33 * 64; e += NTHREADS) { const int rr = e >> 6, k = e & 63, t = t0 - 1 + rr; u32x4 v = (u32x4){0u, 0u, 0u, 0u};
                const int gc = (k < 24) ? ((k >> 3) * 1024 + h * 64 + (k & 7) * 8) : (3072 + (k - 24) * 8);
                if (t >= 0) v = *(const u32x4*)(PA + (size_t)(b * SEQ + t) * NA + gc);
                if (k < 24) *(LAS u32x4*)(RAWH + rr * 192 + k * 8) = v; else *(LAS u32x4*)(RAWL + rr * 320 + (k - 24) * 8) = v; }
            __syncthreads();
            for (int e = tid; e < 32 * 160; e += NTHREADS) { const int tl = e / 160, m = e % 160; const LAS bf16* cur = RAWL + (tl + 1) * 320; const LAS bf16* prv = RAWL + tl * 320;
                if (m < 64) st_bf(F.lds + OFF_LW, tl * AST + m, tanhf(bf2f(cur[m]) + bf2f(prv[64 + m])));
                else if (m < 128) st_bf(F.lds + OFF_LA, tl * AST + (m - 64), bf2f(cur[128 + m - 64]) + bf2f(prv[192 + m - 64]));
                else st_bf(F.lds + OFF_LV, tl * MST + (m - 128), bf2f(cur[256 + m - 128]) + bf2f(prv[288 + m - 128])); }
            __syncthreads();
#pragma unroll
            for (int q = 0; q < 3; ++q) { const int tile = wave * 3 + q, tt = tile / 12, nt = tile % 12, mat = nt >> 2, jt = nt & 3;
                f32x4 acc = (f32x4){0.f, 0.f, 0.f, 0.f};
                if (mat < 2) { const LAS unsigned char* Ab = F.lds + (mat == 0 ? OFF_LW : OFF_LA) + ((16 * tt + c) * AST + 8 * g) * 2; const LAS unsigned char* Bb = F.lds + (mat == 0 ? OFF_W2T : OFF_A2T) + ((16 * jt + c) * AST + 8 * g) * 2;
                    acc = MFMA16(ld_b128(Ab), ld_b128(Bb), acc); acc = MFMA16(ld_b128(Ab + 64), ld_b128(Bb + 64), acc); }
                else { const LAS unsigned char* Ab = F.lds + OFF_LV + ((16 * tt + c) * MST + 8 * g) * 2; const LAS unsigned char* Bb = F.lds + OFF_V2T + ((16 * jt + c) * MST + 8 * g) * 2;
                    acc = MFMA16(ld_b128(Ab), ld_b128(Bb), acc); }
#pragma unroll
                for (int r = 0; r < 4; ++r) PRE[(16 * tt + 4 * g + r) * PRE_ST + 16 * nt + c] = acc[r]; }
            __syncthreads();
            for (int e = tid; e < 32 * 64; e += NTHREADS) { const int t = e >> 6, j = e & 63; const float wpre = PRE[t * PRE_ST + j] + CV[j];
                const float w = -softplusf_(-wpre) - 0.5f; LWG[t * 64 + j] = -__expf(w); }
            __syncthreads();
            if (tid < 64) { float a = 0.f;
#pragma unroll 8
                for (int t = 0; t < 32; ++t) { a += LWG[t * 64 + tid]; LWG[t * 64 + tid] = a; }
                GAM[tid] = __expf(a); }
            __syncthreads();
            for (int tl = wave; tl < 32; tl += NWAVES) { const int j = lane; const size_t row = (size_t)(b * SEQ + t0 + tl);
                const float apre = PRE[tl * PRE_ST + 64 + j] + CV[64 + j], vpre = PRE[tl * PRE_ST + 128 + j] + CV[128 + j];
                const float pr = bf2f(RAWH[(tl + 1) * 192 + j]), prp = bf2f(RAWH[tl * 192 + j]), pk = bf2f(RAWH[(tl + 1) * 192 + 64 + j]), pkp = bf2f(RAWH[tl * 192 + 64 + j]);
                const float pv = bf2f(RAWH[(tl + 1) * 192 + 128 + j]), pvp = bf2f(RAWH[tl * 192 + 128 + j]);
                const float r = pr + (prp - pr) * CV[8 * 64 + j], k = pk + (pkp - pk) * CV[9 * 64 + j]; float v = pv + (pvp - pv) * CV[10 * 64 + j];
                const float asig = sigmoidf_(apre);
                if (l == 0) { if (PASS == 1) VF[row * 1024 + h * 64 + j] = (bf16)f2bf(v); } else { const float vf = bf2f(VF[row * 1024 + h * 64 + j]); v = v + (vf - v) * sigmoidf_(vpre); }
                const float kk = k * CV[3 * 64 + j]; const float ss = wave_sum(kk * kk); const float kkn = kk * (1.f / sqrtf(fmaxf(ss, 1e-24f)));
                const float k2 = k * (1.f + (asig - 1.f) * CV[4 * 64 + j]); const float av = -kkn, bv = kkn * asig;
                const float gt = LWG[tl * 64 + j], gp = (tl > 0) ? LWG[(tl - 1) * 64 + j] : 0.f, gC = LWG[31 * 64 + j];
                const float eg = __expf(gt), egp = __expf(gp), einv = __expf(-gt), eh = __expf(gC - gt);
                const int o = tl * AST + j;
                st_bf(ARR(AR_AT), o, av * egp); st_bf(ARR(AR_BT), o, bv * einv); st_bf(ARR(AR_KT), o, k2 * einv); st_bf(ARR(AR_BH), o, bv * eh); st_bf(ARR(AR_KH), o, k2 * eh); st_bf(ARR(AR_V), o, v);
                if (PASS == 3) { st_bf(ARR(AR_RT), o, r * eg); const float rk = wave_sum(r * k2 * CV[5 * 64 + j]); if (lane == 0) RK[tl] = rk; } }
            __syncthreads();
#pragma unroll
            for (int q = 0; q < 2; ++q) { const int tile = wave * 2 + q, rt = tile >> 2, ct = tile & 3, tt = rt & 1, st = ct & 1;
                if (PASS == 1 && rt >= 2) continue;
                f32x4 acc = (f32x4){0.f, 0.f, 0.f, 0.f};
                if (st <= tt) { const LAS unsigned char* Ab = ARR(rt < 2 ? AR_AT : AR_RT) + ((16 * tt + c) * AST + 8 * g) * 2; const LAS unsigned char* Bb = ARR(ct < 2 ? AR_BT : AR_KT) + ((16 * st + c) * AST + 8 * g) * 2;
                    acc = MFMA16(ld_b128(Ab), ld_b128(Bb), acc); acc = MFMA16(ld_b128(Ab + 64), ld_b128(Bb + 64), acc); }
                const int s = 16 * st + c;
#pragma unroll
                for (int r = 0; r < 4; ++r) { const int t = 16 * tt + 4 * g + r; const bool keep = (rt < 2) ? (s < t) : (s <= t); const float v = keep ? acc[r] : 0.f;
                    if (rt < 2 && ct < 2) Ts[t * T_ST + s] = v; else st_bf(F.lds + (rt < 2 ? OFF_MK : (ct < 2 ? OFF_QB : OFF_QK)), t * MST + s, v); } }
            __syncthreads();
            { const int tt = wave >> 2, itl = wave & 3;
              const bf16x8 a = ld_b128(F.lds + OFF_MK + ((16 * tt + c) * MST + 8 * g) * 2);
              const int q = c >> 2, p = c & 3;
              const LAS unsigned char* vb = ARR(AR_V) + ((8 * g + q) * AST + 16 * itl + 4 * p) * 2;
              const bf16x8 bfr = cat8(ld_tr(vb), ld_tr(vb + 4 * AST * 2));
              f32x4 acc = (f32x4){0.f, 0.f, 0.f, 0.f}; acc = MFMA16(a, bfr, acc);
#pragma unroll
              for (int r = 0; r < 4; ++r) Us[(16 * tt + 4 * g + r) * U_ST + 16 * itl + c] = acc[r]; }
            __syncthreads();
            if (wave < 2) { float x[32];
#pragma unroll
                for (int t = 0; t < 32; ++t) { float a = (wave == 0) ? bf2f(((const LAS bf16*)ARR(AR_AT))[t * AST + lane]) : Us[t * U_ST + lane];
#pragma unroll
                    for (int s4 = 0; s4 < (t + 3) / 4; ++s4) { const f32x4 tv = *(const LAS f32x4*)(Ts + t * T_ST + 4 * s4);
#pragma unroll
                        for (int e = 0; e < 4; ++e) if (4 * s4 + e < t) a += tv[e] * x[4 * s4 + e]; }
                    x[t] = a;
                    if (wave == 0) st_bf(ARR(AR_W), t * AST + lane, a); else Us[t * U_ST + lane] = a; } }
            __syncthreads();
            const bool active = (PASS == 1) ? true : (wave < 4);
            const bool inhom = (PASS == 1) ? (wave < 4) : true;
            const int cw = wave & 3;
            if (active) {
                bf16x8 xf[2];
                xf[0] = pack8(X[0], X[1]); xf[1] = pack8(X[2], X[3]);
                f32x4 Z[2];
#pragma unroll
                for (int tt = 0; tt < 2; ++tt) { f32x4 z = (f32x4){0.f, 0.f, 0.f, 0.f};
                    if (inhom) {
#pragma unroll
                        for (int r = 0; r < 4; ++r) z[r] = Us[(16 * tt + 4 * g + r) * U_ST + 16 * cw + c]; }
#pragma unroll
                    for (int ks = 0; ks < 2; ++ks) { const LAS unsigned char* wb = ARR(AR_W) + ((16 * tt + c) * AST + 32 * ks + 4 * g) * 2;
                        z = MFMA16(cat8(ld_b64(wb), ld_b64(wb + 32)), xf[ks], z); }
                    Z[tt] = z; }
                const bf16x8 zf = pack8(Z[0], Z[1]);
                bf16x8 vf = zf;
                if (inhom) { const int q = c >> 2, p = c & 3; const LAS unsigned char* vb = ARR(AR_V) + ((4 * g + q) * AST + 16 * cw + 4 * p) * 2; vf = cat8(ld_tr(vb), ld_tr(vb + 16 * AST * 2)); }
                if (PASS == 3) {
#pragma unroll
                    for (int tt = 0; tt < 2; ++tt) { f32x4 y = (f32x4){0.f, 0.f, 0.f, 0.f};
#pragma unroll
                        for (int ks = 0; ks < 2; ++ks) { const LAS unsigned char* rb = ARR(AR_RT) + ((16 * tt + c) * AST + 32 * ks + 4 * g) * 2;
                            y = MFMA16(cat8(ld_b64(rb), ld_b64(rb + 32)), xf[ks], y); }
                        const LAS unsigned char* qb = F.lds + OFF_QB + ((16 * tt + c) * MST + 4 * g) * 2; const LAS unsigned char* qk = F.lds + OFF_QK + ((16 * tt + c) * MST + 4 * g) * 2;
                        y = MFMA16(cat8(ld_b64(qb), ld_b64(qb + 32)), zf, y);
                        y = MFMA16(cat8(ld_b64(qk), ld_b64(qk + 32)), vf, y);
#pragma unroll
                        for (int r = 0; r < 4; ++r) YS[(16 * tt + 4 * g + r) * YS_ST + 16 * cw + c] = y[r]; } }
                { const int q = c >> 2, p = c & 3;
#pragma unroll
                  for (int jt = 0; jt < 4; ++jt) { f32x4 xn;
#pragma unroll
                      for (int r = 0; r < 4; ++r) xn[r] = X[jt][r] * GAM[16 * jt + 4 * g + r];
                      const LAS unsigned char* bb = ARR(AR_BH) + ((4 * g + q) * AST + 16 * jt + 4 * p) * 2;
                      xn = MFMA16(cat8(ld_tr(bb), ld_tr(bb + 16 * AST * 2)), zf, xn);
                      if (inhom) { const LAS unsigned char* kb = ARR(AR_KH) + ((4 * g + q) * AST + 16 * jt + 4 * p) * 2; xn = MFMA16(cat8(ld_tr(kb), ld_tr(kb + 16 * AST * 2)), vf, xn); }
                      X[jt] = xn; } }
            }
            if (PASS == 3) {
                __syncthreads();
                for (int tl = wave; tl < 32; tl += NWAVES) { const int i = lane; const size_t row = (size_t)(b * SEQ + t0 + tl);
                    const float y = YS[tl * YS_ST + i]; const float mean = wave_sum(y) * (1.f / 64.f); const float d = y - mean; const float var = wave_sum(d * d) * (1.f / 64.f);
                    const float o = d * (1.f / sqrtf(var + 64e-5f)) * CV[6 * 64 + i] + CV[7 * 64 + i] + RK[tl] * bf2f(((const LAS bf16*)ARR(AR_V))[tl * AST + i]);
                    YA[row * 1024 + h * 64 + i] = (bf16)f2bf(o); }
            }
        }
        if (PASS == 1) { float* pd = PD + (size_t)it * 8192;
#pragma unroll
            for (int jt = 0; jt < 4; ++jt)
#pragma unroll
                for (int r = 0; r < 4; ++r) pd[(16 * jt + 4 * g + r) * 128 + 16 * wave + c] = X[jt][r]; }
    }
}
__device__ __forceinline__ void rwkv_pass2(Frame& F) {
    if (F.bid >= 32) return;
    const float* PD = (const float*)(F.ws + WS_SC); float* SST = (float*)(F.ws + WS_SC + 32 * MiB);
    LAS float* S = (LAS float*)F.lds;
    const int tid = F.tid, j = tid >> 3, i0 = (tid & 7) * 8;
    float s[8];
#pragma unroll
    for (int e = 0; e < 8; ++e) s[e] = 0.f;
    for (int sc = 0; sc < RNSC; ++sc) { const size_t it = (size_t)F.bid * RNSC + sc;
        float* so = SST + it * 4096 + j * 64 + i0;
        *(f32x4*)so = (f32x4){s[0], s[1], s[2], s[3]}; *(f32x4*)(so + 4) = (f32x4){s[4], s[5], s[6], s[7]};
        __syncthreads();
        *(LAS f32x4*)(S + j * 68 + i0) = (f32x4){s[0], s[1], s[2], s[3]}; *(LAS f32x4*)(S + j * 68 + i0 + 4) = (f32x4){s[4], s[5], s[6], s[7]};
        __syncthreads();
        const float* pd = PD + it * 8192 + j * 128;
        const f32x4 d0 = *(const f32x4*)(pd + i0), d1 = *(const f32x4*)(pd + i0 + 4);
        float a[8] = {d0[0], d0[1], d0[2], d0[3], d1[0], d1[1], d1[2], d1[3]};
#pragma unroll 4
        for (int q = 0; q < 16; ++q) { const f32x4 pv = *(const f32x4*)(pd + 64 + 4 * q);
#pragma unroll
            for (int e = 0; e < 4; ++e) { const f32x4 s0 = *(const LAS f32x4*)(S + (4 * q + e) * 68 + i0), s1 = *(const LAS f32x4*)(S + (4 * q + e) * 68 + i0 + 4);
                a[0] += pv[e] * s0[0]; a[1] += pv[e] * s0[1]; a[2] += pv[e] * s0[2]; a[3] += pv[e] * s0[3]; a[4] += pv[e] * s1[0]; a[5] += pv[e] * s1[1]; a[6] += pv[e] * s1[2]; a[7] += pv[e] * s1[3]; } }
#pragma unroll
        for (int e = 0; e < 8; ++e) s[e] = a[e];
    }
}
constexpr size_t WS_LSE = 330 * MiB;
constexpr int AT_KS = 0, AT_VS = 36864, AT_BIAS = 76032, KVST = 72;
__device__ __forceinline__ void phase_attn_mfma(Frame& F) {
    bf16* QKV = (bf16*)(F.ws + WS_QKV); float* LSE = (float*)(F.ws + WS_LSE); const float* rel_bias = F.in[26];
    const int tid = F.tid, lane = F.lane, w = F.wave, g = lane >> 4, c = lane & 15, q4 = c >> 2, p4 = c & 3;
    LAS float* BIAS = (LAS float*)(F.lds + AT_BIAS);
    for (int e = tid; e < 16 * KVST / 2; e += NTHREADS) ((LAS unsigned*)(F.lds + AT_VS + 256 * KVST * 2))[e] = 0u;
    for (int u = F.bid; u < 3072; u += F.G) {
        const int blk = u & 63, h = (u >> 6) & 7, bg = u >> 9, gatt = bg % 3, b = bg / 3;
        const int dil = (gatt == 0) ? 1 : (gatt == 1 ? 4 : 16), nblk = 64 / dil, r = blk / nblk, n = blk % nblk;
        __syncthreads();
        if (tid < 129) BIAS[tid] = rel_bias[(int)T5BUCKET[gatt][tid] * 24 + gatt * 8 + h];
        for (int e = tid; e < 4096; e += NTHREADS) { const int which = e >> 11, rowi = (e >> 3) & 255, chn = e & 7; const int lk = 128 * n - 128 + rowi; u32x4 v = (u32x4){0u, 0u, 0u, 0u};
            if (lk >= 0) v = *(const u32x4*)(QKV + (size_t)(b * SEQ + lk * dil + r) * NQKV + 1536 + which * 1536 + gatt * 512 + h * 64 + chn * 8);
            *(LAS u32x4*)(F.lds + (which ? AT_VS : AT_KS) + (rowi * KVST + chn * 8) * 2) = v; }
        const size_t qrow = (size_t)(b * SEQ + (128 * n + 16 * w + c) * dil + r);
        bf16x8 qf[2];
#pragma unroll
        for (int ks = 0; ks < 2; ++ks) { const u32x4 v = *(const u32x4*)(QKV + qrow * NQKV + gatt * 512 + h * 64 + 32 * ks + 8 * g); u32x4 o;
            o.x = pk2(bflo(v.x) * 0.125f, bfhi(v.x) * 0.125f); o.y = pk2(bflo(v.y) * 0.125f, bfhi(v.y) * 0.125f); o.z = pk2(bflo(v.z) * 0.125f, bfhi(v.z) * 0.125f); o.w = pk2(bflo(v.w) * 0.125f, bfhi(v.w) * 0.125f);
            qf[ks] = __builtin_bit_cast(bf16x8, o); }
        __syncthreads();
        f32x4 S[9];
#pragma unroll
        for (int j = 0; j < 9; ++j) { const LAS unsigned char* kb = F.lds + AT_KS + ((16 * (w + j) + c) * KVST + 8 * g) * 2;
            f32x4 a = (f32x4){0.f, 0.f, 0.f, 0.f}; a = MFMA16(ld_b128(kb), qf[0], a); a = MFMA16(ld_b128(kb + 64), qf[1], a); S[j] = a; }
        float mx = -1e30f;
#pragma unroll
        for (int j = 0; j < 9; ++j)
#pragma unroll
            for (int rr = 0; rr < 4; ++rr) { const int delta = 128 - 16 * j + c - 4 * g - rr, ki = 16 * (w + j) + 4 * g + rr;
                const bool valid = (delta >= 0) && (delta <= 128) && (n > 0 || ki >= 128);
                const float s = valid ? S[j][rr] + BIAS[valid ? delta : 0] : -1e30f; S[j][rr] = s; mx = fmaxf(mx, s); }
        mx = fmaxf(mx, __shfl_xor(mx, 16)); mx = fmaxf(mx, __shfl_xor(mx, 32));
        float lsum = 0.f;
#pragma unroll
        for (int j = 0; j < 9; ++j)
#pragma unroll
            for (int rr = 0; rr < 4; ++rr) { const float p = (S[j][rr] > -1e29f) ? __expf(S[j][rr] - mx) : 0.f; S[j][rr] = p; lsum += p; }
        lsum += __shfl_xor(lsum, 16); lsum += __shfl_xor(lsum, 32);
        f32x4 O[4];
#pragma unroll
        for (int dt = 0; dt < 4; ++dt) O[dt] = (f32x4){0.f, 0.f, 0.f, 0.f};
#pragma unroll
        for (int m5 = 0; m5 < 5; ++m5) { const f32x4 z4 = (f32x4){0.f, 0.f, 0.f, 0.f};
            const bf16x8 pf = pack8(S[2 * m5], (2 * m5 + 1 < 9) ? S[(2 * m5 + 1 < 9) ? 2 * m5 + 1 : 0] : z4);
            const LAS unsigned char* vb = F.lds + AT_VS + ((16 * (w + 2 * m5) + 4 * g + q4) * KVST + 4 * p4) * 2;
#pragma unroll
            for (int dt = 0; dt < 4; ++dt) O[dt] = MFMA16(pf, cat8(ld_tr(vb + dt * 32), ld_tr(vb + dt * 32 + 16 * KVST * 2)), O[dt]); }
        const float linv = 1.f / lsum;
        if (g == 0) LSE[qrow * 24 + gatt * 8 + h] = mx + __logf(lsum);
#pragma unroll
        for (int rr = 0; rr < 4; ++rr) { const float li = __shfl(linv, 4 * g + rr);
            bf16* op = QKV + (size_t)(b * SEQ + (128 * n + 16 * w + 4 * g + rr) * dil + r) * NQKV + gatt * 512 + h * 64 + c;
#pragma unroll
            for (int dt = 0; dt < 4; ++dt) op[16 * dt] = (bf16)f2bf(O[dt][rr] * li); }
    }
}
__device__ __forceinline__ void phase_attn_merge(Frame& F) {
    const bf16* QKV = (const bf16*)(F.ws + WS_QKV); const float* LSE = (const float*)(F.ws + WS_LSE); bf16* YB = (bf16*)(F.ws + WS_YB);
    const size_t gt = (size_t)F.bid * NTHREADS + F.tid, NGT = (size_t)F.G * NTHREADS;
    for (size_t e = gt; e < (size_t)MROWS * 64; e += NGT) { const size_t row = e >> 6; const int h = (int)(e >> 3) & 7, d8 = (int)e & 7;
        const float l0 = LSE[row * 24 + h], l1 = LSE[row * 24 + 8 + h], l2 = LSE[row * 24 + 16 + h]; const float m = fmaxf(l0, fmaxf(l1, l2));
        float w0 = __expf(l0 - m), w1 = __expf(l1 - m), w2 = __expf(l2 - m); const float inv = 1.f / (w0 + w1 + w2); w0 *= inv; w1 *= inv; w2 *= inv;
        const bf16* qp = QKV + row * NQKV + h * 64 + d8 * 8;
        const u32x4 a = *(const u32x4*)qp, bq = *(const u32x4*)(qp + 512), cq = *(const u32x4*)(qp + 1024); u32x4 o;
        o.x = pk2(w0 * bflo(a.x) + w1 * bflo(bq.x) + w2 * bflo(cq.x), w0 * bfhi(a.x) + w1 * bfhi(bq.x) + w2 * bfhi(cq.x));
        o.y = pk2(w0 * bflo(a.y) + w1 * bflo(bq.y) + w2 * bflo(cq.y), w0 * bfhi(a.y) + w1 * bfhi(bq.y) + w2 * bfhi(cq.y));
        o.z = pk2(w0 * bflo(a.z) + w1 * bflo(bq.z) + w2 * bflo(cq.z), w0 * bfhi(a.z) + w1 * bfhi(bq.z) + w2 * bfhi(cq.z));
        o.w = pk2(w0 * bflo(a.w) + w1 * bflo(bq.w) + w2 * bflo(cq.w), w0 * bfhi(a.w) + w1 * bfhi(bq.w) + w2 * bfhi(cq.w));
        *(u32x4*)(YB + row * 512 + h * 64 + d8 * 8) = o; }
}
#define GEMM_LDS ((PG8_LAS unsigned char*)F.lds)
template <class Epi> __device__ __forceinline__ void run_gemm(Frame& F, const bf16* A, const bf16* Bt, int N, int K, const Epi& E) {
    pg8::Gemm g{A, Bt, MROWS, N, K}; pg8::StaticOrder S; S.init(MROWS, N, F.G, F.bid);
    pg8::gemm_phase<Epi, pg8::StaticOrder, true, true>(GEMM_LDS, g, S, E);
}
#ifdef TPROBE
#define STAMP(cls) do { if (blockIdx.x == 0 && threadIdx.x == 0) { unsigned long long* ts_ = (unsigned long long*)(ka->ws + WS_CTL + 4096); const unsigned long long t_ = __builtin_amdgcn_s_memrealtime(); ts_[1 + (cls)] += t_ - ts_[0]; ts_[0] = t_; } } while (0)
#else
#define STAMP(cls) do {} while (0)
#endif
#ifndef PROBE_DUP
#define PROBE_DUP 0
#endif
#ifdef USE_CG_SYNC
#define GSYNC(cls) do { grid.sync(); STAMP(cls); } while (0)
#else
#define GSYNC(cls) do { xcd_barrier(xbar); STAMP(cls); } while (0)
#endif
__global__ void __launch_bounds__(NTHREADS, 2) fwd_kernel(Args a) {
    extern __shared__ __attribute__((aligned(16))) unsigned char lds[];
    cg::grid_group grid = cg::this_grid();
    const KArgs ka = (KArgs)__builtin_amdgcn_kernarg_segment_ptr();
#ifdef TPROBE
    if (blockIdx.x == 0 && threadIdx.x == 0) { unsigned long long* ts_ = (unsigned long long*)(ka->ws + WS_CTL + 4096); for (int i = 1; i < 16; ++i) ts_[i] = 0ull; ts_[0] = __builtin_amdgcn_s_memrealtime(); }
#endif
    if (threadIdx.x < 16) ((LAS unsigned*)lds)[(LDS_BYTES - 64) / 4 + threadIdx.x] = 0u;
    __syncthreads();
    XcdBarrier xbar = xcd_barrier_post((unsigned*)(ka->ws + WS_CTL + 65536), (volatile LAS unsigned*)((LAS unsigned char*)lds + LDS_BYTES - 64));
    { Frame F; make_frame(F, ka, lds); p0_mod(F); p0_weights(F); }
    grid.sync(); STAMP(0);
    for (int l = 0; l < 2; ++l) {
        { Frame F; make_frame(F, ka, lds); phase_modnorm(F, l, (l == 0) ? F.in[0] : F.out); }
        GSYNC(1);
        { Frame F; make_frame(F, ka, lds); run_gemm(F, (const bf16*)(F.ws + WS_XN), (const bf16*)(F.ws + WS_WQKV) + (size_t)l * NQKV * 1024, NQKV, 1024, pg8::EpiStore{(bf16*)(F.ws + WS_QKV), NQKV}); }
        GSYNC(2);
#if PROBE_DUP == 1
        { Frame F; make_frame(F, ka, lds); run_gemm(F, (const bf16*)(F.ws + WS_XN), (const bf16*)(F.ws + WS_WQKV) + (size_t)l * NQKV * 1024, NQKV, 1024, pg8::EpiStore{(bf16*)(F.ws + WS_QKV), NQKV}); }
        GSYNC(2);
#endif
#ifdef ATTN_NAIVE
        { Frame F; make_frame(F, ka, lds); phase_attn_naive(F); }
        GSYNC(3);
#else
        { Frame F; make_frame(F, ka, lds); phase_attn_mfma(F); }
        GSYNC(3);
        { Frame F; make_frame(F, ka, lds); phase_attn_merge(F); }
        GSYNC(4);
#if PROBE_DUP == 2
        { Frame F; make_frame(F, ka, lds); run_gemm(F, (const bf16*)(F.ws + WS_XN), (const bf16*)(F.ws + WS_WQKV) + (size_t)l * NQKV * 1024, NQKV, 1024, pg8::EpiStore{(bf16*)(F.ws + WS_QKV), NQKV}); }
        GSYNC(2);
        { Frame F; make_frame(F, ka, lds); phase_attn_mfma(F); }
        GSYNC(3);
        { Frame F; make_frame(F, ka, lds); phase_attn_merge(F); }
        GSYNC(4);
#endif
#endif
        { Frame F; make_frame(F, ka, lds); run_gemm(F, (const bf16*)(F.ws + WS_XN), (const bf16*)(F.ws + WS_WA) + (size_t)l * NA * 1024, NA, 1024, pg8::EpiStore{(bf16*)(F.ws + WS_PA), NA}); }
        GSYNC(2);
#ifdef RWKV_NAIVE
        { Frame F; make_frame(F, ka, lds); phase_rwkv_naive(F, l); }
        GSYNC(5);
#else
        { Frame F; make_frame(F, ka, lds); rwkv_pass<1>(F, l); }
        GSYNC(5);
#if PROBE_DUP == 3
        { Frame F; make_frame(F, ka, lds); rwkv_pass<1>(F, l); }
        GSYNC(5);
#endif
        { Frame F; make_frame(F, ka, lds); rwkv_pass2(F); }
        GSYNC(6);
#if PROBE_DUP == 6
        { Frame F; make_frame(F, ka, lds); rwkv_pass2(F); }
        GSYNC(6);
#endif
        { Frame F; make_frame(F, ka, lds); rwkv_pass<3>(F, l); }
        GSYNC(7);
#if PROBE_DUP == 4
        { Frame F; make_frame(F, ka, lds); rwkv_pass<3>(F, l); }
        GSYNC(7);
#endif
#if PROBE_DUP == 5
        for (int q_ = 0; q_ < 10; ++q_) grid.sync();
#endif
#endif
        { Frame F; make_frame(F, ka, lds); run_gemm(F, (const bf16*)(F.ws + WS_XN), (const bf16*)(F.ws + WS_WG) + (size_t)l * NG * 1024, NG, 1024, pg8::EpiGates{(bf16*)(F.ws + WS_YA), (bf16*)(F.ws + WS_YB), (bf16*)(F.ws + WS_MG)}); }
        GSYNC(2);
        { Frame F; make_frame(F, ka, lds); run_gemm(F, (const bf16*)(F.ws + WS_YA), (const bf16*)(F.ws + WS_WBA) + (size_t)l * 1024 * 1024, 1024, 1024, pg8::EpiMerge<false>{(bf16*)(F.ws + WS_MERGED), (const bf16*)(F.ws + WS_MG)}); }
        { Frame F; make_frame(F, ka, lds); run_gemm(F, (const bf16*)(F.ws + WS_YB), (const bf16*)(F.ws + WS_WBB) + (size_t)l * 1024 * 512, 1024, 512, pg8::EpiMerge<true>{(bf16*)(F.ws + WS_MERGED), (const bf16*)(F.ws + WS_MG)}); }
        GSYNC(2);
        { Frame F; make_frame(F, ka, lds); run_gemm(F, (const bf16*)(F.ws + WS_MERGED), (const bf16*)(F.ws + WS_WO) + (size_t)l * 1024 * 1024, 1024, 1024,
              pg8::EpiResid{(l == 0) ? F.in[0] : F.out, F.out, (const float*)(F.ws + WS_MOD) + (size_t)l * 2 * 3072 + 2048}); }
        GSYNC(2);
    }
    { Frame F; make_frame(F, ka, lds); phase_final(F); }
#ifdef TPROBE
    if (blockIdx.x == 0 && threadIdx.x == 0) { STAMP(8); const unsigned long long* ts_ = (const unsigned long long*)(ka->ws + WS_CTL + 4096); ka->out[0] = (float)ts_[1 + TPROBE] * 0.01f; }
#endif
}
extern "C" void kernel_launch(void* const* d_in, const int* in_sizes, int n_in, void* d_out, int out_size, void* d_ws, size_t ws_size, hipStream_t stream) {
    static int grid = 0;
    if (grid == 0) {
        int dev = 0, cus = 0, per_cu = 0;
        (void)hipGetDevice(&dev); (void)hipDeviceGetAttribute(&cus, hipDeviceAttributeMultiprocessorCount, dev);
        (void)hipFuncSetAttribute((const void*)fwd_kernel, hipFuncAttributeMaxDynamicSharedMemorySize, LDS_BYTES);
        (void)hipOccupancyMaxActiveBlocksPerMultiprocessor(&per_cu, (const void*)fwd_kernel, NTHREADS, LDS_BYTES);
        if (n_in != 28 || out_size != MROWS * DM || ws_size < (size_t)352 * MiB || per_cu < 1) { fprintf(stderr, "kernel_launch: unexpected problem (n_in %d out %d ws %zu per_cu %d)\n", n_in, out_size, ws_size, per_cu); }
        grid = cus;
        (void)hipGetLastError();
    }
    (void)hipMemsetAsync((char*)d_ws + WS_CTL, 0, 1 * MiB, stream);
    Args a{};
    for (int i = 0; i < 28; ++i) a.in[i] = (const float*)d_in[i];
    a.out = (float*)d_out; a.ws = (unsigned char*)d_ws;
    void* args[] = {&a};
    hipError_t e = hipLaunchCooperativeKernel((void*)fwd_kernel, dim3(grid), dim3(NTHREADS), args, LDS_BYTES, stream);
    if (e != hipSuccess) fprintf(stderr, "cooperative launch failed: %s (grid %d)\n", hipGetErrorString(e), grid);
}
```

```cpp
#include <hip/hip_runtime.h>
#include <hip/hip_cooperative_groups.h>
#include <cstdio>
#include <cstdint>
namespace cg = cooperative_groups;
namespace pg8 {
#define PG8_LAS __attribute__((address_space(3)))
typedef unsigned short bf16_t;
typedef short bf16x8 __attribute__((ext_vector_type(8)));
typedef float f32x4 __attribute__((ext_vector_type(4)));
typedef unsigned u32x4 __attribute__((ext_vector_type(4)));
constexpr int BM = 256, BK = 64, HALF = 128, HTB = HALF * BK * 2  , STAGE_BYTES = 8 * HTB, NXCD = 8, WGM = 8;

__host__ __device__ __forceinline__ int lds_byte(int r, int c) { const int st = (r >> 4) * 2 + (c >> 5), rr = r & 15, cc = c & 31, ob = rr * 64 + cc * 2; return st * 1024 + (ob ^ (((ob >> 9) & 1) << 5)); }
__host__ __device__ __forceinline__ void stage_rc(int b, int& R, int& C) { const int st = b / 1024, sb = b % 1024, swz = sb ^ (((sb >> 9) & 1) << 5); R = (st >> 1) * 16 + swz / 64; C = (st & 1) * 32 + (swz % 64) / 2; }
__host__ __device__ __forceinline__ int perm32(int rho) { const int n = rho >> 4, i = rho & 15; return 8 * (i >> 2) + 4 * n + (i & 3); }

struct Unit { int pm, pn; };
struct Gemm { const bf16_t* A; const bf16_t* Bt; int M, N, K; };

struct StaticOrder {
    int nM, nN, nwg, G, c;
    __host__ __device__ void init(int M, int N, int G_, int c_) { nM = M / BM; nN = N / BM; nwg = nM * nN; G = G_; c = c_; }
    __host__ __device__ bool next(int i, Unit& u) const {
        const long L = (long)i * G + c; if (L >= nwg) return false;
        int wgid = (int)L; { const int q = nwg / NXCD, r = nwg % NXCD, xcd = wgid % NXCD, off = wgid / NXCD; wgid = (xcd < r ? xcd * (q + 1) : r * (q + 1) + (xcd - r) * q) + off; }
        const int nig = WGM * nN, gid = wgid / nig, fm = gid * WGM, gsz = (nM - fm) < WGM ? (nM - fm) : WGM;
        u.pm = fm + ((wgid % nig) % gsz); u.pn = (wgid % nig) / gsz; return true;
    }
    __device__ __forceinline__ void a_ready(const Unit&) const {}
    __device__ __forceinline__ void done(const Unit&) const {}
};

typedef float f32x2c_t __attribute__((ext_vector_type(2))); typedef __bf16 bf16x2c_t __attribute__((ext_vector_type(2)));
__device__ __forceinline__ unsigned cvt_pk_bf16(float lo, float hi) { const f32x2c_t v = {lo, hi}; const bf16x2c_t b = __builtin_convertvector(v, bf16x2c_t); return __builtin_bit_cast(unsigned, b); }
typedef float f32x2 __attribute__((ext_vector_type(2)));
template <class Epi, class Sched, bool ALIGN_EPI = false, bool SP2 = false>
__device__ __forceinline__ void gemm_phase(PG8_LAS unsigned char* lds, const Gemm g, const Sched& S, const Epi& E, int tid_in) {
    int tid_ = tid_in; asm volatile("" : "+v"(tid_));
    const int tid = tid_, wid = __builtin_amdgcn_readfirstlane(tid >> 6), lane = tid & 63, wr = wid >> 2, wc = wid & 3, fr = lane & 15, fq = lane >> 4;
    const int K = g.K, nt = K / BK;
    unsigned voffA[2], voffB[2];
#pragma unroll
    for (int i = 0; i < 2; ++i) { int R, C; stage_rc(tid * 16 + i * 8192, R, C); const int Rb = Epi::PERM ? ((R & ~31) + perm32(R & 31)) : R;
        voffA[i] = (unsigned)(R * K + C) * 2u; voffB[i] = (unsigned)(Rb * K + C) * 2u; }
    const size_t kstep = (size_t)(BK * 2);
    const size_t hstep = (size_t)HALF * K * 2;
    const size_t tstep = 2 * hstep;
    const unsigned ldsw = (unsigned)wid * 1024u;
    const int aoff = lds_byte(wr * 64 + fr, fq * 8), boff = lds_byte(wc * 32 + fr, fq * 8);
#define PG8_SA(b, h) (((b) * 2 + (h)) * HTB)
#define PG8_SB(b, h) ((4 + (b) * 2 + (h)) * HTB)
#define PG8_STAGE(bufoff, gbase, voff) do { _Pragma("unroll") for (int _i = 0; _i < 2; ++_i) \
        __builtin_amdgcn_global_load_lds((const unsigned*)((const char*)(gbase) + (voff)[_i]), (PG8_LAS unsigned*)(lds + (bufoff) + ldsw + _i * 8192), 16, 0, 0); } while (0)
#define PG8_LDA(dst, b, h) do { _Pragma("unroll") for (int m = 0; m < 4; ++m) _Pragma("unroll") for (int k = 0; k < 2; ++k) dst[m][k] = *(const PG8_LAS bf16x8*)(lds + PG8_SA(b, h) + aoff + m * 2048 + k * 1024); } while (0)
#define PG8_LDB(dst, b, h) do { _Pragma("unroll") for (int n = 0; n < 2; ++n) _Pragma("unroll") for (int k = 0; k < 2; ++k) dst[n][k] = *(const PG8_LAS bf16x8*)(lds + PG8_SB(b, h) + boff + n * 2048 + k * 1024); } while (0)
#define PG8_MMA(ai, bj, At, Bt) do { __builtin_amdgcn_s_setprio(1); _Pragma("unroll") for (int m = 0; m < 4; ++m) _Pragma("unroll") for (int n = 0; n < 2; ++n) _Pragma("unroll") for (int k = 0; k < 2; ++k) \
        acc[ai][bj][m][n] = __builtin_amdgcn_mfma_f32_16x16x32_bf16(Bt[n][k], At[m][k], acc[ai][bj][m][n], 0, 0, 0); __builtin_amdgcn_s_setprio(0); } while (0)
#define PG8_WAIT_V(n) asm volatile("s_waitcnt vmcnt(" #n ")" ::: "memory")
#define PG8_WAIT_L(n) asm volatile("s_waitcnt lgkmcnt(" #n ")" ::: "memory")
#define PG8_BAR __builtin_amdgcn_s_barrier()
#define PG8_SCHED __builtin_amdgcn_sched_barrier(0)
    Unit cur, nxt; int ui = 0;
    if (!S.next(0, cur)) return;
    f32x4 acc[2][2][4][2];
#pragma unroll
    for (int a = 0; a < 2; ++a)
#pragma unroll
        for (int b = 0; b < 2; ++b)
#pragma unroll
            for (int m = 0; m < 4; ++m)
#pragma unroll
                for (int n = 0; n < 2; ++n) acc[a][b][m][n] = (f32x4){0.f, 0.f, 0.f, 0.f};
    bf16x8 At[4][2], B0[2][2], B1[2][2];
    const char* cA = (const char*)g.A + (size_t)cur.pm * tstep; const char* cB = (const char*)g.Bt + (size_t)cur.pn * tstep;
    S.a_ready(cur);
    if constexpr (SP2) {
        PG8_STAGE(PG8_SB(0, 0), cB, voffB); PG8_STAGE(PG8_SB(0, 1), cB + hstep, voffB); PG8_STAGE(PG8_SA(0, 0), cA, voffA); PG8_STAGE(PG8_SA(0, 1), cA + hstep, voffA);
        if (wr == 1) PG8_BAR;
        PG8_WAIT_V(2); PG8_BAR;
        PG8_STAGE(PG8_SB(1, 0), cB + kstep, voffB); PG8_STAGE(PG8_SA(1, 0), cA + kstep, voffA); PG8_STAGE(PG8_SB(1, 1), cB + hstep + kstep, voffB);
        PG8_WAIT_V(6); PG8_BAR;
    } else {
        PG8_STAGE(PG8_SB(0, 0), cB, voffB); PG8_STAGE(PG8_SA(0, 0), cA, voffA); PG8_STAGE(PG8_SB(0, 1), cB + hstep, voffB); PG8_STAGE(PG8_SA(0, 1), cA + hstep, voffA);
        if (wr == 1) PG8_BAR;
        PG8_WAIT_V(4); PG8_BAR;
        PG8_STAGE(PG8_SB(1, 0), cB + kstep, voffB); PG8_STAGE(PG8_SA(1, 0), cA + kstep, voffA); PG8_STAGE(PG8_SB(1, 1), cB + hstep + kstep, voffB);
        PG8_WAIT_V(6); PG8_BAR;
    }
    for (;;) {
        const bool has_next = S.next(ui + 1, nxt);
        const char* nA = has_next ? (const char*)g.A + (size_t)nxt.pm * tstep : cA; const char* nB = has_next ? (const char*)g.Bt + (size_t)nxt.pn * tstep : cB;
        for (int t = 0; t < nt; t += 2) {
            const bool last = (t == nt - 2);
            const char* a1 = cA + (size_t)(t + 1) * kstep;
            const char* a2 = last ? nA : cA + (size_t)(t + 2) * kstep; const char* b2 = last ? nB : cB + (size_t)(t + 2) * kstep;
            const char* a3 = a2 + kstep; const char* b3 = b2 + kstep;
            if (last && has_next) S.a_ready(nxt);
            if constexpr (SP2) {
            PG8_LDB(B0, 0, 0); PG8_LDB(B1, 0, 1); PG8_SCHED; PG8_LDA(At, 0, 0); PG8_STAGE(PG8_SA(1, 1), a1 + hstep, voffA);
            PG8_WAIT_V(8); PG8_WAIT_L(0); PG8_BAR; PG8_MMA(0, 0, At, B0); PG8_MMA(0, 1, At, B1); PG8_BAR; PG8_SCHED;
            PG8_LDA(At, 0, 1); PG8_STAGE(PG8_SB(0, 0), b2, voffB); PG8_STAGE(PG8_SB(0, 1), b2 + hstep, voffB); PG8_STAGE(PG8_SA(0, 0), a2, voffA);
            PG8_WAIT_V(8); PG8_WAIT_L(0); PG8_BAR; PG8_MMA(1, 0, At, B0); PG8_MMA(1, 1, At, B1); PG8_BAR; PG8_SCHED;
            PG8_LDB(B0, 1, 0); PG8_LDB(B1, 1, 1); PG8_SCHED; PG8_LDA(At, 1, 0); PG8_STAGE(PG8_SA(0, 1), a2 + hstep, voffA);
            PG8_WAIT_V(8); PG8_WAIT_L(0); PG8_BAR; PG8_MMA(0, 0, At, B0); PG8_MMA(0, 1, At, B1); PG8_BAR; PG8_SCHED;
            PG8_LDA(At, 1, 1); PG8_STAGE(PG8_SB(1, 0), b3, voffB); PG8_STAGE(PG8_SB(1, 1), b3 + hstep, voffB); PG8_STAGE(PG8_SA(1, 0), a3, voffA);
            PG8_WAIT_V(8); PG8_WAIT_L(0); PG8_BAR; PG8_MMA(1, 0, At, B0); PG8_MMA(1, 1, At, B1); PG8_BAR; PG8_SCHED;
            } else {
            PG8_LDB(B0, 0, 0); PG8_SCHED; PG8_LDA(At, 0, 0); PG8_STAGE(PG8_SA(1, 1), a1 + hstep, voffA);
            PG8_WAIT_L(8); PG8_BAR; PG8_WAIT_L(0); PG8_MMA(0, 0, At, B0); PG8_BAR; PG8_SCHED;
            PG8_LDB(B1, 0, 1); PG8_STAGE(PG8_SB(0, 0), b2, voffB);
            PG8_BAR; PG8_WAIT_L(0); PG8_MMA(0, 1, At, B1); PG8_BAR;
            PG8_LDA(At, 0, 1); PG8_STAGE(PG8_SA(0, 0), a2, voffA);
            PG8_BAR; PG8_WAIT_L(0); PG8_MMA(1, 0, At, B0); PG8_BAR; PG8_SCHED;
            PG8_STAGE(PG8_SB(0, 1), b2 + hstep, voffB);
            PG8_WAIT_V(6); PG8_BAR; PG8_MMA(1, 1, At, B1); PG8_BAR;
            PG8_LDB(B0, 1, 0); PG8_SCHED; PG8_LDA(At, 1, 0); PG8_STAGE(PG8_SA(0, 1), a2 + hstep, voffA);
            PG8_WAIT_L(8); PG8_BAR; PG8_WAIT_L(0); PG8_MMA(0, 0, At, B0); PG8_BAR; PG8_SCHED;
            PG8_LDB(B1, 1, 1); PG8_STAGE(PG8_SB(1, 0), b3, voffB);
            PG8_BAR; PG8_WAIT_L(0); PG8_MMA(0, 1, At, B1); PG8_BAR;
            PG8_LDA(At, 1, 1); PG8_STAGE(PG8_SA(1, 0), a3, voffA);
            PG8_BAR; PG8_WAIT_L(0); PG8_MMA(1, 0, At, B0); PG8_BAR; PG8_SCHED;
            PG8_STAGE(PG8_SB(1, 1), b3 + hstep, voffB);
            PG8_WAIT_V(6); PG8_BAR; PG8_MMA(1, 1, At, B1); PG8_BAR;
            }
        }
        if constexpr (ALIGN_EPI) { if (wr == 0) PG8_BAR; }
        if constexpr (!Epi::AFTER_DRAIN) { E(acc, cur, wr, wc, fr, fq); S.done(cur); }
        if (!has_next) break;
#pragma unroll
        for (int a = 0; a < 2; ++a)
#pragma unroll
            for (int b = 0; b < 2; ++b)
#pragma unroll
                for (int m = 0; m < 4; ++m)
#pragma unroll
                    for (int n = 0; n < 2; ++n) acc[a][b][m][n] = (f32x4){0.f, 0.f, 0.f, 0.f};
        cur = nxt; cA = nA; cB = nB; ++ui;
        if constexpr (ALIGN_EPI) { if (wr == 1) PG8_BAR; }
    }
    PG8_WAIT_V(0);
    if constexpr (!ALIGN_EPI) { if (wr == 0) PG8_BAR; }
    PG8_BAR;
    if constexpr (Epi::AFTER_DRAIN) { E.fused(acc, cur, wr, wc, fr, fq, lds, wid, lane); S.done(cur); }
#undef PG8_SA
#undef PG8_SB
#undef PG8_STAGE
#undef PG8_LDA
#undef PG8_LDB
#undef PG8_MMA
#undef PG8_WAIT_V
#undef PG8_WAIT_L
#undef PG8_BAR
#undef PG8_SCHED
}
}
namespace pg8 {
__device__ __forceinline__ float ep_bflo(unsigned w) { return __uint_as_float(w << 16); }
__device__ __forceinline__ float ep_bfhi(unsigned w) { return __uint_as_float(w & 0xffff0000u); }
__device__ __forceinline__ float ep_sigmoid(float x) { return 1.f / (1.f + __expf(-x)); }
struct EpiStore {
    static constexpr bool PERM = true, AFTER_DRAIN = false;
    bf16_t* O; int ldc;
    __device__ __forceinline__ void operator()(const f32x4 (&acc)[2][2][4][2], const Unit& u, int wr, int wc, int fr, int fq) const {
        const int row0 = u.pm * BM + wr * 64 + fr, col0 = u.pn * BM + wc * 32 + 8 * fq;
#pragma unroll
        for (int ai = 0; ai < 2; ++ai)
#pragma unroll
            for (int m = 0; m < 4; ++m) { bf16_t* rowp = O + (size_t)(row0 + ai * HALF + m * 16) * ldc + col0;
#pragma unroll
                for (int bj = 0; bj < 2; ++bj) { const f32x4 v0 = acc[ai][bj][m][0], v1 = acc[ai][bj][m][1]; u32x4 w;
                    w.x = cvt_pk_bf16(v0[0], v0[1]); w.y = cvt_pk_bf16(v0[2], v0[3]); w.z = cvt_pk_bf16(v1[0], v1[1]); w.w = cvt_pk_bf16(v1[2], v1[3]);
                    *(u32x4*)(rowp + bj * HALF) = w; } }
    }
};
struct EpiGates {
    static constexpr bool PERM = true, AFTER_DRAIN = false;
    bf16_t* YA; bf16_t* YB; bf16_t* MG;
    __device__ __forceinline__ void operator()(const f32x4 (&acc)[2][2][4][2], const Unit& u, int wr, int wc, int fr, int fq) const {
        const int colt = u.pn * BM; int mode, ld, cb; bf16_t* P;
        if (colt < 1024) { mode = 0; P = YA; ld = 1024; cb = colt; } else if (colt < 1536) { mode = 1; P = YB; ld = 512; cb = colt - 1024; } else { mode = 2; P = MG; ld = 2048; cb = colt - 1536; }
        const int row0 = u.pm * BM + wr * 64 + fr, col0 = cb + wc * 32 + 8 * fq;
#pragma unroll
        for (int ai = 0; ai < 2; ++ai)
#pragma unroll
            for (int m = 0; m < 4; ++m) { bf16_t* rowp = P + (size_t)(row0 + ai * HALF + m * 16) * ld + col0;
#pragma unroll
                for (int bj = 0; bj < 2; ++bj) { const f32x4 v0 = acc[ai][bj][m][0], v1 = acc[ai][bj][m][1]; float g[8] = {v0[0], v0[1], v0[2], v0[3], v1[0], v1[1], v1[2], v1[3]};
                    u32x4 w;
                    if (mode == 2) {
#pragma unroll
                        for (int e = 0; e < 8; ++e) g[e] = ep_sigmoid(g[e]);
                    } else {
                        const u32x4 y = *(const u32x4*)(rowp + bj * HALF);
                        const float yv[8] = {ep_bflo(y.x), ep_bfhi(y.x), ep_bflo(y.y), ep_bfhi(y.y), ep_bflo(y.z), ep_bfhi(y.z), ep_bflo(y.w), ep_bfhi(y.w)};
#pragma unroll
                        for (int e = 0; e < 8; ++e) g[e] = yv[e] * g[e] * ep_sigmoid(g[e]);
                    }
                    w.x = cvt_pk_bf16(g[0], g[1]); w.y = cvt_pk_bf16(g[2], g[3]); w.z = cvt_pk_bf16(g[4], g[5]); w.w = cvt_pk_bf16(g[6], g[7]);
                    *(u32x4*)(rowp + bj * HALF) = w; } }
    }
};
template <bool SECOND> struct EpiMerge {
    static constexpr bool PERM = true, AFTER_DRAIN = false;
    bf16_t* MERGED; const bf16_t* MG;
    __device__ __forceinline__ void operator()(const f32x4 (&acc)[2][2][4][2], const Unit& u, int wr, int wc, int fr, int fq) const {
        const int row0 = u.pm * BM + wr * 64 + fr, col0 = u.pn * BM + wc * 32 + 8 * fq;
#pragma unroll
        for (int ai = 0; ai < 2; ++ai)
#pragma unroll
            for (int m = 0; m < 4; ++m) { const size_t r = (size_t)(row0 + ai * HALF + m * 16);
#pragma unroll
                for (int bj = 0; bj < 2; ++bj) { const f32x4 v0 = acc[ai][bj][m][0], v1 = acc[ai][bj][m][1]; float g[8] = {v0[0], v0[1], v0[2], v0[3], v1[0], v1[1], v1[2], v1[3]};
                    const int c = col0 + bj * HALF;
                    const u32x4 s = *(const u32x4*)(MG + r * 2048 + (SECOND ? 1024 : 0) + c);
                    const float sv[8] = {ep_bflo(s.x), ep_bfhi(s.x), ep_bflo(s.y), ep_bfhi(s.y), ep_bflo(s.z), ep_bfhi(s.z), ep_bflo(s.w), ep_bfhi(s.w)};
                    bf16_t* dst = MERGED + r * 1024 + c;
                    if (SECOND) { const u32x4 p = *(const u32x4*)dst;
                        const float pv[8] = {ep_bflo(p.x), ep_bfhi(p.x), ep_bflo(p.y), ep_bfhi(p.y), ep_bflo(p.z), ep_bfhi(p.z), ep_bflo(p.w), ep_bfhi(p.w)};
#pragma unroll
                        for (int e = 0; e < 8; ++e) g[e] = pv[e] + sv[e] * g[e];
                    } else {
#pragma unroll
                        for (int e = 0; e < 8; ++e) g[e] = sv[e] * g[e];
                    }
                    u32x4 w; w.x = cvt_pk_bf16(g[0], g[1]); w.y = cvt_pk_bf16(g[2], g[3]); w.z = cvt_pk_bf16(g[4], g[5]); w.w = cvt_pk_bf16(g[6], g[7]);
                    *(u32x4*)dst = w; } }
    }
};
struct EpiResid {
    static constexpr bool PERM = false, AFTER_DRAIN = false;
    const float* xin; float* xout; const float* gate;
    __device__ __forceinline__ void operator()(const f32x4 (&acc)[2][2][4][2], const Unit& u, int wr, int wc, int fr, int fq) const {
        const int b = (u.pm * BM) / 8192; const float* gp = gate + b * 3072;
        const int row0 = u.pm * BM + wr * 64 + fr, col0 = u.pn * BM + wc * 32 + 4 * fq;
#pragma unroll
        for (int bj = 0; bj < 2; ++bj)
#pragma unroll
            for (int n = 0; n < 2; ++n) { const int c = col0 + bj * HALF + n * 16; const f32x4 gv = *(const f32x4*)(gp + c);
#pragma unroll
                for (int ai = 0; ai < 2; ++ai)
#pragma unroll
                    for (int m = 0; m < 4; ++m) { const size_t off = (size_t)(row0 + ai * HALF + m * 16) * 1024 + c;
                        const f32x4 xi = *(const f32x4*)(xin + off); *(f32x4*)(xout + off) = xi + gv * acc[ai][bj][m][n]; } }
    }
};
}
constexpr int BATCH = 2, SEQ = 8192, DM = 1024, MROWS = BATCH * SEQ, PROJW = 11264;
constexpr int NQKV = 4608, NA = 3584, NG = 3584, NLORA = 320;
constexpr size_t MiB = 1u << 20;
constexpr size_t WS_CTL = 0, WS_MOD = 1 * MiB;
constexpr size_t WS_WQKV = 2 * MiB, WS_WA = 20 * MiB, WS_WG = 34 * MiB, WS_WBA = 48 * MiB, WS_WBB = 52 * MiB, WS_WO = 54 * MiB;
constexpr size_t WS_VFIRST = 58 * MiB, WS_XN = 90 * MiB, WS_YB = 122 * MiB;
constexpr size_t WS_QKV = 138 * MiB, WS_PA = 138 * MiB, WS_YA = 250 * MiB, WS_MG = 138 * MiB, WS_MERGED = 202 * MiB, WS_SC = 282 * MiB;
constexpr int LDS_BYTES = 147456;
constexpr int NTHREADS = 512, NWAVES = 8;
#define LAS __attribute__((address_space(3)))
typedef unsigned short bf16;
typedef float f32x4 __attribute__((ext_vector_type(4)));
typedef unsigned u32x4 __attribute__((ext_vector_type(4)));
typedef unsigned u32x2 __attribute__((ext_vector_type(2)));

__device__ const unsigned char T5BUCKET[3][132] = {
 {0,1,2,3,4,5,6,7,8,9,10,11,12,13,14,15,16,16,16,16,16,16,17,17,17,17,17,17,17,17,18,18,18,18,18,18,18,18,18,18,19,19,19,19,19,19,19,19,19,19,19,19,19,19,20,20,20,20,20,20,20,20,20,20,20,20,20,20,20,20,20,20,20,21,21,21,21,21,21,21,21,21,21,21,21,21,21,21,21,21,21,21,21,21,21,21,21,21,21,22,22,22,22,22,22,22,22,22,22,22,22,22,22,22,22,22,22,22,22,22,22,22,22,22,22,22,22,22,22,0,0,0},
 {0,4,8,12,16,16,17,17,18,18,19,19,19,19,20,20,20,20,20,21,21,21,21,21,21,22,22,22,22,22,22,22,22,22,23,23,23,23,23,23,23,23,23,23,23,23,24,24,24,24,24,24,24,24,24,24,24,24,24,24,24,24,25,25,25,25,25,25,25,25,25,25,25,25,25,25,25,25,25,25,25,25,25,26,26,26,26,26,26,26,26,26,26,26,26,26,26,26,26,26,26,26,26,26,26,26,26,26,26,26,26,26,26,27,27,27,27,27,27,27,27,27,27,27,27,27,27,27,27,0,0,0},
 {0,16,18,19,20,21,21,22,22,23,23,23,24,24,24,24,25,25,25,25,25,26,26,26,26,26,26,26,26,27,27,27,27,27,27,27,27,27,27,28,28,28,28,28,28,28,28,28,28,28,28,28,29,29,29,29,29,29,29,29,29,29,29,29,29,29,29,29,29,29,30,30,30,30,30,30,30,30,30,30,30,30,30,30,30,30,30,30,30,30,30,30,30,30,30,31,31,31,31,31,31,31,31,31,31,31,31,31,31,31,31,31,31,31,31,31,31,31,31,31,31,31,31,31,31,31,31,31,31,0,0,0}};

__device__ __forceinline__ unsigned f2bf(float f) { unsigned u = __builtin_bit_cast(unsigned, f); return (u + 0x7fffu + ((u >> 16) & 1u)) >> 16; }
__device__ __forceinline__ unsigned pk2(float lo, float hi) { return pg8::cvt_pk_bf16(lo, hi); }
__device__ __forceinline__ float bflo(unsigned w) { return __uint_as_float(w << 16); }
__device__ __forceinline__ float bfhi(unsigned w) { return __uint_as_float(w & 0xffff0000u); }
__device__ __forceinline__ float bf2f(bf16 h) { return __uint_as_float(((unsigned)h) << 16); }
template <int CTRL, int RMASK> __device__ __forceinline__ float dpp_f(float v) { return __int_as_float(__builtin_amdgcn_update_dpp(0, __float_as_int(v), CTRL, RMASK, 0xF, false)); }
template <int CTRL, int RMASK> __device__ __forceinline__ float dpp_keep(float v) { return __int_as_float(__builtin_amdgcn_update_dpp(__float_as_int(v), __float_as_int(v), CTRL, RMASK, 0xF, false)); }
__device__ __forceinline__ float wave_sum_dpp(float v) {
    v += dpp_f<0xB1, 0xF>(v); v += dpp_f<0x4E, 0xF>(v); v += dpp_f<0x141, 0xF>(v); v += dpp_f<0x140, 0xF>(v);
    v += dpp_f<0x142, 0xA>(v); v += dpp_f<0x143, 0xC>(v);
    return __int_as_float(__builtin_amdgcn_readlane(__float_as_int(v), 63));
}
__device__ __forceinline__ float wave_max_dpp(float v) {
    v = fmaxf(v, dpp_keep<0xB1, 0xF>(v)); v = fmaxf(v, dpp_keep<0x4E, 0xF>(v)); v = fmaxf(v, dpp_keep<0x141, 0xF>(v)); v = fmaxf(v, dpp_keep<0x140, 0xF>(v));
    v = fmaxf(v, dpp_keep<0x142, 0xA>(v)); v = fmaxf(v, dpp_keep<0x143, 0xC>(v));
    return __int_as_float(__builtin_amdgcn_readlane(__float_as_int(v), 63));
}
__device__ __forceinline__ float wave_sum(float v) { return wave_sum_dpp(v); }
__device__ __forceinline__ float wave_max(float v) { return wave_max_dpp(v); }
__device__ __forceinline__ float bperm_f(int src_lane, float v) { return __int_as_float(__builtin_amdgcn_ds_bpermute(src_lane << 2, __float_as_int(v))); }
__device__ __forceinline__ float sigmoidf_(float x) { return 1.f / (1.f + __expf(-x)); }
__device__ __forceinline__ float siluf_(float x) { return x / (1.f + __expf(-x)); }

struct Args { const float* in[28]; float* out; unsigned char* ws; };
typedef const __attribute__((address_space(4))) Args* KArgs;
struct Frame {
    LAS unsigned char* lds;
    int tid, lane, wave, G, bid;
    const float* in[28]; float* out; unsigned char* ws;
};
__device__ __forceinline__ int lane_id_() { return (int)__builtin_amdgcn_mbcnt_hi(~0u, __builtin_amdgcn_mbcnt_lo(~0u, 0u)); }
__device__ __forceinline__ int cur_tid(int wv) { int w2 = wv; asm volatile("" : "+s"(w2)); unsigned z = 0u; asm volatile("" : "+v"(z)); return w2 * 64 + (int)__builtin_amdgcn_mbcnt_hi(~0u, __builtin_amdgcn_mbcnt_lo(~0u, z)); }
__device__ __forceinline__ void make_frame(Frame& F, KArgs ka, unsigned char* lds, int wv) {
    asm volatile("" : "+s"(ka));
    int t = cur_tid(wv);
    F.lds = (LAS unsigned char*)lds; F.tid = t; F.lane = t & 63; F.wave = __builtin_amdgcn_readfirstlane(t >> 6); F.G = gridDim.x; F.bid = blockIdx.x;
#pragma unroll
    for (int i = 0; i < 28; ++i) F.in[i] = ka->in[i];
    F.out = ka->out; F.ws = ka->ws;
}
#define XB_TMO      128
#define XB_XCNT(j)  (256  + 64 * (j))
#define XB_XSUB(j)  (1280 + 64 * (j))
#define XB_XGEN(j)  (2304 + 64 * (j))
#define XB_TOP      3328
#define XB_TOPGEN   3392
#define XCD_BAR_WORDS 3456
#define XB_SPIN_CAP (1u << 18)

__device__ __forceinline__ unsigned xb_ld(unsigned* p)              { return __hip_atomic_load(p, __ATOMIC_RELAXED, __HIP_MEMORY_SCOPE_AGENT); }
__device__ __forceinline__ unsigned xb_add(unsigned* p, unsigned v) { return __hip_atomic_fetch_add(p, v, __ATOMIC_RELAXED, __HIP_MEMORY_SCOPE_AGENT); }
__device__ __forceinline__ unsigned xb_xcc_id() { return (unsigned)__builtin_amdgcn_s_getreg((3 << 11) | 20) & 0xFu; }
#define XB_SPIN(cond, bar) do { unsigned _sp = 0; while (cond) { __builtin_amdgcn_s_sleep(1); \
    if ((++_sp & 255u) == 0u) { if (xb_ld(&(bar)[XB_TMO])) break; if (_sp > XB_SPIN_CAP) { atomicAdd(&(bar)[XB_TMO], 1u); break; } } } } while (0)

struct XcdBarrier {
    unsigned* bar; unsigned x;
    volatile LAS unsigned* st;
};

__device__ __forceinline__ XcdBarrier xcd_barrier_post(unsigned* bar, volatile LAS unsigned* st, int tid) {
    XcdBarrier b; b.bar = bar; b.x = xb_xcc_id(); b.st = st;
    if (tid == 0) (void)xb_add(&bar[XB_XCNT(b.x)], 1u);
    return b;
}
__device__ __forceinline__ void xcd_barrier_complete(unsigned* bar, unsigned x, unsigned& nloc, unsigned& nx) {
    const unsigned G = gridDim.x * gridDim.y * gridDim.z;
    unsigned sum, cnt, mine, sp = 0u;
    for (;;) {
        sum = 0u; cnt = 0u; mine = 0u;
#pragma unroll
        for (unsigned j = 0; j < 16; ++j) { const unsigned c = xb_ld(&bar[XB_XCNT(j)]); sum += c; cnt += (c > 0u) ? 1u : 0u; mine = (j == x) ? c : mine; }
        if (sum == G) break;
        __builtin_amdgcn_s_sleep(1);
        if ((++sp & 255u) == 0u) { if (xb_ld(&bar[XB_TMO])) break; if (sp > XB_SPIN_CAP) { atomicAdd(&bar[XB_TMO], 1u); break; } }
    }
    nloc = mine > 0u ? mine : 1u; nx = cnt > 0u ? cnt : 1u;
}

__device__ __forceinline__ void xcd_barrier(const XcdBarrier& b, int tid) {
    asm volatile("s_waitcnt vmcnt(0)" ::: "memory");
    __syncthreads();
    if (tid == 0) {
        unsigned* bar = b.bar; asm volatile("" : "+s"(bar));
        __builtin_amdgcn_s_waitcnt(0);
        unsigned nloc = b.st[0], nx = b.st[1];
        if (nloc == 0u) { xcd_barrier_complete(bar, b.x, nloc, nx); b.st[0] = nloc; b.st[1] = nx; }
        const unsigned old = xb_add(&bar[XB_XSUB(b.x)], 1u);
        const unsigned gen = old / nloc;
        if (old + 1u == (gen + 1u) * nloc) {
            __builtin_amdgcn_fence(__ATOMIC_RELEASE, "agent");
            asm volatile("s_waitcnt vmcnt(0)" ::: "memory");
            const unsigned og = xb_add(&bar[XB_TOP], 1u);
            const unsigned tg = og / nx;
            if (og + 1u == (tg + 1u) * nx) xb_add(&bar[XB_TOPGEN], 1u);
            else XB_SPIN(xb_ld(&bar[XB_TOPGEN]) == tg, bar);
            __builtin_amdgcn_fence(__ATOMIC_ACQUIRE, "agent");
            xb_add(&bar[XB_XGEN(b.x)], 1u);
            asm volatile("s_waitcnt vmcnt(0)" ::: "memory");
        } else {
            XB_SPIN(xb_ld(&bar[XB_XGEN(b.x)]) == gen, bar);
            __builtin_amdgcn_fence(__ATOMIC_ACQUIRE, "agent");
            asm volatile("s_waitcnt vmcnt(0)" ::: "memory");
        }
    }
    __syncthreads();
}
__device__ __forceinline__ void p0_mod(Frame& F) {
    const float* c = F.in[1]; const float* ada_w = F.in[3]; const float* ada_b = F.in[4];
    float* mod = (float*)(F.ws + WS_MOD);
    LAS float* red = (LAS float*)F.lds;
    const int col = F.tid & 31, kg = F.tid >> 5;
    for (int ch = F.bid; ch < 192; ch += F.G) {
        const int l = ch / 96, n = (ch % 96) * 32 + col;
        const float* W = ada_w + (size_t)l * 1024 * 3072 + n;
        float a0 = 0.f, a1 = 0.f;
        for (int i = 0; i < 64; ++i) { const int k = kg + 16 * i; const float w = W[(size_t)k * 3072]; a0 += siluf_(c[k]) * w; a1 += siluf_(c[1024 + k]) * w; }
        red[kg * 32 + col] = a0; red[512 + kg * 32 + col] = a1;
        __syncthreads();
        if (F.tid < 64) { const int b = F.tid >> 5; float s = 0.f;
            for (int g = 0; g < 16; ++g) s += red[b * 512 + g * 32 + col];
            mod[(size_t)(l * 2 + b) * 3072 + n] = s + ada_b[l * 3072 + n]; }
        __syncthreads();
    }
}
__device__ __forceinline__ void transpose_item(const float* W, int ldw, int col0, int K, int ncols, bf16* WT, LAS float* scr, int item, int lane) {
    const int nblk = ncols / 32, kb = item / nblk, nb = item % nblk, k0 = 64 * kb, n0 = 32 * nb;
#pragma unroll 8
    for (int i = 0; i < 32; ++i) { const int kk = 2 * i + (lane >> 5); scr[kk * 33 + (lane & 31)] = W[(size_t)(k0 + kk) * ldw + col0 + n0 + (lane & 31)]; }
    asm volatile("s_waitcnt lgkmcnt(0)" ::: "memory");
    const int c = lane & 7;
#pragma unroll
    for (int j = 0; j < 4; ++j) { const int n = (lane >> 3) + 8 * j; const LAS float* s = scr + (8 * c) * 33 + n;
        u32x4 o; o.x = pk2(s[0 * 33], s[1 * 33]); o.y = pk2(s[2 * 33], s[3 * 33]); o.z = pk2(s[4 * 33], s[5 * 33]); o.w = pk2(s[6 * 33], s[7 * 33]);
        *(u32x4*)(WT + (size_t)(n0 + n) * K + k0 + 8 * c) = o; }
    asm volatile("s_waitcnt lgkmcnt(0)" ::: "memory");
}
__device__ __forceinline__ void p0_weights(Frame& F) {
    LAS float* scr = (LAS float*)(F.lds + 16384 + F.wave * 16384);
    const int gw = F.bid * NWAVES + F.wave, NGW = F.G * NWAVES;
    constexpr int I_QKV = 16 * 144, I_A = 16 * 96, I_GA = 16 * 32, I_GB = 16 * 16, I_M = 16 * 64, I_BA = 16 * 32, I_BB = 8 * 32, I_O = 16 * 32;
    constexpr int PER_L = I_QKV + I_A + I_GA + I_GB + I_M + I_BA + I_BB + I_O;
    for (int it = gw; it < 2 * PER_L; it += NGW) {
        const int l = it / PER_L; int r = it % PER_L;
        const float* win = F.in[5] + (size_t)l * 1024 * PROJW;
        bf16* wqkv = (bf16*)(F.ws + WS_WQKV) + (size_t)l * NQKV * 1024;
        bf16* wa = (bf16*)(F.ws + WS_WA) + (size_t)l * NA * 1024;
        bf16* wg = (bf16*)(F.ws + WS_WG) + (size_t)l * NG * 1024;
        const float* W; int ldw, col0, K, ncols; bf16* WT;
        if (r < I_QKV) { W = win; ldw = PROJW; col0 = 4096; K = 1024; ncols = 4608; WT = wqkv; }
        else if ((r -= I_QKV) < I_A) { W = win; ldw = PROJW; col0 = 0; K = 1024; ncols = 3072; WT = wa; }
        else if ((r -= I_A) < I_GA) { W = win; ldw = PROJW; col0 = 3072; K = 1024; ncols = 1024; WT = wg; }
        else if ((r -= I_GA) < I_GB) { W = win; ldw = PROJW; col0 = 8704; K = 1024; ncols = 512; WT = wg + (size_t)1024 * 1024; }
        else if ((r -= I_GB) < I_M) { W = win; ldw = PROJW; col0 = 9216; K = 1024; ncols = 2048; WT = wg + (size_t)1536 * 1024; }
        else if ((r -= I_M) < I_BA) { W = F.in[23] + (size_t)l * 1024 * 1024; ldw = 1024; col0 = 0; K = 1024; ncols = 1024; WT = (bf16*)(F.ws + WS_WBA) + (size_t)l * 1024 * 1024; }
        else if ((r -= I_BA) < I_BB) { W = F.in[24] + (size_t)l * 512 * 1024; ldw = 1024; col0 = 0; K = 512; ncols = 1024; WT = (bf16*)(F.ws + WS_WBB) + (size_t)l * 1024 * 512; }
        else { r -= I_BB; W = F.in[25] + (size_t)l * 1024 * 1024; ldw = 1024; col0 = 0; K = 1024; ncols = 1024; WT = (bf16*)(F.ws + WS_WO) + (size_t)l * 1024 * 1024; }
        transpose_item(W, ldw, col0, K, ncols, WT, scr, r, F.lane);
    }
    const size_t gt = (size_t)F.bid * NTHREADS + F.tid, NGT = (size_t)F.G * NTHREADS;
    for (size_t e = gt; e < (size_t)2 * 512 * 1024; e += NGT) {
        const int l = (int)(e / (512 * 1024)), n = (int)((e / 1024) % 512), k = (int)(e % 1024);
        const float muw = F.in[7][(size_t)(l * 2 + 0) * 1024 + k], mua = F.in[7][(size_t)(l * 2 + 1) * 1024 + k];
        float v = 0.f;
        if (n < 64) v = F.in[9][((size_t)l * 1024 + k) * 64 + n] * (1.f - muw);
        else if (n < 128) v = F.in[9][((size_t)l * 1024 + k) * 64 + (n - 64)] * muw;
        else if (n < 192) v = F.in[12][((size_t)l * 1024 + k) * 64 + (n - 128)] * (1.f - mua);
        else if (n < 256) v = F.in[12][((size_t)l * 1024 + k) * 64 + (n - 192)] * mua;
        else if (n < 320 && l == 1) { const float muv = F.in[19][k]; const int m = (n - 256) & 31; const float w = F.in[21][(size_t)k * 32 + m]; v = (n < 288) ? w * (1.f - muv) : w * muv; }
        ((bf16*)(F.ws + WS_WA))[((size_t)l * NA + 3072 + n) * 1024 + k] = (bf16)f2bf(v);
    }
}
__device__ __forceinline__ void phase_modnorm(Frame& F, int l, const float* xin) {
    const float* mod = (const float*)(F.ws + WS_MOD) + (size_t)l * 2 * 3072;
    const float* g = F.in[2] + l * 1024;
    bf16* XN = (bf16*)(F.ws + WS_XN);
    const int gw = F.bid * NWAVES + F.wave, NGW = F.G * NWAVES;
    for (int m = gw; m < MROWS; m += NGW) {
        const int b = m / SEQ; const f32x4* xr = (const f32x4*)(xin + (size_t)m * 1024) + F.lane;
        f32x4 v[4]; float s = 0.f;
#pragma unroll
        for (int j = 0; j < 4; ++j) { v[j] = xr[64 * j]; s += (v[j].x * v[j].x + v[j].y * v[j].y) + (v[j].z * v[j].z + v[j].w * v[j].w); }
        const float rs = 1.f / sqrtf(wave_sum(s) * (1.f / 1024.f) + 1e-6f);
        u32x2* o = (u32x2*)(XN + (size_t)m * 1024) + F.lane;
#pragma unroll
        for (int j = 0; j < 4; ++j) { const int c = 4 * F.lane + 256 * j;
            const f32x4 gg = *(const f32x4*)(g + c), sh = *(const f32x4*)(mod + b * 3072 + c), sc = *(const f32x4*)(mod + b * 3072 + 1024 + c);
            const f32x4 h = v[j] * rs * gg * (sc + 1.f) + sh; u32x2 w; w.x = pk2(h.x, h.y); w.y = pk2(h.z, h.w); o[64 * j] = w; }
    }
}
__device__ __forceinline__ void phase_final(Frame& F) {
    const float* g = F.in[27]; const int gw = F.bid * NWAVES + F.wave, NGW = F.G * NWAVES;
    for (int m = gw; m < MROWS; m += NGW) {
        f32x4* xr = (f32x4*)(F.out + (size_t)m * 1024) + F.lane; f32x4 v[4]; float s = 0.f;
#pragma unroll
        for (int j = 0; j < 4; ++j) { v[j] = xr[64 * j]; s += (v[j].x * v[j].x + v[j].y * v[j].y) + (v[j].z * v[j].z + v[j].w * v[j].w); }
        const float rs = 1.f / sqrtf(wave_sum(s) * (1.f / 1024.f) + 1e-6f);
#pragma unroll
        for (int j = 0; j < 4; ++j) { const f32x4 gg = *(const f32x4*)(g + 4 * F.lane + 256 * j); xr[64 * j] = v[j] * rs * gg; }
    }
}
__device__ __forceinline__ void phase_attn_naive(Frame& F) {
    const bf16* QKV = (const bf16*)(F.ws + WS_QKV); bf16* YB = (bf16*)(F.ws + WS_YB); const float* rel_bias = F.in[26];
    LAS float* QS = (LAS float*)(F.lds) + F.wave * 640;
    LAS float* PS = QS + 192;
    const int gw = F.bid * NWAVES + F.wave, NGW = F.G * NWAVES, lane = F.lane;
    for (int it = gw; it < MROWS * 8; it += NGW) {
        const int row = it >> 3, h = it & 7, b = row / SEQ, t = row % SEQ;
        const bf16* qrow = QKV + (size_t)row * NQKV;
#pragma unroll
        for (int g = 0; g < 3; ++g) QS[g * 64 + lane] = bf2f(qrow[g * 512 + h * 64 + lane]) * 0.125f;
        __builtin_amdgcn_wave_barrier();
        float sc[3][3]; float mx = -1e30f;
#pragma unroll
        for (int g = 0; g < 3; ++g) { const int dil = (g == 0) ? 1 : (g == 1 ? 4 : 16);
#pragma unroll
            for (int jj = 0; jj < 3; ++jj) { const int j = lane + 64 * jj; const int tk = t - j * dil; float s = -1e30f;
                if (j <= 128 && tk >= 0) {
                    const u32x4* kp = (const u32x4*)(QKV + (size_t)(b * SEQ + tk) * NQKV + 1536 + g * 512 + h * 64);
                    float a = 0.f;
#pragma unroll
                    for (int c8 = 0; c8 < 8; ++c8) { const u32x4 kv = kp[c8]; const LAS float* q = QS + g * 64 + c8 * 8;
                        a += q[0] * bflo(kv.x) + q[1] * bfhi(kv.x) + q[2] * bflo(kv.y) + q[3] * bfhi(kv.y) + q[4] * bflo(kv.z) + q[5] * bfhi(kv.z) + q[6] * bflo(kv.w) + q[7] * bfhi(kv.w); }
                    s = a + rel_bias[(int)T5BUCKET[g][j] * 24 + g * 8 + h];
                }
                sc[g][jj] = s; mx = fmaxf(mx, s); } }
        mx = wave_max(mx);
        float den = 0.f;
#pragma unroll
        for (int g = 0; g < 3; ++g)
#pragma unroll
            for (int jj = 0; jj < 3; ++jj) { const int j = lane + 64 * jj; const float p = (sc[g][jj] > -1e29f) ? __expf(sc[g][jj] - mx) : 0.f; den += p; if (j <= 128) PS[g * 132 + j] = p; }
        den = wave_sum(den);
        __builtin_amdgcn_wave_barrier();
        float o = 0.f;
#pragma unroll
        for (int g = 0; g < 3; ++g) { const int dil = (g == 0) ? 1 : (g == 1 ? 4 : 16); const int jmax = min(128, t / dil);
            const bf16* vp = QKV + (size_t)(b * SEQ + t) * NQKV + 3072 + g * 512 + h * 64 + lane;
            for (int j = 0; j <= jmax; ++j) o += PS[g * 132 + j] * bf2f(vp[-(ptrdiff_t)j * dil * NQKV]); }
        YB[(size_t)row * 512 + h * 64 + lane] = (bf16)f2bf(o / den);
        __builtin_amdgcn_wave_barrier();
    }
}
__device__ __forceinline__ float softplusf_(float x) { return fmaxf(x, 0.f) + log1pf(__expf(-fabsf(x))); }
__device__ __forceinline__ void phase_rwkv_naive(Frame& F, int l) {
    if (F.bid >= 32) return;
    constexpr int TB = 16;
    const int b = F.bid >> 4, h = F.bid & 15, tid = F.tid, lane = F.lane, wave = F.wave;
    const bf16* PA = (const bf16*)(F.ws + WS_PA); bf16* YA = (bf16*)(F.ws + WS_YA); bf16* VF = (bf16*)(F.ws + WS_VFIRST);
    LAS float* L = (LAS float*)F.lds;
    LAS float* W2s = L; LAS float* A2s = L + 4096; LAS float* V2s = L + 8192; LAS float* CV = L + 10240;
    LAS float* PRs = L + 11264; LAS float* PKs = PRs + 17 * 64; LAS float* PVs = PKs + 17 * 64; LAS float* LOs = PVs + 17 * 64;
    LAS float* LWs = LOs + 17 * 320; LAS float* LAs = LWs + TB * 64; LAS float* LVs = LAs + TB * 64;
    LAS float* Rs = LVs + TB * 32; LAS float* Ws = Rs + TB * 64; LAS float* Ks = Ws + TB * 64; LAS float* Vs = Ks + TB * 64; LAS float* As = Vs + TB * 64; LAS float* Bs = As + TB * 64;
    LAS float* RKs = Bs + TB * 64; LAS float* Ys = RKs + TB;
    for (int e = tid; e < 4096; e += NTHREADS) { const int m = e >> 6, j = e & 63;
        W2s[e] = F.in[10][((size_t)l * 64 + m) * 1024 + h * 64 + j]; A2s[e] = F.in[13][((size_t)l * 64 + m) * 1024 + h * 64 + j];
        if (m < 32) V2s[e] = (l == 1) ? F.in[22][(size_t)m * 1024 + h * 64 + j] : 0.f; }
    if (tid < 64) { const int c = h * 64 + tid;
        CV[0 * 64 + tid] = F.in[8][l * 1024 + c];  CV[1 * 64 + tid] = F.in[11][l * 1024 + c]; CV[2 * 64 + tid] = (l == 1) ? F.in[20][c] : 0.f;
        CV[3 * 64 + tid] = F.in[14][l * 1024 + c]; CV[4 * 64 + tid] = F.in[15][l * 1024 + c]; CV[5 * 64 + tid] = F.in[16][l * 1024 + c];
        CV[6 * 64 + tid] = F.in[17][l * 1024 + c]; CV[7 * 64 + tid] = F.in[18][l * 1024 + c];
        CV[8 * 64 + tid] = F.in[6][(size_t)(l * 3 + 0) * 1024 + c]; CV[9 * 64 + tid] = F.in[6][(size_t)(l * 3 + 1) * 1024 + c]; CV[10 * 64 + tid] = F.in[6][(size_t)(l * 3 + 2) * 1024 + c]; }
    float S[16];
#pragma unroll
    for (int q = 0; q < 16; ++q) S[q] = 0.f;
    __syncthreads();
    for (int t0 = 0; t0 < SEQ; t0 += TB) {
        for (int e = tid; e < 17 * 512; e += NTHREADS) { const int rr = e >> 9, cc = e & 511, t = t0 - 1 + rr; float v = 0.f;
            if (t >= 0) { const int gc = (cc < 192) ? ((cc >> 6) * 1024 + h * 64 + (cc & 63)) : (3072 + cc - 192); v = bf2f(PA[(size_t)(b * SEQ + t) * NA + gc]); }
            if (cc < 64) PRs[rr * 64 + cc] = v; else if (cc < 128) PKs[rr * 64 + cc - 64] = v; else if (cc < 192) PVs[rr * 64 + cc - 128] = v; else LOs[rr * 320 + cc - 192] = v; }
        __syncthreads();
        for (int e = tid; e < TB * 160; e += NTHREADS) { const int tl = e / 160, m = e % 160; const LAS float* cur = LOs + (tl + 1) * 320; const LAS float* prv = LOs + tl * 320;
            if (m < 64) LWs[tl * 64 + m] = tanhf(cur[m] + prv[64 + m]);
            else if (m < 128) LAs[tl * 64 + m - 64] = cur[128 + m - 64] + prv[192 + m - 64];
            else LVs[tl * 32 + m - 128] = cur[256 + m - 128] + prv[288 + m - 128]; }
        __syncthreads();
        for (int tl = wave; tl < TB; tl += NWAVES) { const int j = lane; const size_t row = (size_t)(b * SEQ + t0 + tl);
            float wpre = CV[j], apre = CV[64 + j], vpre = CV[128 + j];
            for (int m = 0; m < 64; ++m) { wpre += LWs[tl * 64 + m] * W2s[m * 64 + j]; apre += LAs[tl * 64 + m] * A2s[m * 64 + j]; }
            for (int m = 0; m < 32; ++m) vpre += LVs[tl * 32 + m] * V2s[m * 64 + j];
            const float pr = PRs[(tl + 1) * 64 + j], prp = PRs[tl * 64 + j], pk = PKs[(tl + 1) * 64 + j], pkp = PKs[tl * 64 + j], pv = PVs[(tl + 1) * 64 + j], pvp = PVs[tl * 64 + j];
            const float r = pr + (prp - pr) * CV[8 * 64 + j], k = pk + (pkp - pk) * CV[9 * 64 + j]; float v = pv + (pvp - pv) * CV[10 * 64 + j];
            const float w = -softplusf_(-wpre) - 0.5f; const float decay = __expf(-__expf(w)); const float asig = sigmoidf_(apre);
            if (l == 0) VF[row * 1024 + h * 64 + j] = (bf16)f2bf(v); else { const float vf = bf2f(VF[row * 1024 + h * 64 + j]); v = v + (vf - v) * sigmoidf_(vpre); }
            const float kk = k * CV[3 * 64 + j]; const float ss = wave_sum(kk * kk); const float kkn = kk * (1.f / sqrtf(fmaxf(ss, 1e-24f)));
            const float k2 = k * (1.f + (asig - 1.f) * CV[4 * 64 + j]);
            const float rk = wave_sum(r * k2 * CV[5 * 64 + j]);
            Rs[tl * 64 + j] = r; Ws[tl * 64 + j] = decay; Ks[tl * 64 + j] = k2; Vs[tl * 64 + j] = v; As[tl * 64 + j] = -kkn; Bs[tl * 64 + j] = kkn * asig;
            if (lane == 0) RKs[tl] = rk; }
        __syncthreads();
        if (wave < 4) { const int i = wave * 16 + (lane >> 2), jq = lane & 3;
            for (int tl = 0; tl < TB; ++tl) { const int o = tl * 64 + jq * 16; const float vi = Vs[tl * 64 + i];
                float sa = 0.f;
#pragma unroll
                for (int q = 0; q < 16; ++q) sa += S[q] * As[o + q];
                sa += __shfl_xor(sa, 1); sa += __shfl_xor(sa, 2);
                float y = 0.f;
#pragma unroll
                for (int q = 0; q < 16; ++q) { S[q] = S[q] * Ws[o + q] + sa * Bs[o + q] + vi * Ks[o + q]; y += S[q] * Rs[o + q]; }
                y += __shfl_xor(y, 1); y += __shfl_xor(y, 2);
                if (jq == 0) Ys[tl * 64 + i] = y; } }
        __syncthreads();
        for (int tl = wave; tl < TB; tl += NWAVES) { const int i = lane; const size_t row = (size_t)(b * SEQ + t0 + tl);
            const float y = Ys[tl * 64 + i]; const float mean = wave_sum(y) * (1.f / 64.f); const float d = y - mean; const float var = wave_sum(d * d) * (1.f / 64.f);
            const float o = d * (1.f / sqrtf(var + 64e-5f)) * CV[6 * 64 + i] + CV[7 * 64 + i] + RKs[tl] * Vs[tl * 64 + i];
            YA[row * 1024 + h * 64 + i] = (bf16)f2bf(o); }
    }
}
typedef short bf16x8 __attribute__((ext_vector_type(8)));
typedef short s16x4 __attribute__((ext_vector_type(4)));
typedef short v4i16_t __attribute__((ext_vector_type(4)));
constexpr int RC = 32, RLS = 256, RNSC = SEQ / RLS, RNCH = RLS / RC, RITEMS = BATCH * 16 * RNSC;
constexpr int AST = 72;
constexpr int MST = 40;
constexpr int OFF_RAWH = 0, OFF_RAWL = 12800, OFF_GCS = 12800, OFF_MK = 12800, OFF_QB = 15360, OFF_QK = 17920, OFF_YS = 20480, OFF_M = 28928, OFF_MMK = 31488;
constexpr int OFF_LW = 34048, OFF_LA = OFF_LW + 4608, OFF_LV = OFF_LA + 4608;
constexpr int OFF_W2T = 45824, OFF_A2T = OFF_W2T + 9216, OFF_V2T = OFF_A2T + 9216;
constexpr int OFF_CV = 69376, OFF_GAM = 72192, OFF_RK = 72448;
constexpr int OFF_PRE = 72576, OFF_U = 72576, OFF_T = OFF_U + 8704;
constexpr int OFF_LWG = 97664, OFF_ARR = 105856, OFF_VFS = 142720;
constexpr int PRE_ST = 196, U_ST = 68, T_ST = 36, YS_ST = 66;
enum { AR_RT = 0, AR_AT, AR_BT, AR_KT, AR_BH, AR_KH, AR_V, AR_W };
static_assert(OFF_VFS + 4096 <= LDS_BYTES - 64 && OFF_MMK + 2560 <= OFF_LW && OFF_YS + 32 * YS_ST * 4 <= OFF_M, "rwkv LDS map");
#define ARR(k) (F.lds + OFF_ARR + (k) * (32 * AST * 2))

__device__ __forceinline__ bf16x8 ld_b128(const LAS unsigned char* p) { return *(const LAS bf16x8*)p; }
__device__ __forceinline__ s16x4 ld_b64(const LAS unsigned char* p) { return *(const LAS s16x4*)p; }
__device__ __forceinline__ s16x4 ld_tr(const LAS unsigned char* p) { return __builtin_bit_cast(s16x4, __builtin_amdgcn_ds_read_tr16_b64_v4i16((LAS v4i16_t*)p)); }
__device__ __forceinline__ bf16x8 cat8(s16x4 a, s16x4 b) { return (bf16x8){a[0], a[1], a[2], a[3], b[0], b[1], b[2], b[3]}; }
__device__ __forceinline__ bf16x8 pack8(f32x4 a, f32x4 b) { u32x4 w; w.x = pk2(a[0], a[1]); w.y = pk2(a[2], a[3]); w.z = pk2(b[0], b[1]); w.w = pk2(b[2], b[3]); return __builtin_bit_cast(bf16x8, w); }
#define MFMA16(a, b, c) __builtin_amdgcn_mfma_f32_16x16x32_bf16((a), (b), (c), 0, 0, 0)
__device__ __forceinline__ void st_bf(LAS unsigned char* base, int idx, float v) { ((LAS bf16*)base)[idx] = (bf16)pg8::cvt_pk_bf16(v, v); }
__device__ __forceinline__ float fsig(float x) { return __builtin_amdgcn_rcpf(1.f + __expf(-x)); }
__device__ __forceinline__ float fast_tanh(float x) { return 1.f - 2.f * __builtin_amdgcn_rcpf(1.f + __expf(2.f * x)); }

__device__ __forceinline__ u32x4 rwkv_raw_load(const bf16* PA, const bf16* VF, int l, int b, int h, int t0, int s) {
    u32x4 v = (u32x4){0u, 0u, 0u, 0u};
    if (s < 792) { const int rr = s / 24, k = s % 24, t = t0 - 1 + rr; if (t >= 0) v = *(const u32x4*)(PA + (size_t)(b * SEQ + t) * NA + (k >> 3) * 1024 + h * 64 + (k & 7) * 8); }
    else if (s < 2112) { const int q = s - 792, rr = q / 40, k = q % 40, t = t0 - 1 + rr; if (t >= 0) v = *(const u32x4*)(PA + (size_t)(b * SEQ + t) * NA + 3072 + k * 8); }
    else if (s < 2368 && l == 1) { const int q = s - 2112, rr = q >> 3, k = q & 7; v = *(const u32x4*)(VF + (size_t)(b * SEQ + t0 + rr) * 1024 + h * 64 + k * 8); }
    return v;
}
__device__ __forceinline__ void rwkv_raw_store(Frame& F, int s, u32x4 v) {
    if (s < 792) { const int rr = s / 24, k = s % 24; *(LAS u32x4*)(F.lds + OFF_RAWH + (rr * 192 + k * 8) * 2) = v; }
    else if (s < 2112) { const int q = s - 792, rr = q / 40, k = q % 40; *(LAS u32x4*)(F.lds + OFF_RAWL + (rr * 320 + k * 8) * 2) = v; }
    else if (s < 2368) { const int q = s - 2112; *(LAS u32x4*)(F.lds + OFF_VFS + q * 16) = v; }
}

template <int PASS> __device__ __forceinline__ void rwkv_pass(Frame& F, int l) {
    const int tid = F.tid, lane = F.lane, wave = F.wave, g = lane >> 4, c = lane & 15;
    const bf16* PA = (const bf16*)(F.ws + WS_PA); bf16* YA = (bf16*)(F.ws + WS_YA); bf16* VF = (bf16*)(F.ws + WS_VFIRST);
    float* PD = (float*)(F.ws + WS_SC); float* SST = (float*)(F.ws + WS_SC + 32 * MiB);
    LAS float* CV = (LAS float*)(F.lds + OFF_CV); LAS float* GAM = (LAS float*)(F.lds + OFF_GAM); LAS float* RK = (LAS float*)(F.lds + OFF_RK);
    LAS float* PRE = (LAS float*)(F.lds + OFF_PRE); LAS float* Us = (LAS float*)(F.lds + OFF_U); LAS float* Ts = (LAS float*)(F.lds + OFF_T);
    LAS float* LWG = (LAS float*)(F.lds + OFF_LWG); LAS float* GCS = (LAS float*)(F.lds + OFF_GCS); LAS float* YS = (LAS float*)(F.lds + OFF_YS);
    LAS bf16* RAWH = (LAS bf16*)(F.lds + OFF_RAWH); LAS bf16* RAWL = (LAS bf16*)(F.lds + OFF_RAWL); LAS bf16* VFS = (LAS bf16*)(F.lds + OFF_VFS);
    const int chain = F.bid >> 3, b = chain >> 4, h = chain & 15, NIT = RNSC / 8;
    if (F.G != 256) return;
    for (int e = tid; e < 4096; e += NTHREADS) { const int m = e >> 6, j = e & 63;
        st_bf(F.lds + OFF_W2T, j * AST + m, F.in[10][((size_t)l * 64 + m) * 1024 + h * 64 + j]);
        st_bf(F.lds + OFF_A2T, j * AST + m, F.in[13][((size_t)l * 64 + m) * 1024 + h * 64 + j]);
        if (m < 32) st_bf(F.lds + OFF_V2T, j * MST + m, (l == 1) ? F.in[22][(size_t)m * 1024 + h * 64 + j] : 0.f); }
    if (tid < 64) { const int cc = h * 64 + tid;
        CV[0 * 64 + tid] = F.in[8][l * 1024 + cc];  CV[1 * 64 + tid] = F.in[11][l * 1024 + cc]; CV[2 * 64 + tid] = (l == 1) ? F.in[20][cc] : 0.f;
        CV[3 * 64 + tid] = F.in[14][l * 1024 + cc]; CV[4 * 64 + tid] = F.in[15][l * 1024 + cc]; CV[5 * 64 + tid] = F.in[16][l * 1024 + cc];
        CV[6 * 64 + tid] = F.in[17][l * 1024 + cc]; CV[7 * 64 + tid] = F.in[18][l * 1024 + cc];
        CV[8 * 64 + tid] = F.in[6][(size_t)(l * 3 + 0) * 1024 + cc]; CV[9 * 64 + tid] = F.in[6][(size_t)(l * 3 + 1) * 1024 + cc]; CV[10 * 64 + tid] = F.in[6][(size_t)(l * 3 + 2) * 1024 + cc]; }
    u32x4 pre[5];
#pragma unroll
    for (int i = 0; i < 5; ++i) pre[i] = rwkv_raw_load(PA, VF, l, b, h, ((F.bid & 7) * NIT) * RLS, tid + NTHREADS * i);
    for (int ii = 0; ii < NIT; ++ii) {
        const int sc = (F.bid & 7) * NIT + ii, it = chain * RNSC + sc;
        f32x4 X[4];
#pragma unroll
        for (int jt = 0; jt < 4; ++jt) X[jt] = (f32x4){0.f, 0.f, 0.f, 0.f};
        if (PASS == 1) { if (wave >= 4) {
#pragma unroll
                for (int jt = 0; jt < 4; ++jt)
#pragma unroll
                    for (int r = 0; r < 4; ++r) X[jt][r] = (16 * jt + 4 * g + r == 16 * (wave - 4) + c) ? 1.f : 0.f; } }
        else if (wave < 4) { int lz = lane; asm volatile("" : "+v"(lz));
            const float* s0 = SST + (size_t)it * 4096 + (4 * (lz >> 4)) * 64 + 16 * wave + (lz & 15);
#pragma unroll
            for (int jt = 0; jt < 4; ++jt)
#pragma unroll
                for (int r = 0; r < 4; ++r) X[jt][r] = s0[(16 * jt + r) * 64]; }
        for (int ch = 0; ch < RNCH; ++ch) {
            const int t0 = sc * RLS + ch * RC;
            __syncthreads();
            { int tz = tid; asm volatile("" : "+v"(tz));
#pragma unroll
              for (int i = 0; i < 5; ++i) rwkv_raw_store(F, tz + NTHREADS * i, pre[i]);
              const bool last = (ch == RNCH - 1) && (ii == NIT - 1); const int t0n = last ? t0 : t0 + RC;
#pragma unroll
              for (int i = 0; i < 5; ++i) pre[i] = rwkv_raw_load(PA, VF, l, b, h, t0n, tz + NTHREADS * i); }
            __syncthreads();
            { const int tl = tid >> 4, mq = tid & 15; const LAS bf16* cur = RAWL + (tl + 1) * 320; const LAS bf16* prv = RAWL + tl * 320;
#pragma unroll
              for (int e = 0; e < 4; ++e) { const int m = mq * 4 + e;
                  st_bf(F.lds + OFF_LW, tl * AST + m, fast_tanh(bf2f(cur[m]) + bf2f(prv[64 + m])));
                  st_bf(F.lds + OFF_LA, tl * AST + m, bf2f(cur[128 + m]) + bf2f(prv[192 + m])); }
#pragma unroll
              for (int e = 0; e < 2; ++e) { const int m = mq * 2 + e; st_bf(F.lds + OFF_LV, tl * MST + m, bf2f(cur[256 + m]) + bf2f(prv[288 + m])); } }
            __syncthreads();
#pragma unroll
            for (int q = 0; q < 3; ++q) { const int tile = wave * 3 + q, tt = tile / 12, nt = tile % 12, mat = nt >> 2, jt = nt & 3;
                f32x4 acc = (f32x4){0.f, 0.f, 0.f, 0.f};
                if (mat < 2) { const LAS unsigned char* Ab = F.lds + (mat == 0 ? OFF_LW : OFF_LA) + ((16 * tt + c) * AST + 8 * g) * 2; const LAS unsigned char* Bb = F.lds + (mat == 0 ? OFF_W2T : OFF_A2T) + ((16 * jt + c) * AST + 8 * g) * 2;
                    acc = MFMA16(ld_b128(Ab), ld_b128(Bb), acc); acc = MFMA16(ld_b128(Ab + 64), ld_b128(Bb + 64), acc); }
                else { const LAS unsigned char* Ab = F.lds + OFF_LV + ((16 * tt + c) * MST + 8 * g) * 2; const LAS unsigned char* Bb = F.lds + OFF_V2T + ((16 * jt + c) * MST + 8 * g) * 2;
                    acc = MFMA16(ld_b128(Ab), ld_b128(Bb), acc); }
                if (mat == 0) { const float w0 = CV[16 * jt + c];
#pragma unroll
                    for (int r = 0; r < 4; ++r) { const float x = -(acc[r] + w0); const float sp = fmaxf(x, 0.f) + __logf(1.f + __expf(-fabsf(x))); LWG[(16 * tt + 4 * g + r) * 64 + 16 * jt + c] = -__expf(-sp - 0.5f); } }
                else {
#pragma unroll
                    for (int r = 0; r < 4; ++r) PRE[(16 * tt + 4 * g + r) * PRE_ST + 16 * nt + c] = acc[r]; } }
            __syncthreads();
            { const int tt = wave >> 2, jt = wave & 3; f32x4 acc = (f32x4){0.f, 0.f, 0.f, 0.f};
#pragma unroll
              for (int ks = 0; ks < 8; ++ks) { if (ks >= 4 && tt == 0) continue;
                  const float av = (4 * ks + g <= 16 * tt + c) ? 1.f : 0.f; const float bv = LWG[(4 * ks + g) * 64 + 16 * jt + c];
                  acc = __builtin_amdgcn_mfma_f32_16x16x4f32(av, bv, acc, 0, 0, 0); }
#pragma unroll
              for (int r = 0; r < 4; ++r) GCS[(16 * tt + 4 * g + r) * 64 + 16 * jt + c] = acc[r];
              if (tt == 1 && g == 3) GAM[16 * jt + c] = __expf(acc[3]); }
            __syncthreads();
            for (int tl = wave; tl < 32; tl += NWAVES) { const int j = lane; const size_t row = (size_t)(b * SEQ + t0 + tl);
                const float apre = PRE[tl * PRE_ST + 64 + j] + CV[64 + j], vpre = PRE[tl * PRE_ST + 128 + j] + CV[128 + j];
                const float pr = bf2f(RAWH[(tl + 1) * 192 + j]), prp = bf2f(RAWH[tl * 192 + j]), pk = bf2f(RAWH[(tl + 1) * 192 + 64 + j]), pkp = bf2f(RAWH[tl * 192 + 64 + j]);
                const float pv = bf2f(RAWH[(tl + 1) * 192 + 128 + j]), pvp = bf2f(RAWH[tl * 192 + 128 + j]);
                const float r = pr + (prp - pr) * CV[8 * 64 + j], k = pk + (pkp - pk) * CV[9 * 64 + j]; float v = pv + (pvp - pv) * CV[10 * 64 + j];
                const float asig = fsig(apre);
                if (l == 0) { if (PASS == 1) VF[row * 1024 + h * 64 + j] = (bf16)f2bf(v); } else { const float vf = bf2f(VFS[tl * 64 + j]); v = v + (vf - v) * fsig(vpre); }
                const float kk = k * CV[3 * 64 + j]; const float ss = wave_sum_dpp(kk * kk); const float kkn = kk * __builtin_amdgcn_rsqf(fmaxf(ss, 1e-24f));
                const float k2 = k * (1.f + (asig - 1.f) * CV[4 * 64 + j]); const float av = -kkn, bv = kkn * asig;
                const float gt = GCS[tl * 64 + j], gp = (tl > 0) ? GCS[(tl - 1) * 64 + j] : 0.f, gC = GCS[31 * 64 + j];
                const float eg = __expf(gt), egp = __expf(gp), einv = __expf(-gt), eh = __expf(gC - gt);
                const int o = tl * AST + j;
                st_bf(ARR(AR_AT), o, av * egp); st_bf(ARR(AR_BT), o, bv * einv); st_bf(ARR(AR_KT), o, k2 * einv); st_bf(ARR(AR_BH), o, bv * eh); st_bf(ARR(AR_KH), o, k2 * eh); st_bf(ARR(AR_V), o, v);
                if (PASS == 3) { st_bf(ARR(AR_RT), o, r * eg); const float rk = wave_sum_dpp(r * k2 * CV[5 * 64 + j]); if (lane == 0) RK[tl] = rk; } }
            __syncthreads();
#pragma unroll
            for (int q = 0; q < 2; ++q) { const int tile = wave * 2 + q, rt = tile >> 2, ct = tile & 3, tt = rt & 1, st = ct & 1;
                if (PASS == 1 && rt >= 2) continue;
                f32x4 acc = (f32x4){0.f, 0.f, 0.f, 0.f};
                if (st <= tt) { const LAS unsigned char* Ab = ARR(rt < 2 ? AR_AT : AR_RT) + ((16 * tt + c) * AST + 8 * g) * 2; const LAS unsigned char* Bb = ARR(ct < 2 ? AR_BT : AR_KT) + ((16 * st + c) * AST + 8 * g) * 2;
                    acc = MFMA16(ld_b128(Ab), ld_b128(Bb), acc); acc = MFMA16(ld_b128(Ab + 64), ld_b128(Bb + 64), acc); }
                const int s = 16 * st + c;
#pragma unroll
                for (int r = 0; r < 4; ++r) { const int t = 16 * tt + 4 * g + r; const bool keep = (rt < 2) ? (s < t) : (s <= t); const float v = keep ? acc[r] : 0.f;
                    if (rt < 2 && ct < 2) Ts[t * T_ST + s] = v; else st_bf(F.lds + (rt < 2 ? OFF_MK : (ct < 2 ? OFF_QB : OFF_QK)), t * MST + s, v); } }
            __syncthreads();
            { LAS float* Mf = (LAS float*)(F.lds + OFF_U); LAS float* Pf = Mf + 32 * 36;
              if (wave < 2) { const int bb = 16 * wave, s = lane & 15; float x[16]; float trow[16];
#pragma unroll
                  for (int t = 0; t < 16; ++t) trow[t] = Ts[(bb + t) * T_ST + bb + s];
#pragma unroll
                  for (int t = 0; t < 16; ++t) { float a0 = (t == s) ? 1.f : 0.f, a1 = 0.f;
#pragma unroll
                      for (int u = 0; u < t; ++u) { const float tv = __int_as_float(__builtin_amdgcn_readlane(__float_as_int(trow[t]), u)); if (u & 1) a1 += tv * x[u]; else a0 += tv * x[u]; }
                      x[t] = a0 + a1; }
                  const int sl = lane & 31;
#pragma unroll
                  for (int t = 0; t < 16; ++t) { const bool own = (wave == 0) ? (sl < 16) : (sl >= 16); const float v = own ? x[t] : 0.f;
                      if (lane < 32 && (wave == 0 || sl >= 16)) { Mf[(bb + t) * 36 + sl] = v; st_bf(F.lds + OFF_M, (bb + t) * MST + sl, v); } } }
              __syncthreads();
              if (wave == 0) { f32x4 pacc = (f32x4){0.f, 0.f, 0.f, 0.f};
#pragma unroll
                  for (int ks = 0; ks < 4; ++ks) pacc = __builtin_amdgcn_mfma_f32_16x16x4f32(Ts[(16 + c) * T_ST + 4 * ks + g], Mf[(4 * ks + g) * 36 + c], pacc, 0, 0, 0);
#pragma unroll
                  for (int r = 0; r < 4; ++r) Pf[(4 * g + r) * 20 + c] = pacc[r];
                  f32x4 macc = (f32x4){0.f, 0.f, 0.f, 0.f};
#pragma unroll
                  for (int ks = 0; ks < 4; ++ks) macc = __builtin_amdgcn_mfma_f32_16x16x4f32(Mf[(16 + c) * 36 + 16 + 4 * ks + g], Pf[(4 * ks + g) * 20 + c], macc, 0, 0, 0);
#pragma unroll
                  for (int r = 0; r < 4; ++r) st_bf(F.lds + OFF_M, (16 + 4 * g + r) * MST + c, macc[r]); } }
            __syncthreads();
            { const int tt = wave >> 2, jt = wave & 3, q4 = c >> 2, p4 = c & 3;
              const bf16x8 a = ld_b128(F.lds + OFF_M + ((16 * tt + c) * MST + 8 * g) * 2);
              const LAS unsigned char* ab = ARR(AR_AT) + ((8 * g + q4) * AST + 16 * jt + 4 * p4) * 2;
              f32x4 acc = (f32x4){0.f, 0.f, 0.f, 0.f}; acc = MFMA16(a, cat8(ld_tr(ab), ld_tr(ab + 4 * AST * 2)), acc);
#pragma unroll
              for (int r = 0; r < 4; ++r) st_bf(ARR(AR_W), (16 * tt + 4 * g + r) * AST + 16 * jt + c, acc[r]);
              if (wave < 4) { const int t2 = (wave == 0) ? 0 : 1, s2 = (wave == 2) ? 1 : ((wave == 3) ? 1 : 0);
                  const int tt2 = (wave == 3) ? 0 : t2;
                  f32x4 m2 = (f32x4){0.f, 0.f, 0.f, 0.f};
                  if (wave < 3) { const bf16x8 a2 = ld_b128(F.lds + OFF_M + ((16 * tt2 + c) * MST + 8 * g) * 2);
                      const LAS unsigned char* mb = F.lds + OFF_MK + ((8 * g + q4) * MST + 16 * s2 + 4 * p4) * 2;
                      m2 = MFMA16(a2, cat8(ld_tr(mb), ld_tr(mb + 4 * MST * 2)), m2); }
#pragma unroll
                  for (int r = 0; r < 4; ++r) st_bf(F.lds + OFF_MMK, (16 * tt2 + 4 * g + r) * MST + 16 * s2 + c, m2[r]); } }
            __syncthreads();
            { const int tt = wave >> 2, itl = wave & 3, q4 = c >> 2, p4 = c & 3;
              const bf16x8 a = ld_b128(F.lds + OFF_MMK + ((16 * tt + c) * MST + 8 * g) * 2);
              const LAS unsigned char* vb = ARR(AR_V) + ((8 * g + q4) * AST + 16 * itl + 4 * p4) * 2;
              f32x4 acc = (f32x4){0.f, 0.f, 0.f, 0.f}; acc = MFMA16(a, cat8(ld_tr(vb), ld_tr(vb + 4 * AST * 2)), acc);
#pragma unroll
              for (int r = 0; r < 4; ++r) Us[(16 * tt + 4 * g + r) * U_ST + 16 * itl + c] = acc[r]; }
            __syncthreads();
            const bool active = (PASS == 1) ? true : (wave < 4);
            const bool inhom = (PASS == 1) ? (wave < 4) : true;
            const int cw = wave & 3;
            if (active) {
                bf16x8 xf[2];
                xf[0] = pack8(X[0], X[1]); xf[1] = pack8(X[2], X[3]);
                f32x4 Z[2];
#pragma unroll
                for (int tt = 0; tt < 2; ++tt) { f32x4 z = (f32x4){0.f, 0.f, 0.f, 0.f};
                    if (inhom) {
#pragma unroll
                        for (int r = 0; r < 4; ++r) z[r] = Us[(16 * tt + 4 * g + r) * U_ST + 16 * cw + c]; }
#pragma unroll
                    for (int ks = 0; ks < 2; ++ks) { const LAS unsigned char* wb = ARR(AR_W) + ((16 * tt + c) * AST + 32 * ks + 4 * g) * 2;
                        z = MFMA16(cat8(ld_b64(wb), ld_b64(wb + 32)), xf[ks], z); }
                    Z[tt] = z; }
                const bf16x8 zf = pack8(Z[0], Z[1]);
                bf16x8 vf = zf;
                if (inhom) { const int q = c >> 2, p = c & 3; const LAS unsigned char* vb = ARR(AR_V) + ((4 * g + q) * AST + 16 * cw + 4 * p) * 2; vf = cat8(ld_tr(vb), ld_tr(vb + 16 * AST * 2)); }
                if (PASS == 3) {
#pragma unroll
                    for (int tt = 0; tt < 2; ++tt) { f32x4 y = (f32x4){0.f, 0.f, 0.f, 0.f};
#pragma unroll
                        for (int ks = 0; ks < 2; ++ks) { const LAS unsigned char* rb = ARR(AR_RT) + ((16 * tt + c) * AST + 32 * ks + 4 * g) * 2;
                            y = MFMA16(cat8(ld_b64(rb), ld_b64(rb + 32)), xf[ks], y); }
                        const LAS unsigned char* qb = F.lds + OFF_QB + ((16 * tt + c) * MST + 4 * g) * 2; const LAS unsigned char* qk = F.lds + OFF_QK + ((16 * tt + c) * MST + 4 * g) * 2;
                        y = MFMA16(cat8(ld_b64(qb), ld_b64(qb + 32)), zf, y);
                        y = MFMA16(cat8(ld_b64(qk), ld_b64(qk + 32)), vf, y);
#pragma unroll
                        for (int r = 0; r < 4; ++r) YS[(16 * tt + 4 * g + r) * YS_ST + 16 * cw + c] = y[r]; } }
                { const int q = c >> 2, p = c & 3;
#pragma unroll
                  for (int jt = 0; jt < 4; ++jt) { f32x4 xn;
#pragma unroll
                      for (int r = 0; r < 4; ++r) xn[r] = X[jt][r] * GAM[16 * jt + 4 * g + r];
                      const LAS unsigned char* bb = ARR(AR_BH) + ((4 * g + q) * AST + 16 * jt + 4 * p) * 2;
                      xn = MFMA16(cat8(ld_tr(bb), ld_tr(bb + 16 * AST * 2)), zf, xn);
                      if (inhom) { const LAS unsigned char* kb = ARR(AR_KH) + ((4 * g + q) * AST + 16 * jt + 4 * p) * 2; xn = MFMA16(cat8(ld_tr(kb), ld_tr(kb + 16 * AST * 2)), vf, xn); }
                      X[jt] = xn; } }
            }
            if (PASS == 3) {
                __syncthreads();
                for (int tl = wave; tl < 32; tl += NWAVES) { const int i = lane; const size_t row = (size_t)(b * SEQ + t0 + tl);
                    const float y = YS[tl * YS_ST + i]; const float mean = wave_sum_dpp(y) * (1.f / 64.f); const float d = y - mean; const float var = wave_sum_dpp(d * d) * (1.f / 64.f);
                    const float o = d * __builtin_amdgcn_rsqf(var + 64e-5f) * CV[6 * 64 + i] + CV[7 * 64 + i] + RK[tl] * bf2f(((const LAS bf16*)ARR(AR_V))[tl * AST + i]);
                    YA[row * 1024 + h * 64 + i] = (bf16)pg8::cvt_pk_bf16(o, o); }
            }
        }
        if (PASS == 1) { int lz = lane; asm volatile("" : "+v"(lz));
            float* pd = PD + (size_t)it * 8192 + (4 * (lz >> 4)) * 128 + 16 * wave + (lz & 15);
#pragma unroll
            for (int jt = 0; jt < 4; ++jt)
#pragma unroll
                for (int r = 0; r < 4; ++r) pd[(16 * jt + r) * 128] = X[jt][r]; }
    }
}
__device__ __forceinline__ void rwkv_pass2(Frame& F) {
    if (F.bid >= 32) return;
    const float* PD = (const float*)(F.ws + WS_SC); float* SST = (float*)(F.ws + WS_SC + 32 * MiB);
    LAS float* S = (LAS float*)F.lds;
    const int tid = F.tid, j = tid >> 3, i0 = (tid & 7) * 8;
    float s[8];
#pragma unroll
    for (int e = 0; e < 8; ++e) s[e] = 0.f;
    for (int sc = 0; sc < RNSC; ++sc) { const size_t it = (size_t)F.bid * RNSC + sc;
        float* so = SST + it * 4096 + j * 64 + i0;
        *(f32x4*)so = (f32x4){s[0], s[1], s[2], s[3]}; *(f32x4*)(so + 4) = (f32x4){s[4], s[5], s[6], s[7]};
        __syncthreads();
        *(LAS f32x4*)(S + j * 68 + i0) = (f32x4){s[0], s[1], s[2], s[3]}; *(LAS f32x4*)(S + j * 68 + i0 + 4) = (f32x4){s[4], s[5], s[6], s[7]};
        __syncthreads();
        const float* pd = PD + it * 8192 + j * 128;
        const f32x4 d0 = *(const f32x4*)(pd + i0), d1 = *(const f32x4*)(pd + i0 + 4);
        float a[8] = {d0[0], d0[1], d0[2], d0[3], d1[0], d1[1], d1[2], d1[3]};
#pragma unroll 4
        for (int q = 0; q < 16; ++q) { const f32x4 pv = *(const f32x4*)(pd + 64 + 4 * q);
#pragma unroll
            for (int e = 0; e < 4; ++e) { const f32x4 s0 = *(const LAS f32x4*)(S + (4 * q + e) * 68 + i0), s1 = *(const LAS f32x4*)(S + (4 * q + e) * 68 + i0 + 4);
                a[0] += pv[e] * s0[0]; a[1] += pv[e] * s0[1]; a[2] += pv[e] * s0[2]; a[3] += pv[e] * s0[3]; a[4] += pv[e] * s1[0]; a[5] += pv[e] * s1[1]; a[6] += pv[e] * s1[2]; a[7] += pv[e] * s1[3]; } }
#pragma unroll
        for (int e = 0; e < 8; ++e) s[e] = a[e];
    }
}
constexpr size_t WS_LSE = 330 * MiB;
constexpr int AT_KS = 0, AT_VS = 36864, AT_BIAS = 76032, KVST = 72;
__device__ __forceinline__ void phase_attn_mfma(Frame& F) {
    bf16* QKV = (bf16*)(F.ws + WS_QKV); float* LSE = (float*)(F.ws + WS_LSE); const float* rel_bias = F.in[26];
    const int tid = F.tid, lane = F.lane, w = F.wave, g = lane >> 4, c = lane & 15, q4 = c >> 2, p4 = c & 3;
    LAS float* BIAS = (LAS float*)(F.lds + AT_BIAS);
    for (int e = tid; e < 16 * KVST / 2; e += NTHREADS) ((LAS unsigned*)(F.lds + AT_VS + 256 * KVST * 2))[e] = 0u;
    for (int u = F.bid; u < 3072; u += F.G) {
        const int blk = u & 63, h = (u >> 6) & 7, bg = u >> 9, gatt = bg % 3, b = bg / 3;
        const int dil = (gatt == 0) ? 1 : (gatt == 1 ? 4 : 16), nblk = 64 / dil, r = blk / nblk, n = blk % nblk;
        __syncthreads();
        if (tid < 129) BIAS[tid] = rel_bias[(int)T5BUCKET[gatt][tid] * 24 + gatt * 8 + h];
        for (int e = tid; e < 4096; e += NTHREADS) { const int which = e >> 11, rowi = (e >> 3) & 255, chn = e & 7; const int lk = 128 * n - 128 + rowi; u32x4 v = (u32x4){0u, 0u, 0u, 0u};
            if (lk >= 0) v = *(const u32x4*)(QKV + (size_t)(b * SEQ + lk * dil + r) * NQKV + 1536 + which * 1536 + gatt * 512 + h * 64 + chn * 8);
            *(LAS u32x4*)(F.lds + (which ? AT_VS : AT_KS) + (rowi * KVST + chn * 8) * 2) = v; }
        const size_t qrow = (size_t)(b * SEQ + (128 * n + 16 * w + c) * dil + r);
        bf16x8 qf[2];
#pragma unroll
        for (int ks = 0; ks < 2; ++ks) { const u32x4 v = *(const u32x4*)(QKV + qrow * NQKV + gatt * 512 + h * 64 + 32 * ks + 8 * g); u32x4 o;
            o.x = pk2(bflo(v.x) * 0.125f, bfhi(v.x) * 0.125f); o.y = pk2(bflo(v.y) * 0.125f, bfhi(v.y) * 0.125f); o.z = pk2(bflo(v.z) * 0.125f, bfhi(v.z) * 0.125f); o.w = pk2(bflo(v.w) * 0.125f, bfhi(v.w) * 0.125f);
            qf[ks] = __builtin_bit_cast(bf16x8, o); }
        __syncthreads();
        f32x4 S[9];
#pragma unroll
        for (int j = 0; j < 9; ++j) { const LAS unsigned char* kb = F.lds + AT_KS + ((16 * (w + j) + c) * KVST + 8 * g) * 2;
            f32x4 a = (f32x4){0.f, 0.f, 0.f, 0.f}; a = MFMA16(ld_b128(kb), qf[0], a); a = MFMA16(ld_b128(kb + 64), qf[1], a); S[j] = a; }
        float mx = -1e30f;
#pragma unroll
        for (int j = 0; j < 9; ++j)
#pragma unroll
            for (int rr = 0; rr < 4; ++rr) { const int delta = 128 - 16 * j + c - 4 * g - rr, ki = 16 * (w + j) + 4 * g + rr;
                const bool valid = (delta >= 0) && (delta <= 128) && (n > 0 || ki >= 128);
                const float s = valid ? S[j][rr] + BIAS[valid ? delta : 0] : -1e30f; S[j][rr] = s; mx = fmaxf(mx, s); }
        mx = fmaxf(mx, bperm_f(lane ^ 16, mx)); mx = fmaxf(mx, bperm_f(lane ^ 32, mx));
        float lsum = 0.f;
#pragma unroll
        for (int j = 0; j < 9; ++j)
#pragma unroll
            for (int rr = 0; rr < 4; ++rr) { const float p = (S[j][rr] > -1e29f) ? __expf(S[j][rr] - mx) : 0.f; S[j][rr] = p; lsum += p; }
        lsum += bperm_f(lane ^ 16, lsum); lsum += bperm_f(lane ^ 32, lsum);
        f32x4 O[4];
#pragma unroll
        for (int dt = 0; dt < 4; ++dt) O[dt] = (f32x4){0.f, 0.f, 0.f, 0.f};
#pragma unroll
        for (int m5 = 0; m5 < 5; ++m5) { const f32x4 z4 = (f32x4){0.f, 0.f, 0.f, 0.f};
            const bf16x8 pf = pack8(S[2 * m5], (2 * m5 + 1 < 9) ? S[(2 * m5 + 1 < 9) ? 2 * m5 + 1 : 0] : z4);
            const LAS unsigned char* vb = F.lds + AT_VS + ((16 * (w + 2 * m5) + 4 * g + q4) * KVST + 4 * p4) * 2;
#pragma unroll
            for (int dt = 0; dt < 4; ++dt) O[dt] = MFMA16(pf, cat8(ld_tr(vb + dt * 32), ld_tr(vb + dt * 32 + 16 * KVST * 2)), O[dt]); }
        const float linv = 1.f / lsum;
        if (g == 0) LSE[qrow * 24 + gatt * 8 + h] = mx + __logf(lsum);
#pragma unroll
        for (int rr = 0; rr < 4; ++rr) { const float li = bperm_f(4 * g + rr, linv);
            bf16* op = QKV + (size_t)(b * SEQ + (128 * n + 16 * w + 4 * g + rr) * dil + r) * NQKV + gatt * 512 + h * 64 + c;
#pragma unroll
            for (int dt = 0; dt < 4; ++dt) op[16 * dt] = (bf16)f2bf(O[dt][rr] * li); }
    }
}
__device__ __forceinline__ void phase_attn_merge(Frame& F) {
    const bf16* QKV = (const bf16*)(F.ws + WS_QKV); const float* LSE = (const float*)(F.ws + WS_LSE); bf16* YB = (bf16*)(F.ws + WS_YB);
    const size_t gt = (size_t)F.bid * NTHREADS + F.tid, NGT = (size_t)F.G * NTHREADS;
    for (size_t e = gt; e < (size_t)MROWS * 64; e += NGT) { const size_t row = e >> 6; const int h = (int)(e >> 3) & 7, d8 = (int)e & 7;
        const float l0 = LSE[row * 24 + h], l1 = LSE[row * 24 + 8 + h], l2 = LSE[row * 24 + 16 + h]; const float m = fmaxf(l0, fmaxf(l1, l2));
        float w0 = __expf(l0 - m), w1 = __expf(l1 - m), w2 = __expf(l2 - m); const float inv = 1.f / (w0 + w1 + w2); w0 *= inv; w1 *= inv; w2 *= inv;
        const bf16* qp = QKV + row * NQKV + h * 64 + d8 * 8;
        const u32x4 a = *(const u32x4*)qp, bq = *(const u32x4*)(qp + 512), cq = *(const u32x4*)(qp + 1024); u32x4 o;
        o.x = pk2(w0 * bflo(a.x) + w1 * bflo(bq.x) + w2 * bflo(cq.x), w0 * bfhi(a.x) + w1 * bfhi(bq.x) + w2 * bfhi(cq.x));
        o.y = pk2(w0 * bflo(a.y) + w1 * bflo(bq.y) + w2 * bflo(cq.y), w0 * bfhi(a.y) + w1 * bfhi(bq.y) + w2 * bfhi(cq.y));
        o.z = pk2(w0 * bflo(a.z) + w1 * bflo(bq.z) + w2 * bflo(cq.z), w0 * bfhi(a.z) + w1 * bfhi(bq.z) + w2 * bfhi(cq.z));
        o.w = pk2(w0 * bflo(a.w) + w1 * bflo(bq.w) + w2 * bflo(cq.w), w0 * bfhi(a.w) + w1 * bfhi(bq.w) + w2 * bfhi(cq.w));
        *(u32x4*)(YB + row * 512 + h * 64 + d8 * 8) = o; }
}
#define GEMM_LDS ((PG8_LAS unsigned char*)F.lds)
template <class Epi> __device__ __forceinline__ void run_gemm(Frame& F, const bf16* A, const bf16* Bt, int N, int K, const Epi& E) {
    pg8::Gemm g{A, Bt, MROWS, N, K}; pg8::StaticOrder S; S.init(MROWS, N, F.G, F.bid);
    pg8::gemm_phase<Epi, pg8::StaticOrder, true, true>(GEMM_LDS, g, S, E, F.tid);
}
#ifdef TPROBE
#define STAMP(cls) do { if (blockIdx.x == 0 && (cur_tid(wv)) == 0) { unsigned long long* ts_ = (unsigned long long*)(ka->ws + WS_CTL + 4096); const unsigned long long t_ = __builtin_amdgcn_s_memrealtime(); ts_[1 + (cls)] += t_ - ts_[0]; ts_[0] = t_; } } while (0)
#else
#define STAMP(cls) do {} while (0)
#endif
#ifndef PROBE_DUP
#define PROBE_DUP 0
#endif
#ifdef USE_CG_SYNC
#define GSYNC(cls) do { grid.sync(); STAMP(cls); } while (0)
#else
#define GSYNC(cls) do { xcd_barrier(xbar, cur_tid(wv)); STAMP(cls); } while (0)
#endif
__global__ void __launch_bounds__(NTHREADS, 2) fwd_kernel(Args a) {
    extern __shared__ __attribute__((aligned(16))) unsigned char lds[];
    cg::grid_group grid = cg::this_grid();
    const int wv = __builtin_amdgcn_readfirstlane((int)threadIdx.x >> 6);
    const KArgs ka = (KArgs)__builtin_amdgcn_kernarg_segment_ptr();
#ifdef TPROBE
    if (blockIdx.x == 0 && (cur_tid(wv)) == 0) { unsigned long long* ts_ = (unsigned long long*)(ka->ws + WS_CTL + 4096); for (int i = 1; i < 16; ++i) ts_[i] = 0ull; ts_[0] = __builtin_amdgcn_s_memrealtime(); }
#endif
    { const int t0_ = cur_tid(wv); if (t0_ < 16) ((LAS unsigned*)lds)[(LDS_BYTES - 64) / 4 + t0_] = 0u; }
    __syncthreads();
    XcdBarrier xbar = xcd_barrier_post((unsigned*)(ka->ws + WS_CTL + 65536), (volatile LAS unsigned*)((LAS unsigned char*)lds + LDS_BYTES - 64), cur_tid(wv));
    { Frame F; make_frame(F, ka, lds, wv); p0_mod(F); p0_weights(F); }
    grid.sync(); STAMP(0);
    for (int l = 0; l < 2; ++l) {
        { Frame F; make_frame(F, ka, lds, wv); phase_modnorm(F, l, (l == 0) ? F.in[0] : F.out); }
        GSYNC(1);
        { Frame F; make_frame(F, ka, lds, wv); run_gemm(F, (const bf16*)(F.ws + WS_XN), (const bf16*)(F.ws + WS_WQKV) + (size_t)l * NQKV * 1024, NQKV, 1024, pg8::EpiStore{(bf16*)(F.ws + WS_QKV), NQKV}); }
        GSYNC(2);
#if PROBE_DUP == 1
        { Frame F; make_frame(F, ka, lds, wv); run_gemm(F, (const bf16*)(F.ws + WS_XN), (const bf16*)(F.ws + WS_WQKV) + (size_t)l * NQKV * 1024, NQKV, 1024, pg8::EpiStore{(bf16*)(F.ws + WS_QKV), NQKV}); }
        GSYNC(2);
#endif
#ifdef ATTN_NAIVE
        { Frame F; make_frame(F, ka, lds, wv); phase_attn_naive(F); }
        GSYNC(3);
#else
        { Frame F; make_frame(F, ka, lds, wv); phase_attn_mfma(F); }
        GSYNC(3);
        { Frame F; make_frame(F, ka, lds, wv); phase_attn_merge(F); }
        GSYNC(4);
#if PROBE_DUP == 2
        { Frame F; make_frame(F, ka, lds, wv); run_gemm(F, (const bf16*)(F.ws + WS_XN), (const bf16*)(F.ws + WS_WQKV) + (size_t)l * NQKV * 1024, NQKV, 1024, pg8::EpiStore{(bf16*)(F.ws + WS_QKV), NQKV}); }
        GSYNC(2);
        { Frame F; make_frame(F, ka, lds, wv); phase_attn_mfma(F); }
        GSYNC(3);
        { Frame F; make_frame(F, ka, lds, wv); phase_attn_merge(F); }
        GSYNC(4);
#endif
#endif
        { Frame F; make_frame(F, ka, lds, wv); run_gemm(F, (const bf16*)(F.ws + WS_XN), (const bf16*)(F.ws + WS_WA) + (size_t)l * NA * 1024, NA, 1024, pg8::EpiStore{(bf16*)(F.ws + WS_PA), NA}); }
        GSYNC(2);
#ifdef RWKV_NAIVE
        { Frame F; make_frame(F, ka, lds, wv); phase_rwkv_naive(F, l); }
        GSYNC(5);
#else
        { Frame F; make_frame(F, ka, lds, wv); rwkv_pass<1>(F, l); }
        GSYNC(5);
#if PROBE_DUP == 3
        { Frame F; make_frame(F, ka, lds, wv); rwkv_pass<1>(F, l); }
        GSYNC(5);
#endif
        { Frame F; make_frame(F, ka, lds, wv); rwkv_pass2(F); }
        GSYNC(6);
#if PROBE_DUP == 6
        { Frame F; make_frame(F, ka, lds, wv); rwkv_pass2(F); }
        GSYNC(6);
#endif
        { Frame F; make_frame(F, ka, lds, wv); rwkv_pass<3>(F, l); }
        GSYNC(7);
#if PROBE_DUP == 4
        { Frame F; make_frame(F, ka, lds, wv); rwkv_pass<3>(F, l); }
        GSYNC(7);
#endif
#if PROBE_DUP == 5
        for (int q_ = 0; q_ < 10; ++q_) grid.sync();
#endif
#endif
        { Frame F; make_frame(F, ka, lds, wv); run_gemm(F, (const bf16*)(F.ws + WS_XN), (const bf16*)(F.ws + WS_WG) + (size_t)l * NG * 1024, NG, 1024, pg8::EpiGates{(bf16*)(F.ws + WS_YA), (bf16*)(F.ws + WS_YB), (bf16*)(F.ws + WS_MG)}); }
        GSYNC(2);
        { Frame F; make_frame(F, ka, lds, wv); run_gemm(F, (const bf16*)(F.ws + WS_YA), (const bf16*)(F.ws + WS_WBA) + (size_t)l * 1024 * 1024, 1024, 1024, pg8::EpiMerge<false>{(bf16*)(F.ws + WS_MERGED), (const bf16*)(F.ws + WS_MG)}); }
        { Frame F; make_frame(F, ka, lds, wv); run_gemm(F, (const bf16*)(F.ws + WS_YB), (const bf16*)(F.ws + WS_WBB) + (size_t)l * 1024 * 512, 1024, 512, pg8::EpiMerge<true>{(bf16*)(F.ws + WS_MERGED), (const bf16*)(F.ws + WS_MG)}); }
        GSYNC(2);
        { Frame F; make_frame(F, ka, lds, wv); run_gemm(F, (const bf16*)(F.ws + WS_MERGED), (const bf16*)(F.ws + WS_WO) + (size_t)l * 1024 * 1024, 1024, 1024,
              pg8::EpiResid{(l == 0) ? F.in[0] : F.out, F.out, (const float*)(F.ws + WS_MOD) + (size_t)l * 2 * 3072 + 2048}); }
        GSYNC(2);
    }
    { Frame F; make_frame(F, ka, lds, wv); phase_final(F); }
#ifdef TPROBE
    if (blockIdx.x == 0 && (cur_tid(wv)) == 0) { STAMP(8); const unsigned long long* ts_ = (const unsigned long long*)(ka->ws + WS_CTL + 4096); ka->out[0] = (float)ts_[1 + TPROBE] * 0.01f; }
#endif
}
extern "C" void kernel_launch(void* const* d_in, const int* in_sizes, int n_in, void* d_out, int out_size, void* d_ws, size_t ws_size, hipStream_t stream) {
    static int grid = 0;
    if (grid == 0) {
        int dev = 0, cus = 0, per_cu = 0;
        (void)hipGetDevice(&dev); (void)hipDeviceGetAttribute(&cus, hipDeviceAttributeMultiprocessorCount, dev);
        (void)hipFuncSetAttribute((const void*)fwd_kernel, hipFuncAttributeMaxDynamicSharedMemorySize, LDS_BYTES);
        (void)hipOccupancyMaxActiveBlocksPerMultiprocessor(&per_cu, (const void*)fwd_kernel, NTHREADS, LDS_BYTES);
        if (n_in != 28 || out_size != MROWS * DM || ws_size < (size_t)352 * MiB || per_cu < 1) { fprintf(stderr, "kernel_launch: unexpected problem (n_in %d out %d ws %zu per_cu %d)\n", n_in, out_size, ws_size, per_cu); }
        grid = cus;
        (void)hipGetLastError();
    }
    (void)hipMemsetAsync((char*)d_ws + WS_CTL, 0, 1 * MiB, stream);
    Args a{};
    for (int i = 0; i < 28; ++i) a.in[i] = (const float*)d_in[i];
    a.out = (float*)d_out; a.ws = (unsigned char*)d_ws;
    void* args[] = {&a};
    hipError_t e = hipLaunchCooperativeKernel((void*)fwd_kernel, dim3(grid), dim3(NTHREADS), args, LDS_BYTES, stream);
    if (e != hipSuccess) fprintf(stderr, "cooperative launch failed: %s (grid %d)\n", hipGetErrorString(e), grid);
}
```

```cpp
#include <hip/hip_runtime.h>
#include <hip/hip_cooperative_groups.h>
#include <cstdio>
#include <cstdint>
namespace cg = cooperative_groups;
namespace pg8 {
#define PG8_LAS __attribute__((address_space(3)))
typedef unsigned short bf16_t;
typedef short bf16x8 __attribute__((ext_vector_type(8)));
typedef float f32x4 __attribute__((ext_vector_type(4)));
typedef unsigned u32x4 __attribute__((ext_vector_type(4)));
constexpr int BM = 256, BK = 64, HALF = 128, HTB = HALF * BK * 2  , STAGE_BYTES = 8 * HTB, NXCD = 8, WGM = 8;

__host__ __device__ __forceinline__ int lds_byte(int r, int c) { const int st = (r >> 4) * 2 + (c >> 5), rr = r & 15, cc = c & 31, ob = rr * 64 + cc * 2; return st * 1024 + (ob ^ (((ob >> 9) & 1) << 5)); }
__host__ __device__ __forceinline__ void stage_rc(int b, int& R, int& C) { const int st = b / 1024, sb = b % 1024, swz = sb ^ (((sb >> 9) & 1) << 5); R = (st >> 1) * 16 + swz / 64; C = (st & 1) * 32 + (swz % 64) / 2; }
__host__ __device__ __forceinline__ int perm32(int rho) { const int n = rho >> 4, i = rho & 15; return 8 * (i >> 2) + 4 * n + (i & 3); }

struct Unit { int pm, pn; };
struct Gemm { const bf16_t* A; const bf16_t* Bt; int M, N, K; };

struct StaticOrder {
    int nM, nN, nwg, G, c;
    __host__ __device__ void init(int M, int N, int G_, int c_) { nM = M / BM; nN = N / BM; nwg = nM * nN; G = G_; c = c_; }
    __host__ __device__ bool next(int i, Unit& u) const {
        const long L = (long)i * G + c; if (L >= nwg) return false;
        int wgid = (int)L; { const int q = nwg / NXCD, r = nwg % NXCD, xcd = wgid % NXCD, off = wgid / NXCD; wgid = (xcd < r ? xcd * (q + 1) : r * (q + 1) + (xcd - r) * q) + off; }
        const int nig = WGM * nN, gid = wgid / nig, fm = gid * WGM, gsz = (nM - fm) < WGM ? (nM - fm) : WGM;
        u.pm = fm + ((wgid % nig) % gsz); u.pn = (wgid % nig) / gsz; return true;
    }
    __device__ __forceinline__ void a_ready(const Unit&) const {}
    __device__ __forceinline__ void done(const Unit&) const {}
};

typedef float f32x2c_t __attribute__((ext_vector_type(2))); typedef __bf16 bf16x2c_t __attribute__((ext_vector_type(2)));
__device__ __forceinline__ unsigned cvt_pk_bf16(float lo, float hi) { const f32x2c_t v = {lo, hi}; const bf16x2c_t b = __builtin_convertvector(v, bf16x2c_t); return __builtin_bit_cast(unsigned, b); }
typedef float f32x2 __attribute__((ext_vector_type(2)));
template <class Epi, class Sched, bool ALIGN_EPI = false, bool SP2 = false>
__device__ __forceinline__ void gemm_phase(PG8_LAS unsigned char* lds, const Gemm g, const Sched& S, const Epi& E, int tid_in) {
    int tid_ = tid_in; asm volatile("" : "+v"(tid_));
    const int tid = tid_, wid = __builtin_amdgcn_readfirstlane(tid >> 6), lane = tid & 63, wr = wid >> 2, wc = wid & 3, fr = lane & 15, fq = lane >> 4;
    const int K = g.K, nt = K / BK;
    unsigned voffA[2], voffB[2];
#pragma unroll
    for (int i = 0; i < 2; ++i) { int R, C; stage_rc(tid * 16 + i * 8192, R, C); const int Rb = Epi::PERM ? ((R & ~31) + perm32(R & 31)) : R;
        voffA[i] = (unsigned)(R * K + C) * 2u; voffB[i] = (unsigned)(Rb * K + C) * 2u; }
    const size_t kstep = (size_t)(BK * 2);
    const size_t hstep = (size_t)HALF * K * 2;
    const size_t tstep = 2 * hstep;
    const unsigned ldsw = (unsigned)wid * 1024u;
    const int aoff = lds_byte(wr * 64 + fr, fq * 8), boff = lds_byte(wc * 32 + fr, fq * 8);
#define PG8_SA(b, h) (((b) * 2 + (h)) * HTB)
#define PG8_SB(b, h) ((4 + (b) * 2 + (h)) * HTB)
#define PG8_STAGE(bufoff, gbase, voff) do { _Pragma("unroll") for (int _i = 0; _i < 2; ++_i) \
        __builtin_amdgcn_global_load_lds((const unsigned*)((const char*)(gbase) + (voff)[_i]), (PG8_LAS unsigned*)(lds + (bufoff) + ldsw + _i * 8192), 16, 0, 0); } while (0)
#define PG8_LDA(dst, b, h) do { _Pragma("unroll") for (int m = 0; m < 4; ++m) _Pragma("unroll") for (int k = 0; k < 2; ++k) dst[m][k] = *(const PG8_LAS bf16x8*)(lds + PG8_SA(b, h) + aoff + m * 2048 + k * 1024); } while (0)
#define PG8_LDB(dst, b, h) do { _Pragma("unroll") for (int n = 0; n < 2; ++n) _Pragma("unroll") for (int k = 0; k < 2; ++k) dst[n][k] = *(const PG8_LAS bf16x8*)(lds + PG8_SB(b, h) + boff + n * 2048 + k * 1024); } while (0)
#define PG8_MMA(ai, bj, At, Bt) do { __builtin_amdgcn_s_setprio(1); _Pragma("unroll") for (int m = 0; m < 4; ++m) _Pragma("unroll") for (int n = 0; n < 2; ++n) _Pragma("unroll") for (int k = 0; k < 2; ++k) \
        acc[ai][bj][m][n] = __builtin_amdgcn_mfma_f32_16x16x32_bf16(Bt[n][k], At[m][k], acc[ai][bj][m][n], 0, 0, 0); __builtin_amdgcn_s_setprio(0); } while (0)
#define PG8_WAIT_V(n) asm volatile("s_waitcnt vmcnt(" #n ")" ::: "memory")
#define PG8_WAIT_L(n) asm volatile("s_waitcnt lgkmcnt(" #n ")" ::: "memory")
#define PG8_BAR __builtin_amdgcn_s_barrier()
#define PG8_SCHED __builtin_amdgcn_sched_barrier(0)
    Unit cur, nxt; int ui = 0;
    if (!S.next(0, cur)) return;
    f32x4 acc[2][2][4][2];
#pragma unroll
    for (int a = 0; a < 2; ++a)
#pragma unroll
        for (int b = 0; b < 2; ++b)
#pragma unroll
            for (int m = 0; m < 4; ++m)
#pragma unroll
                for (int n = 0; n < 2; ++n) acc[a][b][m][n] = (f32x4){0.f, 0.f, 0.f, 0.f};
    bf16x8 At[4][2], B0[2][2], B1[2][2];
    const char* cA = (const char*)g.A + (size_t)cur.pm * tstep; const char* cB = (const char*)g.Bt + (size_t)cur.pn * tstep;
    S.a_ready(cur);
    if constexpr (SP2) {
        PG8_STAGE(PG8_SB(0, 0), cB, voffB); PG8_STAGE(PG8_SB(0, 1), cB + hstep, voffB); PG8_STAGE(PG8_SA(0, 0), cA, voffA); PG8_STAGE(PG8_SA(0, 1), cA + hstep, voffA);
        if (wr == 1) PG8_BAR;
        PG8_WAIT_V(2); PG8_BAR;
        PG8_STAGE(PG8_SB(1, 0), cB + kstep, voffB); PG8_STAGE(PG8_SA(1, 0), cA + kstep, voffA); PG8_STAGE(PG8_SB(1, 1), cB + hstep + kstep, voffB);
        PG8_WAIT_V(6); PG8_BAR;
    } else {
        PG8_STAGE(PG8_SB(0, 0), cB, voffB); PG8_STAGE(PG8_SA(0, 0), cA, voffA); PG8_STAGE(PG8_SB(0, 1), cB + hstep, voffB); PG8_STAGE(PG8_SA(0, 1), cA + hstep, voffA);
        if (wr == 1) PG8_BAR;
        PG8_WAIT_V(4); PG8_BAR;
        PG8_STAGE(PG8_SB(1, 0), cB + kstep, voffB); PG8_STAGE(PG8_SA(1, 0), cA + kstep, voffA); PG8_STAGE(PG8_SB(1, 1), cB + hstep + kstep, voffB);
        PG8_WAIT_V(6); PG8_BAR;
    }
    for (;;) {
        const bool has_next = S.next(ui + 1, nxt);
        const char* nA = has_next ? (const char*)g.A + (size_t)nxt.pm * tstep : cA; const char* nB = has_next ? (const char*)g.Bt + (size_t)nxt.pn * tstep : cB;
        for (int t = 0; t < nt; t += 2) {
            const bool last = (t == nt - 2);
            const char* a1 = cA + (size_t)(t + 1) * kstep;
            const char* a2 = last ? nA : cA + (size_t)(t + 2) * kstep; const char* b2 = last ? nB : cB + (size_t)(t + 2) * kstep;
            const char* a3 = a2 + kstep; const char* b3 = b2 + kstep;
            if (last && has_next) S.a_ready(nxt);
            if constexpr (SP2) {
            PG8_LDB(B0, 0, 0); PG8_LDB(B1, 0, 1); PG8_SCHED; PG8_LDA(At, 0, 0); PG8_STAGE(PG8_SA(1, 1), a1 + hstep, voffA);
            PG8_WAIT_V(8); PG8_WAIT_L(0); PG8_BAR; PG8_MMA(0, 0, At, B0); PG8_MMA(0, 1, At, B1); PG8_BAR; PG8_SCHED;
            PG8_LDA(At, 0, 1); PG8_STAGE(PG8_SB(0, 0), b2, voffB); PG8_STAGE(PG8_SB(0, 1), b2 + hstep, voffB); PG8_STAGE(PG8_SA(0, 0), a2, voffA);
            PG8_WAIT_V(8); PG8_WAIT_L(0); PG8_BAR; PG8_MMA(1, 0, At, B0); PG8_MMA(1, 1, At, B1); PG8_BAR; PG8_SCHED;
            PG8_LDB(B0, 1, 0); PG8_LDB(B1, 1, 1); PG8_SCHED; PG8_LDA(At, 1, 0); PG8_STAGE(PG8_SA(0, 1), a2 + hstep, voffA);
            PG8_WAIT_V(8); PG8_WAIT_L(0); PG8_BAR; PG8_MMA(0, 0, At, B0); PG8_MMA(0, 1, At, B1); PG8_BAR; PG8_SCHED;
            PG8_LDA(At, 1, 1); PG8_STAGE(PG8_SB(1, 0), b3, voffB); PG8_STAGE(PG8_SB(1, 1), b3 + hstep, voffB); PG8_STAGE(PG8_SA(1, 0), a3, voffA);
            PG8_WAIT_V(8); PG8_WAIT_L(0); PG8_BAR; PG8_MMA(1, 0, At, B0); PG8_MMA(1, 1, At, B1); PG8_BAR; PG8_SCHED;
            } else {
            PG8_LDB(B0, 0, 0); PG8_SCHED; PG8_LDA(At, 0, 0); PG8_STAGE(PG8_SA(1, 1), a1 + hstep, voffA);
            PG8_WAIT_L(8); PG8_BAR; PG8_WAIT_L(0); PG8_MMA(0, 0, At, B0); PG8_BAR; PG8_SCHED;
            PG8_LDB(B1, 0, 1); PG8_STAGE(PG8_SB(0, 0), b2, voffB);
            PG8_BAR; PG8_WAIT_L(0); PG8_MMA(0, 1, At, B1); PG8_BAR;
            PG8_LDA(At, 0, 1); PG8_STAGE(PG8_SA(0, 0), a2, voffA);
            PG8_BAR; PG8_WAIT_L(0); PG8_MMA(1, 0, At, B0); PG8_BAR; PG8_SCHED;
            PG8_STAGE(PG8_SB(0, 1), b2 + hstep, voffB);
            PG8_WAIT_V(6); PG8_BAR; PG8_MMA(1, 1, At, B1); PG8_BAR;
            PG8_LDB(B0, 1, 0); PG8_SCHED; PG8_LDA(At, 1, 0); PG8_STAGE(PG8_SA(0, 1), a2 + hstep, voffA);
            PG8_WAIT_L(8); PG8_BAR; PG8_WAIT_L(0); PG8_MMA(0, 0, At, B0); PG8_BAR; PG8_SCHED;
            PG8_LDB(B1, 1, 1); PG8_STAGE(PG8_SB(1, 0), b3, voffB);
            PG8_BAR; PG8_WAIT_L(0); PG8_MMA(0, 1, At, B1); PG8_BAR;
            PG8_LDA(At, 1, 1); PG8_STAGE(PG8_SA(1, 0), a3, voffA);
            PG8_BAR; PG8_WAIT_L(0); PG8_MMA(1, 0, At, B0); PG8_BAR; PG8_SCHED;
            PG8_STAGE(PG8_SB(1, 1), b3 + hstep, voffB);
            PG8_WAIT_V(6); PG8_BAR; PG8_MMA(1, 1, At, B1); PG8_BAR;
            }
        }
        if constexpr (ALIGN_EPI) { if (wr == 0) PG8_BAR; }
        if constexpr (!Epi::AFTER_DRAIN) { E(acc, cur, wr, wc, fr, fq); S.done(cur); }
        if (!has_next) break;
#pragma unroll
        for (int a = 0; a < 2; ++a)
#pragma unroll
            for (int b = 0; b < 2; ++b)
#pragma unroll
                for (int m = 0; m < 4; ++m)
#pragma unroll
                    for (int n = 0; n < 2; ++n) acc[a][b][m][n] = (f32x4){0.f, 0.f, 0.f, 0.f};
        cur = nxt; cA = nA; cB = nB; ++ui;
        if constexpr (ALIGN_EPI) { if (wr == 1) PG8_BAR; }
    }
    PG8_WAIT_V(0);
    if constexpr (!ALIGN_EPI) { if (wr == 0) PG8_BAR; }
    PG8_BAR;
    if constexpr (Epi::AFTER_DRAIN) { E.fused(acc, cur, wr, wc, fr, fq, lds, wid, lane); S.done(cur); }
#undef PG8_SA
#undef PG8_SB
#undef PG8_STAGE
#undef PG8_LDA
#undef PG8_LDB
#undef PG8_MMA
#undef PG8_WAIT_V
#undef PG8_WAIT_L
#undef PG8_BAR
#undef PG8_SCHED
}
}
namespace pg8 {
__device__ __forceinline__ float ep_bflo(unsigned w) { return __uint_as_float(w << 16); }
__device__ __forceinline__ float ep_bfhi(unsigned w) { return __uint_as_float(w & 0xffff0000u); }
__device__ __forceinline__ float ep_sigmoid(float x) { return 1.f / (1.f + __expf(-x)); }
struct EpiStore {
    static constexpr bool PERM = true, AFTER_DRAIN = false;
    bf16_t* O; int ldc;
    __device__ __forceinline__ void operator()(const f32x4 (&acc)[2][2][4][2], const Unit& u, int wr, int wc, int fr, int fq) const {
        const int row0 = u.pm * BM + wr * 64 + fr, col0 = u.pn * BM + wc * 32 + 8 * fq;
#pragma unroll
        for (int ai = 0; ai < 2; ++ai)
#pragma unroll
            for (int m = 0; m < 4; ++m) { bf16_t* rowp = O + (size_t)(row0 + ai * HALF + m * 16) * ldc + col0;
#pragma unroll
                for (int bj = 0; bj < 2; ++bj) { const f32x4 v0 = acc[ai][bj][m][0], v1 = acc[ai][bj][m][1]; u32x4 w;
                    w.x = cvt_pk_bf16(v0[0], v0[1]); w.y = cvt_pk_bf16(v0[2], v0[3]); w.z = cvt_pk_bf16(v1[0], v1[1]); w.w = cvt_pk_bf16(v1[2], v1[3]);
                    *(u32x4*)(rowp + bj * HALF) = w; } }
    }
};
struct EpiGates {
    static constexpr bool PERM = true, AFTER_DRAIN = false;
    bf16_t* YA; bf16_t* YB; bf16_t* MG;
    __device__ __forceinline__ void operator()(const f32x4 (&acc)[2][2][4][2], const Unit& u, int wr, int wc, int fr, int fq) const {
        const int colt = u.pn * BM; int mode, ld, cb; bf16_t* P;
        if (colt < 1024) { mode = 0; P = YA; ld = 1024; cb = colt; } else if (colt < 1536) { mode = 1; P = YB; ld = 512; cb = colt - 1024; } else { mode = 2; P = MG; ld = 2048; cb = colt - 1536; }
        const int row0 = u.pm * BM + wr * 64 + fr, col0 = cb + wc * 32 + 8 * fq;
#pragma unroll
        for (int ai = 0; ai < 2; ++ai)
#pragma unroll
            for (int m = 0; m < 4; ++m) { bf16_t* rowp = P + (size_t)(row0 + ai * HALF + m * 16) * ld + col0;
#pragma unroll
                for (int bj = 0; bj < 2; ++bj) { const f32x4 v0 = acc[ai][bj][m][0], v1 = acc[ai][bj][m][1]; float g[8] = {v0[0], v0[1], v0[2], v0[3], v1[0], v1[1], v1[2], v1[3]};
                    u32x4 w;
                    if (mode == 2) {
#pragma unroll
                        for (int e = 0; e < 8; ++e) g[e] = ep_sigmoid(g[e]);
                    } else {
                        const u32x4 y = *(const u32x4*)(rowp + bj * HALF);
                        const float yv[8] = {ep_bflo(y.x), ep_bfhi(y.x), ep_bflo(y.y), ep_bfhi(y.y), ep_bflo(y.z), ep_bfhi(y.z), ep_bflo(y.w), ep_bfhi(y.w)};
#pragma unroll
                        for (int e = 0; e < 8; ++e) g[e] = yv[e] * g[e] * ep_sigmoid(g[e]);
                    }
                    w.x = cvt_pk_bf16(g[0], g[1]); w.y = cvt_pk_bf16(g[2], g[3]); w.z = cvt_pk_bf16(g[4], g[5]); w.w = cvt_pk_bf16(g[6], g[7]);
                    *(u32x4*)(rowp + bj * HALF) = w; } }
    }
};
template <bool SECOND> struct EpiMerge {
    static constexpr bool PERM = true, AFTER_DRAIN = false;
    bf16_t* MERGED; const bf16_t* MG;
    __device__ __forceinline__ void operator()(const f32x4 (&acc)[2][2][4][2], const Unit& u, int wr, int wc, int fr, int fq) const {
        const int row0 = u.pm * BM + wr * 64 + fr, col0 = u.pn * BM + wc * 32 + 8 * fq;
#pragma unroll
        for (int ai = 0; ai < 2; ++ai)
#pragma unroll
            for (int m = 0; m < 4; ++m) { const size_t r = (size_t)(row0 + ai * HALF + m * 16);
#pragma unroll
                for (int bj = 0; bj < 2; ++bj) { const f32x4 v0 = acc[ai][bj][m][0], v1 = acc[ai][bj][m][1]; float g[8] = {v0[0], v0[1], v0[2], v0[3], v1[0], v1[1], v1[2], v1[3]};
                    const int c = col0 + bj * HALF;
                    const u32x4 s = *(const u32x4*)(MG + r * 2048 + (SECOND ? 1024 : 0) + c);
                    const float sv[8] = {ep_bflo(s.x), ep_bfhi(s.x), ep_bflo(s.y), ep_bfhi(s.y), ep_bflo(s.z), ep_bfhi(s.z), ep_bflo(s.w), ep_bfhi(s.w)};
                    bf16_t* dst = MERGED + r * 1024 + c;
                    if (SECOND) { const u32x4 p = *(const u32x4*)dst;
                        const float pv[8] = {ep_bflo(p.x), ep_bfhi(p.x), ep_bflo(p.y), ep_bfhi(p.y), ep_bflo(p.z), ep_bfhi(p.z), ep_bflo(p.w), ep_bfhi(p.w)};
#pragma unroll
                        for (int e = 0; e < 8; ++e) g[e] = pv[e] + sv[e] * g[e];
                    } else {
#pragma unroll
                        for (int e = 0; e < 8; ++e) g[e] = sv[e] * g[e];
                    }
                    u32x4 w; w.x = cvt_pk_bf16(g[0], g[1]); w.y = cvt_pk_bf16(g[2], g[3]); w.z = cvt_pk_bf16(g[4], g[5]); w.w = cvt_pk_bf16(g[6], g[7]);
                    *(u32x4*)dst = w; } }
    }
};
struct EpiResid {
    static constexpr bool PERM = false, AFTER_DRAIN = false;
    const float* xin; float* xout; const float* gate;
    __device__ __forceinline__ void operator()(const f32x4 (&acc)[2][2][4][2], const Unit& u, int wr, int wc, int fr, int fq) const {
        const int b = (u.pm * BM) / 8192; const float* gp = gate + b * 3072;
        const int row0 = u.pm * BM + wr * 64 + fr, col0 = u.pn * BM + wc * 32 + 4 * fq;
#pragma unroll
        for (int bj = 0; bj < 2; ++bj)
#pragma unroll
            for (int n = 0; n < 2; ++n) { const int c = col0 + bj * HALF + n * 16; const f32x4 gv = *(const f32x4*)(gp + c);
#pragma unroll
                for (int ai = 0; ai < 2; ++ai)
#pragma unroll
                    for (int m = 0; m < 4; ++m) { const size_t off = (size_t)(row0 + ai * HALF + m * 16) * 1024 + c;
                        const f32x4 xi = *(const f32x4*)(xin + off); *(f32x4*)(xout + off) = xi + gv * acc[ai][bj][m][n]; } }
    }
};
}
constexpr int BATCH = 2, SEQ = 8192, DM = 1024, MROWS = BATCH * SEQ, PROJW = 11264;
constexpr int NQKV = 4608, NA = 3584, NG = 3584, NLORA = 320;
constexpr size_t MiB = 1u << 20;
constexpr size_t WS_CTL = 0, WS_MOD = 1 * MiB;
constexpr size_t WS_WQKV = 2 * MiB, WS_WA = 20 * MiB, WS_WG = 34 * MiB, WS_WBA = 48 * MiB, WS_WBB = 52 * MiB, WS_WO = 54 * MiB;
constexpr size_t WS_VFIRST = 58 * MiB, WS_XN = 90 * MiB, WS_YB = 122 * MiB;
constexpr size_t WS_QKV = 138 * MiB, WS_PA = 138 * MiB, WS_YA = 250 * MiB, WS_MG = 138 * MiB, WS_MERGED = 202 * MiB, WS_SC = 282 * MiB;
constexpr int LDS_BYTES = 147456;
constexpr int NTHREADS = 512, NWAVES = 8;
#define LAS __attribute__((address_space(3)))
typedef unsigned short bf16;
typedef float f32x4 __attribute__((ext_vector_type(4)));
typedef unsigned u32x4 __attribute__((ext_vector_type(4)));
typedef unsigned u32x2 __attribute__((ext_vector_type(2)));

__device__ const unsigned char T5BUCKET[3][132] = {
 {0,1,2,3,4,5,6,7,8,9,10,11,12,13,14,15,16,16,16,16,16,16,17,17,17,17,17,17,17,17,18,18,18,18,18,18,18,18,18,18,19,19,19,19,19,19,19,19,19,19,19,19,19,19,20,20,20,20,20,20,20,20,20,20,20,20,20,20,20,20,20,20,20,21,21,21,21,21,21,21,21,21,21,21,21,21,21,21,21,21,21,21,21,21,21,21,21,21,21,22,22,22,22,22,22,22,22,22,22,22,22,22,22,22,22,22,22,22,22,22,22,22,22,22,22,22,22,22,22,0,0,0},
 {0,4,8,12,16,16,17,17,18,18,19,19,19,19,20,20,20,20,20,21,21,21,21,21,21,22,22,22,22,22,22,22,22,22,23,23,23,23,23,23,23,23,23,23,23,23,24,24,24,24,24,24,24,24,24,24,24,24,24,24,24,24,25,25,25,25,25,25,25,25,25,25,25,25,25,25,25,25,25,25,25,25,25,26,26,26,26,26,26,26,26,26,26,26,26,26,26,26,26,26,26,26,26,26,26,26,26,26,26,26,26,26,26,27,27,27,27,27,27,27,27,27,27,27,27,27,27,27,27,0,0,0},
 {0,16,18,19,20,21,21,22,22,23,23,23,24,24,24,24,25,25,25,25,25,26,26,26,26,26,26,26,26,27,27,27,27,27,27,27,27,27,27,28,28,28,28,28,28,28,28,28,28,28,28,28,29,29,29,29,29,29,29,29,29,29,29,29,29,29,29,29,29,29,30,30,30,30,30,30,30,30,30,30,30,30,30,30,30,30,30,30,30,30,30,30,30,30,30,31,31,31,31,31,31,31,31,31,31,31,31,31,31,31,31,31,31,31,31,31,31,31,31,31,31,31,31,31,31,31,31,31,31,0,0,0}};

__device__ __forceinline__ unsigned f2bf(float f) { unsigned u = __builtin_bit_cast(unsigned, f); return (u + 0x7fffu + ((u >> 16) & 1u)) >> 16; }
__device__ __forceinline__ unsigned pk2(float lo, float hi) { return pg8::cvt_pk_bf16(lo, hi); }
__device__ __forceinline__ float bflo(unsigned w) { return __uint_as_float(w << 16); }
__device__ __forceinline__ float bfhi(unsigned w) { return __uint_as_float(w & 0xffff0000u); }
__device__ __forceinline__ float bf2f(bf16 h) { return __uint_as_float(((unsigned)h) << 16); }
template <int CTRL, int RMASK> __device__ __forceinline__ float dpp_f(float v) { return __int_as_float(__builtin_amdgcn_update_dpp(0, __float_as_int(v), CTRL, RMASK, 0xF, false)); }
template <int CTRL, int RMASK> __device__ __forceinline__ float dpp_keep(float v) { return __int_as_float(__builtin_amdgcn_update_dpp(__float_as_int(v), __float_as_int(v), CTRL, RMASK, 0xF, false)); }
__device__ __forceinline__ float wave_sum_dpp(float v) {
    v += dpp_f<0xB1, 0xF>(v); v += dpp_f<0x4E, 0xF>(v); v += dpp_f<0x141, 0xF>(v); v += dpp_f<0x140, 0xF>(v);
    v += dpp_f<0x142, 0xA>(v); v += dpp_f<0x143, 0xC>(v);
    return __int_as_float(__builtin_amdgcn_readlane(__float_as_int(v), 63));
}
__device__ __forceinline__ float wave_max_dpp(float v) {
    v = fmaxf(v, dpp_keep<0xB1, 0xF>(v)); v = fmaxf(v, dpp_keep<0x4E, 0xF>(v)); v = fmaxf(v, dpp_keep<0x141, 0xF>(v)); v = fmaxf(v, dpp_keep<0x140, 0xF>(v));
    v = fmaxf(v, dpp_keep<0x142, 0xA>(v)); v = fmaxf(v, dpp_keep<0x143, 0xC>(v));
    return __int_as_float(__builtin_amdgcn_readlane(__float_as_int(v), 63));
}
__device__ __forceinline__ float wave_sum(float v) { return wave_sum_dpp(v); }
__device__ __forceinline__ float wave_max(float v) { return wave_max_dpp(v); }
__device__ __forceinline__ float bperm_f(int src_lane, float v) { return __int_as_float(__builtin_amdgcn_ds_bpermute(src_lane << 2, __float_as_int(v))); }
__device__ __forceinline__ float sigmoidf_(float x) { return 1.f / (1.f + __expf(-x)); }
__device__ __forceinline__ float siluf_(float x) { return x / (1.f + __expf(-x)); }

struct Args { const float* in[28]; float* out; unsigned char* ws; };
typedef const __attribute__((address_space(4))) Args* KArgs;
struct Frame {
    LAS unsigned char* lds;
    int tid, lane, wave, G, bid;
    const float* in[28]; float* out; unsigned char* ws;
};
__device__ __forceinline__ int lane_id_() { return (int)__builtin_amdgcn_mbcnt_hi(~0u, __builtin_amdgcn_mbcnt_lo(~0u, 0u)); }
__device__ __forceinline__ int cur_tid(int wv) { int w2 = wv; asm volatile("" : "+s"(w2)); unsigned z = 0u; asm volatile("" : "+v"(z)); return w2 * 64 + (int)__builtin_amdgcn_mbcnt_hi(~0u, __builtin_amdgcn_mbcnt_lo(~0u, z)); }
__device__ __forceinline__ void make_frame(Frame& F, KArgs ka, unsigned char* lds, int wv) {
    asm volatile("" : "+s"(ka));
    int t = cur_tid(wv);
    F.lds = (LAS unsigned char*)lds; F.tid = t; F.lane = t & 63; F.wave = __builtin_amdgcn_readfirstlane(t >> 6); F.G = gridDim.x; F.bid = blockIdx.x;
    const __attribute__((address_space(4))) unsigned long long* kr = (const __attribute__((address_space(4))) unsigned long long*)ka;
#pragma unroll
    for (int i = 0; i < 28; ++i) F.in[i] = (const float*)(const __attribute__((address_space(1))) float*)kr[i];
    F.out = (float*)(__attribute__((address_space(1))) float*)kr[28]; F.ws = (unsigned char*)(__attribute__((address_space(1))) unsigned char*)kr[29];
}
#define XB_TMO      128
#define XB_XCNT(j)  (256  + 64 * (j))
#define XB_XSUB(j)  (1280 + 64 * (j))
#define XB_XGEN(j)  (2304 + 64 * (j))
#define XB_TOP      3328
#define XB_TOPGEN   3392
#define XCD_BAR_WORDS 3456
#define XB_SPIN_CAP (1u << 18)

__device__ __forceinline__ unsigned xb_ld(unsigned* p)              { return __hip_atomic_load(p, __ATOMIC_RELAXED, __HIP_MEMORY_SCOPE_AGENT); }
__device__ __forceinline__ unsigned xb_add(unsigned* p, unsigned v) { return __hip_atomic_fetch_add(p, v, __ATOMIC_RELAXED, __HIP_MEMORY_SCOPE_AGENT); }
__device__ __forceinline__ unsigned xb_xcc_id() { return (unsigned)__builtin_amdgcn_s_getreg((3 << 11) | 20) & 0xFu; }
#define XB_SPIN(cond, bar) do { unsigned _sp = 0; while (cond) { __builtin_amdgcn_s_sleep(1); \
    if ((++_sp & 255u) == 0u) { if (xb_ld(&(bar)[XB_TMO])) break; if (_sp > XB_SPIN_CAP) { atomicAdd(&(bar)[XB_TMO], 1u); break; } } } } while (0)

struct XcdBarrier {
    unsigned* bar; unsigned x;
    volatile LAS unsigned* st;
};

__device__ __forceinline__ XcdBarrier xcd_barrier_post(unsigned* bar, volatile LAS unsigned* st, int tid) {
    XcdBarrier b; b.bar = bar; b.x = xb_xcc_id(); b.st = st;
    if (tid == 0) (void)xb_add(&bar[XB_XCNT(b.x)], 1u);
    return b;
}
__device__ __forceinline__ void xcd_barrier_complete(unsigned* bar, unsigned x, unsigned& nloc, unsigned& nx) {
    const unsigned G = gridDim.x * gridDim.y * gridDim.z;
    unsigned sum, cnt, mine, sp = 0u;
    for (;;) {
        sum = 0u; cnt = 0u; mine = 0u;
#pragma unroll
        for (unsigned j = 0; j < 16; ++j) { const unsigned c = xb_ld(&bar[XB_XCNT(j)]); sum += c; cnt += (c > 0u) ? 1u : 0u; mine = (j == x) ? c : mine; }
        if (sum == G) break;
        __builtin_amdgcn_s_sleep(1);
        if ((++sp & 255u) == 0u) { if (xb_ld(&bar[XB_TMO])) break; if (sp > XB_SPIN_CAP) { atomicAdd(&bar[XB_TMO], 1u); break; } }
    }
    nloc = mine > 0u ? mine : 1u; nx = cnt > 0u ? cnt : 1u;
}

__device__ __forceinline__ void xcd_barrier(const XcdBarrier& b, int tid) {
    asm volatile("s_waitcnt vmcnt(0)" ::: "memory");
    __syncthreads();
    if (tid == 0) {
        unsigned* bar = b.bar; asm volatile("" : "+s"(bar));
        __builtin_amdgcn_s_waitcnt(0);
        unsigned nloc = b.st[0], nx = b.st[1];
        if (nloc == 0u) { xcd_barrier_complete(bar, b.x, nloc, nx); b.st[0] = nloc; b.st[1] = nx; }
        const unsigned old = xb_add(&bar[XB_XSUB(b.x)], 1u);
        const unsigned gen = old / nloc;
        if (old + 1u == (gen + 1u) * nloc) {
            __builtin_amdgcn_fence(__ATOMIC_RELEASE, "agent");
            asm volatile("s_waitcnt vmcnt(0)" ::: "memory");
            const unsigned og = xb_add(&bar[XB_TOP], 1u);
            const unsigned tg = og / nx;
            if (og + 1u == (tg + 1u) * nx) xb_add(&bar[XB_TOPGEN], 1u);
            else XB_SPIN(xb_ld(&bar[XB_TOPGEN]) == tg, bar);
            __builtin_amdgcn_fence(__ATOMIC_ACQUIRE, "agent");
            xb_add(&bar[XB_XGEN(b.x)], 1u);
            asm volatile("s_waitcnt vmcnt(0)" ::: "memory");
        } else {
            XB_SPIN(xb_ld(&bar[XB_XGEN(b.x)]) == gen, bar);
            __builtin_amdgcn_fence(__ATOMIC_ACQUIRE, "agent");
            asm volatile("s_waitcnt vmcnt(0)" ::: "memory");
        }
    }
    __syncthreads();
}
__device__ __forceinline__ void p0_mod(Frame& F) {
    const float* c = F.in[1]; const float* ada_w = F.in[3]; const float* ada_b = F.in[4];
    float* mod = (float*)(F.ws + WS_MOD);
    LAS float* red = (LAS float*)F.lds;
    const int col = F.tid & 31, kg = F.tid >> 5;
    for (int ch = F.bid; ch < 192; ch += F.G) {
        const int l = ch / 96, n = (ch % 96) * 32 + col;
        const float* W = ada_w + (size_t)l * 1024 * 3072 + n;
        float a0 = 0.f, a1 = 0.f;
        for (int i = 0; i < 64; ++i) { const int k = kg + 16 * i; const float w = W[(size_t)k * 3072]; a0 += siluf_(c[k]) * w; a1 += siluf_(c[1024 + k]) * w; }
        red[kg * 32 + col] = a0; red[512 + kg * 32 + col] = a1;
        __syncthreads();
        if (F.tid < 64) { const int b = F.tid >> 5; float s = 0.f;
            for (int g = 0; g < 16; ++g) s += red[b * 512 + g * 32 + col];
            mod[(size_t)(l * 2 + b) * 3072 + n] = s + ada_b[l * 3072 + n]; }
        __syncthreads();
    }
}
__device__ __forceinline__ void transpose_item(const float* W, int ldw, int col0, int K, int ncols, bf16* WT, LAS float* scr, int item, int lane) {
    const int nblk = ncols / 32, kb = item / nblk, nb = item % nblk, k0 = 64 * kb, n0 = 32 * nb;
#pragma unroll 8
    for (int i = 0; i < 32; ++i) { const int kk = 2 * i + (lane >> 5); scr[kk * 33 + (lane & 31)] = W[(size_t)(k0 + kk) * ldw + col0 + n0 + (lane & 31)]; }
    asm volatile("s_waitcnt lgkmcnt(0)" ::: "memory");
    const int c = lane & 7;
#pragma unroll
    for (int j = 0; j < 4; ++j) { const int n = (lane >> 3) + 8 * j; const LAS float* s = scr + (8 * c) * 33 + n;
        u32x4 o; o.x = pk2(s[0 * 33], s[1 * 33]); o.y = pk2(s[2 * 33], s[3 * 33]); o.z = pk2(s[4 * 33], s[5 * 33]); o.w = pk2(s[6 * 33], s[7 * 33]);
        *(u32x4*)(WT + (size_t)(n0 + n) * K + k0 + 8 * c) = o; }
    asm volatile("s_waitcnt lgkmcnt(0)" ::: "memory");
}
__device__ __forceinline__ void p0_weights(Frame& F) {
    LAS float* scr = (LAS float*)(F.lds + 16384 + F.wave * 16384);
    const int gw = F.bid * NWAVES + F.wave, NGW = F.G * NWAVES;
    constexpr int I_QKV = 16 * 144, I_A = 16 * 96, I_GA = 16 * 32, I_GB = 16 * 16, I_M = 16 * 64, I_BA = 16 * 32, I_BB = 8 * 32, I_O = 16 * 32;
    constexpr int PER_L = I_QKV + I_A + I_GA + I_GB + I_M + I_BA + I_BB + I_O;
    for (int it = gw; it < 2 * PER_L; it += NGW) {
        const int l = it / PER_L; int r = it % PER_L;
        const float* win = F.in[5] + (size_t)l * 1024 * PROJW;
        bf16* wqkv = (bf16*)(F.ws + WS_WQKV) + (size_t)l * NQKV * 1024;
        bf16* wa = (bf16*)(F.ws + WS_WA) + (size_t)l * NA * 1024;
        bf16* wg = (bf16*)(F.ws + WS_WG) + (size_t)l * NG * 1024;
        const float* W; int ldw, col0, K, ncols; bf16* WT;
        if (r < I_QKV) { W = win; ldw = PROJW; col0 = 4096; K = 1024; ncols = 4608; WT = wqkv; }
        else if ((r -= I_QKV) < I_A) { W = win; ldw = PROJW; col0 = 0; K = 1024; ncols = 3072; WT = wa; }
        else if ((r -= I_A) < I_GA) { W = win; ldw = PROJW; col0 = 3072; K = 1024; ncols = 1024; WT = wg; }
        else if ((r -= I_GA) < I_GB) { W = win; ldw = PROJW; col0 = 8704; K = 1024; ncols = 512; WT = wg + (size_t)1024 * 1024; }
        else if ((r -= I_GB) < I_M) { W = win; ldw = PROJW; col0 = 9216; K = 1024; ncols = 2048; WT = wg + (size_t)1536 * 1024; }
        else if ((r -= I_M) < I_BA) { W = F.in[23] + (size_t)l * 1024 * 1024; ldw = 1024; col0 = 0; K = 1024; ncols = 1024; WT = (bf16*)(F.ws + WS_WBA) + (size_t)l * 1024 * 1024; }
        else if ((r -= I_BA) < I_BB) { W = F.in[24] + (size_t)l * 512 * 1024; ldw = 1024; col0 = 0; K = 512; ncols = 1024; WT = (bf16*)(F.ws + WS_WBB) + (size_t)l * 1024 * 512; }
        else { r -= I_BB; W = F.in[25] + (size_t)l * 1024 * 1024; ldw = 1024; col0 = 0; K = 1024; ncols = 1024; WT = (bf16*)(F.ws + WS_WO) + (size_t)l * 1024 * 1024; }
        transpose_item(W, ldw, col0, K, ncols, WT, scr, r, F.lane);
    }
    const size_t gt = (size_t)F.bid * NTHREADS + F.tid, NGT = (size_t)F.G * NTHREADS;
    for (size_t e = gt; e < (size_t)2 * 512 * 1024; e += NGT) {
        const int l = (int)(e / (512 * 1024)), n = (int)((e / 1024) % 512), k = (int)(e % 1024);
        const float muw = F.in[7][(size_t)(l * 2 + 0) * 1024 + k], mua = F.in[7][(size_t)(l * 2 + 1) * 1024 + k];
        float v = 0.f;
        if (n < 64) v = F.in[9][((size_t)l * 1024 + k) * 64 + n] * (1.f - muw);
        else if (n < 128) v = F.in[9][((size_t)l * 1024 + k) * 64 + (n - 64)] * muw;
        else if (n < 192) v = F.in[12][((size_t)l * 1024 + k) * 64 + (n - 128)] * (1.f - mua);
        else if (n < 256) v = F.in[12][((size_t)l * 1024 + k) * 64 + (n - 192)] * mua;
        else if (n < 320 && l == 1) { const float muv = F.in[19][k]; const int m = (n - 256) & 31; const float w = F.in[21][(size_t)k * 32 + m]; v = (n < 288) ? w * (1.f - muv) : w * muv; }
        ((bf16*)(F.ws + WS_WA))[((size_t)l * NA + 3072 + n) * 1024 + k] = (bf16)f2bf(v);
    }
}
__device__ __forceinline__ void phase_modnorm(Frame& F, int l, const float* xin) {
    const float* mod = (const float*)(F.ws + WS_MOD) + (size_t)l * 2 * 3072;
    const float* g = F.in[2] + l * 1024;
    bf16* XN = (bf16*)(F.ws + WS_XN);
    const int gw = F.bid * NWAVES + F.wave, NGW = F.G * NWAVES;
    for (int m = gw; m < MROWS; m += NGW) {
        const int b = m / SEQ; const f32x4* xr = (const f32x4*)(xin + (size_t)m * 1024) + F.lane;
        f32x4 v[4]; float s = 0.f;
#pragma unroll
        for (int j = 0; j < 4; ++j) { v[j] = xr[64 * j]; s += (v[j].x * v[j].x + v[j].y * v[j].y) + (v[j].z * v[j].z + v[j].w * v[j].w); }
        const float rs = 1.f / sqrtf(wave_sum(s) * (1.f / 1024.f) + 1e-6f);
        u32x2* o = (u32x2*)(XN + (size_t)m * 1024) + F.lane;
#pragma unroll
        for (int j = 0; j < 4; ++j) { const int c = 4 * F.lane + 256 * j;
            const f32x4 gg = *(const f32x4*)(g + c), sh = *(const f32x4*)(mod + b * 3072 + c), sc = *(const f32x4*)(mod + b * 3072 + 1024 + c);
            const f32x4 h = v[j] * rs * gg * (sc + 1.f) + sh; u32x2 w; w.x = pk2(h.x, h.y); w.y = pk2(h.z, h.w); o[64 * j] = w; }
    }
}
__device__ __forceinline__ void phase_final(Frame& F) {
    const float* g = F.in[27]; const int gw = F.bid * NWAVES + F.wave, NGW = F.G * NWAVES;
    for (int m = gw; m < MROWS; m += NGW) {
        f32x4* xr = (f32x4*)(F.out + (size_t)m * 1024) + F.lane; f32x4 v[4]; float s = 0.f;
#pragma unroll
        for (int j = 0; j < 4; ++j) { v[j] = xr[64 * j]; s += (v[j].x * v[j].x + v[j].y * v[j].y) + (v[j].z * v[j].z + v[j].w * v[j].w); }
        const float rs = 1.f / sqrtf(wave_sum(s) * (1.f / 1024.f) + 1e-6f);
#pragma unroll
        for (int j = 0; j < 4; ++j) { const f32x4 gg = *(const f32x4*)(g + 4 * F.lane + 256 * j); xr[64 * j] = v[j] * rs * gg; }
    }
}
__device__ __forceinline__ void phase_attn_naive(Frame& F) {
    const bf16* QKV = (const bf16*)(F.ws + WS_QKV); bf16* YB = (bf16*)(F.ws + WS_YB); const float* rel_bias = F.in[26];
    LAS float* QS = (LAS float*)(F.lds) + F.wave * 640;
    LAS float* PS = QS + 192;
    const int gw = F.bid * NWAVES + F.wave, NGW = F.G * NWAVES, lane = F.lane;
    for (int it = gw; it < MROWS * 8; it += NGW) {
        const int row = it >> 3, h = it & 7, b = row / SEQ, t = row % SEQ;
        const bf16* qrow = QKV + (size_t)row * NQKV;
#pragma unroll
        for (int g = 0; g < 3; ++g) QS[g * 64 + lane] = bf2f(qrow[g * 512 + h * 64 + lane]) * 0.125f;
        __builtin_amdgcn_wave_barrier();
        float sc[3][3]; float mx = -1e30f;
#pragma unroll
        for (int g = 0; g < 3; ++g) { const int dil = (g == 0) ? 1 : (g == 1 ? 4 : 16);
#pragma unroll
            for (int jj = 0; jj < 3; ++jj) { const int j = lane + 64 * jj; const int tk = t - j * dil; float s = -1e30f;
                if (j <= 128 && tk >= 0) {
                    const u32x4* kp = (const u32x4*)(QKV + (size_t)(b * SEQ + tk) * NQKV + 1536 + g * 512 + h * 64);
                    float a = 0.f;
#pragma unroll
                    for (int c8 = 0; c8 < 8; ++c8) { const u32x4 kv = kp[c8]; const LAS float* q = QS + g * 64 + c8 * 8;
                        a += q[0] * bflo(kv.x) + q[1] * bfhi(kv.x) + q[2] * bflo(kv.y) + q[3] * bfhi(kv.y) + q[4] * bflo(kv.z) + q[5] * bfhi(kv.z) + q[6] * bflo(kv.w) + q[7] * bfhi(kv.w); }
                    s = a + rel_bias[(int)T5BUCKET[g][j] * 24 + g * 8 + h];
                }
                sc[g][jj] = s; mx = fmaxf(mx, s); } }
        mx = wave_max(mx);
        float den = 0.f;
#pragma unroll
        for (int g = 0; g < 3; ++g)
#pragma unroll
            for (int jj = 0; jj < 3; ++jj) { const int j = lane + 64 * jj; const float p = (sc[g][jj] > -1e29f) ? __expf(sc[g][jj] - mx) : 0.f; den += p; if (j <= 128) PS[g * 132 + j] = p; }
        den = wave_sum(den);
        __builtin_amdgcn_wave_barrier();
        float o = 0.f;
#pragma unroll
        for (int g = 0; g < 3; ++g) { const int dil = (g == 0) ? 1 : (g == 1 ? 4 : 16); const int jmax = min(128, t / dil);
            const bf16* vp = QKV + (size_t)(b * SEQ + t) * NQKV + 3072 + g * 512 + h * 64 + lane;
            for (int j = 0; j <= jmax; ++j) o += PS[g * 132 + j] * bf2f(vp[-(ptrdiff_t)j * dil * NQKV]); }
        YB[(size_t)row * 512 + h * 64 + lane] = (bf16)f2bf(o / den);
        __builtin_amdgcn_wave_barrier();
    }
}
__device__ __forceinline__ float softplusf_(float x) { return fmaxf(x, 0.f) + log1pf(__expf(-fabsf(x))); }
__device__ __forceinline__ void phase_rwkv_naive(Frame& F, int l) {
    if (F.bid >= 32) return;
    constexpr int TB = 16;
    const int b = F.bid >> 4, h = F.bid & 15, tid = F.tid, lane = F.lane, wave = F.wave;
    const bf16* PA = (const bf16*)(F.ws + WS_PA); bf16* YA = (bf16*)(F.ws + WS_YA); bf16* VF = (bf16*)(F.ws + WS_VFIRST);
    LAS float* L = (LAS float*)F.lds;
    LAS float* W2s = L; LAS float* A2s = L + 4096; LAS float* V2s = L + 8192; LAS float* CV = L + 10240;
    LAS float* PRs = L + 11264; LAS float* PKs = PRs + 17 * 64; LAS float* PVs = PKs + 17 * 64; LAS float* LOs = PVs + 17 * 64;
    LAS float* LWs = LOs + 17 * 320; LAS float* LAs = LWs + TB * 64; LAS float* LVs = LAs + TB * 64;
    LAS float* Rs = LVs + TB * 32; LAS float* Ws = Rs + TB * 64; LAS float* Ks = Ws + TB * 64; LAS float* Vs = Ks + TB * 64; LAS float* As = Vs + TB * 64; LAS float* Bs = As + TB * 64;
    LAS float* RKs = Bs + TB * 64; LAS float* Ys = RKs + TB;
    for (int e = tid; e < 4096; e += NTHREADS) { const int m = e >> 6, j = e & 63;
        W2s[e] = F.in[10][((size_t)l * 64 + m) * 1024 + h * 64 + j]; A2s[e] = F.in[13][((size_t)l * 64 + m) * 1024 + h * 64 + j];
        if (m < 32) V2s[e] = (l == 1) ? F.in[22][(size_t)m * 1024 + h * 64 + j] : 0.f; }
    if (tid < 64) { const int c = h * 64 + tid;
        CV[0 * 64 + tid] = F.in[8][l * 1024 + c];  CV[1 * 64 + tid] = F.in[11][l * 1024 + c]; CV[2 * 64 + tid] = (l == 1) ? F.in[20][c] : 0.f;
        CV[3 * 64 + tid] = F.in[14][l * 1024 + c]; CV[4 * 64 + tid] = F.in[15][l * 1024 + c]; CV[5 * 64 + tid] = F.in[16][l * 1024 + c];
        CV[6 * 64 + tid] = F.in[17][l * 1024 + c]; CV[7 * 64 + tid] = F.in[18][l * 1024 + c];
        CV[8 * 64 + tid] = F.in[6][(size_t)(l * 3 + 0) * 1024 + c]; CV[9 * 64 + tid] = F.in[6][(size_t)(l * 3 + 1) * 1024 + c]; CV[10 * 64 + tid] = F.in[6][(size_t)(l * 3 + 2) * 1024 + c]; }
    float S[16];
#pragma unroll
    for (int q = 0; q < 16; ++q) S[q] = 0.f;
    __syncthreads();
    for (int t0 = 0; t0 < SEQ; t0 += TB) {
        for (int e = tid; e < 17 * 512; e += NTHREADS) { const int rr = e >> 9, cc = e & 511, t = t0 - 1 + rr; float v = 0.f;
            if (t >= 0) { const int gc = (cc < 192) ? ((cc >> 6) * 1024 + h * 64 + (cc & 63)) : (3072 + cc - 192); v = bf2f(PA[(size_t)(b * SEQ + t) * NA + gc]); }
            if (cc < 64) PRs[rr * 64 + cc] = v; else if (cc < 128) PKs[rr * 64 + cc - 64] = v; else if (cc < 192) PVs[rr * 64 + cc - 128] = v; else LOs[rr * 320 + cc - 192] = v; }
        __syncthreads();
        for (int e = tid; e < TB * 160; e += NTHREADS) { const int tl = e / 160, m = e % 160; const LAS float* cur = LOs + (tl + 1) * 320; const LAS float* prv = LOs + tl * 320;
            if (m < 64) LWs[tl * 64 + m] = tanhf(cur[m] + prv[64 + m]);
            else if (m < 128) LAs[tl * 64 + m - 64] = cur[128 + m - 64] + prv[192 + m - 64];
            else LVs[tl * 32 + m - 128] = cur[256 + m - 128] + prv[288 + m - 128]; }
        __syncthreads();
        for (int tl = wave; tl < TB; tl += NWAVES) { const int j = lane; const size_t row = (size_t)(b * SEQ + t0 + tl);
            float wpre = CV[j], apre = CV[64 + j], vpre = CV[128 + j];
            for (int m = 0; m < 64; ++m) { wpre += LWs[tl * 64 + m] * W2s[m * 64 + j]; apre += LAs[tl * 64 + m] * A2s[m * 64 + j]; }
            for (int m = 0; m < 32; ++m) vpre += LVs[tl * 32 + m] * V2s[m * 64 + j];
            const float pr = PRs[(tl + 1) * 64 + j], prp = PRs[tl * 64 + j], pk = PKs[(tl + 1) * 64 + j], pkp = PKs[tl * 64 + j], pv = PVs[(tl + 1) * 64 + j], pvp = PVs[tl * 64 + j];
            const float r = pr + (prp - pr) * CV[8 * 64 + j], k = pk + (pkp - pk) * CV[9 * 64 + j]; float v = pv + (pvp - pv) * CV[10 * 64 + j];
            const float w = -softplusf_(-wpre) - 0.5f; const float decay = __expf(-__expf(w)); const float asig = sigmoidf_(apre);
            if (l == 0) VF[row * 1024 + h * 64 + j] = (bf16)f2bf(v); else { const float vf = bf2f(VF[row * 1024 + h * 64 + j]); v = v + (vf - v) * sigmoidf_(vpre); }
            const float kk = k * CV[3 * 64 + j]; const float ss = wave_sum(kk * kk); const float kkn = kk * (1.f / sqrtf(fmaxf(ss, 1e-24f)));
            const float k2 = k * (1.f + (asig - 1.f) * CV[4 * 64 + j]);
            const float rk = wave_sum(r * k2 * CV[5 * 64 + j]);
            Rs[tl * 64 + j] = r; Ws[tl * 64 + j] = decay; Ks[tl * 64 + j] = k2; Vs[tl * 64 + j] = v; As[tl * 64 + j] = -kkn; Bs[tl * 64 + j] = kkn * asig;
            if (lane == 0) RKs[tl] = rk; }
        __syncthreads();
        if (wave < 4) { const int i = wave * 16 + (lane >> 2), jq = lane & 3;
            for (int tl = 0; tl < TB; ++tl) { const int o = tl * 64 + jq * 16; const float vi = Vs[tl * 64 + i];
                float sa = 0.f;
#pragma unroll
                for (int q = 0; q < 16; ++q) sa += S[q] * As[o + q];
                sa += __shfl_xor(sa, 1); sa += __shfl_xor(sa, 2);
                float y = 0.f;
#pragma unroll
                for (int q = 0; q < 16; ++q) { S[q] = S[q] * Ws[o + q] + sa * Bs[o + q] + vi * Ks[o + q]; y += S[q] * Rs[o + q]; }
                y += __shfl_xor(y, 1); y += __shfl_xor(y, 2);
                if (jq == 0) Ys[tl * 64 + i] = y; } }
        __syncthreads();
        for (int tl = wave; tl < TB; tl += NWAVES) { const int i = lane; const size_t row = (size_t)(b * SEQ + t0 + tl);
            const float y = Ys[tl * 64 + i]; const float mean = wave_sum(y) * (1.f / 64.f); const float d = y - mean; const float var = wave_sum(d * d) * (1.f / 64.f);
            const float o = d * (1.f / sqrtf(var + 64e-5f)) * CV[6 * 64 + i] + CV[7 * 64 + i] + RKs[tl] * Vs[tl * 64 + i];
            YA[row * 1024 + h * 64 + i] = (bf16)f2bf(o); }
    }
}
#define LDSBAR() do { asm volatile("s_waitcnt lgkmcnt(0)" ::: "memory"); __builtin_amdgcn_s_barrier(); asm volatile("" ::: "memory"); } while (0)
typedef short bf16x8 __attribute__((ext_vector_type(8)));
typedef short s16x4 __attribute__((ext_vector_type(4)));
typedef short v4i16_t __attribute__((ext_vector_type(4)));
constexpr int RC = 32, RLS = 512, RNSC = SEQ / RLS, RNCH = RLS / RC, RITEMS = BATCH * 16 * RNSC;
constexpr int AST = 72;
constexpr int MST = 40;
constexpr int OFF_RAWH = 0, OFF_RAWL = 12800, OFF_GCS = 12800, OFF_MK = 12800, OFF_QB = 15360, OFF_QK = 17920, OFF_YS = 20480, OFF_M = 28928, OFF_MMK = 31488;
constexpr int OFF_LW = 34048, OFF_LA = OFF_LW + 4608, OFF_LV = OFF_LA + 4608;
constexpr int OFF_W2T = 45824, OFF_A2T = OFF_W2T + 9216, OFF_V2T = OFF_A2T + 9216;
constexpr int OFF_CV = 69376, OFF_GAM = 72192, OFF_RK = 72448;
constexpr int OFF_PRE = 72576, OFF_U = 72576, OFF_T = OFF_U + 8704;
constexpr int OFF_LWG = 97664, OFF_ARR = 105856, OFF_VFS = 142720;
constexpr int PRE_ST = 196, U_ST = 68, T_ST = 36, YS_ST = 66;
enum { AR_RT = 0, AR_AT, AR_BT, AR_KT, AR_BH, AR_KH, AR_V, AR_W };
static_assert(OFF_VFS + 4096 <= LDS_BYTES - 64 && OFF_MMK + 2560 <= OFF_LW && OFF_YS + 32 * YS_ST * 4 <= OFF_M, "rwkv LDS map");
#define ARR(k) (F.lds + OFF_ARR + (k) * (32 * AST * 2))

__device__ __forceinline__ bf16x8 ld_b128(const LAS unsigned char* p) { return *(const LAS bf16x8*)p; }
__device__ __forceinline__ s16x4 ld_b64(const LAS unsigned char* p) { return *(const LAS s16x4*)p; }
__device__ __forceinline__ s16x4 ld_tr(const LAS unsigned char* p) { return __builtin_bit_cast(s16x4, __builtin_amdgcn_ds_read_tr16_b64_v4i16((LAS v4i16_t*)p)); }
__device__ __forceinline__ bf16x8 cat8(s16x4 a, s16x4 b) { return (bf16x8){a[0], a[1], a[2], a[3], b[0], b[1], b[2], b[3]}; }
__device__ __forceinline__ bf16x8 pack8(f32x4 a, f32x4 b) { u32x4 w; w.x = pk2(a[0], a[1]); w.y = pk2(a[2], a[3]); w.z = pk2(b[0], b[1]); w.w = pk2(b[2], b[3]); return __builtin_bit_cast(bf16x8, w); }
#define MFMA16(a, b, c) __builtin_amdgcn_mfma_f32_16x16x32_bf16((a), (b), (c), 0, 0, 0)
__device__ __forceinline__ void st_bf(LAS unsigned char* base, int idx, float v) { ((LAS bf16*)base)[idx] = (bf16)pg8::cvt_pk_bf16(v, v); }
__device__ __forceinline__ float fsig(float x) { return __builtin_amdgcn_rcpf(1.f + __expf(-x)); }
__device__ __forceinline__ float fast_tanh(float x) { return 1.f - 2.f * __builtin_amdgcn_rcpf(1.f + __expf(2.f * x)); }

__device__ __forceinline__ u32x4 rwkv_raw_load(const bf16* PA, const bf16* VF, int l, int b, int h, int t0, int i, int tid) {
    u32x4 v = (u32x4){0u, 0u, 0u, 0u};
    const int e = tid + NTHREADS * i, rr = (i < 4) ? (e >> 6) : 32, k = tid & 63, t = t0 - 1 + rr;
    const int col = (k < 24) ? ((k >> 3) * 1024 + h * 64 + (k & 7) * 8) : (3072 + (k - 24) * 8);
    if (i < 4 || tid < 64) { if (t >= 0) v = *(const u32x4*)(PA + (size_t)(b * SEQ + t) * NA + col); }
    else if (l == 1 && tid < 320) { const int q = tid - 64; v = *(const u32x4*)(VF + (size_t)(b * SEQ + t0 + (q >> 3)) * 1024 + h * 64 + (q & 7) * 8); }
    return v;
}
__device__ __forceinline__ void rwkv_raw_store(Frame& F, int i, int tid, u32x4 v) {
    const int e = tid + NTHREADS * i, rr = (i < 4) ? (e >> 6) : 32, k = tid & 63;
    const int off = (k < 24) ? (OFF_RAWH + (rr * 192 + k * 8) * 2) : (OFF_RAWL + (rr * 320 + (k - 24) * 8) * 2);
    if (i < 4 || tid < 64) *(LAS u32x4*)(F.lds + off) = v;
    else if (tid < 320) *(LAS u32x4*)(F.lds + OFF_VFS + (tid - 64) * 16) = v;
}

template <int PASS> __device__ __forceinline__ void rwkv_pass(Frame& F, int l) {
    const int tid = F.tid, lane = F.lane, wave = F.wave, g = lane >> 4, c = lane & 15;
    const bf16* PA = (const bf16*)(F.ws + WS_PA); bf16* YA = (bf16*)(F.ws + WS_YA); bf16* VF = (bf16*)(F.ws + WS_VFIRST);
    float* PD = (float*)(F.ws + WS_SC); float* SST = (float*)(F.ws + WS_SC + 32 * MiB);
    LAS float* CV = (LAS float*)(F.lds + OFF_CV); LAS float* GAM = (LAS float*)(F.lds + OFF_GAM); LAS float* RK = (LAS float*)(F.lds + OFF_RK);
    LAS float* PRE = (LAS float*)(F.lds + OFF_PRE); LAS float* Us = (LAS float*)(F.lds + OFF_U); LAS float* Ts = (LAS float*)(F.lds + OFF_T);
    LAS float* LWG = (LAS float*)(F.lds + OFF_LWG); LAS float* GCS = (LAS float*)(F.lds + OFF_GCS); LAS float* YS = (LAS float*)(F.lds + OFF_YS);
    LAS bf16* RAWH = (LAS bf16*)(F.lds + OFF_RAWH); LAS bf16* RAWL = (LAS bf16*)(F.lds + OFF_RAWL); LAS bf16* VFS = (LAS bf16*)(F.lds + OFF_VFS);
    const int chain = F.bid >> 3, b = chain >> 4, h = chain & 15, NIT = RNSC / 8;
    if (F.G != 256) return;
    for (int e = tid; e < 4096; e += NTHREADS) { const int m = e >> 6, j = e & 63;
        st_bf(F.lds + OFF_W2T, j * AST + m, F.in[10][((size_t)l * 64 + m) * 1024 + h * 64 + j]);
        st_bf(F.lds + OFF_A2T, j * AST + m, F.in[13][((size_t)l * 64 + m) * 1024 + h * 64 + j]);
        if (m < 32) st_bf(F.lds + OFF_V2T, j * MST + m, (l == 1) ? F.in[22][(size_t)m * 1024 + h * 64 + j] : 0.f); }
    if (tid < 64) { const int cc = h * 64 + tid;
        CV[0 * 64 + tid] = F.in[8][l * 1024 + cc];  CV[1 * 64 + tid] = F.in[11][l * 1024 + cc]; CV[2 * 64 + tid] = (l == 1) ? F.in[20][cc] : 0.f;
        CV[3 * 64 + tid] = F.in[14][l * 1024 + cc]; CV[4 * 64 + tid] = F.in[15][l * 1024 + cc]; CV[5 * 64 + tid] = F.in[16][l * 1024 + cc];
        CV[6 * 64 + tid] = F.in[17][l * 1024 + cc]; CV[7 * 64 + tid] = F.in[18][l * 1024 + cc];
        CV[8 * 64 + tid] = F.in[6][(size_t)(l * 3 + 0) * 1024 + cc]; CV[9 * 64 + tid] = F.in[6][(size_t)(l * 3 + 1) * 1024 + cc]; CV[10 * 64 + tid] = F.in[6][(size_t)(l * 3 + 2) * 1024 + cc]; }
    u32x4 pre[5];
#pragma unroll
    for (int i = 0; i < 5; ++i) pre[i] = rwkv_raw_load(PA, VF, l, b, h, ((F.bid & 7) * NIT) * RLS, i, tid);
    for (int ii = 0; ii < NIT; ++ii) {
        const int sc = (F.bid & 7) * NIT + ii, it = chain * RNSC + sc;
        f32x4 X[4];
#pragma unroll
        for (int jt = 0; jt < 4; ++jt) X[jt] = (f32x4){0.f, 0.f, 0.f, 0.f};
        if (PASS == 1) { if (wave >= 4) {
#pragma unroll
                for (int jt = 0; jt < 4; ++jt)
#pragma unroll
                    for (int r = 0; r < 4; ++r) X[jt][r] = (16 * jt + 4 * g + r == 16 * (wave - 4) + c) ? 1.f : 0.f; } }
        else if (wave < 4) { int lz = lane; asm volatile("" : "+v"(lz));
            const float* s0 = SST + (size_t)it * 4096 + (4 * (lz >> 4)) * 64 + 16 * wave + (lz & 15);
#pragma unroll
            for (int jt = 0; jt < 4; ++jt)
#pragma unroll
                for (int r = 0; r < 4; ++r) X[jt][r] = s0[(16 * jt + r) * 64]; }
        for (int ch = 0; ch < RNCH; ++ch) {
            const int t0 = sc * RLS + ch * RC;
            LDSBAR();
            { int tz = tid; asm volatile("" : "+v"(tz));
#pragma unroll
              for (int i = 0; i < 5; ++i) rwkv_raw_store(F, i, tz, pre[i]);
              const bool last = (ch == RNCH - 1) && (ii == NIT - 1); const int t0n = last ? t0 : t0 + RC;
#pragma unroll
              for (int i = 0; i < 5; ++i) pre[i] = rwkv_raw_load(PA, VF, l, b, h, t0n, i, tz); }
            LDSBAR();
            { const int tl = tid >> 4, mq = tid & 15; const LAS bf16* cur = RAWL + (tl + 1) * 320; const LAS bf16* prv = RAWL + tl * 320;
#pragma unroll
              for (int e = 0; e < 4; ++e) { const int m = mq * 4 + e;
                  st_bf(F.lds + OFF_LW, tl * AST + m, fast_tanh(bf2f(cur[m]) + bf2f(prv[64 + m])));
                  st_bf(F.lds + OFF_LA, tl * AST + m, bf2f(cur[128 + m]) + bf2f(prv[192 + m])); }
#pragma unroll
              for (int e = 0; e < 2; ++e) { const int m = mq * 2 + e; st_bf(F.lds + OFF_LV, tl * MST + m, bf2f(cur[256 + m]) + bf2f(prv[288 + m])); } }
            LDSBAR();
#pragma unroll
            for (int q = 0; q < 3; ++q) { const int tile = wave * 3 + q, tt = tile / 12, nt = tile % 12, mat = nt >> 2, jt = nt & 3;
                f32x4 acc = (f32x4){0.f, 0.f, 0.f, 0.f};
                if (mat < 2) { const LAS unsigned char* Ab = F.lds + (mat == 0 ? OFF_LW : OFF_LA) + ((16 * tt + c) * AST + 8 * g) * 2; const LAS unsigned char* Bb = F.lds + (mat == 0 ? OFF_W2T : OFF_A2T) + ((16 * jt + c) * AST + 8 * g) * 2;
                    acc = MFMA16(ld_b128(Ab), ld_b128(Bb), acc); acc = MFMA16(ld_b128(Ab + 64), ld_b128(Bb + 64), acc); }
                else { const LAS unsigned char* Ab = F.lds + OFF_LV + ((16 * tt + c) * MST + 8 * g) * 2; const LAS unsigned char* Bb = F.lds + OFF_V2T + ((16 * jt + c) * MST + 8 * g) * 2;
                    acc = MFMA16(ld_b128(Ab), ld_b128(Bb), acc); }
                if (mat == 0) { const float w0 = CV[16 * jt + c];
#pragma unroll
                    for (int r = 0; r < 4; ++r) { const float x = -(acc[r] + w0); const float sp = fmaxf(x, 0.f) + __logf(1.f + __expf(-fabsf(x))); LWG[(16 * tt + 4 * g + r) * 64 + 16 * jt + c] = -__expf(-sp - 0.5f); } }
                else {
#pragma unroll
                    for (int r = 0; r < 4; ++r) PRE[(16 * tt + 4 * g + r) * PRE_ST + 16 * nt + c] = acc[r]; } }
            LDSBAR();
            { const int tt = wave >> 2, jt = wave & 3; f32x4 acc = (f32x4){0.f, 0.f, 0.f, 0.f};
#pragma unroll
              for (int ks = 0; ks < 8; ++ks) { if (ks >= 4 && tt == 0) continue;
                  const float av = (4 * ks + g <= 16 * tt + c) ? 1.f : 0.f; const float bv = LWG[(4 * ks + g) * 64 + 16 * jt + c];
                  acc = __builtin_amdgcn_mfma_f32_16x16x4f32(av, bv, acc, 0, 0, 0); }
#pragma unroll
              for (int r = 0; r < 4; ++r) GCS[(16 * tt + 4 * g + r) * 64 + 16 * jt + c] = acc[r];
              if (tt == 1 && g == 3) GAM[16 * jt + c] = __expf(acc[3]); }
            LDSBAR();
#pragma unroll 2
            for (int tl = wave; tl < 32; tl += NWAVES) { const int j = lane; const size_t row = (size_t)(b * SEQ + t0 + tl);
                const float apre = PRE[tl * PRE_ST + 64 + j] + CV[64 + j], vpre = PRE[tl * PRE_ST + 128 + j] + CV[128 + j];
                const float pr = bf2f(RAWH[(tl + 1) * 192 + j]), prp = bf2f(RAWH[tl * 192 + j]), pk = bf2f(RAWH[(tl + 1) * 192 + 64 + j]), pkp = bf2f(RAWH[tl * 192 + 64 + j]);
                const float pv = bf2f(RAWH[(tl + 1) * 192 + 128 + j]), pvp = bf2f(RAWH[tl * 192 + 128 + j]);
                const float r = pr + (prp - pr) * CV[8 * 64 + j], k = pk + (pkp - pk) * CV[9 * 64 + j]; float v = pv + (pvp - pv) * CV[10 * 64 + j];
                const float asig = fsig(apre);
                if (l == 0) { if (PASS == 1) VF[row * 1024 + h * 64 + j] = (bf16)f2bf(v); } else { const float vf = bf2f(VFS[tl * 64 + j]); v = v + (vf - v) * fsig(vpre); }
                const float kk = k * CV[3 * 64 + j]; const float ss = wave_sum_dpp(kk * kk); const float kkn = kk * __builtin_amdgcn_rsqf(fmaxf(ss, 1e-24f));
                const float k2 = k * (1.f + (asig - 1.f) * CV[4 * 64 + j]); const float av = -kkn, bv = kkn * asig;
                const float gt = GCS[tl * 64 + j], gp = (tl > 0) ? GCS[(tl - 1) * 64 + j] : 0.f, gC = GCS[31 * 64 + j];
                const float eg = __expf(gt), egp = __expf(gp), einv = __expf(-gt), eh = __expf(gC - gt);
                const int o = tl * AST + j;
                st_bf(ARR(AR_AT), o, av * egp); st_bf(ARR(AR_BT), o, bv * einv); st_bf(ARR(AR_KT), o, k2 * einv); st_bf(ARR(AR_BH), o, bv * eh); st_bf(ARR(AR_KH), o, k2 * eh); st_bf(ARR(AR_V), o, v);
                if (PASS == 3) { st_bf(ARR(AR_RT), o, r * eg); const float rk = wave_sum_dpp(r * k2 * CV[5 * 64 + j]); if (lane == 0) RK[tl] = rk; } }
            LDSBAR();
#pragma unroll
            for (int q = 0; q < 2; ++q) { const int tile = wave * 2 + q, rt = tile >> 2, ct = tile & 3, tt = rt & 1, st = ct & 1;
                if (PASS == 1 && rt >= 2) continue;
                f32x4 acc = (f32x4){0.f, 0.f, 0.f, 0.f};
                if (st <= tt) { const LAS unsigned char* Ab = ARR(rt < 2 ? AR_AT : AR_RT) + ((16 * tt + c) * AST + 8 * g) * 2; const LAS unsigned char* Bb = ARR(ct < 2 ? AR_BT : AR_KT) + ((16 * st + c) * AST + 8 * g) * 2;
                    acc = MFMA16(ld_b128(Ab), ld_b128(Bb), acc); acc = MFMA16(ld_b128(Ab + 64), ld_b128(Bb + 64), acc); }
                const int s = 16 * st + c;
#pragma unroll
                for (int r = 0; r < 4; ++r) { const int t = 16 * tt + 4 * g + r; const bool keep = (rt < 2) ? (s < t) : (s <= t); const float v = keep ? acc[r] : 0.f;
                    if (rt < 2 && ct < 2) Ts[t * T_ST + s] = v; else st_bf(F.lds + (rt < 2 ? OFF_MK : (ct < 2 ? OFF_QB : OFF_QK)), t * MST + s, v); } }
            LDSBAR();
            f32x4 mkv[2]; mkv[0] = (f32x4){0.f, 0.f, 0.f, 0.f}; mkv[1] = mkv[0];
            { LAS float* Mf = (LAS float*)(F.lds + OFF_U); LAS float* Pf = Mf + 32 * 36;
              if (wave == 4 || wave == 5) { const int bb = 16 * (wave - 4), s = lane & 15; float x[16]; float trow[16];
#pragma unroll
                  for (int t = 0; t < 16; ++t) trow[t] = Ts[(bb + t) * T_ST + bb + s];
#pragma unroll
                  for (int t = 0; t < 16; ++t) { float a0 = (t == s) ? 1.f : 0.f, a1 = 0.f;
#pragma unroll
                      for (int u = 0; u < t; ++u) { const float tv = __int_as_float(__builtin_amdgcn_readlane(__float_as_int(trow[t]), u)); if (u & 1) a1 += tv * x[u]; else a0 += tv * x[u]; }
                      x[t] = a0 + a1; }
                  const int sl = lane & 31;
#pragma unroll
                  for (int t = 0; t < 16; ++t) { const bool own = (wave == 4) ? (sl < 16) : (sl >= 16); const float v = own ? x[t] : 0.f;
                      if (lane < 32 && (wave == 4 || sl >= 16)) { Mf[(bb + t) * 36 + sl] = v; st_bf(F.lds + OFF_M, (bb + t) * MST + sl, v); } } }
              else if (wave < 4 && (PASS == 3 || true)) { const int q4 = c >> 2, p4 = c & 3;
                  const LAS unsigned char* vb = ARR(AR_V) + ((8 * g + q4) * AST + 16 * wave + 4 * p4) * 2; const bf16x8 vfr = cat8(ld_tr(vb), ld_tr(vb + 4 * AST * 2));
#pragma unroll
                  for (int st = 0; st < 2; ++st) mkv[st] = MFMA16(ld_b128(F.lds + OFF_MK + ((16 * st + c) * MST + 8 * g) * 2), vfr, mkv[st]); }
              LDSBAR();
              if (wave == 4) { f32x4 pacc = (f32x4){0.f, 0.f, 0.f, 0.f};
#pragma unroll
                  for (int ks = 0; ks < 4; ++ks) pacc = __builtin_amdgcn_mfma_f32_16x16x4f32(Ts[(16 + c) * T_ST + 4 * ks + g], Mf[(4 * ks + g) * 36 + c], pacc, 0, 0, 0);
#pragma unroll
                  for (int r = 0; r < 4; ++r) Pf[(4 * g + r) * 20 + c] = pacc[r];
                  f32x4 macc = (f32x4){0.f, 0.f, 0.f, 0.f};
#pragma unroll
                  for (int ks = 0; ks < 4; ++ks) macc = __builtin_amdgcn_mfma_f32_16x16x4f32(Mf[(16 + c) * 36 + 16 + 4 * ks + g], Pf[(4 * ks + g) * 20 + c], macc, 0, 0, 0);
#pragma unroll
                  for (int r = 0; r < 4; ++r) st_bf(F.lds + OFF_M, (16 + 4 * g + r) * MST + c, macc[r]); } }
            LDSBAR();
            f32x4 Ureg[2]; Ureg[0] = (f32x4){0.f, 0.f, 0.f, 0.f}; Ureg[1] = Ureg[0];
            if (wave >= 4) { const int jt = wave - 4, q4 = c >> 2, p4 = c & 3;
                const LAS unsigned char* ab = ARR(AR_AT) + ((8 * g + q4) * AST + 16 * jt + 4 * p4) * 2; const bf16x8 afr = cat8(ld_tr(ab), ld_tr(ab + 4 * AST * 2));
#pragma unroll
                for (int tt = 0; tt < 2; ++tt) { f32x4 acc = (f32x4){0.f, 0.f, 0.f, 0.f}; acc = MFMA16(ld_b128(F.lds + OFF_M + ((16 * tt + c) * MST + 8 * g) * 2), afr, acc);
#pragma unroll
                    for (int r = 0; r < 4; ++r) st_bf(ARR(AR_W), (16 * tt + 4 * g + r) * AST + 16 * jt + c, acc[r]); } }
            else { const bf16x8 mf = pack8(mkv[0], mkv[1]);
#pragma unroll
                for (int tt = 0; tt < 2; ++tt) { const LAS unsigned char* mb = F.lds + OFF_M + ((16 * tt + c) * MST + 4 * g) * 2; Ureg[tt] = MFMA16(cat8(ld_b64(mb), ld_b64(mb + 32)), mf, Ureg[tt]); } }
            LDSBAR();
            const bool active = (PASS == 1) ? true : (wave < 4);
            const bool inhom = (PASS == 1) ? (wave < 4) : true;
            const int cw = wave & 3;
            if (active) {
                bf16x8 xf[2];
                xf[0] = pack8(X[0], X[1]); xf[1] = pack8(X[2], X[3]);
                f32x4 Z[2];
#pragma unroll
                for (int tt = 0; tt < 2; ++tt) { f32x4 z = (f32x4){0.f, 0.f, 0.f, 0.f};
                    if (inhom) z = Ureg[tt];
#pragma unroll
                    for (int ks = 0; ks < 2; ++ks) { const LAS unsigned char* wb = ARR(AR_W) + ((16 * tt + c) * AST + 32 * ks + 4 * g) * 2;
                        z = MFMA16(cat8(ld_b64(wb), ld_b64(wb + 32)), xf[ks], z); }
                    Z[tt] = z; }
                const bf16x8 zf = pack8(Z[0], Z[1]);
                bf16x8 vf = zf;
                if (inhom) { const int q = c >> 2, p = c & 3; const LAS unsigned char* vb = ARR(AR_V) + ((4 * g + q) * AST + 16 * cw + 4 * p) * 2; vf = cat8(ld_tr(vb), ld_tr(vb + 16 * AST * 2)); }
                if (PASS == 3) {
#pragma unroll
                    for (int tt = 0; tt < 2; ++tt) { f32x4 y = (f32x4){0.f, 0.f, 0.f, 0.f};
#pragma unroll
                        for (int ks = 0; ks < 2; ++ks) { const LAS unsigned char* rb = ARR(AR_RT) + ((16 * tt + c) * AST + 32 * ks + 4 * g) * 2;
                            y = MFMA16(cat8(ld_b64(rb), ld_b64(rb + 32)), xf[ks], y); }
                        const LAS unsigned char* qb = F.lds + OFF_QB + ((16 * tt + c) * MST + 4 * g) * 2; const LAS unsigned char* qk = F.lds + OFF_QK + ((16 * tt + c) * MST + 4 * g) * 2;
                        y = MFMA16(cat8(ld_b64(qb), ld_b64(qb + 32)), zf, y);
                        y = MFMA16(cat8(ld_b64(qk), ld_b64(qk + 32)), vf, y);
#pragma unroll
                        for (int r = 0; r < 4; ++r) YS[(16 * tt + 4 * g + r) * YS_ST + 16 * cw + c] = y[r]; } }
                { const int q = c >> 2, p = c & 3;
#pragma unroll
                  for (int jt = 0; jt < 4; ++jt) { f32x4 xn;
#pragma unroll
                      for (int r = 0; r < 4; ++r) xn[r] = X[jt][r] * GAM[16 * jt + 4 * g + r];
                      const LAS unsigned char* bb = ARR(AR_BH) + ((4 * g + q) * AST + 16 * jt + 4 * p) * 2;
                      xn = MFMA16(cat8(ld_tr(bb), ld_tr(bb + 16 * AST * 2)), zf, xn);
                      if (inhom) { const LAS unsigned char* kb = ARR(AR_KH) + ((4 * g + q) * AST + 16 * jt + 4 * p) * 2; xn = MFMA16(cat8(ld_tr(kb), ld_tr(kb + 16 * AST * 2)), vf, xn); }
                      X[jt] = xn; } }
            }
            if (PASS == 3) {
                LDSBAR();
#pragma unroll 2
                for (int tl = wave; tl < 32; tl += NWAVES) { const int i = lane; const size_t row = (size_t)(b * SEQ + t0 + tl);
                    const float y = YS[tl * YS_ST + i]; const float mean = wave_sum_dpp(y) * (1.f / 64.f); const float d = y - mean; const float var = wave_sum_dpp(d * d) * (1.f / 64.f);
                    const float o = d * __builtin_amdgcn_rsqf(var + 64e-5f) * CV[6 * 64 + i] + CV[7 * 64 + i] + RK[tl] * bf2f(((const LAS bf16*)ARR(AR_V))[tl * AST + i]);
                    YA[row * 1024 + h * 64 + i] = (bf16)pg8::cvt_pk_bf16(o, o); }
            }
        }
        if (PASS == 1) { int lz = lane; asm volatile("" : "+v"(lz));
            float* pd = PD + (size_t)it * 8192 + (4 * (lz >> 4)) * 128 + 16 * wave + (lz & 15);
#pragma unroll
            for (int jt = 0; jt < 4; ++jt)
#pragma unroll
                for (int r = 0; r < 4; ++r) pd[(16 * jt + r) * 128] = X[jt][r]; }
    }
}
#define R2_LOAD(SET_, ITEM) do { const f32x4* pd_ = (const f32x4*)(PD + (size_t)(ITEM) * 8192); _Pragma("unroll") for (int q = 0; q < 4; ++q) SET_[q] = pd_[F.tid + NTHREADS * q]; } while (0)
#define R2_STEP(SET_, SC) do { const size_t it_ = (size_t)F.bid * RNSC + (SC); \
    _Pragma("unroll") for (int q = 0; q < 4; ++q) { const int e = F.tid + NTHREADS * q; *(LAS f32x4*)(PL + (e >> 5) * 132 + (e & 31) * 4) = SET_[q]; } \
    if ((SC) + 2 < RNSC) R2_LOAD(SET_, it_ + 2); \
    LDSBAR(); \
    { float* so = SST + it_ * 4096; for (int e = F.tid; e < 1024; e += NTHREADS) { const int j = e >> 4, i4 = (e & 15) * 4; *(f32x4*)(so + j * 64 + i4) = *(const LAS f32x4*)(S + j * 68 + i4); } } \
    f32x4 acc[2]; float pc[16], sb[2][16]; \
    _Pragma("unroll") for (int q = 0; q < 2; ++q) _Pragma("unroll") for (int r = 0; r < 4; ++r) acc[q][r] = PL[(16 * jt + 4 * g + r) * 132 + 16 * (it0 + q) + c]; \
    _Pragma("unroll") for (int ks = 0; ks < 16; ++ks) { pc[ks] = PL[(16 * jt + c) * 132 + 64 + 4 * ks + g]; _Pragma("unroll") for (int q = 0; q < 2; ++q) sb[q][ks] = S[(4 * ks + g) * 68 + 16 * (it0 + q) + c]; } \
    _Pragma("unroll") for (int ks = 0; ks < 16; ++ks) { _Pragma("unroll") for (int q = 0; q < 2; ++q) acc[q] = __builtin_amdgcn_mfma_f32_16x16x4f32(pc[ks], sb[q][ks], acc[q], 0, 0, 0); } \
    LDSBAR(); \
    _Pragma("unroll") for (int q = 0; q < 2; ++q) _Pragma("unroll") for (int r = 0; r < 4; ++r) S[(16 * jt + 4 * g + r) * 68 + 16 * (it0 + q) + c] = acc[q][r]; \
    } while (0)
__device__ __forceinline__ void rwkv_pass2(Frame& F) {
    if (F.bid >= 32) return;
    const float* PD = (const float*)(F.ws + WS_SC); float* SST = (float*)(F.ws + WS_SC + 32 * MiB);
    LAS float* S = (LAS float*)F.lds; LAS float* PL = S + 64 * 68;
    const int lane = F.lane, wave = F.wave, g = lane >> 4, c = lane & 15, jt = wave >> 1, it0 = 2 * (wave & 1);
    for (int e = F.tid; e < 64 * 68; e += NTHREADS) S[e] = 0.f;
    f32x4 set0[4], set1[4];
    R2_LOAD(set0, (size_t)F.bid * RNSC); R2_LOAD(set1, (size_t)F.bid * RNSC + 1);
    for (int sc = 0; sc < RNSC; sc += 2) { R2_STEP(set0, sc); R2_STEP(set1, sc + 1); }
}
constexpr size_t WS_LSE = 330 * MiB;
constexpr int AT_KS = 0, AT_VS = 36864, AT_BIAS = 76032, KVST = 72;
__device__ __forceinline__ void phase_attn_mfma(Frame& F) {
    bf16* QKV = (bf16*)(F.ws + WS_QKV); float* LSE = (float*)(F.ws + WS_LSE); const float* rel_bias = F.in[26];
    const int tid = F.tid, lane = F.lane, w = F.wave, g = lane >> 4, c = lane & 15, q4 = c >> 2, p4 = c & 3;
    LAS float* BIAS = (LAS float*)(F.lds + AT_BIAS);
    for (int e = tid; e < 16 * KVST / 2; e += NTHREADS) ((LAS unsigned*)(F.lds + AT_VS + 256 * KVST * 2))[e] = 0u;
    for (int u = F.bid; u < 3072; u += F.G) {
        const int blk = u & 63, h = (u >> 6) & 7, bg = u >> 9, gatt = bg % 3, b = bg / 3;
        const int dil = (gatt == 0) ? 1 : (gatt == 1 ? 4 : 16), nblk = 64 / dil, r = blk / nblk, n = blk % nblk;
        __syncthreads();
        if (tid < 129) BIAS[tid] = rel_bias[(int)T5BUCKET[gatt][tid] * 24 + gatt * 8 + h];
        for (int e = tid; e < 4096; e += NTHREADS) { const int which = e >> 11, rowi = (e >> 3) & 255, chn = e & 7; const int lk = 128 * n - 128 + rowi; u32x4 v = (u32x4){0u, 0u, 0u, 0u};
            if (lk >= 0) v = *(const u32x4*)(QKV + (size_t)(b * SEQ + lk * dil + r) * NQKV + 1536 + which * 1536 + gatt * 512 + h * 64 + chn * 8);
            *(LAS u32x4*)(F.lds + (which ? AT_VS : AT_KS) + (rowi * KVST + chn * 8) * 2) = v; }
        const size_t qrow = (size_t)(b * SEQ + (128 * n + 16 * w + c) * dil + r);
        bf16x8 qf[2];
#pragma unroll
        for (int ks = 0; ks < 2; ++ks) { const u32x4 v = *(const u32x4*)(QKV + qrow * NQKV + gatt * 512 + h * 64 + 32 * ks + 8 * g); u32x4 o;
            o.x = pk2(bflo(v.x) * 0.125f, bfhi(v.x) * 0.125f); o.y = pk2(bflo(v.y) * 0.125f, bfhi(v.y) * 0.125f); o.z = pk2(bflo(v.z) * 0.125f, bfhi(v.z) * 0.125f); o.w = pk2(bflo(v.w) * 0.125f, bfhi(v.w) * 0.125f);
            qf[ks] = __builtin_bit_cast(bf16x8, o); }
        __syncthreads();
        f32x4 S[9];
#pragma unroll
        for (int j = 0; j < 9; ++j) { const LAS unsigned char* kb = F.lds + AT_KS + ((16 * (w + j) + c) * KVST + 8 * g) * 2;
            f32x4 a = (f32x4){0.f, 0.f, 0.f, 0.f}; a = MFMA16(ld_b128(kb), qf[0], a); a = MFMA16(ld_b128(kb + 64), qf[1], a); S[j] = a; }
        float mx = -1e30f;
#pragma unroll
        for (int j = 0; j < 9; ++j)
#pragma unroll
            for (int rr = 0; rr < 4; ++rr) { const int delta = 128 - 16 * j + c - 4 * g - rr, ki = 16 * (w + j) + 4 * g + rr;
                const bool valid = (delta >= 0) && (delta <= 128) && (n > 0 || ki >= 128);
                const float s = valid ? S[j][rr] + BIAS[valid ? delta : 0] : -1e30f; S[j][rr] = s; mx = fmaxf(mx, s); }
        mx = fmaxf(mx, bperm_f(lane ^ 16, mx)); mx = fmaxf(mx, bperm_f(lane ^ 32, mx));
        float lsum = 0.f;
#pragma unroll
        for (int j = 0; j < 9; ++j)
#pragma unroll
            for (int rr = 0; rr < 4; ++rr) { const float p = (S[j][rr] > -1e29f) ? __expf(S[j][rr] - mx) : 0.f; S[j][rr] = p; lsum += p; }
        lsum += bperm_f(lane ^ 16, lsum); lsum += bperm_f(lane ^ 32, lsum);
        f32x4 O[4];
#pragma unroll
        for (int dt = 0; dt < 4; ++dt) O[dt] = (f32x4){0.f, 0.f, 0.f, 0.f};
#pragma unroll
        for (int m5 = 0; m5 < 5; ++m5) { const f32x4 z4 = (f32x4){0.f, 0.f, 0.f, 0.f};
            const bf16x8 pf = pack8(S[2 * m5], (2 * m5 + 1 < 9) ? S[(2 * m5 + 1 < 9) ? 2 * m5 + 1 : 0] : z4);
            const LAS unsigned char* vb = F.lds + AT_VS + ((16 * (w + 2 * m5) + 4 * g + q4) * KVST + 4 * p4) * 2;
#pragma unroll
            for (int dt = 0; dt < 4; ++dt) O[dt] = MFMA16(pf, cat8(ld_tr(vb + dt * 32), ld_tr(vb + dt * 32 + 16 * KVST * 2)), O[dt]); }
        const float linv = 1.f / lsum;
        if (g == 0) LSE[qrow * 24 + gatt * 8 + h] = mx + __logf(lsum);
#pragma unroll
        for (int rr = 0; rr < 4; ++rr) { const float li = bperm_f(4 * g + rr, linv);
            bf16* op = QKV + (size_t)(b * SEQ + (128 * n + 16 * w + 4 * g + rr) * dil + r) * NQKV + gatt * 512 + h * 64 + c;
#pragma unroll
            for (int dt = 0; dt < 4; ++dt) op[16 * dt] = (bf16)f2bf(O[dt][rr] * li); }
    }
}
__device__ __forceinline__ void phase_attn_merge(Frame& F) {
    const bf16* QKV = (const bf16*)(F.ws + WS_QKV); const float* LSE = (const float*)(F.ws + WS_LSE); bf16* YB = (bf16*)(F.ws + WS_YB);
    const size_t gt = (size_t)F.bid * NTHREADS + F.tid, NGT = (size_t)F.G * NTHREADS;
    for (size_t e = gt; e < (size_t)MROWS * 64; e += NGT) { const size_t row = e >> 6; const int h = (int)(e >> 3) & 7, d8 = (int)e & 7;
        const float l0 = LSE[row * 24 + h], l1 = LSE[row * 24 + 8 + h], l2 = LSE[row * 24 + 16 + h]; const float m = fmaxf(l0, fmaxf(l1, l2));
        float w0 = __expf(l0 - m), w1 = __expf(l1 - m), w2 = __expf(l2 - m); const float inv = 1.f / (w0 + w1 + w2); w0 *= inv; w1 *= inv; w2 *= inv;
        const bf16* qp = QKV + row * NQKV + h * 64 + d8 * 8;
        const u32x4 a = *(const u32x4*)qp, bq = *(const u32x4*)(qp + 512), cq = *(const u32x4*)(qp + 1024); u32x4 o;
        o.x = pk2(w0 * bflo(a.x) + w1 * bflo(bq.x) + w2 * bflo(cq.x), w0 * bfhi(a.x) + w1 * bfhi(bq.x) + w2 * bfhi(cq.x));
        o.y = pk2(w0 * bflo(a.y) + w1 * bflo(bq.y) + w2 * bflo(cq.y), w0 * bfhi(a.y) + w1 * bfhi(bq.y) + w2 * bfhi(cq.y));
        o.z = pk2(w0 * bflo(a.z) + w1 * bflo(bq.z) + w2 * bflo(cq.z), w0 * bfhi(a.z) + w1 * bfhi(bq.z) + w2 * bfhi(cq.z));
        o.w = pk2(w0 * bflo(a.w) + w1 * bflo(bq.w) + w2 * bflo(cq.w), w0 * bfhi(a.w) + w1 * bfhi(bq.w) + w2 * bfhi(cq.w));
        *(u32x4*)(YB + row * 512 + h * 64 + d8 * 8) = o; }
}
#define GEMM_LDS ((PG8_LAS unsigned char*)F.lds)
template <class Epi> __device__ __forceinline__ void run_gemm(Frame& F, const bf16* A, const bf16* Bt, int N, int K, const Epi& E) {
    pg8::Gemm g{A, Bt, MROWS, N, K}; pg8::StaticOrder S; S.init(MROWS, N, F.G, F.bid);
    pg8::gemm_phase<Epi, pg8::StaticOrder, true, true>(GEMM_LDS, g, S, E, F.tid);
}
#ifdef TPROBE
#define STAMP(cls) do { if (blockIdx.x == 0 && (cur_tid(wv)) == 0) { unsigned long long* ts_ = (unsigned long long*)(ka->ws + WS_CTL + 4096); const unsigned long long t_ = __builtin_amdgcn_s_memrealtime(); ts_[1 + (cls)] += t_ - ts_[0]; ts_[0] = t_; } } while (0)
#else
#define STAMP(cls) do {} while (0)
#endif
#ifndef PROBE_DUP
#define PROBE_DUP 0
#endif
#ifdef USE_CG_SYNC
#define GSYNC(cls) do { grid.sync(); STAMP(cls); } while (0)
#else
#define GSYNC(cls) do { xcd_barrier(xbar, cur_tid(wv)); STAMP(cls); } while (0)
#endif
__global__ void __launch_bounds__(NTHREADS, 2) fwd_kernel(Args a) {
    extern __shared__ __attribute__((aligned(16))) unsigned char lds[];
    cg::grid_group grid = cg::this_grid();
    const int wv = __builtin_amdgcn_readfirstlane((int)threadIdx.x >> 6);
    const KArgs ka = (KArgs)__builtin_amdgcn_kernarg_segment_ptr();
#ifdef TPROBE
    if (blockIdx.x == 0 && (cur_tid(wv)) == 0) { unsigned long long* ts_ = (unsigned long long*)(ka->ws + WS_CTL + 4096); for (int i = 1; i < 16; ++i) ts_[i] = 0ull; ts_[0] = __builtin_amdgcn_s_memrealtime(); }
#endif
    { const int t0_ = cur_tid(wv); if (t0_ < 16) ((LAS unsigned*)lds)[(LDS_BYTES - 64) / 4 + t0_] = 0u; }
    __syncthreads();
    XcdBarrier xbar = xcd_barrier_post((unsigned*)(ka->ws + WS_CTL + 65536), (volatile LAS unsigned*)((LAS unsigned char*)lds + LDS_BYTES - 64), cur_tid(wv));
    { Frame F; make_frame(F, ka, lds, wv); p0_mod(F); p0_weights(F); }
#if PROBE_DUP == 7
    __syncthreads();
    { Frame F; make_frame(F, ka, lds, wv); p0_mod(F); p0_weights(F); }
#endif
    grid.sync(); STAMP(0);
    for (int l = 0; l < 2; ++l) {
        { Frame F; make_frame(F, ka, lds, wv); phase_modnorm(F, l, (l == 0) ? F.in[0] : F.out); }
#if PROBE_DUP == 8
        __syncthreads();
        { Frame F; make_frame(F, ka, lds, wv); phase_modnorm(F, l, (l == 0) ? F.in[0] : F.out); }
#endif
        GSYNC(1);
        { Frame F; make_frame(F, ka, lds, wv); run_gemm(F, (const bf16*)(F.ws + WS_XN), (const bf16*)(F.ws + WS_WQKV) + (size_t)l * NQKV * 1024, NQKV, 1024, pg8::EpiStore{(bf16*)(F.ws + WS_QKV), NQKV}); }
        GSYNC(2);
#if PROBE_DUP == 1
        { Frame F; make_frame(F, ka, lds, wv); run_gemm(F, (const bf16*)(F.ws + WS_XN), (const bf16*)(F.ws + WS_WQKV) + (size_t)l * NQKV * 1024, NQKV, 1024, pg8::EpiStore{(bf16*)(F.ws + WS_QKV), NQKV}); }
        GSYNC(2);
#endif
#ifdef ATTN_NAIVE
        { Frame F; make_frame(F, ka, lds, wv); phase_attn_naive(F); }
        GSYNC(3);
#else
        { Frame F; make_frame(F, ka, lds, wv); phase_attn_mfma(F); }
        GSYNC(3);
        { Frame F; make_frame(F, ka, lds, wv); phase_attn_merge(F); }
        GSYNC(4);
#if PROBE_DUP == 2
        { Frame F; make_frame(F, ka, lds, wv); run_gemm(F, (const bf16*)(F.ws + WS_XN), (const bf16*)(F.ws + WS_WQKV) + (size_t)l * NQKV * 1024, NQKV, 1024, pg8::EpiStore{(bf16*)(F.ws + WS_QKV), NQKV}); }
        GSYNC(2);
        { Frame F; make_frame(F, ka, lds, wv); phase_attn_mfma(F); }
        GSYNC(3);
        { Frame F; make_frame(F, ka, lds, wv); phase_attn_merge(F); }
        GSYNC(4);
#endif
#endif
        { Frame F; make_frame(F, ka, lds, wv); run_gemm(F, (const bf16*)(F.ws + WS_XN), (const bf16*)(F.ws + WS_WA) + (size_t)l * NA * 1024, NA, 1024, pg8::EpiStore{(bf16*)(F.ws + WS_PA), NA}); }
        GSYNC(2);
#ifdef RWKV_NAIVE
        { Frame F; make_frame(F, ka, lds, wv); phase_rwkv_naive(F, l); }
        GSYNC(5);
#else
        { Frame F; make_frame(F, ka, lds, wv); rwkv_pass<1>(F, l); }
        GSYNC(5);
#if PROBE_DUP == 3
        { Frame F; make_frame(F, ka, lds, wv); rwkv_pass<1>(F, l); }
        GSYNC(5);
#endif
        { Frame F; make_frame(F, ka, lds, wv); rwkv_pass2(F); }
        GSYNC(6);
#if PROBE_DUP == 6
        { Frame F; make_frame(F, ka, lds, wv); rwkv_pass2(F); }
        GSYNC(6);
#endif
        { Frame F; make_frame(F, ka, lds, wv); rwkv_pass<3>(F, l); }
        GSYNC(7);
#if PROBE_DUP == 4
        { Frame F; make_frame(F, ka, lds, wv); rwkv_pass<3>(F, l); }
        GSYNC(7);
#endif
#if PROBE_DUP == 5
        for (int q_ = 0; q_ < 10; ++q_) grid.sync();
#endif
#endif
        { Frame F; make_frame(F, ka, lds, wv); run_gemm(F, (const bf16*)(F.ws + WS_XN), (const bf16*)(F.ws + WS_WG) + (size_t)l * NG * 1024, NG, 1024, pg8::EpiGates{(bf16*)(F.ws + WS_YA), (bf16*)(F.ws + WS_YB), (bf16*)(F.ws + WS_MG)}); }
        GSYNC(2);
        { Frame F; make_frame(F, ka, lds, wv); run_gemm(F, (const bf16*)(F.ws + WS_YA), (const bf16*)(F.ws + WS_WBA) + (size_t)l * 1024 * 1024, 1024, 1024, pg8::EpiMerge<false>{(bf16*)(F.ws + WS_MERGED), (const bf16*)(F.ws + WS_MG)}); }
        { Frame F; make_frame(F, ka, lds, wv); run_gemm(F, (const bf16*)(F.ws + WS_YB), (const bf16*)(F.ws + WS_WBB) + (size_t)l * 1024 * 512, 1024, 512, pg8::EpiMerge<true>{(bf16*)(F.ws + WS_MERGED), (const bf16*)(F.ws + WS_MG)}); }
        GSYNC(2);
        { Frame F; make_frame(F, ka, lds, wv); run_gemm(F, (const bf16*)(F.ws + WS_MERGED), (const bf16*)(F.ws + WS_WO) + (size_t)l * 1024 * 1024, 1024, 1024,
              pg8::EpiResid{(l == 0) ? F.in[0] : F.out, F.out, (const float*)(F.ws + WS_MOD) + (size_t)l * 2 * 3072 + 2048}); }
        GSYNC(2);
    }
    { Frame F; make_frame(F, ka, lds, wv); phase_final(F); }
#ifdef TPROBE
    if (blockIdx.x == 0 && (cur_tid(wv)) == 0) { STAMP(8); const unsigned long long* ts_ = (const unsigned long long*)(ka->ws + WS_CTL + 4096); ka->out[0] = (float)ts_[1 + TPROBE] * 0.01f; }
#endif
}
extern "C" void kernel_launch(void* const* d_in, const int* in_sizes, int n_in, void* d_out, int out_size, void* d_ws, size_t ws_size, hipStream_t stream) {
    static int grid = 0;
    if (grid == 0) {
        int dev = 0, cus = 0, per_cu = 0;
        (void)hipGetDevice(&dev); (void)hipDeviceGetAttribute(&cus, hipDeviceAttributeMultiprocessorCount, dev);
        (void)hipFuncSetAttribute((const void*)fwd_kernel, hipFuncAttributeMaxDynamicSharedMemorySize, LDS_BYTES);
        (void)hipOccupancyMaxActiveBlocksPerMultiprocessor(&per_cu, (const void*)fwd_kernel, NTHREADS, LDS_BYTES);
        if (n_in != 28 || out_size != MROWS * DM || ws_size < (size_t)352 * MiB || per_cu < 1) { fprintf(stderr, "kernel_launch: unexpected problem (n_in %d out %d ws %zu per_cu %d)\n", n_in, out_size, ws_size, per_cu); }
        grid = cus;
        (void)hipGetLastError();
    }
    (void)hipMemsetAsync((char*)d_ws + WS_CTL, 0, 1 * MiB, stream);
    Args a{};
    for (int i = 0; i < 28; ++i) a.in[i] = (const float*)d_in[i];
    a.out = (float*)d_out; a.ws = (unsigned char*)d_ws;
    void* args[] = {&a};
    hipError_t e = hipLaunchCooperativeKernel((void*)fwd_kernel, dim3(grid), dim3(NTHREADS), args, LDS_BYTES, stream);
    if (e != hipSuccess) fprintf(stderr, "cooperative launch failed: %s (grid %d)\n", hipGetErrorString(e), grid);
}
```

```cpp
#include <hip/hip_runtime.h>
#include <hip/hip_cooperative_groups.h>
#include <cstdio>
#include <cstdint>
namespace cg = cooperative_groups;
namespace pg8 {
#define PG8_LAS __attribute__((address_space(3)))
typedef unsigned short bf16_t;
typedef short bf16x8 __attribute__((ext_vector_type(8)));
typedef float f32x4 __attribute__((ext_vector_type(4)));
typedef unsigned u32x4 __attribute__((ext_vector_type(4)));
constexpr int BM = 256, BK = 64, HALF = 128, HTB = HALF * BK * 2  , STAGE_BYTES = 8 * HTB, NXCD = 8, WGM = 8;

__host__ __device__ __forceinline__ int lds_byte(int r, int c) { const int st = (r >> 4) * 2 + (c >> 5), rr = r & 15, cc = c & 31, ob = rr * 64 + cc * 2; return st * 1024 + (ob ^ (((ob >> 9) & 1) << 5)); }
__host__ __device__ __forceinline__ void stage_rc(int b, int& R, int& C) { const int st = b / 1024, sb = b % 1024, swz = sb ^ (((sb >> 9) & 1) << 5); R = (st >> 1) * 16 + swz / 64; C = (st & 1) * 32 + (swz % 64) / 2; }
__host__ __device__ __forceinline__ int perm32(int rho) { const int n = rho >> 4, i = rho & 15; return 8 * (i >> 2) + 4 * n + (i & 3); }

struct Unit { int pm, pn; };
struct Gemm { const bf16_t* A; const bf16_t* Bt; int M, N, K; };

struct StaticOrder {
    int nM, nN, nwg, G, c;
    __host__ __device__ void init(int M, int N, int G_, int c_) { nM = M / BM; nN = N / BM; nwg = nM * nN; G = G_; c = c_; }
    __host__ __device__ bool next(int i, Unit& u) const {
        const long L = (long)i * G + c; if (L >= nwg) return false;
        int wgid = (int)L; { const int q = nwg / NXCD, r = nwg % NXCD, xcd = wgid % NXCD, off = wgid / NXCD; wgid = (xcd < r ? xcd * (q + 1) : r * (q + 1) + (xcd - r) * q) + off; }
        const int nig = WGM * nN, gid = wgid / nig, fm = gid * WGM, gsz = (nM - fm) < WGM ? (nM - fm) : WGM;
        u.pm = fm + ((wgid % nig) % gsz); u.pn = (wgid % nig) / gsz; return true;
    }
    __device__ __forceinline__ void a_ready(const Unit&) const {}
    __device__ __forceinline__ void done(const Unit&) const {}
};

typedef float f32x2c_t __attribute__((ext_vector_type(2))); typedef __bf16 bf16x2c_t __attribute__((ext_vector_type(2)));
__device__ __forceinline__ unsigned cvt_pk_bf16(float lo, float hi) { const f32x2c_t v = {lo, hi}; const bf16x2c_t b = __builtin_convertvector(v, bf16x2c_t); return __builtin_bit_cast(unsigned, b); }
typedef float f32x2 __attribute__((ext_vector_type(2)));
template <class Epi, class Sched, bool ALIGN_EPI = false, bool SP2 = false>
__device__ __forceinline__ void gemm_phase(PG8_LAS unsigned char* lds, const Gemm g, const Sched& S, const Epi& E, int tid_in) {
    int tid_ = tid_in; asm volatile("" : "+v"(tid_));
    const int tid = tid_, wid = __builtin_amdgcn_readfirstlane(tid >> 6), lane = tid & 63, wr = wid >> 2, wc = wid & 3, fr = lane & 15, fq = lane >> 4;
    const int K = g.K, nt = K / BK;
    unsigned voffA[2], voffB[2];
#pragma unroll
    for (int i = 0; i < 2; ++i) { int R, C; stage_rc(tid * 16 + i * 8192, R, C); const int Rb = Epi::PERM ? ((R & ~31) + perm32(R & 31)) : R;
        voffA[i] = (unsigned)(R * K + C) * 2u; voffB[i] = (unsigned)(Rb * K + C) * 2u; }
    const size_t kstep = (size_t)(BK * 2);
    const size_t hstep = (size_t)HALF * K * 2;
    const size_t tstep = 2 * hstep;
    const unsigned ldsw = (unsigned)wid * 1024u;
    const int aoff = lds_byte(wr * 64 + fr, fq * 8), boff = lds_byte(wc * 32 + fr, fq * 8);
#define PG8_SA(b, h) (((b) * 2 + (h)) * HTB)
#define PG8_SB(b, h) ((4 + (b) * 2 + (h)) * HTB)
#define PG8_STAGE(bufoff, gbase, voff) do { _Pragma("unroll") for (int _i = 0; _i < 2; ++_i) \
        __builtin_amdgcn_global_load_lds((const unsigned*)((const char*)(gbase) + (voff)[_i]), (PG8_LAS unsigned*)(lds + (bufoff) + ldsw + _i * 8192), 16, 0, 0); } while (0)
#define PG8_LDA(dst, b, h) do { _Pragma("unroll") for (int m = 0; m < 4; ++m) _Pragma("unroll") for (int k = 0; k < 2; ++k) dst[m][k] = *(const PG8_LAS bf16x8*)(lds + PG8_SA(b, h) + aoff + m * 2048 + k * 1024); } while (0)
#define PG8_LDB(dst, b, h) do { _Pragma("unroll") for (int n = 0; n < 2; ++n) _Pragma("unroll") for (int k = 0; k < 2; ++k) dst[n][k] = *(const PG8_LAS bf16x8*)(lds + PG8_SB(b, h) + boff + n * 2048 + k * 1024); } while (0)
#define PG8_MMA(ai, bj, At, Bt) do { __builtin_amdgcn_s_setprio(1); _Pragma("unroll") for (int m = 0; m < 4; ++m) _Pragma("unroll") for (int n = 0; n < 2; ++n) _Pragma("unroll") for (int k = 0; k < 2; ++k) \
        acc[ai][bj][m][n] = __builtin_amdgcn_mfma_f32_16x16x32_bf16(Bt[n][k], At[m][k], acc[ai][bj][m][n], 0, 0, 0); __builtin_amdgcn_s_setprio(0); } while (0)
#define PG8_WAIT_V(n) asm volatile("s_waitcnt vmcnt(" #n ")" ::: "memory")
#define PG8_WAIT_L(n) asm volatile("s_waitcnt lgkmcnt(" #n ")" ::: "memory")
#define PG8_BAR __builtin_amdgcn_s_barrier()
#define PG8_SCHED __builtin_amdgcn_sched_barrier(0)
    Unit cur, nxt; int ui = 0;
    if (!S.next(0, cur)) return;
    f32x4 acc[2][2][4][2];
#pragma unroll
    for (int a = 0; a < 2; ++a)
#pragma unroll
        for (int b = 0; b < 2; ++b)
#pragma unroll
            for (int m = 0; m < 4; ++m)
#pragma unroll
                for (int n = 0; n < 2; ++n) acc[a][b][m][n] = (f32x4){0.f, 0.f, 0.f, 0.f};
    bf16x8 At[4][2], B0[2][2], B1[2][2];
    const char* cA = (const char*)g.A + (size_t)cur.pm * tstep; const char* cB = (const char*)g.Bt + (size_t)cur.pn * tstep;
    S.a_ready(cur);
    if constexpr (SP2) {
        PG8_STAGE(PG8_SB(0, 0), cB, voffB); PG8_STAGE(PG8_SB(0, 1), cB + hstep, voffB); PG8_STAGE(PG8_SA(0, 0), cA, voffA); PG8_STAGE(PG8_SA(0, 1), cA + hstep, voffA);
        if (wr == 1) PG8_BAR;
        PG8_WAIT_V(2); PG8_BAR;
        PG8_STAGE(PG8_SB(1, 0), cB + kstep, voffB); PG8_STAGE(PG8_SA(1, 0), cA + kstep, voffA); PG8_STAGE(PG8_SB(1, 1), cB + hstep + kstep, voffB);
        PG8_WAIT_V(6); PG8_BAR;
    } else {
        PG8_STAGE(PG8_SB(0, 0), cB, voffB); PG8_STAGE(PG8_SA(0, 0), cA, voffA); PG8_STAGE(PG8_SB(0, 1), cB + hstep, voffB); PG8_STAGE(PG8_SA(0, 1), cA + hstep, voffA);
        if (wr == 1) PG8_BAR;
        PG8_WAIT_V(4); PG8_BAR;
        PG8_STAGE(PG8_SB(1, 0), cB + kstep, voffB); PG8_STAGE(PG8_SA(1, 0), cA + kstep, voffA); PG8_STAGE(PG8_SB(1, 1), cB + hstep + kstep, voffB);
        PG8_WAIT_V(6); PG8_BAR;
    }
    for (;;) {
        const bool has_next = S.next(ui + 1, nxt);
        const char* nA = has_next ? (const char*)g.A + (size_t)nxt.pm * tstep : cA; const char* nB = has_next ? (const char*)g.Bt + (size_t)nxt.pn * tstep : cB;
        for (int t = 0; t < nt; t += 2) {
            const bool last = (t == nt - 2);
            const char* a1 = cA + (size_t)(t + 1) * kstep;
            const char* a2 = last ? nA : cA + (size_t)(t + 2) * kstep; const char* b2 = last ? nB : cB + (size_t)(t + 2) * kstep;
            const char* a3 = a2 + kstep; const char* b3 = b2 + kstep;
            if (last && has_next) S.a_ready(nxt);
            if constexpr (SP2) {
            PG8_LDB(B0, 0, 0); PG8_LDB(B1, 0, 1); PG8_SCHED; PG8_LDA(At, 0, 0); PG8_STAGE(PG8_SA(1, 1), a1 + hstep, voffA);
            PG8_WAIT_V(8); PG8_WAIT_L(0); PG8_BAR; PG8_MMA(0, 0, At, B0); PG8_MMA(0, 1, At, B1); PG8_BAR; PG8_SCHED;
            PG8_LDA(At, 0, 1); PG8_STAGE(PG8_SB(0, 0), b2, voffB); PG8_STAGE(PG8_SB(0, 1), b2 + hstep, voffB); PG8_STAGE(PG8_SA(0, 0), a2, voffA);
            PG8_WAIT_V(8); PG8_WAIT_L(0); PG8_BAR; PG8_MMA(1, 0, At, B0); PG8_MMA(1, 1, At, B1); PG8_BAR; PG8_SCHED;
            PG8_LDB(B0, 1, 0); PG8_LDB(B1, 1, 1); PG8_SCHED; PG8_LDA(At, 1, 0); PG8_STAGE(PG8_SA(0, 1), a2 + hstep, voffA);
            PG8_WAIT_V(8); PG8_WAIT_L(0); PG8_BAR; PG8_MMA(0, 0, At, B0); PG8_MMA(0, 1, At, B1); PG8_BAR; PG8_SCHED;
            PG8_LDA(At, 1, 1); PG8_STAGE(PG8_SB(1, 0), b3, voffB); PG8_STAGE(PG8_SB(1, 1), b3 + hstep, voffB); PG8_STAGE(PG8_SA(1, 0), a3, voffA);
            PG8_WAIT_V(8); PG8_WAIT_L(0); PG8_BAR; PG8_MMA(1, 0, At, B0); PG8_MMA(1, 1, At, B1); PG8_BAR; PG8_SCHED;
            } else {
            PG8_LDB(B0, 0, 0); PG8_SCHED; PG8_LDA(At, 0, 0); PG8_STAGE(PG8_SA(1, 1), a1 + hstep, voffA);
            PG8_WAIT_L(8); PG8_BAR; PG8_WAIT_L(0); PG8_MMA(0, 0, At, B0); PG8_BAR; PG8_SCHED;
            PG8_LDB(B1, 0, 1); PG8_STAGE(PG8_SB(0, 0), b2, voffB);
            PG8_BAR; PG8_WAIT_L(0); PG8_MMA(0, 1, At, B1); PG8_BAR;
            PG8_LDA(At, 0, 1); PG8_STAGE(PG8_SA(0, 0), a2, voffA);
            PG8_BAR; PG8_WAIT_L(0); PG8_MMA(1, 0, At, B0); PG8_BAR; PG8_SCHED;
            PG8_STAGE(PG8_SB(0, 1), b2 + hstep, voffB);
            PG8_WAIT_V(6); PG8_BAR; PG8_MMA(1, 1, At, B1); PG8_BAR;
            PG8_LDB(B0, 1, 0); PG8_SCHED; PG8_LDA(At, 1, 0); PG8_STAGE(PG8_SA(0, 1), a2 + hstep, voffA);
            PG8_WAIT_L(8); PG8_BAR; PG8_WAIT_L(0); PG8_MMA(0, 0, At, B0); PG8_BAR; PG8_SCHED;
            PG8_LDB(B1, 1, 1); PG8_STAGE(PG8_SB(1, 0), b3, voffB);
            PG8_BAR; PG8_WAIT_L(0); PG8_MMA(0, 1, At, B1); PG8_BAR;
            PG8_LDA(At, 1, 1); PG8_STAGE(PG8_SA(1, 0), a3, voffA);
            PG8_BAR; PG8_WAIT_L(0); PG8_MMA(1, 0, At, B0); PG8_BAR; PG8_SCHED;
            PG8_STAGE(PG8_SB(1, 1), b3 + hstep, voffB);
            PG8_WAIT_V(6); PG8_BAR; PG8_MMA(1, 1, At, B1); PG8_BAR;
            }
        }
        if constexpr (ALIGN_EPI) { if (wr == 0) PG8_BAR; }
        if constexpr (!Epi::AFTER_DRAIN) { E(acc, cur, wr, wc, fr, fq); S.done(cur); }
        if (!has_next) break;
#pragma unroll
        for (int a = 0; a < 2; ++a)
#pragma unroll
            for (int b = 0; b < 2; ++b)
#pragma unroll
                for (int m = 0; m < 4; ++m)
#pragma unroll
                    for (int n = 0; n < 2; ++n) acc[a][b][m][n] = (f32x4){0.f, 0.f, 0.f, 0.f};
        cur = nxt; cA = nA; cB = nB; ++ui;
        if constexpr (ALIGN_EPI) { if (wr == 1) PG8_BAR; }
    }
    PG8_WAIT_V(0);
    if constexpr (!ALIGN_EPI) { if (wr == 0) PG8_BAR; }
    PG8_BAR;
    if constexpr (Epi::AFTER_DRAIN) { E.fused(acc, cur, wr, wc, fr, fq, lds, wid, lane); S.done(cur); }
#undef PG8_SA
#undef PG8_SB
#undef PG8_STAGE
#undef PG8_LDA
#undef PG8_LDB
#undef PG8_MMA
#undef PG8_WAIT_V
#undef PG8_WAIT_L
#undef PG8_BAR
#undef PG8_SCHED
}
}
namespace pg8 {
__device__ __forceinline__ float ep_bflo(unsigned w) { return __uint_as_float(w << 16); }
__device__ __forceinline__ float ep_bfhi(unsigned w) { return __uint_as_float(w & 0xffff0000u); }
__device__ __forceinline__ float ep_sigmoid(float x) { return 1.f / (1.f + __expf(-x)); }
struct EpiStore {
    static constexpr bool PERM = true, AFTER_DRAIN = false;
    bf16_t* O; int ldc;
    __device__ __forceinline__ void operator()(const f32x4 (&acc)[2][2][4][2], const Unit& u, int wr, int wc, int fr, int fq) const {
        const int row0 = u.pm * BM + wr * 64 + fr, col0 = u.pn * BM + wc * 32 + 8 * fq;
#pragma unroll
        for (int ai = 0; ai < 2; ++ai)
#pragma unroll
            for (int m = 0; m < 4; ++m) { bf16_t* rowp = O + (size_t)(row0 + ai * HALF + m * 16) * ldc + col0;
#pragma unroll
                for (int bj = 0; bj < 2; ++bj) { const f32x4 v0 = acc[ai][bj][m][0], v1 = acc[ai][bj][m][1]; u32x4 w;
                    w.x = cvt_pk_bf16(v0[0], v0[1]); w.y = cvt_pk_bf16(v0[2], v0[3]); w.z = cvt_pk_bf16(v1[0], v1[1]); w.w = cvt_pk_bf16(v1[2], v1[3]);
                    *(u32x4*)(rowp + bj * HALF) = w; } }
    }
};
struct EpiD {
    static constexpr bool PERM = true, AFTER_DRAIN = false;
    bf16_t* PA; bf16_t* GA; bf16_t* YB;
    __device__ __forceinline__ void operator()(const f32x4 (&acc)[2][2][4][2], const Unit& u, int wr, int wc, int fr, int fq) const {
        const int colt = u.pn * BM; int mode, ld, cb; bf16_t* P;
        if (colt < 3584) { mode = 0; P = PA; ld = 3584; cb = colt; } else if (colt < 4608) { mode = 1; P = GA; ld = 1024; cb = colt - 3584; } else { mode = 2; P = YB; ld = 512; cb = colt - 4608; }
        const int row0 = u.pm * BM + wr * 64 + fr, col0 = cb + wc * 32 + 8 * fq;
#pragma unroll
        for (int ai = 0; ai < 2; ++ai)
#pragma unroll
            for (int m = 0; m < 4; ++m) { bf16_t* rowp = P + (size_t)(row0 + ai * HALF + m * 16) * ld + col0;
#pragma unroll
                for (int bj = 0; bj < 2; ++bj) { const f32x4 v0 = acc[ai][bj][m][0], v1 = acc[ai][bj][m][1]; float g[8] = {v0[0], v0[1], v0[2], v0[3], v1[0], v1[1], v1[2], v1[3]};
                    if (mode == 1) {
#pragma unroll
                        for (int e = 0; e < 8; ++e) g[e] = g[e] * ep_sigmoid(g[e]);
                    } else if (mode == 2) {
                        const u32x4 y = *(const u32x4*)(rowp + bj * HALF);
                        const float yv[8] = {ep_bflo(y.x), ep_bfhi(y.x), ep_bflo(y.y), ep_bfhi(y.y), ep_bflo(y.z), ep_bfhi(y.z), ep_bflo(y.w), ep_bfhi(y.w)};
#pragma unroll
                        for (int e = 0; e < 8; ++e) g[e] = yv[e] * g[e] * ep_sigmoid(g[e]);
                    }
                    u32x4 w; w.x = cvt_pk_bf16(g[0], g[1]); w.y = cvt_pk_bf16(g[2], g[3]); w.z = cvt_pk_bf16(g[4], g[5]); w.w = cvt_pk_bf16(g[6], g[7]);
                    *(u32x4*)(rowp + bj * HALF) = w; } }
    }
};
struct EpiSig {
    static constexpr bool PERM = true, AFTER_DRAIN = false;
    bf16_t* MG; int coff;
    __device__ __forceinline__ void operator()(const f32x4 (&acc)[2][2][4][2], const Unit& u, int wr, int wc, int fr, int fq) const {
        const int row0 = u.pm * BM + wr * 64 + fr, col0 = coff + u.pn * BM + wc * 32 + 8 * fq;
#pragma unroll
        for (int ai = 0; ai < 2; ++ai)
#pragma unroll
            for (int m = 0; m < 4; ++m) { bf16_t* rowp = MG + (size_t)(row0 + ai * HALF + m * 16) * 2048 + col0;
#pragma unroll
                for (int bj = 0; bj < 2; ++bj) { const f32x4 v0 = acc[ai][bj][m][0], v1 = acc[ai][bj][m][1]; u32x4 w;
                    w.x = cvt_pk_bf16(ep_sigmoid(v0[0]), ep_sigmoid(v0[1])); w.y = cvt_pk_bf16(ep_sigmoid(v0[2]), ep_sigmoid(v0[3])); w.z = cvt_pk_bf16(ep_sigmoid(v1[0]), ep_sigmoid(v1[1])); w.w = cvt_pk_bf16(ep_sigmoid(v1[2]), ep_sigmoid(v1[3]));
                    *(u32x4*)(rowp + bj * HALF) = w; } }
    }
};
template <bool SECOND> struct EpiMerge {
    static constexpr bool PERM = true, AFTER_DRAIN = false;
    bf16_t* MERGED; const bf16_t* MG;
    __device__ __forceinline__ void operator()(const f32x4 (&acc)[2][2][4][2], const Unit& u, int wr, int wc, int fr, int fq) const {
        const int row0 = u.pm * BM + wr * 64 + fr, col0 = u.pn * BM + wc * 32 + 8 * fq;
#pragma unroll
        for (int ai = 0; ai < 2; ++ai)
#pragma unroll
            for (int m = 0; m < 4; ++m) { const size_t r = (size_t)(row0 + ai * HALF + m * 16);
#pragma unroll
                for (int bj = 0; bj < 2; ++bj) { const f32x4 v0 = acc[ai][bj][m][0], v1 = acc[ai][bj][m][1]; float g[8] = {v0[0], v0[1], v0[2], v0[3], v1[0], v1[1], v1[2], v1[3]};
                    const int c = col0 + bj * HALF;
                    const u32x4 s = *(const u32x4*)(MG + r * 2048 + (SECOND ? 1024 : 0) + c);
                    const float sv[8] = {ep_bflo(s.x), ep_bfhi(s.x), ep_bflo(s.y), ep_bfhi(s.y), ep_bflo(s.z), ep_bfhi(s.z), ep_bflo(s.w), ep_bfhi(s.w)};
                    bf16_t* dst = MERGED + r * 1024 + c;
                    if (SECOND) { const u32x4 p = *(const u32x4*)dst;
                        const float pv[8] = {ep_bflo(p.x), ep_bfhi(p.x), ep_bflo(p.y), ep_bfhi(p.y), ep_bflo(p.z), ep_bfhi(p.z), ep_bflo(p.w), ep_bfhi(p.w)};
#pragma unroll
                        for (int e = 0; e < 8; ++e) g[e] = pv[e] + sv[e] * g[e];
                    } else {
#pragma unroll
                        for (int e = 0; e < 8; ++e) g[e] = sv[e] * g[e];
                    }
                    u32x4 w; w.x = cvt_pk_bf16(g[0], g[1]); w.y = cvt_pk_bf16(g[2], g[3]); w.z = cvt_pk_bf16(g[4], g[5]); w.w = cvt_pk_bf16(g[6], g[7]);
                    *(u32x4*)dst = w; } }
    }
};
struct EpiResid {
    static constexpr bool PERM = false, AFTER_DRAIN = false;
    const float* xin; float* xout; const float* gate;
    __device__ __forceinline__ void operator()(const f32x4 (&acc)[2][2][4][2], const Unit& u, int wr, int wc, int fr, int fq) const {
        const int b = (u.pm * BM) / 8192; const float* gp = gate + b * 3072;
        const int row0 = u.pm * BM + wr * 64 + fr, col0 = u.pn * BM + wc * 32 + 4 * fq;
#pragma unroll
        for (int bj = 0; bj < 2; ++bj)
#pragma unroll
            for (int n = 0; n < 2; ++n) { const int c = col0 + bj * HALF + n * 16; const f32x4 gv = *(const f32x4*)(gp + c);
#pragma unroll
                for (int ai = 0; ai < 2; ++ai)
#pragma unroll
                    for (int m = 0; m < 4; ++m) { const size_t off = (size_t)(row0 + ai * HALF + m * 16) * 1024 + c;
                        const f32x4 xi = *(const f32x4*)(xin + off); *(f32x4*)(xout + off) = xi + gv * acc[ai][bj][m][n]; } }
    }
};
}
constexpr int BATCH = 2, SEQ = 8192, DM = 1024, MROWS = BATCH * SEQ, PROJW = 11264;
constexpr int NQKV = 4608, NA = 3584, NAG = 5120, NLORA = 320;
constexpr size_t MiB = 1u << 20;
constexpr size_t WS_CTL = 0, WS_MOD = 1 * MiB;
constexpr size_t WS_WQKV = 2 * MiB, WS_WA = 20 * MiB, WS_WM = 40 * MiB, WS_WBA = 48 * MiB, WS_WBB = 52 * MiB, WS_WO = 54 * MiB;
constexpr size_t WS_VFIRST = 58 * MiB, WS_XN = 90 * MiB, WS_YB = 122 * MiB;
constexpr size_t WS_QKV = 138 * MiB, WS_PA = 138 * MiB, WS_YA = 250 * MiB, WS_MG = 138 * MiB, WS_MERGED = 202 * MiB, WS_SC = 282 * MiB, WS_GA = 314 * MiB;
constexpr int LDS_BYTES = 147456;
constexpr int NTHREADS = 512, NWAVES = 8;
#define LAS __attribute__((address_space(3)))
typedef unsigned short bf16;
typedef float f32x4 __attribute__((ext_vector_type(4)));
typedef unsigned u32x4 __attribute__((ext_vector_type(4)));
typedef unsigned u32x2 __attribute__((ext_vector_type(2)));

__device__ const unsigned char T5BUCKET[3][132] = {
 {0,1,2,3,4,5,6,7,8,9,10,11,12,13,14,15,16,16,16,16,16,16,17,17,17,17,17,17,17,17,18,18,18,18,18,18,18,18,18,18,19,19,19,19,19,19,19,19,19,19,19,19,19,19,20,20,20,20,20,20,20,20,20,20,20,20,20,20,20,20,20,20,20,21,21,21,21,21,21,21,21,21,21,21,21,21,21,21,21,21,21,21,21,21,21,21,21,21,21,22,22,22,22,22,22,22,22,22,22,22,22,22,22,22,22,22,22,22,22,22,22,22,22,22,22,22,22,22,22,0,0,0},
 {0,4,8,12,16,16,17,17,18,18,19,19,19,19,20,20,20,20,20,21,21,21,21,21,21,22,22,22,22,22,22,22,22,22,23,23,23,23,23,23,23,23,23,23,23,23,24,24,24,24,24,24,24,24,24,24,24,24,24,24,24,24,25,25,25,25,25,25,25,25,25,25,25,25,25,25,25,25,25,25,25,25,25,26,26,26,26,26,26,26,26,26,26,26,26,26,26,26,26,26,26,26,26,26,26,26,26,26,26,26,26,26,26,27,27,27,27,27,27,27,27,27,27,27,27,27,27,27,27,0,0,0},
 {0,16,18,19,20,21,21,22,22,23,23,23,24,24,24,24,25,25,25,25,25,26,26,26,26,26,26,26,26,27,27,27,27,27,27,27,27,27,27,28,28,28,28,28,28,28,28,28,28,28,28,28,29,29,29,29,29,29,29,29,29,29,29,29,29,29,29,29,29,29,30,30,30,30,30,30,30,30,30,30,30,30,30,30,30,30,30,30,30,30,30,30,30,30,30,31,31,31,31,31,31,31,31,31,31,31,31,31,31,31,31,31,31,31,31,31,31,31,31,31,31,31,31,31,31,31,31,31,31,0,0,0}};

__device__ __forceinline__ unsigned f2bf(float f) { unsigned u = __builtin_bit_cast(unsigned, f); return (u + 0x7fffu + ((u >> 16) & 1u)) >> 16; }
__device__ __forceinline__ unsigned pk2(float lo, float hi) { return pg8::cvt_pk_bf16(lo, hi); }
__device__ __forceinline__ float bflo(unsigned w) { return __uint_as_float(w << 16); }
__device__ __forceinline__ float bfhi(unsigned w) { return __uint_as_float(w & 0xffff0000u); }
__device__ __forceinline__ float bf2f(bf16 h) { return __uint_as_float(((unsigned)h) << 16); }
template <int CTRL, int RMASK> __device__ __forceinline__ float dpp_f(float v) { return __int_as_float(__builtin_amdgcn_update_dpp(0, __float_as_int(v), CTRL, RMASK, 0xF, false)); }
template <int CTRL, int RMASK> __device__ __forceinline__ float dpp_keep(float v) { return __int_as_float(__builtin_amdgcn_update_dpp(__float_as_int(v), __float_as_int(v), CTRL, RMASK, 0xF, false)); }
__device__ __forceinline__ float wave_sum_dpp(float v) {
    v += dpp_f<0xB1, 0xF>(v); v += dpp_f<0x4E, 0xF>(v); v += dpp_f<0x141, 0xF>(v); v += dpp_f<0x140, 0xF>(v);
    v += dpp_f<0x142, 0xA>(v); v += dpp_f<0x143, 0xC>(v);
    return __int_as_float(__builtin_amdgcn_readlane(__float_as_int(v), 63));
}
__device__ __forceinline__ float wave_max_dpp(float v) {
    v = fmaxf(v, dpp_keep<0xB1, 0xF>(v)); v = fmaxf(v, dpp_keep<0x4E, 0xF>(v)); v = fmaxf(v, dpp_keep<0x141, 0xF>(v)); v = fmaxf(v, dpp_keep<0x140, 0xF>(v));
    v = fmaxf(v, dpp_keep<0x142, 0xA>(v)); v = fmaxf(v, dpp_keep<0x143, 0xC>(v));
    return __int_as_float(__builtin_amdgcn_readlane(__float_as_int(v), 63));
}
__device__ __forceinline__ float wave_sum(float v) { return wave_sum_dpp(v); }
__device__ __forceinline__ float wave_max(float v) { return wave_max_dpp(v); }
__device__ __forceinline__ float bperm_f(int src_lane, float v) { return __int_as_float(__builtin_amdgcn_ds_bpermute(src_lane << 2, __float_as_int(v))); }
__device__ __forceinline__ float sigmoidf_(float x) { return 1.f / (1.f + __expf(-x)); }
__device__ __forceinline__ float siluf_(float x) { return x / (1.f + __expf(-x)); }

struct Args { const float* in[28]; float* out; unsigned char* ws; };
typedef const __attribute__((address_space(4))) Args* KArgs;
struct Frame {
    LAS unsigned char* lds;
    int tid, lane, wave, G, bid;
    const float* in[28]; float* out; unsigned char* ws;
};
__device__ __forceinline__ int lane_id_() { return (int)__builtin_amdgcn_mbcnt_hi(~0u, __builtin_amdgcn_mbcnt_lo(~0u, 0u)); }
__device__ __forceinline__ int cur_tid(int wv) { int w2 = wv; asm volatile("" : "+s"(w2)); unsigned z = 0u; asm volatile("" : "+v"(z)); return w2 * 64 + (int)__builtin_amdgcn_mbcnt_hi(~0u, __builtin_amdgcn_mbcnt_lo(~0u, z)); }
__device__ __forceinline__ void make_frame(Frame& F, KArgs ka, unsigned char* lds, int wv) {
    asm volatile("" : "+s"(ka));
    int t = cur_tid(wv);
    F.lds = (LAS unsigned char*)lds; F.tid = t; F.lane = t & 63; F.wave = __builtin_amdgcn_readfirstlane(t >> 6); F.G = gridDim.x; F.bid = blockIdx.x;
    const __attribute__((address_space(4))) unsigned long long* kr = (const __attribute__((address_space(4))) unsigned long long*)ka;
#pragma unroll
    for (int i = 0; i < 28; ++i) F.in[i] = (const float*)(const __attribute__((address_space(1))) float*)kr[i];
    F.out = (float*)(__attribute__((address_space(1))) float*)kr[28]; F.ws = (unsigned char*)(__attribute__((address_space(1))) unsigned char*)kr[29];
}
#define XB_TMO      128
#define XB_XCNT(j)  (256  + 64 * (j))
#define XB_XSUB(j)  (1280 + 64 * (j))
#define XB_XGEN(j)  (2304 + 64 * (j))
#define XB_TOP      3328
#define XB_TOPGEN   3392
#define XCD_BAR_WORDS 3456
#define XB_SPIN_CAP (1u << 18)

__device__ __forceinline__ unsigned xb_ld(unsigned* p)              { return __hip_atomic_load(p, __ATOMIC_RELAXED, __HIP_MEMORY_SCOPE_AGENT); }
__device__ __forceinline__ unsigned xb_add(unsigned* p, unsigned v) { return __hip_atomic_fetch_add(p, v, __ATOMIC_RELAXED, __HIP_MEMORY_SCOPE_AGENT); }
__device__ __forceinline__ unsigned xb_xcc_id() { return (unsigned)__builtin_amdgcn_s_getreg((3 << 11) | 20) & 0xFu; }
#define XB_SPIN(cond, bar) do { unsigned _sp = 0; while (cond) { __builtin_amdgcn_s_sleep(1); \
    if ((++_sp & 255u) == 0u) { if (xb_ld(&(bar)[XB_TMO])) break; if (_sp > XB_SPIN_CAP) { atomicAdd(&(bar)[XB_TMO], 1u); break; } } } } while (0)

struct XcdBarrier {
    unsigned* bar; unsigned x;
    volatile LAS unsigned* st;
};

__device__ __forceinline__ XcdBarrier xcd_barrier_post(unsigned* bar, volatile LAS unsigned* st, int tid) {
    XcdBarrier b; b.bar = bar; b.x = xb_xcc_id(); b.st = st;
    if (tid == 0) (void)xb_add(&bar[XB_XCNT(b.x)], 1u);
    return b;
}
__device__ __forceinline__ void xcd_barrier_complete(unsigned* bar, unsigned x, unsigned& nloc, unsigned& nx) {
    const unsigned G = gridDim.x * gridDim.y * gridDim.z;
    unsigned sum, cnt, mine, sp = 0u;
    for (;;) {
        sum = 0u; cnt = 0u; mine = 0u;
#pragma unroll
        for (unsigned j = 0; j < 16; ++j) { const unsigned c = xb_ld(&bar[XB_XCNT(j)]); sum += c; cnt += (c > 0u) ? 1u : 0u; mine = (j == x) ? c : mine; }
        if (sum == G) break;
        __builtin_amdgcn_s_sleep(1);
        if ((++sp & 255u) == 0u) { if (xb_ld(&bar[XB_TMO])) break; if (sp > XB_SPIN_CAP) { atomicAdd(&bar[XB_TMO], 1u); break; } }
    }
    nloc = mine > 0u ? mine : 1u; nx = cnt > 0u ? cnt : 1u;
}

__device__ __forceinline__ void xcd_barrier(const XcdBarrier& b, int tid) {
    asm volatile("s_waitcnt vmcnt(0)" ::: "memory");
    __syncthreads();
    if (tid == 0) {
        unsigned* bar = b.bar; asm volatile("" : "+s"(bar));
        __builtin_amdgcn_s_waitcnt(0);
        unsigned nloc = b.st[0], nx = b.st[1];
        if (nloc == 0u) { xcd_barrier_complete(bar, b.x, nloc, nx); b.st[0] = nloc; b.st[1] = nx; }
        const unsigned old = xb_add(&bar[XB_XSUB(b.x)], 1u);
        const unsigned gen = old / nloc;
        if (old + 1u == (gen + 1u) * nloc) {
            __builtin_amdgcn_fence(__ATOMIC_RELEASE, "agent");
            asm volatile("s_waitcnt vmcnt(0)" ::: "memory");
            const unsigned og = xb_add(&bar[XB_TOP], 1u);
            const unsigned tg = og / nx;
            if (og + 1u == (tg + 1u) * nx) xb_add(&bar[XB_TOPGEN], 1u);
            else XB_SPIN(xb_ld(&bar[XB_TOPGEN]) == tg, bar);
            __builtin_amdgcn_fence(__ATOMIC_ACQUIRE, "agent");
            xb_add(&bar[XB_XGEN(b.x)], 1u);
            asm volatile("s_waitcnt vmcnt(0)" ::: "memory");
        } else {
            XB_SPIN(xb_ld(&bar[XB_XGEN(b.x)]) == gen, bar);
            __builtin_amdgcn_fence(__ATOMIC_ACQUIRE, "agent");
            asm volatile("s_waitcnt vmcnt(0)" ::: "memory");
        }
    }
    __syncthreads();
}
__device__ __forceinline__ void p0_mod(Frame& F) {
    const float* c = F.in[1]; const float* ada_w = F.in[3]; const float* ada_b = F.in[4];
    float* mod = (float*)(F.ws + WS_MOD);
    LAS float* red = (LAS float*)F.lds;
    const int col = F.tid & 31, kg = F.tid >> 5;
    for (int ch = F.bid; ch < 192; ch += F.G) {
        const int l = ch / 96, n = (ch % 96) * 32 + col;
        const float* W = ada_w + (size_t)l * 1024 * 3072 + n;
        float a0 = 0.f, a1 = 0.f;
        for (int i = 0; i < 64; ++i) { const int k = kg + 16 * i; const float w = W[(size_t)k * 3072]; a0 += siluf_(c[k]) * w; a1 += siluf_(c[1024 + k]) * w; }
        red[kg * 32 + col] = a0; red[512 + kg * 32 + col] = a1;
        __syncthreads();
        if (F.tid < 64) { const int b = F.tid >> 5; float s = 0.f;
            for (int g = 0; g < 16; ++g) s += red[b * 512 + g * 32 + col];
            mod[(size_t)(l * 2 + b) * 3072 + n] = s + ada_b[l * 3072 + n]; }
        __syncthreads();
    }
}
__device__ __forceinline__ void transpose_item(const float* W, int ldw, int col0, int K, int ncols, bf16* WT, LAS float* scr, int item, int lane) {
    const int nblk = ncols / 32, kb = item / nblk, nb = item % nblk, k0 = 64 * kb, n0 = 32 * nb;
#pragma unroll 8
    for (int i = 0; i < 32; ++i) { const int kk = 2 * i + (lane >> 5); scr[kk * 33 + (lane & 31)] = W[(size_t)(k0 + kk) * ldw + col0 + n0 + (lane & 31)]; }
    asm volatile("s_waitcnt lgkmcnt(0)" ::: "memory");
    const int c = lane & 7;
#pragma unroll
    for (int j = 0; j < 4; ++j) { const int n = (lane >> 3) + 8 * j; const LAS float* s = scr + (8 * c) * 33 + n;
        u32x4 o; o.x = pk2(s[0 * 33], s[1 * 33]); o.y = pk2(s[2 * 33], s[3 * 33]); o.z = pk2(s[4 * 33], s[5 * 33]); o.w = pk2(s[6 * 33], s[7 * 33]);
        *(u32x4*)(WT + (size_t)(n0 + n) * K + k0 + 8 * c) = o; }
    asm volatile("s_waitcnt lgkmcnt(0)" ::: "memory");
}
__device__ __forceinline__ void p0_weights(Frame& F) {
    LAS float* scr = (LAS float*)(F.lds + 16384 + F.wave * 16384);
    const int gw = F.bid * NWAVES + F.wave, NGW = F.G * NWAVES;
    constexpr int I_QKV = 16 * 144, I_A = 16 * 96, I_GA = 16 * 32, I_GB = 16 * 16, I_M = 16 * 64, I_BA = 16 * 32, I_BB = 8 * 32, I_O = 16 * 32;
    constexpr int PER_L = I_QKV + I_A + I_GA + I_GB + I_M + I_BA + I_BB + I_O;
    for (int it = gw; it < 2 * PER_L; it += NGW) {
        const int l = it / PER_L; int r = it % PER_L;
        const float* win = F.in[5] + (size_t)l * 1024 * PROJW;
        bf16* wqkv = (bf16*)(F.ws + WS_WQKV) + (size_t)l * NQKV * 1024;
        bf16* wa = (bf16*)(F.ws + WS_WA) + (size_t)l * NAG * 1024;
        bf16* wm = (bf16*)(F.ws + WS_WM) + (size_t)l * 2048 * 1024;
        const float* W; int ldw, col0, K, ncols; bf16* WT;
        if (r < I_QKV) { W = win; ldw = PROJW; col0 = 4096; K = 1024; ncols = 4608; WT = wqkv; }
        else if ((r -= I_QKV) < I_A) { W = win; ldw = PROJW; col0 = 0; K = 1024; ncols = 3072; WT = wa; }
        else if ((r -= I_A) < I_GA) { W = win; ldw = PROJW; col0 = 3072; K = 1024; ncols = 1024; WT = wa + (size_t)3584 * 1024; }
        else if ((r -= I_GA) < I_GB) { W = win; ldw = PROJW; col0 = 8704; K = 1024; ncols = 512; WT = wa + (size_t)4608 * 1024; }
        else if ((r -= I_GB) < I_M) { W = win; ldw = PROJW; col0 = 9216; K = 1024; ncols = 2048; WT = wm; }
        else if ((r -= I_M) < I_BA) { W = F.in[23] + (size_t)l * 1024 * 1024; ldw = 1024; col0 = 0; K = 1024; ncols = 1024; WT = (bf16*)(F.ws + WS_WBA) + (size_t)l * 1024 * 1024; }
        else if ((r -= I_BA) < I_BB) { W = F.in[24] + (size_t)l * 512 * 1024; ldw = 1024; col0 = 0; K = 512; ncols = 1024; WT = (bf16*)(F.ws + WS_WBB) + (size_t)l * 1024 * 512; }
        else { r -= I_BB; W = F.in[25] + (size_t)l * 1024 * 1024; ldw = 1024; col0 = 0; K = 1024; ncols = 1024; WT = (bf16*)(F.ws + WS_WO) + (size_t)l * 1024 * 1024; }
        transpose_item(W, ldw, col0, K, ncols, WT, scr, r, F.lane);
    }
    const size_t gt = (size_t)F.bid * NTHREADS + F.tid, NGT = (size_t)F.G * NTHREADS;
    for (size_t e = gt; e < (size_t)2 * 512 * 1024; e += NGT) {
        const int l = (int)(e / (512 * 1024)), n = (int)((e / 1024) % 512), k = (int)(e % 1024);
        const float muw = F.in[7][(size_t)(l * 2 + 0) * 1024 + k], mua = F.in[7][(size_t)(l * 2 + 1) * 1024 + k];
        float v = 0.f;
        if (n < 64) v = F.in[9][((size_t)l * 1024 + k) * 64 + n] * (1.f - muw);
        else if (n < 128) v = F.in[9][((size_t)l * 1024 + k) * 64 + (n - 64)] * muw;
        else if (n < 192) v = F.in[12][((size_t)l * 1024 + k) * 64 + (n - 128)] * (1.f - mua);
        else if (n < 256) v = F.in[12][((size_t)l * 1024 + k) * 64 + (n - 192)] * mua;
        else if (n < 320 && l == 1) { const float muv = F.in[19][k]; const int m = (n - 256) & 31; const float w = F.in[21][(size_t)k * 32 + m]; v = (n < 288) ? w * (1.f - muv) : w * muv; }
        ((bf16*)(F.ws + WS_WA))[((size_t)l * NAG + 3072 + n) * 1024 + k] = (bf16)f2bf(v);
    }
}
__device__ __forceinline__ void phase_modnorm(Frame& F, int l, const float* xin) {
    const float* mod = (const float*)(F.ws + WS_MOD) + (size_t)l * 2 * 3072;
    const float* g = F.in[2] + l * 1024;
    bf16* XN = (bf16*)(F.ws + WS_XN);
    const int gw = F.bid * NWAVES + F.wave, NGW = F.G * NWAVES;
    for (int m = gw; m < MROWS; m += NGW) {
        const int b = m / SEQ; const f32x4* xr = (const f32x4*)(xin + (size_t)m * 1024) + F.lane;
        f32x4 v[4]; float s = 0.f;
#pragma unroll
        for (int j = 0; j < 4; ++j) { v[j] = xr[64 * j]; s += (v[j].x * v[j].x + v[j].y * v[j].y) + (v[j].z * v[j].z + v[j].w * v[j].w); }
        const float rs = 1.f / sqrtf(wave_sum(s) * (1.f / 1024.f) + 1e-6f);
        u32x2* o = (u32x2*)(XN + (size_t)m * 1024) + F.lane;
#pragma unroll
        for (int j = 0; j < 4; ++j) { const int c = 4 * F.lane + 256 * j;
            const f32x4 gg = *(const f32x4*)(g + c), sh = *(const f32x4*)(mod + b * 3072 + c), sc = *(const f32x4*)(mod + b * 3072 + 1024 + c);
            const f32x4 h = v[j] * rs * gg * (sc + 1.f) + sh; u32x2 w; w.x = pk2(h.x, h.y); w.y = pk2(h.z, h.w); o[64 * j] = w; }
    }
}
__device__ __forceinline__ void phase_final(Frame& F) {
    const float* g = F.in[27]; const int gw = F.bid * NWAVES + F.wave, NGW = F.G * NWAVES;
    for (int m = gw; m < MROWS; m += NGW) {
        f32x4* xr = (f32x4*)(F.out + (size_t)m * 1024) + F.lane; f32x4 v[4]; float s = 0.f;
#pragma unroll
        for (int j = 0; j < 4; ++j) { v[j] = xr[64 * j]; s += (v[j].x * v[j].x + v[j].y * v[j].y) + (v[j].z * v[j].z + v[j].w * v[j].w); }
        const float rs = 1.f / sqrtf(wave_sum(s) * (1.f / 1024.f) + 1e-6f);
#pragma unroll
        for (int j = 0; j < 4; ++j) { const f32x4 gg = *(const f32x4*)(g + 4 * F.lane + 256 * j); xr[64 * j] = v[j] * rs * gg; }
    }
}
__device__ __forceinline__ void phase_attn_naive(Frame& F) {
    const bf16* QKV = (const bf16*)(F.ws + WS_QKV); bf16* YB = (bf16*)(F.ws + WS_YB); const float* rel_bias = F.in[26];
    LAS float* QS = (LAS float*)(F.lds) + F.wave * 640;
    LAS float* PS = QS + 192;
    const int gw = F.bid * NWAVES + F.wave, NGW = F.G * NWAVES, lane = F.lane;
    for (int it = gw; it < MROWS * 8; it += NGW) {
        const int row = it >> 3, h = it & 7, b = row / SEQ, t = row % SEQ;
        const bf16* qrow = QKV + (size_t)row * NQKV;
#pragma unroll
        for (int g = 0; g < 3; ++g) QS[g * 64 + lane] = bf2f(qrow[g * 512 + h * 64 + lane]) * 0.125f;
        __builtin_amdgcn_wave_barrier();
        float sc[3][3]; float mx = -1e30f;
#pragma unroll
        for (int g = 0; g < 3; ++g) { const int dil = (g == 0) ? 1 : (g == 1 ? 4 : 16);
#pragma unroll
            for (int jj = 0; jj < 3; ++jj) { const int j = lane + 64 * jj; const int tk = t - j * dil; float s = -1e30f;
                if (j <= 128 && tk >= 0) {
                    const u32x4* kp = (const u32x4*)(QKV + (size_t)(b * SEQ + tk) * NQKV + 1536 + g * 512 + h * 64);
                    float a = 0.f;
#pragma unroll
                    for (int c8 = 0; c8 < 8; ++c8) { const u32x4 kv = kp[c8]; const LAS float* q = QS + g * 64 + c8 * 8;
                        a += q[0] * bflo(kv.x) + q[1] * bfhi(kv.x) + q[2] * bflo(kv.y) + q[3] * bfhi(kv.y) + q[4] * bflo(kv.z) + q[5] * bfhi(kv.z) + q[6] * bflo(kv.w) + q[7] * bfhi(kv.w); }
                    s = a + rel_bias[(int)T5BUCKET[g][j] * 24 + g * 8 + h];
                }
                sc[g][jj] = s; mx = fmaxf(mx, s); } }
        mx = wave_max(mx);
        float den = 0.f;
#pragma unroll
        for (int g = 0; g < 3; ++g)
#pragma unroll
            for (int jj = 0; jj < 3; ++jj) { const int j = lane + 64 * jj; const float p = (sc[g][jj] > -1e29f) ? __expf(sc[g][jj] - mx) : 0.f; den += p; if (j <= 128) PS[g * 132 + j] = p; }
        den = wave_sum(den);
        __builtin_amdgcn_wave_barrier();
        float o = 0.f;
#pragma unroll
        for (int g = 0; g < 3; ++g) { const int dil = (g == 0) ? 1 : (g == 1 ? 4 : 16); const int jmax = min(128, t / dil);
            const bf16* vp = QKV + (size_t)(b * SEQ + t) * NQKV + 3072 + g * 512 + h * 64 + lane;
            for (int j = 0; j <= jmax; ++j) o += PS[g * 132 + j] * bf2f(vp[-(ptrdiff_t)j * dil * NQKV]); }
        YB[(size_t)row * 512 + h * 64 + lane] = (bf16)f2bf(o / den);
        __builtin_amdgcn_wave_barrier();
    }
}
__device__ __forceinline__ float softplusf_(float x) { return fmaxf(x, 0.f) + log1pf(__expf(-fabsf(x))); }
__device__ __forceinline__ void phase_rwkv_naive(Frame& F, int l) {
    if (F.bid >= 32) return;
    constexpr int TB = 16;
    const int b = F.bid >> 4, h = F.bid & 15, tid = F.tid, lane = F.lane, wave = F.wave;
    const bf16* PA = (const bf16*)(F.ws + WS_PA); bf16* YA = (bf16*)(F.ws + WS_YA); bf16* VF = (bf16*)(F.ws + WS_VFIRST);
    LAS float* L = (LAS float*)F.lds;
    LAS float* W2s = L; LAS float* A2s = L + 4096; LAS float* V2s = L + 8192; LAS float* CV = L + 10240;
    LAS float* PRs = L + 11264; LAS float* PKs = PRs + 17 * 64; LAS float* PVs = PKs + 17 * 64; LAS float* LOs = PVs + 17 * 64;
    LAS float* LWs = LOs + 17 * 320; LAS float* LAs = LWs + TB * 64; LAS float* LVs = LAs + TB * 64;
    LAS float* Rs = LVs + TB * 32; LAS float* Ws = Rs + TB * 64; LAS float* Ks = Ws + TB * 64; LAS float* Vs = Ks + TB * 64; LAS float* As = Vs + TB * 64; LAS float* Bs = As + TB * 64;
    LAS float* RKs = Bs + TB * 64; LAS float* Ys = RKs + TB;
    for (int e = tid; e < 4096; e += NTHREADS) { const int m = e >> 6, j = e & 63;
        W2s[e] = F.in[10][((size_t)l * 64 + m) * 1024 + h * 64 + j]; A2s[e] = F.in[13][((size_t)l * 64 + m) * 1024 + h * 64 + j];
        if (m < 32) V2s[e] = (l == 1) ? F.in[22][(size_t)m * 1024 + h * 64 + j] : 0.f; }
    if (tid < 64) { const int c = h * 64 + tid;
        CV[0 * 64 + tid] = F.in[8][l * 1024 + c];  CV[1 * 64 + tid] = F.in[11][l * 1024 + c]; CV[2 * 64 + tid] = (l == 1) ? F.in[20][c] : 0.f;
        CV[3 * 64 + tid] = F.in[14][l * 1024 + c]; CV[4 * 64 + tid] = F.in[15][l * 1024 + c]; CV[5 * 64 + tid] = F.in[16][l * 1024 + c];
        CV[6 * 64 + tid] = F.in[17][l * 1024 + c]; CV[7 * 64 + tid] = F.in[18][l * 1024 + c];
        CV[8 * 64 + tid] = F.in[6][(size_t)(l * 3 + 0) * 1024 + c]; CV[9 * 64 + tid] = F.in[6][(size_t)(l * 3 + 1) * 1024 + c]; CV[10 * 64 + tid] = F.in[6][(size_t)(l * 3 + 2) * 1024 + c]; }
    float S[16];
#pragma unroll
    for (int q = 0; q < 16; ++q) S[q] = 0.f;
    __syncthreads();
    for (int t0 = 0; t0 < SEQ; t0 += TB) {
        for (int e = tid; e < 17 * 512; e += NTHREADS) { const int rr = e >> 9, cc = e & 511, t = t0 - 1 + rr; float v = 0.f;
            if (t >= 0) { const int gc = (cc < 192) ? ((cc >> 6) * 1024 + h * 64 + (cc & 63)) : (3072 + cc - 192); v = bf2f(PA[(size_t)(b * SEQ + t) * NA + gc]); }
            if (cc < 64) PRs[rr * 64 + cc] = v; else if (cc < 128) PKs[rr * 64 + cc - 64] = v; else if (cc < 192) PVs[rr * 64 + cc - 128] = v; else LOs[rr * 320 + cc - 192] = v; }
        __syncthreads();
        for (int e = tid; e < TB * 160; e += NTHREADS) { const int tl = e / 160, m = e % 160; const LAS float* cur = LOs + (tl + 1) * 320; const LAS float* prv = LOs + tl * 320;
            if (m < 64) LWs[tl * 64 + m] = tanhf(cur[m] + prv[64 + m]);
            else if (m < 128) LAs[tl * 64 + m - 64] = cur[128 + m - 64] + prv[192 + m - 64];
            else LVs[tl * 32 + m - 128] = cur[256 + m - 128] + prv[288 + m - 128]; }
        __syncthreads();
        for (int tl = wave; tl < TB; tl += NWAVES) { const int j = lane; const size_t row = (size_t)(b * SEQ + t0 + tl);
            float wpre = CV[j], apre = CV[64 + j], vpre = CV[128 + j];
            for (int m = 0; m < 64; ++m) { wpre += LWs[tl * 64 + m] * W2s[m * 64 + j]; apre += LAs[tl * 64 + m] * A2s[m * 64 + j]; }
            for (int m = 0; m < 32; ++m) vpre += LVs[tl * 32 + m] * V2s[m * 64 + j];
            const float pr = PRs[(tl + 1) * 64 + j], prp = PRs[tl * 64 + j], pk = PKs[(tl + 1) * 64 + j], pkp = PKs[tl * 64 + j], pv = PVs[(tl + 1) * 64 + j], pvp = PVs[tl * 64 + j];
            const float r = pr + (prp - pr) * CV[8 * 64 + j], k = pk + (pkp - pk) * CV[9 * 64 + j]; float v = pv + (pvp - pv) * CV[10 * 64 + j];
            const float w = -softplusf_(-wpre) - 0.5f; const float decay = __expf(-__expf(w)); const float asig = sigmoidf_(apre);
            if (l == 0) VF[row * 1024 + h * 64 + j] = (bf16)f2bf(v); else { const float vf = bf2f(VF[row * 1024 + h * 64 + j]); v = v + (vf - v) * sigmoidf_(vpre); }
            const float kk = k * CV[3 * 64 + j]; const float ss = wave_sum(kk * kk); const float kkn = kk * (1.f / sqrtf(fmaxf(ss, 1e-24f)));
            const float k2 = k * (1.f + (asig - 1.f) * CV[4 * 64 + j]);
            const float rk = wave_sum(r * k2 * CV[5 * 64 + j]);
            Rs[tl * 64 + j] = r; Ws[tl * 64 + j] = decay; Ks[tl * 64 + j] = k2; Vs[tl * 64 + j] = v; As[tl * 64 + j] = -kkn; Bs[tl * 64 + j] = kkn * asig;
            if (lane == 0) RKs[tl] = rk; }
        __syncthreads();
        if (wave < 4) { const int i = wave * 16 + (lane >> 2), jq = lane & 3;
            for (int tl = 0; tl < TB; ++tl) { const int o = tl * 64 + jq * 16; const float vi = Vs[tl * 64 + i];
                float sa = 0.f;
#pragma unroll
                for (int q = 0; q < 16; ++q) sa += S[q] * As[o + q];
                sa += __shfl_xor(sa, 1); sa += __shfl_xor(sa, 2);
                float y = 0.f;
#pragma unroll
                for (int q = 0; q < 16; ++q) { S[q] = S[q] * Ws[o + q] + sa * Bs[o + q] + vi * Ks[o + q]; y += S[q] * Rs[o + q]; }
                y += __shfl_xor(y, 1); y += __shfl_xor(y, 2);
                if (jq == 0) Ys[tl * 64 + i] = y; } }
        __syncthreads();
        for (int tl = wave; tl < TB; tl += NWAVES) { const int i = lane; const size_t row = (size_t)(b * SEQ + t0 + tl);
            const float y = Ys[tl * 64 + i]; const float mean = wave_sum(y) * (1.f / 64.f); const float d = y - mean; const float var = wave_sum(d * d) * (1.f / 64.f);
            const float o = d * (1.f / sqrtf(var + 64e-5f)) * CV[6 * 64 + i] + CV[7 * 64 + i] + RKs[tl] * Vs[tl * 64 + i];
            YA[row * 1024 + h * 64 + i] = (bf16)f2bf(o); }
    }
}
#define LDSBAR() do { asm volatile("s_waitcnt lgkmcnt(0)" ::: "memory"); __builtin_amdgcn_s_barrier(); asm volatile("" ::: "memory"); } while (0)
typedef short bf16x8 __attribute__((ext_vector_type(8)));
typedef short s16x4 __attribute__((ext_vector_type(4)));
typedef short v4i16_t __attribute__((ext_vector_type(4)));
constexpr int RC = 32, RLS = 512, RNSC = SEQ / RLS, RNCH = RLS / RC, RITEMS = BATCH * 16 * RNSC;
constexpr int AST = 72;
constexpr int MST = 40;
constexpr int OFF_RAWH = 0, OFF_RAWL = 12800, OFF_GCS = 12800, OFF_MK = 12800, OFF_QB = 15360, OFF_QK = 17920, OFF_YS = 20480, OFF_M = 28928, OFF_MMK = 31488;
constexpr int OFF_LW = 34048, OFF_LA = OFF_LW + 4608, OFF_LV = OFF_LA + 4608;
constexpr int OFF_W2T = 45824, OFF_A2T = OFF_W2T + 9216, OFF_V2T = OFF_A2T + 9216;
constexpr int OFF_CV = 69376, OFF_GAM = 72192, OFF_RK = 72448;
constexpr int OFF_PRE = 72576, OFF_U = 72576, OFF_T = OFF_U + 8704;
constexpr int OFF_LWG = 97664, OFF_ARR = 105856, OFF_VFS = 142720, OFF_GAS = OFF_ARR + 4 * (32 * AST * 2);
constexpr int PRE_ST = 196, U_ST = 68, T_ST = 36, YS_ST = 66;
enum { AR_RT = 0, AR_AT, AR_BT, AR_KT, AR_BH, AR_KH, AR_V, AR_W };
static_assert(OFF_VFS + 4096 <= LDS_BYTES - 64 && OFF_MMK + 2560 <= OFF_LW && OFF_YS + 32 * YS_ST * 4 <= OFF_M, "rwkv LDS map");
#define ARR(k) (F.lds + OFF_ARR + (k) * (32 * AST * 2))

__device__ __forceinline__ bf16x8 ld_b128(const LAS unsigned char* p) { return *(const LAS bf16x8*)p; }
__device__ __forceinline__ s16x4 ld_b64(const LAS unsigned char* p) { return *(const LAS s16x4*)p; }
__device__ __forceinline__ s16x4 ld_tr(const LAS unsigned char* p) { return __builtin_bit_cast(s16x4, __builtin_amdgcn_ds_read_tr16_b64_v4i16((LAS v4i16_t*)p)); }
__device__ __forceinline__ bf16x8 cat8(s16x4 a, s16x4 b) { return (bf16x8){a[0], a[1], a[2], a[3], b[0], b[1], b[2], b[3]}; }
__device__ __forceinline__ bf16x8 pack8(f32x4 a, f32x4 b) { u32x4 w; w.x = pk2(a[0], a[1]); w.y = pk2(a[2], a[3]); w.z = pk2(b[0], b[1]); w.w = pk2(b[2], b[3]); return __builtin_bit_cast(bf16x8, w); }
#define MFMA16(a, b, c) __builtin_amdgcn_mfma_f32_16x16x32_bf16((a), (b), (c), 0, 0, 0)
__device__ __forceinline__ void st_bf(LAS unsigned char* base, int idx, float v) { ((LAS bf16*)base)[idx] = (bf16)pg8::cvt_pk_bf16(v, v); }
__device__ __forceinline__ float fsig(float x) { return __builtin_amdgcn_rcpf(1.f + __expf(-x)); }
__device__ __forceinline__ float fast_tanh(float x) { return 1.f - 2.f * __builtin_amdgcn_rcpf(1.f + __expf(2.f * x)); }

__device__ __forceinline__ u32x4 rwkv_raw_load(const bf16* PA, const bf16* VF, int l, int b, int h, int t0, int i, int tid) {
    u32x4 v = (u32x4){0u, 0u, 0u, 0u};
    if (i == 5) { if (tid < 256) v = *(const u32x4*)(VF + (size_t)(b * SEQ + t0 + (tid >> 3)) * 1024 + h * 64 + (tid & 7) * 8); return v; }
    const int e = tid + NTHREADS * i, rr = (i < 4) ? (e >> 6) : 32, k = tid & 63, t = t0 - 1 + rr;
    const int col = (k < 24) ? ((k >> 3) * 1024 + h * 64 + (k & 7) * 8) : (3072 + (k - 24) * 8);
    if (i < 4 || tid < 64) { if (t >= 0) v = *(const u32x4*)(PA + (size_t)(b * SEQ + t) * NA + col); }
    else if (l == 1 && tid < 320) { const int q = tid - 64; v = *(const u32x4*)(VF + (size_t)(b * SEQ + t0 + (q >> 3)) * 1024 + h * 64 + (q & 7) * 8); }
    return v;
}
__device__ __forceinline__ void rwkv_raw_store(Frame& F, int i, int tid, u32x4 v) {
    if (i == 5) { if (tid < 256) *(LAS u32x4*)(F.lds + OFF_GAS + tid * 16) = v; return; }
    const int e = tid + NTHREADS * i, rr = (i < 4) ? (e >> 6) : 32, k = tid & 63;
    const int off = (k < 24) ? (OFF_RAWH + (rr * 192 + k * 8) * 2) : (OFF_RAWL + (rr * 320 + (k - 24) * 8) * 2);
    if (i < 4 || tid < 64) *(LAS u32x4*)(F.lds + off) = v;
    else if (tid < 320) *(LAS u32x4*)(F.lds + OFF_VFS + (tid - 64) * 16) = v;
}

#ifndef RDUP
#define RDUP 0
#endif
#ifdef STGPROBE
#define STG_MARK(k) do { if (PASS == 3 && (k) == STGPROBE) stg_acc += __builtin_amdgcn_s_memrealtime() - stg_t0; } while (0)
#else
#define STG_MARK(k) do {} while (0)
#endif
template <int PASS> __device__ __forceinline__ void rwkv_pass(Frame& F, int l) {
    unsigned long long stg_acc = 0ull, stg_t0 = 0ull;
    const int tid = F.tid, lane = F.lane, wave = F.wave, g = lane >> 4, c = lane & 15;
    const bf16* PA = (const bf16*)(F.ws + WS_PA); bf16* YA = (bf16*)(F.ws + WS_YA); bf16* VF = (bf16*)(F.ws + WS_VFIRST);
    float* PD = (float*)(F.ws + WS_SC); float* SST = (float*)(F.ws + WS_SC + 16 * MiB);
    LAS float* CV = (LAS float*)(F.lds + OFF_CV); LAS float* GAM = (LAS float*)(F.lds + OFF_GAM); LAS float* RK = (LAS float*)(F.lds + OFF_RK);
    LAS float* PRE = (LAS float*)(F.lds + OFF_PRE); LAS float* Us = (LAS float*)(F.lds + OFF_U); LAS float* Ts = (LAS float*)(F.lds + OFF_T);
    LAS float* LWG = (LAS float*)(F.lds + OFF_LWG); LAS float* GCS = (LAS float*)(F.lds + OFF_GCS); LAS float* YS = (LAS float*)(F.lds + OFF_YS);
    LAS bf16* RAWH = (LAS bf16*)(F.lds + OFF_RAWH); LAS bf16* RAWL = (LAS bf16*)(F.lds + OFF_RAWL); LAS bf16* VFS = (LAS bf16*)(F.lds + OFF_VFS);
    const int chain = F.bid >> 3, b = chain >> 4, h = chain & 15, NIT = RNSC / 8;
    if (F.G != 256) return;
    for (int e = tid; e < 4096; e += NTHREADS) { const int m = e >> 6, j = e & 63;
        st_bf(F.lds + OFF_W2T, j * AST + m, F.in[10][((size_t)l * 64 + m) * 1024 + h * 64 + j]);
        st_bf(F.lds + OFF_A2T, j * AST + m, F.in[13][((size_t)l * 64 + m) * 1024 + h * 64 + j]);
        if (m < 32) st_bf(F.lds + OFF_V2T, j * MST + m, (l == 1) ? F.in[22][(size_t)m * 1024 + h * 64 + j] : 0.f); }
    if (tid < 64) { const int cc = h * 64 + tid;
        CV[0 * 64 + tid] = F.in[8][l * 1024 + cc];  CV[1 * 64 + tid] = F.in[11][l * 1024 + cc]; CV[2 * 64 + tid] = (l == 1) ? F.in[20][cc] : 0.f;
        CV[3 * 64 + tid] = F.in[14][l * 1024 + cc]; CV[4 * 64 + tid] = F.in[15][l * 1024 + cc]; CV[5 * 64 + tid] = F.in[16][l * 1024 + cc];
        CV[6 * 64 + tid] = F.in[17][l * 1024 + cc]; CV[7 * 64 + tid] = F.in[18][l * 1024 + cc];
        CV[8 * 64 + tid] = F.in[6][(size_t)(l * 3 + 0) * 1024 + cc]; CV[9 * 64 + tid] = F.in[6][(size_t)(l * 3 + 1) * 1024 + cc]; CV[10 * 64 + tid] = F.in[6][(size_t)(l * 3 + 2) * 1024 + cc]; }
    const bf16* GAp = (const bf16*)(F.ws + WS_GA);
    u32x4 pre[5], preg = (u32x4){0u, 0u, 0u, 0u};
#pragma unroll
    for (int i = 0; i < 5; ++i) pre[i] = rwkv_raw_load(PA, VF, l, b, h, ((F.bid & 7) * NIT) * RLS, i, tid);
    if (PASS == 3) preg = rwkv_raw_load(PA, GAp, l, b, h, ((F.bid & 7) * NIT) * RLS, 5, tid);
    for (int ii = 0; ii < NIT; ++ii) {
        const int sc = (F.bid & 7) * NIT + ii, it = chain * RNSC + sc;
        f32x4 X[4];
#pragma unroll
        for (int jt = 0; jt < 4; ++jt) X[jt] = (f32x4){0.f, 0.f, 0.f, 0.f};
        if (PASS == 1) { if (wave >= 4) {
#pragma unroll
                for (int jt = 0; jt < 4; ++jt)
#pragma unroll
                    for (int r = 0; r < 4; ++r) X[jt][r] = (16 * jt + 4 * g + r == 16 * (wave - 4) + c) ? 1.f : 0.f; } }
        else if (wave < 4) { int lz = lane; asm volatile("" : "+v"(lz));
            const float* s0 = SST + (size_t)it * 4096 + (4 * (lz >> 4)) * 64 + 16 * wave + (lz & 15);
#pragma unroll
            for (int jt = 0; jt < 4; ++jt)
#pragma unroll
                for (int r = 0; r < 4; ++r) X[jt][r] = s0[(16 * jt + r) * 64]; }
        for (int ch = 0; ch < RNCH; ++ch) {
            const int t0 = sc * RLS + ch * RC;
            LDSBAR();
#ifdef STGPROBE
            stg_t0 = __builtin_amdgcn_s_memrealtime();
#endif
            for (int rep_ = 0; rep_ < ((PASS == 3 && RDUP == 1) ? 2 : 1); ++rep_) {
            { int tz = tid; asm volatile("" : "+v"(tz));
#pragma unroll
              for (int i = 0; i < 5; ++i) rwkv_raw_store(F, i, tz, pre[i]);
              if (PASS == 3) rwkv_raw_store(F, 5, tz, preg);
              const bool last = (ch == RNCH - 1) && (ii == NIT - 1); const int t0n = last ? t0 : t0 + RC;
#pragma unroll
              for (int i = 0; i < 5; ++i) pre[i] = rwkv_raw_load(PA, VF, l, b, h, t0n, i, tz);
              if (PASS == 3) preg = rwkv_raw_load(PA, GAp, l, b, h, t0n, 5, tz); }
            LDSBAR();
            }
            for (int rep_ = 0; rep_ < ((PASS == 3 && RDUP == 2) ? 2 : 1); ++rep_) {
            STG_MARK(1);
            { const int tl = tid >> 4, mq = tid & 15; const LAS unsigned char* cur = F.lds + OFF_RAWL + (tl + 1) * 640 + mq * 8; const LAS unsigned char* prv = F.lds + OFF_RAWL + tl * 640 + mq * 8;
              const u32x2 cw = *(const LAS u32x2*)(cur), pw = *(const LAS u32x2*)(prv + 128), ca = *(const LAS u32x2*)(cur + 256), pa = *(const LAS u32x2*)(prv + 384);
              const unsigned cv2 = *(const LAS unsigned*)(F.lds + OFF_RAWL + (tl + 1) * 640 + 512 + mq * 4), pv2 = *(const LAS unsigned*)(F.lds + OFF_RAWL + tl * 640 + 576 + mq * 4);
              u32x2 lw, la;
              lw.x = pk2(fast_tanh(bflo(cw.x) + bflo(pw.x)), fast_tanh(bfhi(cw.x) + bfhi(pw.x))); lw.y = pk2(fast_tanh(bflo(cw.y) + bflo(pw.y)), fast_tanh(bfhi(cw.y) + bfhi(pw.y)));
              la.x = pk2(bflo(ca.x) + bflo(pa.x), bfhi(ca.x) + bfhi(pa.x)); la.y = pk2(bflo(ca.y) + bflo(pa.y), bfhi(ca.y) + bfhi(pa.y));
              const unsigned lv = pk2(bflo(cv2) + bflo(pv2), bfhi(cv2) + bfhi(pv2));
              *(LAS u32x2*)(F.lds + OFF_LW + (tl * AST + mq * 4) * 2) = lw; *(LAS u32x2*)(F.lds + OFF_LA + (tl * AST + mq * 4) * 2) = la; *(LAS unsigned*)(F.lds + OFF_LV + (tl * MST + mq * 2) * 2) = lv; }
            LDSBAR();
            }
            for (int rep_ = 0; rep_ < ((PASS == 3 && RDUP == 3) ? 2 : 1); ++rep_) {
            STG_MARK(2);
            { f32x4 acc3[3];
#pragma unroll
              for (int q = 0; q < 3; ++q) { const int o16 = 2 * wave + q - 1;
                const int tt = (q == 0) ? (wave >> 2) : (o16 >> 3), mat = (q == 0) ? 0 : 1 + ((o16 >> 2) & 1), jt = (q == 0) ? (wave & 3) : (o16 & 3);
                f32x4 acc = (f32x4){0.f, 0.f, 0.f, 0.f};
                if (mat < 2) { const LAS unsigned char* Ab = F.lds + (mat == 0 ? OFF_LW : OFF_LA) + ((16 * tt + c) * AST + 8 * g) * 2; const LAS unsigned char* Bb = F.lds + (mat == 0 ? OFF_W2T : OFF_A2T) + ((16 * jt + c) * AST + 8 * g) * 2;
                    acc = MFMA16(ld_b128(Ab), ld_b128(Bb), acc); acc = MFMA16(ld_b128(Ab + 64), ld_b128(Bb + 64), acc); }
                else { const LAS unsigned char* Ab = F.lds + OFF_LV + ((16 * tt + c) * MST + 8 * g) * 2; const LAS unsigned char* Bb = F.lds + OFF_V2T + ((16 * jt + c) * MST + 8 * g) * 2;
                    acc = MFMA16(ld_b128(Ab), ld_b128(Bb), acc); }
                acc3[q] = acc; }
              const float w0 = CV[16 * (wave & 3) + c];
#pragma unroll
              for (int q = 0; q < 3; ++q) { const int o16 = 2 * wave + q - 1;
                const int tt = (q == 0) ? (wave >> 2) : (o16 >> 3), mat = (q == 0) ? 0 : 1 + ((o16 >> 2) & 1), jt = (q == 0) ? (wave & 3) : (o16 & 3), nt = mat * 4 + jt;
                if (q == 0) {
#pragma unroll
                    for (int r = 0; r < 4; ++r) { const float x = -(acc3[0][r] + w0); const float sp = fmaxf(x, 0.f) + __logf(1.f + __expf(-fabsf(x))); LWG[(16 * tt + 4 * g + r) * 64 + 16 * jt + c] = -__expf(-sp - 0.5f); } }
                else {
#pragma unroll
                    for (int r = 0; r < 4; ++r) PRE[(16 * tt + 4 * g + r) * PRE_ST + 16 * nt + c] = acc3[q][r]; } } }
            LDSBAR();
            }
            for (int rep_ = 0; rep_ < ((PASS == 3 && RDUP == 6) ? 2 : 1); ++rep_) {
            STG_MARK(3);
            { const int tt = wave >> 2, jt = wave & 3; f32x4 acc = (f32x4){0.f, 0.f, 0.f, 0.f};
#pragma unroll
              for (int ks = 0; ks < 8; ++ks) { if (ks >= 4 && tt == 0) continue;
                  const float av = (4 * ks + g <= 16 * tt + c) ? 1.f : 0.f; const float bv = LWG[(4 * ks + g) * 64 + 16 * jt + c];
                  acc = __builtin_amdgcn_mfma_f32_16x16x4f32(av, bv, acc, 0, 0, 0); }
#pragma unroll
              for (int r = 0; r < 4; ++r) GCS[(16 * tt + 4 * g + r) * 64 + 16 * jt + c] = acc[r];
              if (tt == 1 && g == 3) GAM[16 * jt + c] = __expf(acc[3]); }
            LDSBAR();
            }
            for (int rep_ = 0; rep_ < ((PASS == 3 && RDUP == 4) ? 2 : 1); ++rep_) {
            STG_MARK(4);
            { const int j = lane;
              const float c_a0 = CV[64 + j], c_v0 = CV[128 + j], c_kk = CV[3 * 64 + j], c_ka = CV[4 * 64 + j], c_rk = CV[5 * 64 + j], c_mr = CV[8 * 64 + j], c_mk = CV[9 * 64 + j], c_mv = CV[10 * 64 + j];
#pragma unroll
              for (int kb = 0; kb < 4; kb += 2) {
              float apre[2], vpre[2], pr[2], prp[2], pk[2], pkp[2], pvv[2], pvp[2], vfv[2], gt[2], gp[2];
#pragma unroll
              for (int k = 0; k < 2; ++k) { const int tl = wave + 8 * (kb + k);
                  apre[k] = PRE[tl * PRE_ST + 64 + j]; vpre[k] = PRE[tl * PRE_ST + 128 + j];
                  pr[k] = bf2f(RAWH[(tl + 1) * 192 + j]); prp[k] = bf2f(RAWH[tl * 192 + j]); pk[k] = bf2f(RAWH[(tl + 1) * 192 + 64 + j]); pkp[k] = bf2f(RAWH[tl * 192 + 64 + j]);
                  pvv[k] = bf2f(RAWH[(tl + 1) * 192 + 128 + j]); pvp[k] = bf2f(RAWH[tl * 192 + 128 + j]);
                  vfv[k] = bf2f(VFS[tl * 64 + j]);
                  gt[k] = GCS[tl * 64 + j]; gp[k] = GCS[(tl > 0 ? tl - 1 : 0) * 64 + j]; }
              float o_at[2], o_bt[2], o_kt[2], o_v[2], o_rt[2], o_rk[2];
#pragma unroll
              for (int k = 0; k < 2; ++k) {
                  const float r = pr[k] + (prp[k] - pr[k]) * c_mr, kx = pk[k] + (pkp[k] - pk[k]) * c_mk; float v = pvv[k] + (pvp[k] - pvv[k]) * c_mv;
                  const float asig = fsig(apre[k] + c_a0);
                  if (l == 1) v = v + (vfv[k] - v) * fsig(vpre[k] + c_v0);
                  const float kk = kx * c_kk; const float ss = wave_sum_dpp(kk * kk); const float kkn = kk * __builtin_amdgcn_rsqf(fmaxf(ss, 1e-24f));
                  const float k2 = kx * (1.f + (asig - 1.f) * c_ka); const float av = -kkn, bv = kkn * asig;
                  const float eg = __expf(gt[k]), egp = (wave + 8 * (kb + k) > 0) ? __expf(gp[k]) : 1.f, einv = __expf(-gt[k]);
                  o_at[k] = av * egp; o_bt[k] = bv * einv; o_kt[k] = k2 * einv; o_v[k] = v; o_rt[k] = r * eg;
                  o_rk[k] = (PASS == 3) ? wave_sum_dpp(r * k2 * c_rk) : 0.f; }
#pragma unroll
              for (int k = 0; k < 2; ++k) { const int tl = wave + 8 * (kb + k), o = tl * AST + j;
                  st_bf(ARR(AR_AT), o, o_at[k]); st_bf(ARR(AR_BT), o, o_bt[k]); st_bf(ARR(AR_KT), o, o_kt[k]); st_bf(ARR(AR_V), o, o_v[k]);
                  if (PASS == 3) { st_bf(ARR(AR_RT), o, o_rt[k]); if (lane == 0) RK[tl] = o_rk[k]; }
                  if (l == 0 && PASS == 1) VF[(size_t)(b * SEQ + t0 + tl) * 1024 + h * 64 + j] = (bf16)pk2(o_v[k], 0.f); } } }
            LDSBAR();
            }
            for (int rep_ = 0; rep_ < ((PASS == 3 && RDUP == 5) ? 2 : 1); ++rep_) {
            STG_MARK(5);
            { f32x4 acc7[2];
#pragma unroll
              for (int q = 0; q < 2; ++q) { const int tile = wave * 2 + q, rt = tile >> 2, ct = tile & 3, tt = rt & 1, st = ct & 1;
                f32x4 acc = (f32x4){0.f, 0.f, 0.f, 0.f};
                if (!(PASS == 1 && rt >= 2) && st <= tt) { const LAS unsigned char* Ab = ARR(rt < 2 ? AR_AT : AR_RT) + ((16 * tt + c) * AST + 8 * g) * 2; const LAS unsigned char* Bb = ARR(ct < 2 ? AR_BT : AR_KT) + ((16 * st + c) * AST + 8 * g) * 2;
                    acc = MFMA16(ld_b128(Ab), ld_b128(Bb), acc); acc = MFMA16(ld_b128(Ab + 64), ld_b128(Bb + 64), acc); }
                acc7[q] = acc; }
#pragma unroll
              for (int q = 0; q < 2; ++q) { const int tile = wave * 2 + q, rt = tile >> 2, ct = tile & 3, tt = rt & 1, st = ct & 1;
                if (PASS == 1 && rt >= 2) continue;
                const int s = 16 * st + c;
#pragma unroll
                for (int r = 0; r < 4; ++r) { const int t = 16 * tt + 4 * g + r; const bool keep = (rt < 2) ? (s < t) : (s <= t); const float v = keep ? acc7[q][r] : 0.f;
                    if (rt < 2 && ct < 2) { Ts[t * T_ST + s] = v; if (tt == 1 && st == 0) st_bf(F.lds + OFF_M, t * MST + s, v); } else st_bf(F.lds + (rt < 2 ? OFF_MK : (ct < 2 ? OFF_QB : OFF_QK)), t * MST + s, v); } } }
            LDSBAR();
            }
            f32x4 mkv[2], Ureg[2];
            for (int rep_ = 0; rep_ < ((PASS == 3 && RDUP == 7) ? 2 : 1); ++rep_) {
            STG_MARK(6);
            mkv[0] = (f32x4){0.f, 0.f, 0.f, 0.f}; mkv[1] = mkv[0];
            if (wave == 4 || wave == 5) { const int bb = 16 * (wave - 4), s = lane & 15; float x[16]; float trow[16];
#pragma unroll
                for (int t = 0; t < 16; ++t) trow[t] = Ts[(bb + t) * T_ST + bb + s];
#pragma unroll
                for (int t = 0; t < 16; ++t) { float a0 = (t == s) ? 1.f : 0.f, a1 = 0.f;
#pragma unroll
                    for (int u = 0; u < t; ++u) { const float tv = __int_as_float(__builtin_amdgcn_readlane(__float_as_int(trow[t]), u)); if (u & 1) a1 += tv * x[u]; else a0 += tv * x[u]; }
                    x[t] = a0 + a1; }
#pragma unroll
                for (int t = 0; t < 16; ++t) { if (lane < 16) st_bf(F.lds + OFF_M, (bb + t) * MST + bb + s, x[t]); } }
            else if (wave < 4) { const int q4 = c >> 2, p4 = c & 3;
                const LAS unsigned char* vb = ARR(AR_V) + ((8 * g + q4) * AST + 16 * wave + 4 * p4) * 2; const bf16x8 vfr = cat8(ld_tr(vb), ld_tr(vb + 4 * AST * 2));
#pragma unroll
                for (int st = 0; st < 2; ++st) mkv[st] = MFMA16(ld_b128(F.lds + OFF_MK + ((16 * st + c) * MST + 8 * g) * 2), vfr, mkv[st]); }
            LDSBAR();
            STG_MARK(8);
            { const s16x4 z4 = (s16x4){0, 0, 0, 0};
              const bf16x8 m00 = cat8(ld_b64(F.lds + OFF_M + (c * MST + 4 * g) * 2), z4), t10 = cat8(ld_b64(F.lds + OFF_M + ((16 + c) * MST + 4 * g) * 2), z4), m11 = cat8(ld_b64(F.lds + OFF_M + ((16 + c) * MST + 16 + 4 * g) * 2), z4);
              bf16x8 r0; f32x4 r1;
              if (wave < 4) { r0 = pack8(mkv[0], (f32x4){0.f, 0.f, 0.f, 0.f}); r1 = mkv[1]; }
              else { const int jt = wave - 4, q4 = c >> 2, p4 = c & 3;
                  r0 = cat8(ld_tr(ARR(AR_AT) + ((4 * g + q4) * AST + 16 * jt + 4 * p4) * 2), z4);
#pragma unroll
                  for (int r = 0; r < 4; ++r) r1[r] = bf2f(((const LAS bf16*)ARR(AR_AT))[(16 + 4 * g + r) * AST + 16 * jt + c]); }
              const f32x4 zero4 = (f32x4){0.f, 0.f, 0.f, 0.f};
              const f32x4 x0 = MFMA16(m00, r0, zero4);
              const f32x4 yv = MFMA16(t10, pack8(x0, zero4), r1);
              const f32x4 x1 = MFMA16(m11, pack8(yv, zero4), zero4);
              Ureg[0] = x0; Ureg[1] = x1;
              if (wave >= 4) { const int jt = wave - 4;
#pragma unroll
                  for (int r = 0; r < 4; ++r) { st_bf(ARR(AR_W), (4 * g + r) * AST + 16 * jt + c, x0[r]); st_bf(ARR(AR_W), (16 + 4 * g + r) * AST + 16 * jt + c, x1[r]); } } }
            LDSBAR();
            }
            STG_MARK(9);
            const bool active = (PASS == 1) ? true : (wave < 4);
            const bool inhom = (PASS == 1) ? (wave < 4) : true;
            const int cw = wave & 3;
            if (active) {
                bf16x8 xf[2];
                xf[0] = pack8(X[0], X[1]); xf[1] = pack8(X[2], X[3]);
                f32x4 Z[2];
#pragma unroll
                for (int tt = 0; tt < 2; ++tt) { f32x4 z = (f32x4){0.f, 0.f, 0.f, 0.f};
                    if (inhom) z = Ureg[tt];
#pragma unroll
                    for (int ks = 0; ks < 2; ++ks) { const LAS unsigned char* wb = ARR(AR_W) + ((16 * tt + c) * AST + 32 * ks + 4 * g) * 2;
                        z = MFMA16(cat8(ld_b64(wb), ld_b64(wb + 32)), xf[ks], z); }
                    Z[tt] = z; }
                const bf16x8 zf = pack8(Z[0], Z[1]);
                bf16x8 vf = zf;
                if (inhom) { const int q = c >> 2, p = c & 3; const LAS unsigned char* vb = ARR(AR_V) + ((4 * g + q) * AST + 16 * cw + 4 * p) * 2; vf = cat8(ld_tr(vb), ld_tr(vb + 16 * AST * 2)); }
                f32x4 Yt[2]; Yt[0] = (f32x4){0.f, 0.f, 0.f, 0.f}; Yt[1] = Yt[0];
                if (PASS == 3) {
#pragma unroll
                    for (int tt = 0; tt < 2; ++tt) { f32x4 y = (f32x4){0.f, 0.f, 0.f, 0.f};
#pragma unroll
                        for (int ks = 0; ks < 2; ++ks) { const LAS unsigned char* rb = ARR(AR_RT) + ((16 * tt + c) * AST + 32 * ks + 4 * g) * 2;
                            y = MFMA16(cat8(ld_b64(rb), ld_b64(rb + 32)), xf[ks], y); }
                        const LAS unsigned char* qb = F.lds + OFF_QB + ((16 * tt + c) * MST + 4 * g) * 2; const LAS unsigned char* qk = F.lds + OFF_QK + ((16 * tt + c) * MST + 4 * g) * 2;
                        y = MFMA16(cat8(ld_b64(qb), ld_b64(qb + 32)), zf, y);
                        y = MFMA16(cat8(ld_b64(qk), ld_b64(qk + 32)), vf, y);
                        Yt[tt] = y; } }
                { const int q = c >> 2, p = c & 3;
#pragma unroll
                  for (int jt = 0; jt < 4; ++jt) { f32x4 xn = X[jt];
                      const LAS unsigned char* bb = ARR(AR_BT) + ((4 * g + q) * AST + 16 * jt + 4 * p) * 2;
                      xn = MFMA16(cat8(ld_tr(bb), ld_tr(bb + 16 * AST * 2)), zf, xn);
                      if (inhom) { const LAS unsigned char* kb = ARR(AR_KT) + ((4 * g + q) * AST + 16 * jt + 4 * p) * 2; xn = MFMA16(cat8(ld_tr(kb), ld_tr(kb + 16 * AST * 2)), vf, xn); }
#pragma unroll
                      for (int r = 0; r < 4; ++r) xn[r] *= GAM[16 * jt + 4 * g + r];
                      X[jt] = xn; } }
                if (PASS == 3) {
#pragma unroll
                    for (int tt = 0; tt < 2; ++tt)
#pragma unroll
                        for (int r = 0; r < 4; ++r) YS[(16 * tt + 4 * g + r) * YS_ST + 16 * cw + c] = Yt[tt][r]; }
            }
            STG_MARK(10);
            if (PASS == 3) {
                LDSBAR();
                STG_MARK(11);
                { const int i = lane; float y[4], rk[4], vv[4], ga[4];
#pragma unroll
                  for (int k = 0; k < 4; ++k) { const int tl = wave + 8 * k; y[k] = YS[tl * YS_ST + i]; rk[k] = RK[tl]; vv[k] = bf2f(((const LAS bf16*)ARR(AR_V))[tl * AST + i]); ga[k] = bf2f(((const LAS bf16*)(F.lds + OFF_GAS))[tl * 64 + i]); }
                  const float c_g = CV[6 * 64 + i], c_b = CV[7 * 64 + i];
#pragma unroll
                  for (int k = 0; k < 4; ++k) { const int tl = wave + 8 * k; const size_t row = (size_t)(b * SEQ + t0 + tl);
                      const float mean = wave_sum_dpp(y[k]) * (1.f / 64.f); const float dd = y[k] - mean; const float var = wave_sum_dpp(dd * dd) * (1.f / 64.f);
                      const float o = (dd * __builtin_amdgcn_rsqf(var + 64e-5f) * c_g + c_b + rk[k] * vv[k]) * ga[k];
                      YA[row * 1024 + h * 64 + i] = (bf16)pg8::cvt_pk_bf16(o, o); } }
            }
            STG_MARK(12);
        }
        if (PASS == 1) { int lz = lane; asm volatile("" : "+v"(lz));
            float* pd = PD + (size_t)it * 8192 + (4 * (lz >> 4)) * 128 + 16 * wave + (lz & 15);
#pragma unroll
            for (int jt = 0; jt < 4; ++jt)
#pragma unroll
                for (int r = 0; r < 4; ++r) pd[(16 * jt + r) * 128] = X[jt][r]; }
    }
#ifdef STGPROBE
    if (PASS == 3 && F.bid == 0 && F.tid == 0) { unsigned long long* ts_ = (unsigned long long*)(F.ws + WS_CTL + 8192); ts_[0] += stg_acc; }
#endif
}
#define R2_LOAD(SET_, ITEM) do { const f32x4* pd_ = (const f32x4*)(PD + (size_t)(ITEM) * 8192); _Pragma("unroll") for (int q = 0; q < 4; ++q) SET_[q] = pd_[F.tid + NTHREADS * q]; } while (0)
#define R2_STEP(SET_, SC) do { const size_t it_ = (size_t)F.bid * RNSC + (SC); \
    _Pragma("unroll") for (int q = 0; q < 4; ++q) { const int e = F.tid + NTHREADS * q; *(LAS f32x4*)(PL + (e >> 5) * 132 + (e & 31) * 4) = SET_[q]; } \
    if ((SC) + 2 < RNSC) R2_LOAD(SET_, it_ + 2); \
    LDSBAR(); \
    { float* so = SST + it_ * 4096; for (int e = F.tid; e < 1024; e += NTHREADS) { const int j = e >> 4, i4 = (e & 15) * 4; *(f32x4*)(so + j * 64 + i4) = *(const LAS f32x4*)(S + j * 68 + i4); } } \
    f32x4 acc[2]; float pc[16], sb[2][16]; \
    _Pragma("unroll") for (int q = 0; q < 2; ++q) _Pragma("unroll") for (int r = 0; r < 4; ++r) acc[q][r] = PL[(16 * jt + 4 * g + r) * 132 + 16 * (it0 + q) + c]; \
    _Pragma("unroll") for (int ks = 0; ks < 16; ++ks) { pc[ks] = PL[(16 * jt + c) * 132 + 64 + 4 * ks + g]; _Pragma("unroll") for (int q = 0; q < 2; ++q) sb[q][ks] = S[(4 * ks + g) * 68 + 16 * (it0 + q) + c]; } \
    _Pragma("unroll") for (int ks = 0; ks < 16; ++ks) { _Pragma("unroll") for (int q = 0; q < 2; ++q) acc[q] = __builtin_amdgcn_mfma_f32_16x16x4f32(pc[ks], sb[q][ks], acc[q], 0, 0, 0); } \
    LDSBAR(); \
    _Pragma("unroll") for (int q = 0; q < 2; ++q) _Pragma("unroll") for (int r = 0; r < 4; ++r) S[(16 * jt + 4 * g + r) * 68 + 16 * (it0 + q) + c] = acc[q][r]; \
    } while (0)
__device__ __forceinline__ void rwkv_pass2(Frame& F) {
    if (F.bid >= 32) return;
    const float* PD = (const float*)(F.ws + WS_SC); float* SST = (float*)(F.ws + WS_SC + 16 * MiB);
    LAS float* S = (LAS float*)F.lds; LAS float* PL = S + 64 * 68;
    const int lane = F.lane, wave = F.wave, g = lane >> 4, c = lane & 15, jt = wave >> 1, it0 = 2 * (wave & 1);
    for (int e = F.tid; e < 64 * 68; e += NTHREADS) S[e] = 0.f;
    f32x4 set0[4], set1[4];
    R2_LOAD(set0, (size_t)F.bid * RNSC); R2_LOAD(set1, (size_t)F.bid * RNSC + 1);
    for (int sc = 0; sc < RNSC; sc += 2) { R2_STEP(set0, sc); R2_STEP(set1, sc + 1); }
}
constexpr size_t WS_LSE = 330 * MiB;
constexpr int AT_KS = 0, AT_VS = 36864, AT_BIAS = 76032, AT_OST = 76800, KVST = 72;
__device__ __forceinline__ void attn_decode(int u, int& b, int& gatt, int& h, int& dil, int& r, int& n) {
    const int blk = u & 63; h = (u >> 6) & 7; const int bg = u >> 9; gatt = bg % 3; b = bg / 3;
    dil = (gatt == 0) ? 1 : (gatt == 1 ? 4 : 16); const int nblk = 64 / dil; r = blk / nblk; n = blk % nblk;
}
__device__ __forceinline__ u32x4 attn_kv_load(const bf16* QKV, int b, int gatt, int h, int dil, int r, int n, int i, int tid) {
    const int e = tid + NTHREADS * i, which = e >> 11, rowi = (e >> 3) & 255, chn = e & 7, lk = 128 * n - 128 + rowi; u32x4 v = (u32x4){0u, 0u, 0u, 0u};
    if (lk >= 0) v = *(const u32x4*)(QKV + (size_t)(b * SEQ + lk * dil + r) * NQKV + 1536 + which * 1536 + gatt * 512 + h * 64 + chn * 8);
    return v;
}
__device__ __forceinline__ void phase_attn_mfma(Frame& F) {
    bf16* QKV = (bf16*)(F.ws + WS_QKV); float* LSE = (float*)(F.ws + WS_LSE); const float* rel_bias = F.in[26];
    const int tid = F.tid, lane = F.lane, w = F.wave, g = lane >> 4, c = lane & 15, q4 = c >> 2, p4 = c & 3;
    LAS float* BIAS = (LAS float*)(F.lds + AT_BIAS);
    LAS bf16* OST = (LAS bf16*)(F.lds + AT_OST) + w * 16 * 72;
    for (int e = tid; e < 16 * KVST / 2; e += NTHREADS) ((LAS unsigned*)(F.lds + AT_VS + 256 * KVST * 2))[e] = 0u;
    int b, gatt, h, dil, r, n;
    u32x4 kv[8];
    if (F.bid < 3072) { attn_decode(F.bid, b, gatt, h, dil, r, n);
#pragma unroll
        for (int i = 0; i < 8; ++i) kv[i] = attn_kv_load(QKV, b, gatt, h, dil, r, n, i, tid); }
    for (int u = F.bid; u < 3072; u += F.G) {
        attn_decode(u, b, gatt, h, dil, r, n);
        LDSBAR();
        if (tid < 129) BIAS[tid] = rel_bias[(int)T5BUCKET[gatt][tid] * 24 + gatt * 8 + h];
        { int tz = tid; asm volatile("" : "+v"(tz));
#pragma unroll
          for (int i = 0; i < 8; ++i) { const int e = tz + NTHREADS * i, which = e >> 11, rowi = (e >> 3) & 255, chn = e & 7;
              *(LAS u32x4*)(F.lds + (which ? AT_VS : AT_KS) + (rowi * KVST + chn * 8) * 2) = kv[i]; } }
        const size_t qrow = (size_t)(b * SEQ + (128 * n + 16 * w + c) * dil + r);
        u32x4 qraw[2];
#pragma unroll
        for (int ks = 0; ks < 2; ++ks) qraw[ks] = *(const u32x4*)(QKV + qrow * NQKV + gatt * 512 + h * 64 + 32 * ks + 8 * g);
        if (u + F.G < 3072) { int b2, g2, h2, d2, r2, n2; attn_decode(u + F.G, b2, g2, h2, d2, r2, n2); int tz = tid; asm volatile("" : "+v"(tz));
#pragma unroll
            for (int i = 0; i < 8; ++i) kv[i] = attn_kv_load(QKV, b2, g2, h2, d2, r2, n2, i, tz); }
        bf16x8 qf[2];
#pragma unroll
        for (int ks = 0; ks < 2; ++ks) { const u32x4 v = qraw[ks]; u32x4 o;
            o.x = pk2(bflo(v.x) * 0.125f, bfhi(v.x) * 0.125f); o.y = pk2(bflo(v.y) * 0.125f, bfhi(v.y) * 0.125f); o.z = pk2(bflo(v.z) * 0.125f, bfhi(v.z) * 0.125f); o.w = pk2(bflo(v.w) * 0.125f, bfhi(v.w) * 0.125f);
            qf[ks] = __builtin_bit_cast(bf16x8, o); }
        LDSBAR();
        f32x4 S[9];
#pragma unroll
        for (int j = 0; j < 9; ++j) { const LAS unsigned char* kb = F.lds + AT_KS + ((16 * (w + j) + c) * KVST + 8 * g) * 2;
            f32x4 a = (f32x4){0.f, 0.f, 0.f, 0.f}; a = MFMA16(ld_b128(kb), qf[0], a); a = MFMA16(ld_b128(kb + 64), qf[1], a); S[j] = a; }
        float mx = -1e30f;
#pragma unroll
        for (int j = 0; j < 9; ++j)
#pragma unroll
            for (int rr = 0; rr < 4; ++rr) { const int delta = 128 - 16 * j + c - 4 * g - rr, ki = 16 * (w + j) + 4 * g + rr;
                const bool valid = (delta >= 0) && (delta <= 128) && (n > 0 || ki >= 128);
                const float s = valid ? S[j][rr] + BIAS[valid ? delta : 0] : -1e30f; S[j][rr] = s; mx = fmaxf(mx, s); }
        mx = fmaxf(mx, bperm_f(lane ^ 16, mx)); mx = fmaxf(mx, bperm_f(lane ^ 32, mx));
        float lsum = 0.f;
#pragma unroll
        for (int j = 0; j < 9; ++j)
#pragma unroll
            for (int rr = 0; rr < 4; ++rr) { const float p = (S[j][rr] > -1e29f) ? __expf(S[j][rr] - mx) : 0.f; S[j][rr] = p; lsum += p; }
        lsum += bperm_f(lane ^ 16, lsum); lsum += bperm_f(lane ^ 32, lsum);
        f32x4 O[4];
#pragma unroll
        for (int dt = 0; dt < 4; ++dt) O[dt] = (f32x4){0.f, 0.f, 0.f, 0.f};
#pragma unroll
        for (int m5 = 0; m5 < 5; ++m5) { const f32x4 z4 = (f32x4){0.f, 0.f, 0.f, 0.f};
            const bf16x8 pf = pack8(S[2 * m5], (2 * m5 + 1 < 9) ? S[(2 * m5 + 1 < 9) ? 2 * m5 + 1 : 0] : z4);
            const LAS unsigned char* vb = F.lds + AT_VS + ((16 * (w + 2 * m5) + 4 * g + q4) * KVST + 4 * p4) * 2;
#pragma unroll
            for (int dt = 0; dt < 4; ++dt) O[dt] = MFMA16(pf, cat8(ld_tr(vb + dt * 32), ld_tr(vb + dt * 32 + 16 * KVST * 2)), O[dt]); }
        const float linv = __builtin_amdgcn_rcpf(lsum);
        if (g == 0) LSE[qrow * 24 + gatt * 8 + h] = mx + __logf(lsum);
#pragma unroll
        for (int rr = 0; rr < 4; ++rr) { const float li = bperm_f(4 * g + rr, linv);
#pragma unroll
            for (int dt = 0; dt < 4; ++dt) OST[(4 * g + rr) * 72 + 16 * dt + c] = (bf16)pk2(O[dt][rr] * li, 0.f); }
#pragma unroll
        for (int i = 0; i < 2; ++i) { const int row = i * 8 + (lane >> 3), ch = lane & 7; const u32x4 v = *(const LAS u32x4*)(OST + row * 72 + ch * 8);
            *(u32x4*)(QKV + (size_t)(b * SEQ + (128 * n + 16 * w + row) * dil + r) * NQKV + gatt * 512 + h * 64 + ch * 8) = v; }
    }
}
__device__ __forceinline__ void phase_attn_merge(Frame& F) {
    const bf16* QKV = (const bf16*)(F.ws + WS_QKV); const float* LSE = (const float*)(F.ws + WS_LSE); bf16* YB = (bf16*)(F.ws + WS_YB);
    const size_t gt = (size_t)F.bid * NTHREADS + F.tid, NGT = (size_t)F.G * NTHREADS;
    for (size_t e = gt; e < (size_t)MROWS * 64; e += NGT) { const size_t row = e >> 6; const int h = (int)(e >> 3) & 7, d8 = (int)e & 7;
        const float l0 = LSE[row * 24 + h], l1 = LSE[row * 24 + 8 + h], l2 = LSE[row * 24 + 16 + h]; const float m = fmaxf(l0, fmaxf(l1, l2));
        float w0 = __expf(l0 - m), w1 = __expf(l1 - m), w2 = __expf(l2 - m); const float inv = 1.f / (w0 + w1 + w2); w0 *= inv; w1 *= inv; w2 *= inv;
        const bf16* qp = QKV + row * NQKV + h * 64 + d8 * 8;
        const u32x4 a = *(const u32x4*)qp, bq = *(const u32x4*)(qp + 512), cq = *(const u32x4*)(qp + 1024); u32x4 o;
        o.x = pk2(w0 * bflo(a.x) + w1 * bflo(bq.x) + w2 * bflo(cq.x), w0 * bfhi(a.x) + w1 * bfhi(bq.x) + w2 * bfhi(cq.x));
        o.y = pk2(w0 * bflo(a.y) + w1 * bflo(bq.y) + w2 * bflo(cq.y), w0 * bfhi(a.y) + w1 * bfhi(bq.y) + w2 * bfhi(cq.y));
        o.z = pk2(w0 * bflo(a.z) + w1 * bflo(bq.z) + w2 * bflo(cq.z), w0 * bfhi(a.z) + w1 * bfhi(bq.z) + w2 * bfhi(cq.z));
        o.w = pk2(w0 * bflo(a.w) + w1 * bflo(bq.w) + w2 * bflo(cq.w), w0 * bfhi(a.w) + w1 * bfhi(bq.w) + w2 * bfhi(cq.w));
        *(u32x4*)(YB + row * 512 + h * 64 + d8 * 8) = o; }
}
#define GEMM_LDS ((PG8_LAS unsigned char*)F.lds)
template <class Epi> __device__ __forceinline__ void run_gemm(Frame& F, const bf16* A, const bf16* Bt, int N, int K, const Epi& E) {
    pg8::Gemm g{A, Bt, MROWS, N, K}; pg8::StaticOrder S; S.init(MROWS, N, F.G, F.bid);
    pg8::gemm_phase<Epi, pg8::StaticOrder, true, true>(GEMM_LDS, g, S, E, F.tid);
}
#ifdef TPROBE
#define STAMP(cls) do { if (blockIdx.x == 0 && (cur_tid(wv)) == 0) { unsigned long long* ts_ = (unsigned long long*)(ka->ws + WS_CTL + 4096); const unsigned long long t_ = __builtin_amdgcn_s_memrealtime(); ts_[1 + (cls)] += t_ - ts_[0]; ts_[0] = t_; } } while (0)
#else
#define STAMP(cls) do {} while (0)
#endif
#ifndef PROBE_DUP
#define PROBE_DUP 0
#endif
#ifdef USE_CG_SYNC
#define GSYNC(cls) do { grid.sync(); STAMP(cls); } while (0)
#else
#define GSYNC(cls) do { xcd_barrier(xbar, cur_tid(wv)); STAMP(cls); } while (0)
#endif
struct PairOrder {
    pg8::StaticOrder base;
    __device__ bool next(int i, pg8::Unit& u) const { if (i >= 2) return false; pg8::Unit u0; if (!base.next(0, u0)) return false; u.pm = u0.pm; u.pn = u0.pn + 4 * i; return true; }
    __device__ __forceinline__ void a_ready(const pg8::Unit&) const {}
    __device__ __forceinline__ void done(const pg8::Unit&) const {}
};
__global__ void __launch_bounds__(NTHREADS, 2) fwd_kernel(Args a) {
    extern __shared__ __attribute__((aligned(16))) unsigned char lds[];
    cg::grid_group grid = cg::this_grid();
    const int wv = __builtin_amdgcn_readfirstlane((int)threadIdx.x >> 6);
    const KArgs ka = (KArgs)__builtin_amdgcn_kernarg_segment_ptr();
#ifdef TPROBE
    if (blockIdx.x == 0 && (cur_tid(wv)) == 0) { unsigned long long* ts_ = (unsigned long long*)(ka->ws + WS_CTL + 4096); for (int i = 1; i < 16; ++i) ts_[i] = 0ull; ts_[0] = __builtin_amdgcn_s_memrealtime(); }
#endif
    { const int t0_ = cur_tid(wv); if (t0_ < 16) ((LAS unsigned*)lds)[(LDS_BYTES - 64) / 4 + t0_] = 0u; }
    __syncthreads();
    XcdBarrier xbar = xcd_barrier_post((unsigned*)(ka->ws + WS_CTL + 65536), (volatile LAS unsigned*)((LAS unsigned char*)lds + LDS_BYTES - 64), cur_tid(wv));
    { Frame F; make_frame(F, ka, lds, wv); p0_mod(F); p0_weights(F); }
#if PROBE_DUP == 7
    __syncthreads();
    { Frame F; make_frame(F, ka, lds, wv); p0_mod(F); p0_weights(F); }
#endif
    grid.sync(); STAMP(0);
    for (int l = 0; l < 2; ++l) {
        { Frame F; make_frame(F, ka, lds, wv); phase_modnorm(F, l, (l == 0) ? F.in[0] : F.out); }
#if PROBE_DUP == 8
        __syncthreads();
        { Frame F; make_frame(F, ka, lds, wv); phase_modnorm(F, l, (l == 0) ? F.in[0] : F.out); }
#endif
        GSYNC(1);
        { Frame F; make_frame(F, ka, lds, wv); run_gemm(F, (const bf16*)(F.ws + WS_XN), (const bf16*)(F.ws + WS_WQKV) + (size_t)l * NQKV * 1024, NQKV, 1024, pg8::EpiStore{(bf16*)(F.ws + WS_QKV), NQKV}); }
        GSYNC(2);
#if PROBE_DUP == 1
        { Frame F; make_frame(F, ka, lds, wv); run_gemm(F, (const bf16*)(F.ws + WS_XN), (const bf16*)(F.ws + WS_WQKV) + (size_t)l * NQKV * 1024, NQKV, 1024, pg8::EpiStore{(bf16*)(F.ws + WS_QKV), NQKV}); }
        GSYNC(2);
#endif
#ifdef ATTN_NAIVE
        { Frame F; make_frame(F, ka, lds, wv); phase_attn_naive(F); }
        GSYNC(3);
#else
        { Frame F; make_frame(F, ka, lds, wv); phase_attn_mfma(F); }
        GSYNC(3);
        { Frame F; make_frame(F, ka, lds, wv); phase_attn_merge(F); }
        GSYNC(4);
#if PROBE_DUP == 2
        { Frame F; make_frame(F, ka, lds, wv); run_gemm(F, (const bf16*)(F.ws + WS_XN), (const bf16*)(F.ws + WS_WQKV) + (size_t)l * NQKV * 1024, NQKV, 1024, pg8::EpiStore{(bf16*)(F.ws + WS_QKV), NQKV}); }
        GSYNC(2);
        { Frame F; make_frame(F, ka, lds, wv); phase_attn_mfma(F); }
        GSYNC(3);
        { Frame F; make_frame(F, ka, lds, wv); phase_attn_merge(F); }
        GSYNC(4);
#endif
#endif
        { Frame F; make_frame(F, ka, lds, wv); run_gemm(F, (const bf16*)(F.ws + WS_XN), (const bf16*)(F.ws + WS_WA) + (size_t)l * NAG * 1024, NAG, 1024, pg8::EpiD{(bf16*)(F.ws + WS_PA), (bf16*)(F.ws + WS_GA), (bf16*)(F.ws + WS_YB)}); }
        GSYNC(2);
#ifdef RWKV_NAIVE
        { Frame F; make_frame(F, ka, lds, wv); phase_rwkv_naive(F, l); }
        GSYNC(5);
#else
        { Frame F; make_frame(F, ka, lds, wv); rwkv_pass<1>(F, l); }
        GSYNC(5);
#if PROBE_DUP == 3
        { Frame F; make_frame(F, ka, lds, wv); rwkv_pass<1>(F, l); }
        GSYNC(5);
#endif
        { Frame F; make_frame(F, ka, lds, wv); rwkv_pass2(F); }
        GSYNC(6);
#if PROBE_DUP == 6
        { Frame F; make_frame(F, ka, lds, wv); rwkv_pass2(F); }
        GSYNC(6);
#endif
        { Frame F; make_frame(F, ka, lds, wv); rwkv_pass<3>(F, l); }
        GSYNC(7);
#if PROBE_DUP == 4
        { Frame F; make_frame(F, ka, lds, wv); rwkv_pass<3>(F, l); }
        GSYNC(7);
#endif
#if PROBE_DUP == 5
        for (int q_ = 0; q_ < 10; ++q_) grid.sync();
#endif
#endif
        { Frame F; make_frame(F, ka, lds, wv); pg8::Gemm g{(const bf16*)(F.ws + WS_XN), (const bf16*)(F.ws + WS_WM) + (size_t)l * 2048 * 1024, MROWS, 2048, 1024}; PairOrder S; S.base.init(MROWS, 1024, F.G, F.bid);
          pg8::gemm_phase<pg8::EpiSig, PairOrder, true, true>(GEMM_LDS, g, S, pg8::EpiSig{(bf16*)(F.ws + WS_MG), 0}, F.tid); }
        { Frame F; make_frame(F, ka, lds, wv); run_gemm(F, (const bf16*)(F.ws + WS_YA), (const bf16*)(F.ws + WS_WBA) + (size_t)l * 1024 * 1024, 1024, 1024, pg8::EpiMerge<false>{(bf16*)(F.ws + WS_MERGED), (const bf16*)(F.ws + WS_MG)}); }
        { Frame F; make_frame(F, ka, lds, wv); run_gemm(F, (const bf16*)(F.ws + WS_YB), (const bf16*)(F.ws + WS_WBB) + (size_t)l * 1024 * 512, 1024, 512, pg8::EpiMerge<true>{(bf16*)(F.ws + WS_MERGED), (const bf16*)(F.ws + WS_MG)}); }
        GSYNC(2);
        { Frame F; make_frame(F, ka, lds, wv); run_gemm(F, (const bf16*)(F.ws + WS_MERGED), (const bf16*)(F.ws + WS_WO) + (size_t)l * 1024 * 1024, 1024, 1024,
              pg8::EpiResid{(l == 0) ? F.in[0] : F.out, F.out, (const float*)(F.ws + WS_MOD) + (size_t)l * 2 * 3072 + 2048}); }
        GSYNC(2);
    }
    { Frame F; make_frame(F, ka, lds, wv); phase_final(F); }
#ifdef STGPROBE
    if (blockIdx.x == 0 && cur_tid(wv) == 0) { const unsigned long long* ts_ = (const unsigned long long*)(ka->ws + WS_CTL + 8192); ka->out[0] = (float)ts_[0] * 0.01f; }
#endif
#ifdef TPROBE
    if (blockIdx.x == 0 && (cur_tid(wv)) == 0) { STAMP(8); const unsigned long long* ts_ = (const unsigned long long*)(ka->ws + WS_CTL + 4096); ka->out[0] = (float)ts_[1 + TPROBE] * 0.01f; }
#endif
}
extern "C" void kernel_launch(void* const* d_in, const int* in_sizes, int n_in, void* d_out, int out_size, void* d_ws, size_t ws_size, hipStream_t stream) {
    static int grid = 0;
    if (grid == 0) {
        int dev = 0, cus = 0, per_cu = 0;
        (void)hipGetDevice(&dev); (void)hipDeviceGetAttribute(&cus, hipDeviceAttributeMultiprocessorCount, dev);
        (void)hipFuncSetAttribute((const void*)fwd_kernel, hipFuncAttributeMaxDynamicSharedMemorySize, LDS_BYTES);
        (void)hipOccupancyMaxActiveBlocksPerMultiprocessor(&per_cu, (const void*)fwd_kernel, NTHREADS, LDS_BYTES);
        if (n_in != 28 || out_size != MROWS * DM || ws_size < (size_t)352 * MiB || per_cu < 1) { fprintf(stderr, "kernel_launch: unexpected problem (n_in %d out %d ws %zu per_cu %d)\n", n_in, out_size, ws_size, per_cu); }
        grid = cus;
        (void)hipGetLastError();
    }
    (void)hipMemsetAsync((char*)d_ws + WS_CTL, 0, 1 * MiB, stream);
    Args a{};
    for (int i = 0; i < 28; ++i) a.in[i] = (const float*)d_in[i];
    a.out = (float*)d_out; a.ws = (unsigned char*)d_ws;
    void* args[] = {&a};
    hipError_t e = hipLaunchCooperativeKernel((void*)fwd_kernel, dim3(grid), dim3(NTHREADS), args, LDS_BYTES, stream);
    if (e != hipSuccess) fprintf(stderr, "cooperative launch failed: %s (grid %d)\n", hipGetErrorString(e), grid);
}
```

```cpp
#include <hip/hip_runtime.h>
#include <hip/hip_cooperative_groups.h>
#include <cstdio>
#include <cstdint>
namespace cg = cooperative_groups;
namespace pg8 {
#define PG8_LAS __attribute__((address_space(3)))
typedef unsigned short bf16_t;
typedef short bf16x8 __attribute__((ext_vector_type(8)));
typedef float f32x4 __attribute__((ext_vector_type(4)));
typedef unsigned u32x4 __attribute__((ext_vector_type(4)));
constexpr int BM = 256, BK = 64, HALF = 128, HTB = HALF * BK * 2  , STAGE_BYTES = 8 * HTB, NXCD = 8, WGM = 8;

__host__ __device__ __forceinline__ int lds_byte(int r, int c) { const int st = (r >> 4) * 2 + (c >> 5), rr = r & 15, cc = c & 31, ob = rr * 64 + cc * 2; return st * 1024 + (ob ^ (((ob >> 9) & 1) << 5)); }
__host__ __device__ __forceinline__ void stage_rc(int b, int& R, int& C) { const int st = b / 1024, sb = b % 1024, swz = sb ^ (((sb >> 9) & 1) << 5); R = (st >> 1) * 16 + swz / 64; C = (st & 1) * 32 + (swz % 64) / 2; }
__host__ __device__ __forceinline__ int perm32(int rho) { const int n = rho >> 4, i = rho & 15; return 8 * (i >> 2) + 4 * n + (i & 3); }

struct Unit { int pm, pn; };
struct Gemm { const bf16_t* A; const bf16_t* Bt; int M, N, K; };

struct StaticOrder {
    int nM, nN, nwg, G, c;
    __host__ __device__ void init(int M, int N, int G_, int c_) { nM = M / BM; nN = N / BM; nwg = nM * nN; G = G_; c = c_; }
    __host__ __device__ bool next(int i, Unit& u) const {
        const long L = (long)i * G + c; if (L >= nwg) return false;
        int wgid = (int)L; { const int q = nwg / NXCD, r = nwg % NXCD, xcd = wgid % NXCD, off = wgid / NXCD; wgid = (xcd < r ? xcd * (q + 1) : r * (q + 1) + (xcd - r) * q) + off; }
        const int nig = WGM * nN, gid = wgid / nig, fm = gid * WGM, gsz = (nM - fm) < WGM ? (nM - fm) : WGM;
        u.pm = fm + ((wgid % nig) % gsz); u.pn = (wgid % nig) / gsz; return true;
    }
    __device__ __forceinline__ void a_ready(const Unit&) const {}
    __device__ __forceinline__ void done(const Unit&) const {}
};

typedef float f32x2c_t __attribute__((ext_vector_type(2))); typedef __bf16 bf16x2c_t __attribute__((ext_vector_type(2)));
__device__ __forceinline__ unsigned cvt_pk_bf16(float lo, float hi) { const f32x2c_t v = {lo, hi}; const bf16x2c_t b = __builtin_convertvector(v, bf16x2c_t); return __builtin_bit_cast(unsigned, b); }
typedef float f32x2 __attribute__((ext_vector_type(2)));
template <class Epi, class Sched, bool ALIGN_EPI = false, bool SP2 = false>
__device__ __forceinline__ void gemm_phase(PG8_LAS unsigned char* lds, const Gemm g, const Sched& S, const Epi& E, int tid_in) {
    int tid_ = tid_in; asm volatile("" : "+v"(tid_));
    const int tid = tid_, wid = __builtin_amdgcn_readfirstlane(tid >> 6), lane = tid & 63, wr = wid >> 2, wc = wid & 3, fr = lane & 15, fq = lane >> 4;
    const int K = g.K, nt = K / BK;
    unsigned voffA[2], voffB[2];
#pragma unroll
    for (int i = 0; i < 2; ++i) { int R, C; stage_rc(tid * 16 + i * 8192, R, C); const int Rb = Epi::PERM ? ((R & ~31) + perm32(R & 31)) : R;
        voffA[i] = (unsigned)(R * K + C) * 2u; voffB[i] = (unsigned)(Rb * K + C) * 2u; }
    const size_t kstep = (size_t)(BK * 2);
    const size_t hstep = (size_t)HALF * K * 2;
    const size_t tstep = 2 * hstep;
    const unsigned ldsw = (unsigned)wid * 1024u;
    const int aoff = lds_byte(wr * 64 + fr, fq * 8), boff = lds_byte(wc * 32 + fr, fq * 8);
#define PG8_SA(b, h) (((b) * 2 + (h)) * HTB)
#define PG8_SB(b, h) ((4 + (b) * 2 + (h)) * HTB)
#define PG8_STAGE(bufoff, gbase, voff) do { _Pragma("unroll") for (int _i = 0; _i < 2; ++_i) \
        __builtin_amdgcn_global_load_lds((const unsigned*)((const char*)(gbase) + (voff)[_i]), (PG8_LAS unsigned*)(lds + (bufoff) + ldsw + _i * 8192), 16, 0, 0); } while (0)
#define PG8_LDA(dst, b, h) do { _Pragma("unroll") for (int m = 0; m < 4; ++m) _Pragma("unroll") for (int k = 0; k < 2; ++k) dst[m][k] = *(const PG8_LAS bf16x8*)(lds + PG8_SA(b, h) + aoff + m * 2048 + k * 1024); } while (0)
#define PG8_LDB(dst, b, h) do { _Pragma("unroll") for (int n = 0; n < 2; ++n) _Pragma("unroll") for (int k = 0; k < 2; ++k) dst[n][k] = *(const PG8_LAS bf16x8*)(lds + PG8_SB(b, h) + boff + n * 2048 + k * 1024); } while (0)
#define PG8_MMA(ai, bj, At, Bt) do { __builtin_amdgcn_s_setprio(1); _Pragma("unroll") for (int m = 0; m < 4; ++m) _Pragma("unroll") for (int n = 0; n < 2; ++n) _Pragma("unroll") for (int k = 0; k < 2; ++k) \
        acc[ai][bj][m][n] = __builtin_amdgcn_mfma_f32_16x16x32_bf16(Bt[n][k], At[m][k], acc[ai][bj][m][n], 0, 0, 0); __builtin_amdgcn_s_setprio(0); } while (0)
#define PG8_WAIT_V(n) asm volatile("s_waitcnt vmcnt(" #n ")" ::: "memory")
#define PG8_WAIT_L(n) asm volatile("s_waitcnt lgkmcnt(" #n ")" ::: "memory")
#define PG8_BAR __builtin_amdgcn_s_barrier()
#define PG8_SCHED __builtin_amdgcn_sched_barrier(0)
    Unit cur, nxt; int ui = 0;
    if (!S.next(0, cur)) return;
    f32x4 acc[2][2][4][2];
#pragma unroll
    for (int a = 0; a < 2; ++a)
#pragma unroll
        for (int b = 0; b < 2; ++b)
#pragma unroll
            for (int m = 0; m < 4; ++m)
#pragma unroll
                for (int n = 0; n < 2; ++n) acc[a][b][m][n] = (f32x4){0.f, 0.f, 0.f, 0.f};
    bf16x8 At[4][2], B0[2][2], B1[2][2];
    const char* cA = (const char*)g.A + (size_t)cur.pm * tstep; const char* cB = (const char*)g.Bt + (size_t)cur.pn * tstep;
    S.a_ready(cur);
    if constexpr (SP2) {
        PG8_STAGE(PG8_SB(0, 0), cB, voffB); PG8_STAGE(PG8_SB(0, 1), cB + hstep, voffB); PG8_STAGE(PG8_SA(0, 0), cA, voffA); PG8_STAGE(PG8_SA(0, 1), cA + hstep, voffA);
        if (wr == 1) PG8_BAR;
        PG8_WAIT_V(2); PG8_BAR;
        PG8_STAGE(PG8_SB(1, 0), cB + kstep, voffB); PG8_STAGE(PG8_SA(1, 0), cA + kstep, voffA); PG8_STAGE(PG8_SB(1, 1), cB + hstep + kstep, voffB);
        PG8_WAIT_V(6); PG8_BAR;
    } else {
        PG8_STAGE(PG8_SB(0, 0), cB, voffB); PG8_STAGE(PG8_SA(0, 0), cA, voffA); PG8_STAGE(PG8_SB(0, 1), cB + hstep, voffB); PG8_STAGE(PG8_SA(0, 1), cA + hstep, voffA);
        if (wr == 1) PG8_BAR;
        PG8_WAIT_V(4); PG8_BAR;
        PG8_STAGE(PG8_SB(1, 0), cB + kstep, voffB); PG8_STAGE(PG8_SA(1, 0), cA + kstep, voffA); PG8_STAGE(PG8_SB(1, 1), cB + hstep + kstep, voffB);
        PG8_WAIT_V(6); PG8_BAR;
    }
    for (;;) {
        const bool has_next = S.next(ui + 1, nxt);
        const char* nA = has_next ? (const char*)g.A + (size_t)nxt.pm * tstep : cA; const char* nB = has_next ? (const char*)g.Bt + (size_t)nxt.pn * tstep : cB;
        for (int t = 0; t < nt; t += 2) {
            const bool last = (t == nt - 2);
            const char* a1 = cA + (size_t)(t + 1) * kstep;
            const char* a2 = last ? nA : cA + (size_t)(t + 2) * kstep; const char* b2 = last ? nB : cB + (size_t)(t + 2) * kstep;
            const char* a3 = a2 + kstep; const char* b3 = b2 + kstep;
            if (last && has_next) S.a_ready(nxt);
            if constexpr (SP2) {
            PG8_LDB(B0, 0, 0); PG8_LDB(B1, 0, 1); PG8_SCHED; PG8_LDA(At, 0, 0); PG8_STAGE(PG8_SA(1, 1), a1 + hstep, voffA);
            PG8_WAIT_V(8); PG8_WAIT_L(0); PG8_BAR; PG8_MMA(0, 0, At, B0); PG8_MMA(0, 1, At, B1); PG8_BAR; PG8_SCHED;
            PG8_LDA(At, 0, 1); PG8_STAGE(PG8_SB(0, 0), b2, voffB); PG8_STAGE(PG8_SB(0, 1), b2 + hstep, voffB); PG8_STAGE(PG8_SA(0, 0), a2, voffA);
            PG8_WAIT_V(8); PG8_WAIT_L(0); PG8_BAR; PG8_MMA(1, 0, At, B0); PG8_MMA(1, 1, At, B1); PG8_BAR; PG8_SCHED;
            PG8_LDB(B0, 1, 0); PG8_LDB(B1, 1, 1); PG8_SCHED; PG8_LDA(At, 1, 0); PG8_STAGE(PG8_SA(0, 1), a2 + hstep, voffA);
            PG8_WAIT_V(8); PG8_WAIT_L(0); PG8_BAR; PG8_MMA(0, 0, At, B0); PG8_MMA(0, 1, At, B1); PG8_BAR; PG8_SCHED;
            PG8_LDA(At, 1, 1); PG8_STAGE(PG8_SB(1, 0), b3, voffB); PG8_STAGE(PG8_SB(1, 1), b3 + hstep, voffB); PG8_STAGE(PG8_SA(1, 0), a3, voffA);
            PG8_WAIT_V(8); PG8_WAIT_L(0); PG8_BAR; PG8_MMA(1, 0, At, B0); PG8_MMA(1, 1, At, B1); PG8_BAR; PG8_SCHED;
            } else {
            PG8_LDB(B0, 0, 0); PG8_SCHED; PG8_LDA(At, 0, 0); PG8_STAGE(PG8_SA(1, 1), a1 + hstep, voffA);
            PG8_WAIT_L(8); PG8_BAR; PG8_WAIT_L(0); PG8_MMA(0, 0, At, B0); PG8_BAR; PG8_SCHED;
            PG8_LDB(B1, 0, 1); PG8_STAGE(PG8_SB(0, 0), b2, voffB);
            PG8_BAR; PG8_WAIT_L(0); PG8_MMA(0, 1, At, B1); PG8_BAR;
            PG8_LDA(At, 0, 1); PG8_STAGE(PG8_SA(0, 0), a2, voffA);
            PG8_BAR; PG8_WAIT_L(0); PG8_MMA(1, 0, At, B0); PG8_BAR; PG8_SCHED;
            PG8_STAGE(PG8_SB(0, 1), b2 + hstep, voffB);
            PG8_WAIT_V(6); PG8_BAR; PG8_MMA(1, 1, At, B1); PG8_BAR;
            PG8_LDB(B0, 1, 0); PG8_SCHED; PG8_LDA(At, 1, 0); PG8_STAGE(PG8_SA(0, 1), a2 + hstep, voffA);
            PG8_WAIT_L(8); PG8_BAR; PG8_WAIT_L(0); PG8_MMA(0, 0, At, B0); PG8_BAR; PG8_SCHED;
            PG8_LDB(B1, 1, 1); PG8_STAGE(PG8_SB(1, 0), b3, voffB);
            PG8_BAR; PG8_WAIT_L(0); PG8_MMA(0, 1, At, B1); PG8_BAR;
            PG8_LDA(At, 1, 1); PG8_STAGE(PG8_SA(1, 0), a3, voffA);
            PG8_BAR; PG8_WAIT_L(0); PG8_MMA(1, 0, At, B0); PG8_BAR; PG8_SCHED;
            PG8_STAGE(PG8_SB(1, 1), b3 + hstep, voffB);
            PG8_WAIT_V(6); PG8_BAR; PG8_MMA(1, 1, At, B1); PG8_BAR;
            }
        }
        if constexpr (ALIGN_EPI) { if (wr == 0) PG8_BAR; }
        if constexpr (!Epi::AFTER_DRAIN) { E(acc, cur, wr, wc, fr, fq); S.done(cur); }
        if (!has_next) break;
#pragma unroll
        for (int a = 0; a < 2; ++a)
#pragma unroll
            for (int b = 0; b < 2; ++b)
#pragma unroll
                for (int m = 0; m < 4; ++m)
#pragma unroll
                    for (int n = 0; n < 2; ++n) acc[a][b][m][n] = (f32x4){0.f, 0.f, 0.f, 0.f};
        cur = nxt; cA = nA; cB = nB; ++ui;
        if constexpr (ALIGN_EPI) { if (wr == 1) PG8_BAR; }
    }
    PG8_WAIT_V(0);
    if constexpr (!ALIGN_EPI) { if (wr == 0) PG8_BAR; }
    PG8_BAR;
    if constexpr (Epi::AFTER_DRAIN) { E.fused(acc, cur, wr, wc, fr, fq, lds, wid, lane); S.done(cur); }
#undef PG8_SA
#undef PG8_SB
#undef PG8_STAGE
#undef PG8_LDA
#undef PG8_LDB
#undef PG8_MMA
#undef PG8_WAIT_V
#undef PG8_WAIT_L
#undef PG8_BAR
#undef PG8_SCHED
}
}
namespace pg8 {
__device__ __forceinline__ float ep_bflo(unsigned w) { return __uint_as_float(w << 16); }
__device__ __forceinline__ float ep_bfhi(unsigned w) { return __uint_as_float(w & 0xffff0000u); }
__device__ __forceinline__ float ep_sigmoid(float x) { return 1.f / (1.f + __expf(-x)); }
struct EpiStore {
    static constexpr bool PERM = true, AFTER_DRAIN = false;
    bf16_t* O; int ldc;
    __device__ __forceinline__ void operator()(const f32x4 (&acc)[2][2][4][2], const Unit& u, int wr, int wc, int fr, int fq) const {
        const int row0 = u.pm * BM + wr * 64 + fr, col0 = u.pn * BM + wc * 32 + 8 * fq;
#pragma unroll
        for (int ai = 0; ai < 2; ++ai)
#pragma unroll
            for (int m = 0; m < 4; ++m) { bf16_t* rowp = O + (size_t)(row0 + ai * HALF + m * 16) * ldc + col0;
#pragma unroll
                for (int bj = 0; bj < 2; ++bj) { const f32x4 v0 = acc[ai][bj][m][0], v1 = acc[ai][bj][m][1]; u32x4 w;
                    w.x = cvt_pk_bf16(v0[0], v0[1]); w.y = cvt_pk_bf16(v0[2], v0[3]); w.z = cvt_pk_bf16(v1[0], v1[1]); w.w = cvt_pk_bf16(v1[2], v1[3]);
                    *(u32x4*)(rowp + bj * HALF) = w; } }
    }
};
struct EpiD {
    static constexpr bool PERM = true, AFTER_DRAIN = false;
    bf16_t* PA; bf16_t* GA; bf16_t* YB;
    __device__ __forceinline__ void operator()(const f32x4 (&acc)[2][2][4][2], const Unit& u, int wr, int wc, int fr, int fq) const {
        const int colt = u.pn * BM; int mode, ld, cb; bf16_t* P;
        if (colt < 3584) { mode = 0; P = PA; ld = 3584; cb = colt; } else if (colt < 4608) { mode = 1; P = GA; ld = 1024; cb = colt - 3584; } else { mode = 2; P = YB; ld = 512; cb = colt - 4608; }
        const int row0 = u.pm * BM + wr * 64 + fr, col0 = cb + wc * 32 + 8 * fq;
#pragma unroll
        for (int ai = 0; ai < 2; ++ai)
#pragma unroll
            for (int m = 0; m < 4; ++m) { bf16_t* rowp = P + (size_t)(row0 + ai * HALF + m * 16) * ld + col0;
#pragma unroll
                for (int bj = 0; bj < 2; ++bj) { const f32x4 v0 = acc[ai][bj][m][0], v1 = acc[ai][bj][m][1]; float g[8] = {v0[0], v0[1], v0[2], v0[3], v1[0], v1[1], v1[2], v1[3]};
                    if (mode == 1) {
#pragma unroll
                        for (int e = 0; e < 8; ++e) g[e] = g[e] * ep_sigmoid(g[e]);
                    } else if (mode == 2) {
                        const u32x4 y = *(const u32x4*)(rowp + bj * HALF);
                        const float yv[8] = {ep_bflo(y.x), ep_bfhi(y.x), ep_bflo(y.y), ep_bfhi(y.y), ep_bflo(y.z), ep_bfhi(y.z), ep_bflo(y.w), ep_bfhi(y.w)};
#pragma unroll
                        for (int e = 0; e < 8; ++e) g[e] = yv[e] * g[e] * ep_sigmoid(g[e]);
                    }
                    u32x4 w; w.x = cvt_pk_bf16(g[0], g[1]); w.y = cvt_pk_bf16(g[2], g[3]); w.z = cvt_pk_bf16(g[4], g[5]); w.w = cvt_pk_bf16(g[6], g[7]);
                    *(u32x4*)(rowp + bj * HALF) = w; } }
    }
};
struct EpiSig {
    static constexpr bool PERM = true, AFTER_DRAIN = false;
    bf16_t* MG; int coff;
    __device__ __forceinline__ void operator()(const f32x4 (&acc)[2][2][4][2], const Unit& u, int wr, int wc, int fr, int fq) const {
        const int row0 = u.pm * BM + wr * 64 + fr, col0 = coff + u.pn * BM + wc * 32 + 8 * fq;
#pragma unroll
        for (int ai = 0; ai < 2; ++ai)
#pragma unroll
            for (int m = 0; m < 4; ++m) { bf16_t* rowp = MG + (size_t)(row0 + ai * HALF + m * 16) * 2048 + col0;
#pragma unroll
                for (int bj = 0; bj < 2; ++bj) { const f32x4 v0 = acc[ai][bj][m][0], v1 = acc[ai][bj][m][1]; u32x4 w;
                    w.x = cvt_pk_bf16(ep_sigmoid(v0[0]), ep_sigmoid(v0[1])); w.y = cvt_pk_bf16(ep_sigmoid(v0[2]), ep_sigmoid(v0[3])); w.z = cvt_pk_bf16(ep_sigmoid(v1[0]), ep_sigmoid(v1[1])); w.w = cvt_pk_bf16(ep_sigmoid(v1[2]), ep_sigmoid(v1[3]));
                    *(u32x4*)(rowp + bj * HALF) = w; } }
    }
};
template <bool SECOND> struct EpiMerge {
    static constexpr bool PERM = true, AFTER_DRAIN = false;
    bf16_t* MERGED; const bf16_t* MG;
    __device__ __forceinline__ void operator()(const f32x4 (&acc)[2][2][4][2], const Unit& u, int wr, int wc, int fr, int fq) const {
        const int row0 = u.pm * BM + wr * 64 + fr, col0 = u.pn * BM + wc * 32 + 8 * fq;
#pragma unroll
        for (int ai = 0; ai < 2; ++ai)
#pragma unroll
            for (int m = 0; m < 4; ++m) { const size_t r = (size_t)(row0 + ai * HALF + m * 16);
#pragma unroll
                for (int bj = 0; bj < 2; ++bj) { const f32x4 v0 = acc[ai][bj][m][0], v1 = acc[ai][bj][m][1]; float g[8] = {v0[0], v0[1], v0[2], v0[3], v1[0], v1[1], v1[2], v1[3]};
                    const int c = col0 + bj * HALF;
                    const u32x4 s = *(const u32x4*)(MG + r * 2048 + (SECOND ? 1024 : 0) + c);
                    const float sv[8] = {ep_bflo(s.x), ep_bfhi(s.x), ep_bflo(s.y), ep_bfhi(s.y), ep_bflo(s.z), ep_bfhi(s.z), ep_bflo(s.w), ep_bfhi(s.w)};
                    bf16_t* dst = MERGED + r * 1024 + c;
                    if (SECOND) { const u32x4 p = *(const u32x4*)dst;
                        const float pv[8] = {ep_bflo(p.x), ep_bfhi(p.x), ep_bflo(p.y), ep_bfhi(p.y), ep_bflo(p.z), ep_bfhi(p.z), ep_bflo(p.w), ep_bfhi(p.w)};
#pragma unroll
                        for (int e = 0; e < 8; ++e) g[e] = pv[e] + sv[e] * g[e];
                    } else {
#pragma unroll
                        for (int e = 0; e < 8; ++e) g[e] = sv[e] * g[e];
                    }
                    u32x4 w; w.x = cvt_pk_bf16(g[0], g[1]); w.y = cvt_pk_bf16(g[2], g[3]); w.z = cvt_pk_bf16(g[4], g[5]); w.w = cvt_pk_bf16(g[6], g[7]);
                    *(u32x4*)dst = w; } }
    }
};
struct EpiResid {
    static constexpr bool PERM = false, AFTER_DRAIN = false;
    const float* xin; float* xout; const float* gate;
    __device__ __forceinline__ void operator()(const f32x4 (&acc)[2][2][4][2], const Unit& u, int wr, int wc, int fr, int fq) const {
        const int b = (u.pm * BM) / 8192; const float* gp = gate + b * 3072;
        const int row0 = u.pm * BM + wr * 64 + fr, col0 = u.pn * BM + wc * 32 + 4 * fq;
#pragma unroll
        for (int bj = 0; bj < 2; ++bj)
#pragma unroll
            for (int n = 0; n < 2; ++n) { const int c = col0 + bj * HALF + n * 16; const f32x4 gv = *(const f32x4*)(gp + c);
#pragma unroll
                for (int ai = 0; ai < 2; ++ai)
#pragma unroll
                    for (int m = 0; m < 4; ++m) { const size_t off = (size_t)(row0 + ai * HALF + m * 16) * 1024 + c;
                        const f32x4 xi = *(const f32x4*)(xin + off); *(f32x4*)(xout + off) = xi + gv * acc[ai][bj][m][n]; } }
    }
};
}
constexpr int BATCH = 2, SEQ = 8192, DM = 1024, MROWS = BATCH * SEQ, PROJW = 11264;
constexpr int NQKV = 4608, NA = 3584, NAG = 5120, NLORA = 320;
constexpr size_t MiB = 1u << 20;
constexpr size_t WS_CTL = 0, WS_MOD = 1 * MiB;
constexpr size_t WS_WQKV = 2 * MiB, WS_WA = 20 * MiB, WS_WM = 40 * MiB, WS_WBA = 48 * MiB, WS_WBB = 52 * MiB, WS_WO = 54 * MiB;
constexpr size_t WS_VFIRST = 58 * MiB, WS_XN = 90 * MiB, WS_YB = 122 * MiB;
constexpr size_t WS_QKV = 138 * MiB, WS_PA = 138 * MiB, WS_YA = 250 * MiB, WS_MG = 138 * MiB, WS_MERGED = 202 * MiB, WS_SC = 282 * MiB, WS_GA = 314 * MiB;
constexpr int LDS_BYTES = 147456;
constexpr int NTHREADS = 512, NWAVES = 8;
#define LAS __attribute__((address_space(3)))
typedef unsigned short bf16;
typedef float f32x4 __attribute__((ext_vector_type(4)));
typedef unsigned u32x4 __attribute__((ext_vector_type(4)));
typedef unsigned u32x2 __attribute__((ext_vector_type(2)));

__device__ const unsigned char T5BUCKET[3][132] = {
 {0,1,2,3,4,5,6,7,8,9,10,11,12,13,14,15,16,16,16,16,16,16,17,17,17,17,17,17,17,17,18,18,18,18,18,18,18,18,18,18,19,19,19,19,19,19,19,19,19,19,19,19,19,19,20,20,20,20,20,20,20,20,20,20,20,20,20,20,20,20,20,20,20,21,21,21,21,21,21,21,21,21,21,21,21,21,21,21,21,21,21,21,21,21,21,21,21,21,21,22,22,22,22,22,22,22,22,22,22,22,22,22,22,22,22,22,22,22,22,22,22,22,22,22,22,22,22,22,22,0,0,0},
 {0,4,8,12,16,16,17,17,18,18,19,19,19,19,20,20,20,20,20,21,21,21,21,21,21,22,22,22,22,22,22,22,22,22,23,23,23,23,23,23,23,23,23,23,23,23,24,24,24,24,24,24,24,24,24,24,24,24,24,24,24,24,25,25,25,25,25,25,25,25,25,25,25,25,25,25,25,25,25,25,25,25,25,26,26,26,26,26,26,26,26,26,26,26,26,26,26,26,26,26,26,26,26,26,26,26,26,26,26,26,26,26,26,27,27,27,27,27,27,27,27,27,27,27,27,27,27,27,27,0,0,0},
 {0,16,18,19,20,21,21,22,22,23,23,23,24,24,24,24,25,25,25,25,25,26,26,26,26,26,26,26,26,27,27,27,27,27,27,27,27,27,27,28,28,28,28,28,28,28,28,28,28,28,28,28,29,29,29,29,29,29,29,29,29,29,29,29,29,29,29,29,29,29,30,30,30,30,30,30,30,30,30,30,30,30,30,30,30,30,30,30,30,30,30,30,30,30,30,31,31,31,31,31,31,31,31,31,31,31,31,31,31,31,31,31,31,31,31,31,31,31,31,31,31,31,31,31,31,31,31,31,31,0,0,0}};

__device__ __forceinline__ unsigned f2bf(float f) { unsigned u = __builtin_bit_cast(unsigned, f); return (u + 0x7fffu + ((u >> 16) & 1u)) >> 16; }
__device__ __forceinline__ unsigned pk2(float lo, float hi) { return pg8::cvt_pk_bf16(lo, hi); }
__device__ __forceinline__ float bflo(unsigned w) { return __uint_as_float(w << 16); }
__device__ __forceinline__ float bfhi(unsigned w) { return __uint_as_float(w & 0xffff0000u); }
__device__ __forceinline__ float bf2f(bf16 h) { return __uint_as_float(((unsigned)h) << 16); }
template <int CTRL, int RMASK> __device__ __forceinline__ float dpp_f(float v) { return __int_as_float(__builtin_amdgcn_update_dpp(0, __float_as_int(v), CTRL, RMASK, 0xF, false)); }
template <int CTRL, int RMASK> __device__ __forceinline__ float dpp_keep(float v) { return __int_as_float(__builtin_amdgcn_update_dpp(__float_as_int(v), __float_as_int(v), CTRL, RMASK, 0xF, false)); }
__device__ __forceinline__ float wave_sum_dpp(float v) {
    v += dpp_f<0xB1, 0xF>(v); v += dpp_f<0x4E, 0xF>(v); v += dpp_f<0x141, 0xF>(v); v += dpp_f<0x140, 0xF>(v);
    v += dpp_f<0x142, 0xA>(v); v += dpp_f<0x143, 0xC>(v);
    return __int_as_float(__builtin_amdgcn_readlane(__float_as_int(v), 63));
}
__device__ __forceinline__ float wave_max_dpp(float v) {
    v = fmaxf(v, dpp_keep<0xB1, 0xF>(v)); v = fmaxf(v, dpp_keep<0x4E, 0xF>(v)); v = fmaxf(v, dpp_keep<0x141, 0xF>(v)); v = fmaxf(v, dpp_keep<0x140, 0xF>(v));
    v = fmaxf(v, dpp_keep<0x142, 0xA>(v)); v = fmaxf(v, dpp_keep<0x143, 0xC>(v));
    return __int_as_float(__builtin_amdgcn_readlane(__float_as_int(v), 63));
}
__device__ __forceinline__ float wave_sum(float v) { return wave_sum_dpp(v); }
__device__ __forceinline__ float wave_max(float v) { return wave_max_dpp(v); }
__device__ __forceinline__ float bperm_f(int src_lane, float v) { return __int_as_float(__builtin_amdgcn_ds_bpermute(src_lane << 2, __float_as_int(v))); }
__device__ __forceinline__ float sigmoidf_(float x) { return 1.f / (1.f + __expf(-x)); }
__device__ __forceinline__ float siluf_(float x) { return x / (1.f + __expf(-x)); }

struct Args { const float* in[28]; float* out; unsigned char* ws; };
typedef const __attribute__((address_space(4))) Args* KArgs;
struct Frame {
    LAS unsigned char* lds;
    int tid, lane, wave, G, bid;
    const float* in[28]; float* out; unsigned char* ws;
};
__device__ __forceinline__ int lane_id_() { return (int)__builtin_amdgcn_mbcnt_hi(~0u, __builtin_amdgcn_mbcnt_lo(~0u, 0u)); }
__device__ __forceinline__ int cur_tid(int wv) { int w2 = wv; asm volatile("" : "+s"(w2)); unsigned z = 0u; asm volatile("" : "+v"(z)); return w2 * 64 + (int)__builtin_amdgcn_mbcnt_hi(~0u, __builtin_amdgcn_mbcnt_lo(~0u, z)); }
__device__ __forceinline__ void make_frame(Frame& F, KArgs ka, unsigned char* lds, int wv) {
    asm volatile("" : "+s"(ka));
    int t = cur_tid(wv);
    F.lds = (LAS unsigned char*)lds; F.tid = t; F.lane = t & 63; F.wave = __builtin_amdgcn_readfirstlane(t >> 6); F.G = gridDim.x; F.bid = blockIdx.x;
    const __attribute__((address_space(4))) unsigned long long* kr = (const __attribute__((address_space(4))) unsigned long long*)ka;
#pragma unroll
    for (int i = 0; i < 28; ++i) F.in[i] = (const float*)(const __attribute__((address_space(1))) float*)kr[i];
    F.out = (float*)(__attribute__((address_space(1))) float*)kr[28]; F.ws = (unsigned char*)(__attribute__((address_space(1))) unsigned char*)kr[29];
}
#define XB_TMO      128
#define XB_XCNT(j)  (256  + 64 * (j))
#define XB_XSUB(j)  (1280 + 64 * (j))
#define XB_XGEN(j)  (2304 + 64 * (j))
#define XB_TOP      3328
#define XB_TOPGEN   3392
#define XCD_BAR_WORDS 3456
#define XB_SPIN_CAP (1u << 18)

__device__ __forceinline__ unsigned xb_ld(unsigned* p)              { return __hip_atomic_load(p, __ATOMIC_RELAXED, __HIP_MEMORY_SCOPE_AGENT); }
__device__ __forceinline__ unsigned xb_add(unsigned* p, unsigned v) { return __hip_atomic_fetch_add(p, v, __ATOMIC_RELAXED, __HIP_MEMORY_SCOPE_AGENT); }
__device__ __forceinline__ unsigned xb_xcc_id() { return (unsigned)__builtin_amdgcn_s_getreg((3 << 11) | 20) & 0xFu; }
#define XB_SPIN(cond, bar) do { unsigned _sp = 0; while (cond) { __builtin_amdgcn_s_sleep(1); \
    if ((++_sp & 255u) == 0u) { if (xb_ld(&(bar)[XB_TMO])) break; if (_sp > XB_SPIN_CAP) { atomicAdd(&(bar)[XB_TMO], 1u); break; } } } } while (0)

struct XcdBarrier {
    unsigned* bar; unsigned x;
    volatile LAS unsigned* st;
};

__device__ __forceinline__ XcdBarrier xcd_barrier_post(unsigned* bar, volatile LAS unsigned* st, int tid) {
    XcdBarrier b; b.bar = bar; b.x = xb_xcc_id(); b.st = st;
    if (tid == 0) (void)xb_add(&bar[XB_XCNT(b.x)], 1u);
    return b;
}
__device__ __forceinline__ void xcd_barrier_complete(unsigned* bar, unsigned x, unsigned& nloc, unsigned& nx) {
    const unsigned G = gridDim.x * gridDim.y * gridDim.z;
    unsigned sum, cnt, mine, sp = 0u;
    for (;;) {
        sum = 0u; cnt = 0u; mine = 0u;
#pragma unroll
        for (unsigned j = 0; j < 16; ++j) { const unsigned c = xb_ld(&bar[XB_XCNT(j)]); sum += c; cnt += (c > 0u) ? 1u : 0u; mine = (j == x) ? c : mine; }
        if (sum == G) break;
        __builtin_amdgcn_s_sleep(1);
        if ((++sp & 255u) == 0u) { if (xb_ld(&bar[XB_TMO])) break; if (sp > XB_SPIN_CAP) { atomicAdd(&bar[XB_TMO], 1u); break; } }
    }
    nloc = mine > 0u ? mine : 1u; nx = cnt > 0u ? cnt : 1u;
}

__device__ __forceinline__ void xcd_barrier(const XcdBarrier& b, int tid) {
    asm volatile("s_waitcnt vmcnt(0)" ::: "memory");
    __syncthreads();
    if (tid == 0) {
        unsigned* bar = b.bar; asm volatile("" : "+s"(bar));
        __builtin_amdgcn_s_waitcnt(0);
        unsigned nloc = b.st[0], nx = b.st[1];
        if (nloc == 0u) { xcd_barrier_complete(bar, b.x, nloc, nx); b.st[0] = nloc; b.st[1] = nx; }
        const unsigned old = xb_add(&bar[XB_XSUB(b.x)], 1u);
        const unsigned gen = old / nloc;
        if (old + 1u == (gen + 1u) * nloc) {
            __builtin_amdgcn_fence(__ATOMIC_RELEASE, "agent");
            asm volatile("s_waitcnt vmcnt(0)" ::: "memory");
            const unsigned og = xb_add(&bar[XB_TOP], 1u);
            const unsigned tg = og / nx;
            if (og + 1u == (tg + 1u) * nx) xb_add(&bar[XB_TOPGEN], 1u);
            else XB_SPIN(xb_ld(&bar[XB_TOPGEN]) == tg, bar);
            __builtin_amdgcn_fence(__ATOMIC_ACQUIRE, "agent");
            xb_add(&bar[XB_XGEN(b.x)], 1u);
            asm volatile("s_waitcnt vmcnt(0)" ::: "memory");
        } else {
            XB_SPIN(xb_ld(&bar[XB_XGEN(b.x)]) == gen, bar);
            __builtin_amdgcn_fence(__ATOMIC_ACQUIRE, "agent");
            asm volatile("s_waitcnt vmcnt(0)" ::: "memory");
        }
    }
    __syncthreads();
}
__device__ __forceinline__ void p0_mod(Frame& F) {
    const float* c = F.in[1]; const float* ada_w = F.in[3]; const float* ada_b = F.in[4];
    float* mod = (float*)(F.ws + WS_MOD);
    LAS float* red = (LAS float*)F.lds;
    const int col = F.tid & 31, kg = F.tid >> 5;
    for (int ch = F.bid; ch < 192; ch += F.G) {
        const int l = ch / 96, n = (ch % 96) * 32 + col;
        const float* W = ada_w + (size_t)l * 1024 * 3072 + n;
        float a0 = 0.f, a1 = 0.f;
        for (int i = 0; i < 64; ++i) { const int k = kg + 16 * i; const float w = W[(size_t)k * 3072]; a0 += siluf_(c[k]) * w; a1 += siluf_(c[1024 + k]) * w; }
        red[kg * 32 + col] = a0; red[512 + kg * 32 + col] = a1;
        __syncthreads();
        if (F.tid < 64) { const int b = F.tid >> 5; float s = 0.f;
            for (int g = 0; g < 16; ++g) s += red[b * 512 + g * 32 + col];
            mod[(size_t)(l * 2 + b) * 3072 + n] = s + ada_b[l * 3072 + n]; }
        __syncthreads();
    }
}
__device__ __forceinline__ void transpose_item(const float* W, int ldw, int col0, int K, int ncols, bf16* WT, LAS float* scr, int item, int lane) {
    const int nblk = ncols / 32, kb = item / nblk, nb = item % nblk, k0 = 64 * kb, n0 = 32 * nb;
#pragma unroll 8
    for (int i = 0; i < 32; ++i) { const int kk = 2 * i + (lane >> 5); scr[kk * 33 + (lane & 31)] = W[(size_t)(k0 + kk) * ldw + col0 + n0 + (lane & 31)]; }
    asm volatile("s_waitcnt lgkmcnt(0)" ::: "memory");
    const int c = lane & 7;
#pragma unroll
    for (int j = 0; j < 4; ++j) { const int n = (lane >> 3) + 8 * j; const LAS float* s = scr + (8 * c) * 33 + n;
        u32x4 o; o.x = pk2(s[0 * 33], s[1 * 33]); o.y = pk2(s[2 * 33], s[3 * 33]); o.z = pk2(s[4 * 33], s[5 * 33]); o.w = pk2(s[6 * 33], s[7 * 33]);
        *(u32x4*)(WT + (size_t)(n0 + n) * K + k0 + 8 * c) = o; }
    asm volatile("s_waitcnt lgkmcnt(0)" ::: "memory");
}
__device__ __forceinline__ void p0_weights(Frame& F) {
    LAS float* scr = (LAS float*)(F.lds + 16384 + F.wave * 16384);
    const int gw = F.bid * NWAVES + F.wave, NGW = F.G * NWAVES;
    constexpr int I_QKV = 16 * 144, I_A = 16 * 96, I_GA = 16 * 32, I_GB = 16 * 16, I_M = 16 * 64, I_BA = 16 * 32, I_BB = 8 * 32, I_O = 16 * 32;
    constexpr int PER_L = I_QKV + I_A + I_GA + I_GB + I_M + I_BA + I_BB + I_O;
    for (int it = gw; it < 2 * PER_L; it += NGW) {
        const int l = it / PER_L; int r = it % PER_L;
        const float* win = F.in[5] + (size_t)l * 1024 * PROJW;
        bf16* wqkv = (bf16*)(F.ws + WS_WQKV) + (size_t)l * NQKV * 1024;
        bf16* wa = (bf16*)(F.ws + WS_WA) + (size_t)l * NAG * 1024;
        bf16* wm = (bf16*)(F.ws + WS_WM) + (size_t)l * 2048 * 1024;
        const float* W; int ldw, col0, K, ncols; bf16* WT;
        if (r < I_QKV) { W = win; ldw = PROJW; col0 = 4096; K = 1024; ncols = 4608; WT = wqkv; }
        else if ((r -= I_QKV) < I_A) { W = win; ldw = PROJW; col0 = 0; K = 1024; ncols = 3072; WT = wa; }
        else if ((r -= I_A) < I_GA) { W = win; ldw = PROJW; col0 = 3072; K = 1024; ncols = 1024; WT = wa + (size_t)3584 * 1024; }
        else if ((r -= I_GA) < I_GB) { W = win; ldw = PROJW; col0 = 8704; K = 1024; ncols = 512; WT = wa + (size_t)4608 * 1024; }
        else if ((r -= I_GB) < I_M) { W = win; ldw = PROJW; col0 = 9216; K = 1024; ncols = 2048; WT = wm; }
        else if ((r -= I_M) < I_BA) { W = F.in[23] + (size_t)l * 1024 * 1024; ldw = 1024; col0 = 0; K = 1024; ncols = 1024; WT = (bf16*)(F.ws + WS_WBA) + (size_t)l * 1024 * 1024; }
        else if ((r -= I_BA) < I_BB) { W = F.in[24] + (size_t)l * 512 * 1024; ldw = 1024; col0 = 0; K = 512; ncols = 1024; WT = (bf16*)(F.ws + WS_WBB) + (size_t)l * 1024 * 512; }
        else { r -= I_BB; W = F.in[25] + (size_t)l * 1024 * 1024; ldw = 1024; col0 = 0; K = 1024; ncols = 1024; WT = (bf16*)(F.ws + WS_WO) + (size_t)l * 1024 * 1024; }
        transpose_item(W, ldw, col0, K, ncols, WT, scr, r, F.lane);
    }
    const size_t gt = (size_t)F.bid * NTHREADS + F.tid, NGT = (size_t)F.G * NTHREADS;
    for (size_t e = gt; e < (size_t)2 * 512 * 1024; e += NGT) {
        const int l = (int)(e / (512 * 1024)), n = (int)((e / 1024) % 512), k = (int)(e % 1024);
        const float muw = F.in[7][(size_t)(l * 2 + 0) * 1024 + k], mua = F.in[7][(size_t)(l * 2 + 1) * 1024 + k];
        float v = 0.f;
        if (n < 64) v = F.in[9][((size_t)l * 1024 + k) * 64 + n] * (1.f - muw);
        else if (n < 128) v = F.in[9][((size_t)l * 1024 + k) * 64 + (n - 64)] * muw;
        else if (n < 192) v = F.in[12][((size_t)l * 1024 + k) * 64 + (n - 128)] * (1.f - mua);
        else if (n < 256) v = F.in[12][((size_t)l * 1024 + k) * 64 + (n - 192)] * mua;
        else if (n < 320 && l == 1) { const float muv = F.in[19][k]; const int m = (n - 256) & 31; const float w = F.in[21][(size_t)k * 32 + m]; v = (n < 288) ? w * (1.f - muv) : w * muv; }
        ((bf16*)(F.ws + WS_WA))[((size_t)l * NAG + 3072 + n) * 1024 + k] = (bf16)f2bf(v);
    }
}
__device__ __forceinline__ void phase_modnorm(Frame& F, int l, const float* xin) {
    const float* mod = (const float*)(F.ws + WS_MOD) + (size_t)l * 2 * 3072;
    const float* g = F.in[2] + l * 1024;
    bf16* XN = (bf16*)(F.ws + WS_XN);
    const int gw = F.bid * NWAVES + F.wave, NGW = F.G * NWAVES;
    for (int m = gw; m < MROWS; m += NGW) {
        const int b = m / SEQ; const f32x4* xr = (const f32x4*)(xin + (size_t)m * 1024) + F.lane;
        f32x4 v[4]; float s = 0.f;
#pragma unroll
        for (int j = 0; j < 4; ++j) { v[j] = xr[64 * j]; s += (v[j].x * v[j].x + v[j].y * v[j].y) + (v[j].z * v[j].z + v[j].w * v[j].w); }
        const float rs = 1.f / sqrtf(wave_sum(s) * (1.f / 1024.f) + 1e-6f);
        u32x2* o = (u32x2*)(XN + (size_t)m * 1024) + F.lane;
#pragma unroll
        for (int j = 0; j < 4; ++j) { const int c = 4 * F.lane + 256 * j;
            const f32x4 gg = *(const f32x4*)(g + c), sh = *(const f32x4*)(mod + b * 3072 + c), sc = *(const f32x4*)(mod + b * 3072 + 1024 + c);
            const f32x4 h = v[j] * rs * gg * (sc + 1.f) + sh; u32x2 w; w.x = pk2(h.x, h.y); w.y = pk2(h.z, h.w); o[64 * j] = w; }
    }
}
__device__ __forceinline__ void phase_final(Frame& F) {
    const float* g = F.in[27]; const int gw = F.bid * NWAVES + F.wave, NGW = F.G * NWAVES;
    for (int m = gw; m < MROWS; m += NGW) {
        f32x4* xr = (f32x4*)(F.out + (size_t)m * 1024) + F.lane; f32x4 v[4]; float s = 0.f;
#pragma unroll
        for (int j = 0; j < 4; ++j) { v[j] = xr[64 * j]; s += (v[j].x * v[j].x + v[j].y * v[j].y) + (v[j].z * v[j].z + v[j].w * v[j].w); }
        const float rs = 1.f / sqrtf(wave_sum(s) * (1.f / 1024.f) + 1e-6f);
#pragma unroll
        for (int j = 0; j < 4; ++j) { const f32x4 gg = *(const f32x4*)(g + 4 * F.lane + 256 * j); xr[64 * j] = v[j] * rs * gg; }
    }
}
__device__ __forceinline__ void phase_attn_naive(Frame& F) {
    const bf16* QKV = (const bf16*)(F.ws + WS_QKV); bf16* YB = (bf16*)(F.ws + WS_YB); const float* rel_bias = F.in[26];
    LAS float* QS = (LAS float*)(F.lds) + F.wave * 640;
    LAS float* PS = QS + 192;
    const int gw = F.bid * NWAVES + F.wave, NGW = F.G * NWAVES, lane = F.lane;
    for (int it = gw; it < MROWS * 8; it += NGW) {
        const int row = it >> 3, h = it & 7, b = row / SEQ, t = row % SEQ;
        const bf16* qrow = QKV + (size_t)row * NQKV;
#pragma unroll
        for (int g = 0; g < 3; ++g) QS[g * 64 + lane] = bf2f(qrow[g * 512 + h * 64 + lane]) * 0.125f;
        __builtin_amdgcn_wave_barrier();
        float sc[3][3]; float mx = -1e30f;
#pragma unroll
        for (int g = 0; g < 3; ++g) { const int dil = (g == 0) ? 1 : (g == 1 ? 4 : 16);
#pragma unroll
            for (int jj = 0; jj < 3; ++jj) { const int j = lane + 64 * jj; const int tk = t - j * dil; float s = -1e30f;
                if (j <= 128 && tk >= 0) {
                    const u32x4* kp = (const u32x4*)(QKV + (size_t)(b * SEQ + tk) * NQKV + 1536 + g * 512 + h * 64);
                    float a = 0.f;
#pragma unroll
                    for (int c8 = 0; c8 < 8; ++c8) { const u32x4 kv = kp[c8]; const LAS float* q = QS + g * 64 + c8 * 8;
                        a += q[0] * bflo(kv.x) + q[1] * bfhi(kv.x) + q[2] * bflo(kv.y) + q[3] * bfhi(kv.y) + q[4] * bflo(kv.z) + q[5] * bfhi(kv.z) + q[6] * bflo(kv.w) + q[7] * bfhi(kv.w); }
                    s = a + rel_bias[(int)T5BUCKET[g][j] * 24 + g * 8 + h];
                }
                sc[g][jj] = s; mx = fmaxf(mx, s); } }
        mx = wave_max(mx);
        float den = 0.f;
#pragma unroll
        for (int g = 0; g < 3; ++g)
#pragma unroll
            for (int jj = 0; jj < 3; ++jj) { const int j = lane + 64 * jj; const float p = (sc[g][jj] > -1e29f) ? __expf(sc[g][jj] - mx) : 0.f; den += p; if (j <= 128) PS[g * 132 + j] = p; }
        den = wave_sum(den);
        __builtin_amdgcn_wave_barrier();
        float o = 0.f;
#pragma unroll
        for (int g = 0; g < 3; ++g) { const int dil = (g == 0) ? 1 : (g == 1 ? 4 : 16); const int jmax = min(128, t / dil);
            const bf16* vp = QKV + (size_t)(b * SEQ + t) * NQKV + 3072 + g * 512 + h * 64 + lane;
            for (int j = 0; j <= jmax; ++j) o += PS[g * 132 + j] * bf2f(vp[-(ptrdiff_t)j * dil * NQKV]); }
        YB[(size_t)row * 512 + h * 64 + lane] = (bf16)f2bf(o / den);
        __builtin_amdgcn_wave_barrier();
    }
}
__device__ __forceinline__ float softplusf_(float x) { return fmaxf(x, 0.f) + log1pf(__expf(-fabsf(x))); }
__device__ __forceinline__ void phase_rwkv_naive(Frame& F, int l) {
    if (F.bid >= 32) return;
    constexpr int TB = 16;
    const int b = F.bid >> 4, h = F.bid & 15, tid = F.tid, lane = F.lane, wave = F.wave;
    const bf16* PA = (const bf16*)(F.ws + WS_PA); bf16* YA = (bf16*)(F.ws + WS_YA); bf16* VF = (bf16*)(F.ws + WS_VFIRST);
    LAS float* L = (LAS float*)F.lds;
    LAS float* W2s = L; LAS float* A2s = L + 4096; LAS float* V2s = L + 8192; LAS float* CV = L + 10240;
    LAS float* PRs = L + 11264; LAS float* PKs = PRs + 17 * 64; LAS float* PVs = PKs + 17 * 64; LAS float* LOs = PVs + 17 * 64;
    LAS float* LWs = LOs + 17 * 320; LAS float* LAs = LWs + TB * 64; LAS float* LVs = LAs + TB * 64;
    LAS float* Rs = LVs + TB * 32; LAS float* Ws = Rs + TB * 64; LAS float* Ks = Ws + TB * 64; LAS float* Vs = Ks + TB * 64; LAS float* As = Vs + TB * 64; LAS float* Bs = As + TB * 64;
    LAS float* RKs = Bs + TB * 64; LAS float* Ys = RKs + TB;
    for (int e = tid; e < 4096; e += NTHREADS) { const int m = e >> 6, j = e & 63;
        W2s[e] = F.in[10][((size_t)l * 64 + m) * 1024 + h * 64 + j]; A2s[e] = F.in[13][((size_t)l * 64 + m) * 1024 + h * 64 + j];
        if (m < 32) V2s[e] = (l == 1) ? F.in[22][(size_t)m * 1024 + h * 64 + j] : 0.f; }
    if (tid < 64) { const int c = h * 64 + tid;
        CV[0 * 64 + tid] = F.in[8][l * 1024 + c];  CV[1 * 64 + tid] = F.in[11][l * 1024 + c]; CV[2 * 64 + tid] = (l == 1) ? F.in[20][c] : 0.f;
        CV[3 * 64 + tid] = F.in[14][l * 1024 + c]; CV[4 * 64 + tid] = F.in[15][l * 1024 + c]; CV[5 * 64 + tid] = F.in[16][l * 1024 + c];
        CV[6 * 64 + tid] = F.in[17][l * 1024 + c]; CV[7 * 64 + tid] = F.in[18][l * 1024 + c];
        CV[8 * 64 + tid] = F.in[6][(size_t)(l * 3 + 0) * 1024 + c]; CV[9 * 64 + tid] = F.in[6][(size_t)(l * 3 + 1) * 1024 + c]; CV[10 * 64 + tid] = F.in[6][(size_t)(l * 3 + 2) * 1024 + c]; }
    float S[16];
#pragma unroll
    for (int q = 0; q < 16; ++q) S[q] = 0.f;
    __syncthreads();
    for (int t0 = 0; t0 < SEQ; t0 += TB) {
        for (int e = tid; e < 17 * 512; e += NTHREADS) { const int rr = e >> 9, cc = e & 511, t = t0 - 1 + rr; float v = 0.f;
            if (t >= 0) { const int gc = (cc < 192) ? ((cc >> 6) * 1024 + h * 64 + (cc & 63)) : (3072 + cc - 192); v = bf2f(PA[(size_t)(b * SEQ + t) * NA + gc]); }
            if (cc < 64) PRs[rr * 64 + cc] = v; else if (cc < 128) PKs[rr * 64 + cc - 64] = v; else if (cc < 192) PVs[rr * 64 + cc - 128] = v; else LOs[rr * 320 + cc - 192] = v; }
        __syncthreads();
        for (int e = tid; e < TB * 160; e += NTHREADS) { const int tl = e / 160, m = e % 160; const LAS float* cur = LOs + (tl + 1) * 320; const LAS float* prv = LOs + tl * 320;
            if (m < 64) LWs[tl * 64 + m] = tanhf(cur[m] + prv[64 + m]);
            else if (m < 128) LAs[tl * 64 + m - 64] = cur[128 + m - 64] + prv[192 + m - 64];
            else LVs[tl * 32 + m - 128] = cur[256 + m - 128] + prv[288 + m - 128]; }
        __syncthreads();
        for (int tl = wave; tl < TB; tl += NWAVES) { const int j = lane; const size_t row = (size_t)(b * SEQ + t0 + tl);
            float wpre = CV[j], apre = CV[64 + j], vpre = CV[128 + j];
            for (int m = 0; m < 64; ++m) { wpre += LWs[tl * 64 + m] * W2s[m * 64 + j]; apre += LAs[tl * 64 + m] * A2s[m * 64 + j]; }
            for (int m = 0; m < 32; ++m) vpre += LVs[tl * 32 + m] * V2s[m * 64 + j];
            const float pr = PRs[(tl + 1) * 64 + j], prp = PRs[tl * 64 + j], pk = PKs[(tl + 1) * 64 + j], pkp = PKs[tl * 64 + j], pv = PVs[(tl + 1) * 64 + j], pvp = PVs[tl * 64 + j];
            const float r = pr + (prp - pr) * CV[8 * 64 + j], k = pk + (pkp - pk) * CV[9 * 64 + j]; float v = pv + (pvp - pv) * CV[10 * 64 + j];
            const float w = -softplusf_(-wpre) - 0.5f; const float decay = __expf(-__expf(w)); const float asig = sigmoidf_(apre);
            if (l == 0) VF[row * 1024 + h * 64 + j] = (bf16)f2bf(v); else { const float vf = bf2f(VF[row * 1024 + h * 64 + j]); v = v + (vf - v) * sigmoidf_(vpre); }
            const float kk = k * CV[3 * 64 + j]; const float ss = wave_sum(kk * kk); const float kkn = kk * (1.f / sqrtf(fmaxf(ss, 1e-24f)));
            const float k2 = k * (1.f + (asig - 1.f) * CV[4 * 64 + j]);
            const float rk = wave_sum(r * k2 * CV[5 * 64 + j]);
            Rs[tl * 64 + j] = r; Ws[tl * 64 + j] = decay; Ks[tl * 64 + j] = k2; Vs[tl * 64 + j] = v; As[tl * 64 + j] = -kkn; Bs[tl * 64 + j] = kkn * asig;
            if (lane == 0) RKs[tl] = rk; }
        __syncthreads();
        if (wave < 4) { const int i = wave * 16 + (lane >> 2), jq = lane & 3;
            for (int tl = 0; tl < TB; ++tl) { const int o = tl * 64 + jq * 16; const float vi = Vs[tl * 64 + i];
                float sa = 0.f;
#pragma unroll
                for (int q = 0; q < 16; ++q) sa += S[q] * As[o + q];
                sa += __shfl_xor(sa, 1); sa += __shfl_xor(sa, 2);
                float y = 0.f;
#pragma unroll
                for (int q = 0; q < 16; ++q) { S[q] = S[q] * Ws[o + q] + sa * Bs[o + q] + vi * Ks[o + q]; y += S[q] * Rs[o + q]; }
                y += __shfl_xor(y, 1); y += __shfl_xor(y, 2);
                if (jq == 0) Ys[tl * 64 + i] = y; } }
        __syncthreads();
        for (int tl = wave; tl < TB; tl += NWAVES) { const int i = lane; const size_t row = (size_t)(b * SEQ + t0 + tl);
            const float y = Ys[tl * 64 + i]; const float mean = wave_sum(y) * (1.f / 64.f); const float d = y - mean; const float var = wave_sum(d * d) * (1.f / 64.f);
            const float o = d * (1.f / sqrtf(var + 64e-5f)) * CV[6 * 64 + i] + CV[7 * 64 + i] + RKs[tl] * Vs[tl * 64 + i];
            YA[row * 1024 + h * 64 + i] = (bf16)f2bf(o); }
    }
}
#define LDSBAR() do { asm volatile("s_waitcnt lgkmcnt(0)" ::: "memory"); __builtin_amdgcn_s_barrier(); asm volatile("" ::: "memory"); } while (0)
typedef short bf16x8 __attribute__((ext_vector_type(8)));
typedef short s16x4 __attribute__((ext_vector_type(4)));
typedef short v4i16_t __attribute__((ext_vector_type(4)));
constexpr int RC = 32, RLS = 512, RNSC = SEQ / RLS, RNCH = RLS / RC, RITEMS = BATCH * 16 * RNSC;
constexpr int AST = 72;
constexpr int MST = 40;
constexpr int OFF_RAWH = 0, OFF_RAWL = 12800, OFF_GCS = 12800, OFF_MK = 12800, OFF_QB = 15360, OFF_QK = 17920, OFF_YS = 20480, OFF_M = 28928, OFF_MMK = 31488;
constexpr int OFF_LW = 34048, OFF_LA = OFF_LW + 4608, OFF_LV = OFF_LA + 4608;
constexpr int OFF_W2T = 45824, OFF_A2T = OFF_W2T + 9216, OFF_V2T = OFF_A2T + 9216;
constexpr int OFF_CV = 69376, OFF_GAM = 72192, OFF_RK = 72448;
constexpr int OFF_PRE = 72576, OFF_U = 72576, OFF_T = OFF_U + 8704;
constexpr int OFF_LWG = 97664, OFF_ARR = 105856, OFF_VFS = 142720, OFF_GAS = OFF_ARR + 4 * (32 * AST * 2);
constexpr int PRE_ST = 196, U_ST = 68, T_ST = 36, YS_ST = 66;
enum { AR_RT = 0, AR_AT, AR_BT, AR_KT, AR_BH, AR_KH, AR_V, AR_W };
static_assert(OFF_VFS + 4096 <= LDS_BYTES - 64 && OFF_MMK + 2560 <= OFF_LW && OFF_YS + 32 * YS_ST * 4 <= OFF_M, "rwkv LDS map");
#define ARR(k) (F.lds + OFF_ARR + (k) * (32 * AST * 2))

__device__ __forceinline__ bf16x8 ld_b128(const LAS unsigned char* p) { return *(const LAS bf16x8*)p; }
__device__ __forceinline__ s16x4 ld_b64(const LAS unsigned char* p) { return *(const LAS s16x4*)p; }
__device__ __forceinline__ s16x4 ld_tr(const LAS unsigned char* p) { return __builtin_bit_cast(s16x4, __builtin_amdgcn_ds_read_tr16_b64_v4i16((LAS v4i16_t*)p)); }
__device__ __forceinline__ bf16x8 cat8(s16x4 a, s16x4 b) { return (bf16x8){a[0], a[1], a[2], a[3], b[0], b[1], b[2], b[3]}; }
__device__ __forceinline__ bf16x8 pack8(f32x4 a, f32x4 b) { u32x4 w; w.x = pk2(a[0], a[1]); w.y = pk2(a[2], a[3]); w.z = pk2(b[0], b[1]); w.w = pk2(b[2], b[3]); return __builtin_bit_cast(bf16x8, w); }
#define MFMA16(a, b, c) __builtin_amdgcn_mfma_f32_16x16x32_bf16((a), (b), (c), 0, 0, 0)
__device__ __forceinline__ void st_bf(LAS unsigned char* base, int idx, float v) { ((LAS bf16*)base)[idx] = (bf16)pg8::cvt_pk_bf16(v, v); }
__device__ __forceinline__ float fsig(float x) { return __builtin_amdgcn_rcpf(1.f + __expf(-x)); }
__device__ __forceinline__ float fast_tanh(float x) { return 1.f - 2.f * __builtin_amdgcn_rcpf(1.f + __expf(2.f * x)); }

__device__ __forceinline__ u32x4 rwkv_raw_load(const bf16* PA, const bf16* VF, int l, int b, int h, int t0, int i, int tid) {
    u32x4 v = (u32x4){0u, 0u, 0u, 0u};
    if (i == 5) { if (tid < 256) v = *(const u32x4*)(VF + (size_t)(b * SEQ + t0 + (tid >> 3)) * 1024 + h * 64 + (tid & 7) * 8); return v; }
    const int e = tid + NTHREADS * i, rr = (i < 4) ? (e >> 6) : 32, k = tid & 63, t = t0 - 1 + rr;
    const int col = (k < 24) ? ((k >> 3) * 1024 + h * 64 + (k & 7) * 8) : (3072 + (k - 24) * 8);
    if (i < 4 || tid < 64) { if (t >= 0) v = *(const u32x4*)(PA + (size_t)(b * SEQ + t) * NA + col); }
    else if (l == 1 && tid < 320) { const int q = tid - 64; v = *(const u32x4*)(VF + (size_t)(b * SEQ + t0 + (q >> 3)) * 1024 + h * 64 + (q & 7) * 8); }
    return v;
}
__device__ __forceinline__ void rwkv_raw_store(Frame& F, int i, int tid, u32x4 v) {
    if (i == 5) { if (tid < 256) *(LAS u32x4*)(F.lds + OFF_GAS + tid * 16) = v; return; }
    const int e = tid + NTHREADS * i, rr = (i < 4) ? (e >> 6) : 32, k = tid & 63;
    const int off = (k < 24) ? (OFF_RAWH + (rr * 192 + k * 8) * 2) : (OFF_RAWL + (rr * 320 + (k - 24) * 8) * 2);
    if (i < 4 || tid < 64) *(LAS u32x4*)(F.lds + off) = v;
    else if (tid < 320) *(LAS u32x4*)(F.lds + OFF_VFS + (tid - 64) * 16) = v;
}

#ifndef RDUP
#define RDUP 0
#endif
#ifdef STGPROBE
#define STG_MARK(k) do { if (PASS == 3 && (k) == STGPROBE) stg_acc += __builtin_amdgcn_s_memrealtime() - stg_t0; } while (0)
#else
#define STG_MARK(k) do {} while (0)
#endif
template <int PASS> __device__ __forceinline__ void rwkv_pass(Frame& F, int l) {
    unsigned long long stg_acc = 0ull, stg_t0 = 0ull;
    const int tid = F.tid, lane = F.lane, wave = F.wave, g = lane >> 4, c = lane & 15;
    const bf16* PA = (const bf16*)(F.ws + WS_PA); bf16* YA = (bf16*)(F.ws + WS_YA); bf16* VF = (bf16*)(F.ws + WS_VFIRST);
    float* PD = (float*)(F.ws + WS_SC); float* SST = (float*)(F.ws + WS_SC + 16 * MiB);
    LAS float* CV = (LAS float*)(F.lds + OFF_CV); LAS float* GAM = (LAS float*)(F.lds + OFF_GAM); LAS float* RK = (LAS float*)(F.lds + OFF_RK);
    LAS float* PRE = (LAS float*)(F.lds + OFF_PRE); LAS float* Us = (LAS float*)(F.lds + OFF_U); LAS float* Ts = (LAS float*)(F.lds + OFF_T);
    LAS float* LWG = (LAS float*)(F.lds + OFF_LWG); LAS float* GCS = (LAS float*)(F.lds + OFF_GCS); LAS float* YS = (LAS float*)(F.lds + OFF_YS);
    LAS bf16* RAWH = (LAS bf16*)(F.lds + OFF_RAWH); LAS bf16* RAWL = (LAS bf16*)(F.lds + OFF_RAWL); LAS bf16* VFS = (LAS bf16*)(F.lds + OFF_VFS);
    const int chain = F.bid >> 3, b = chain >> 4, h = chain & 15, NIT = RNSC / 8;
    if (F.G != 256) return;
    for (int e = tid; e < 4096; e += NTHREADS) { const int m = e >> 6, j = e & 63;
        st_bf(F.lds + OFF_W2T, j * AST + m, F.in[10][((size_t)l * 64 + m) * 1024 + h * 64 + j]);
        st_bf(F.lds + OFF_A2T, j * AST + m, F.in[13][((size_t)l * 64 + m) * 1024 + h * 64 + j]);
        if (m < 32) st_bf(F.lds + OFF_V2T, j * MST + m, (l == 1) ? F.in[22][(size_t)m * 1024 + h * 64 + j] : 0.f); }
    if (tid < 64) { const int cc = h * 64 + tid;
        CV[0 * 64 + tid] = F.in[8][l * 1024 + cc];  CV[1 * 64 + tid] = F.in[11][l * 1024 + cc]; CV[2 * 64 + tid] = (l == 1) ? F.in[20][cc] : 0.f;
        CV[3 * 64 + tid] = F.in[14][l * 1024 + cc]; CV[4 * 64 + tid] = F.in[15][l * 1024 + cc]; CV[5 * 64 + tid] = F.in[16][l * 1024 + cc];
        CV[6 * 64 + tid] = F.in[17][l * 1024 + cc]; CV[7 * 64 + tid] = F.in[18][l * 1024 + cc];
        CV[8 * 64 + tid] = F.in[6][(size_t)(l * 3 + 0) * 1024 + cc]; CV[9 * 64 + tid] = F.in[6][(size_t)(l * 3 + 1) * 1024 + cc]; CV[10 * 64 + tid] = F.in[6][(size_t)(l * 3 + 2) * 1024 + cc]; }
    const bf16* GAp = (const bf16*)(F.ws + WS_GA);
    u32x4 pre[5], preg = (u32x4){0u, 0u, 0u, 0u};
#pragma unroll
    for (int i = 0; i < 5; ++i) pre[i] = rwkv_raw_load(PA, VF, l, b, h, ((F.bid & 7) * NIT) * RLS, i, tid);
    if (PASS == 3) preg = rwkv_raw_load(PA, GAp, l, b, h, ((F.bid & 7) * NIT) * RLS, 5, tid);
    for (int ii = 0; ii < NIT; ++ii) {
        const int sc = (F.bid & 7) * NIT + ii, it = chain * RNSC + sc;
        f32x4 X[4];
#pragma unroll
        for (int jt = 0; jt < 4; ++jt) X[jt] = (f32x4){0.f, 0.f, 0.f, 0.f};
        if (PASS == 1) { if (wave >= 4) {
#pragma unroll
                for (int jt = 0; jt < 4; ++jt)
#pragma unroll
                    for (int r = 0; r < 4; ++r) X[jt][r] = (16 * jt + 4 * g + r == 16 * (wave - 4) + c) ? 1.f : 0.f; } }
        else if (wave < 4) { int lz = lane; asm volatile("" : "+v"(lz));
            const float* s0 = SST + (size_t)it * 4096 + (4 * (lz >> 4)) * 64 + 16 * wave + (lz & 15);
#pragma unroll
            for (int jt = 0; jt < 4; ++jt)
#pragma unroll
                for (int r = 0; r < 4; ++r) X[jt][r] = s0[(16 * jt + r) * 64]; }
        for (int ch = 0; ch < RNCH; ++ch) {
            const int t0 = sc * RLS + ch * RC;
            LDSBAR();
#ifdef STGPROBE
            stg_t0 = __builtin_amdgcn_s_memrealtime();
#endif
            for (int rep_ = 0; rep_ < ((PASS == 3 && RDUP == 1) ? 2 : 1); ++rep_) {
            { int tz = tid; asm volatile("" : "+v"(tz));
#pragma unroll
              for (int i = 0; i < 5; ++i) rwkv_raw_store(F, i, tz, pre[i]);
              if (PASS == 3) rwkv_raw_store(F, 5, tz, preg);
              const bool last = (ch == RNCH - 1) && (ii == NIT - 1); const int t0n = last ? t0 : t0 + RC;
#pragma unroll
              for (int i = 0; i < 5; ++i) pre[i] = rwkv_raw_load(PA, VF, l, b, h, t0n, i, tz);
              if (PASS == 3) preg = rwkv_raw_load(PA, GAp, l, b, h, t0n, 5, tz); }
            LDSBAR();
            }
            for (int rep_ = 0; rep_ < ((PASS == 3 && RDUP == 2) ? 2 : 1); ++rep_) {
            STG_MARK(1);
            { const int tl = tid >> 4, mq = tid & 15; const LAS unsigned char* cur = F.lds + OFF_RAWL + (tl + 1) * 640 + mq * 8; const LAS unsigned char* prv = F.lds + OFF_RAWL + tl * 640 + mq * 8;
              const u32x2 cw = *(const LAS u32x2*)(cur), pw = *(const LAS u32x2*)(prv + 128), ca = *(const LAS u32x2*)(cur + 256), pa = *(const LAS u32x2*)(prv + 384);
              const unsigned cv2 = *(const LAS unsigned*)(F.lds + OFF_RAWL + (tl + 1) * 640 + 512 + mq * 4), pv2 = *(const LAS unsigned*)(F.lds + OFF_RAWL + tl * 640 + 576 + mq * 4);
              u32x2 lw, la;
              lw.x = pk2(fast_tanh(bflo(cw.x) + bflo(pw.x)), fast_tanh(bfhi(cw.x) + bfhi(pw.x))); lw.y = pk2(fast_tanh(bflo(cw.y) + bflo(pw.y)), fast_tanh(bfhi(cw.y) + bfhi(pw.y)));
              la.x = pk2(bflo(ca.x) + bflo(pa.x), bfhi(ca.x) + bfhi(pa.x)); la.y = pk2(bflo(ca.y) + bflo(pa.y), bfhi(ca.y) + bfhi(pa.y));
              const unsigned lv = pk2(bflo(cv2) + bflo(pv2), bfhi(cv2) + bfhi(pv2));
              *(LAS u32x2*)(F.lds + OFF_LW + (tl * AST + mq * 4) * 2) = lw; *(LAS u32x2*)(F.lds + OFF_LA + (tl * AST + mq * 4) * 2) = la; *(LAS unsigned*)(F.lds + OFF_LV + (tl * MST + mq * 2) * 2) = lv; }
            LDSBAR();
            }
            for (int rep_ = 0; rep_ < ((PASS == 3 && RDUP == 3) ? 2 : 1); ++rep_) {
            STG_MARK(2);
            { f32x4 acc3[3];
#pragma unroll
              for (int q = 0; q < 3; ++q) { const int o16 = 2 * wave + q - 1;
                const int tt = (q == 0) ? (wave >> 2) : (o16 >> 3), mat = (q == 0) ? 0 : 1 + ((o16 >> 2) & 1), jt = (q == 0) ? (wave & 3) : (o16 & 3);
                f32x4 acc = (f32x4){0.f, 0.f, 0.f, 0.f};
                if (mat < 2) { const LAS unsigned char* Ab = F.lds + (mat == 0 ? OFF_LW : OFF_LA) + ((16 * tt + c) * AST + 8 * g) * 2; const LAS unsigned char* Bb = F.lds + (mat == 0 ? OFF_W2T : OFF_A2T) + ((16 * jt + c) * AST + 8 * g) * 2;
                    acc = MFMA16(ld_b128(Ab), ld_b128(Bb), acc); acc = MFMA16(ld_b128(Ab + 64), ld_b128(Bb + 64), acc); }
                else { const LAS unsigned char* Ab = F.lds + OFF_LV + ((16 * tt + c) * MST + 8 * g) * 2; const LAS unsigned char* Bb = F.lds + OFF_V2T + ((16 * jt + c) * MST + 8 * g) * 2;
                    acc = MFMA16(ld_b128(Ab), ld_b128(Bb), acc); }
                acc3[q] = acc; }
              const float w0 = CV[16 * (wave & 3) + c];
#pragma unroll
              for (int q = 0; q < 3; ++q) { const int o16 = 2 * wave + q - 1;
                const int tt = (q == 0) ? (wave >> 2) : (o16 >> 3), mat = (q == 0) ? 0 : 1 + ((o16 >> 2) & 1), jt = (q == 0) ? (wave & 3) : (o16 & 3), nt = mat * 4 + jt;
                if (q == 0) {
#pragma unroll
                    for (int r = 0; r < 4; ++r) { const float x = -(acc3[0][r] + w0); const float sp = fmaxf(x, 0.f) + __logf(1.f + __expf(-fabsf(x))); LWG[(16 * tt + 4 * g + r) * 64 + 16 * jt + c] = -__expf(-sp - 0.5f); } }
                else {
#pragma unroll
                    for (int r = 0; r < 4; ++r) PRE[(16 * tt + 4 * g + r) * PRE_ST + 16 * nt + c] = acc3[q][r]; } } }
            LDSBAR();
            }
            for (int rep_ = 0; rep_ < ((PASS == 3 && RDUP == 6) ? 2 : 1); ++rep_) {
            STG_MARK(3);
            { const int tt = wave >> 2, jt = wave & 3; f32x4 acc = (f32x4){0.f, 0.f, 0.f, 0.f};
#pragma unroll
              for (int ks = 0; ks < 8; ++ks) { if (ks >= 4 && tt == 0) continue;
                  const float av = (4 * ks + g <= 16 * tt + c) ? 1.f : 0.f; const float bv = LWG[(4 * ks + g) * 64 + 16 * jt + c];
                  acc = __builtin_amdgcn_mfma_f32_16x16x4f32(av, bv, acc, 0, 0, 0); }
#pragma unroll
              for (int r = 0; r < 4; ++r) GCS[(16 * tt + 4 * g + r) * 64 + 16 * jt + c] = acc[r];
              if (tt == 1 && g == 3) GAM[16 * jt + c] = __expf(acc[3]); }
            LDSBAR();
            }
            for (int rep_ = 0; rep_ < ((PASS == 3 && RDUP == 4) ? 2 : 1); ++rep_) {
            STG_MARK(4);
            { const int j = lane;
              const float c_a0 = CV[64 + j], c_v0 = CV[128 + j], c_kk = CV[3 * 64 + j], c_ka = CV[4 * 64 + j], c_rk = CV[5 * 64 + j], c_mr = CV[8 * 64 + j], c_mk = CV[9 * 64 + j], c_mv = CV[10 * 64 + j];
#pragma unroll
              for (int kb = 0; kb < 4; kb += 2) {
              float apre[2], vpre[2], pr[2], prp[2], pk[2], pkp[2], pvv[2], pvp[2], vfv[2], gt[2], gp[2];
#pragma unroll
              for (int k = 0; k < 2; ++k) { const int tl = wave + 8 * (kb + k);
                  apre[k] = PRE[tl * PRE_ST + 64 + j]; vpre[k] = PRE[tl * PRE_ST + 128 + j];
                  pr[k] = bf2f(RAWH[(tl + 1) * 192 + j]); prp[k] = bf2f(RAWH[tl * 192 + j]); pk[k] = bf2f(RAWH[(tl + 1) * 192 + 64 + j]); pkp[k] = bf2f(RAWH[tl * 192 + 64 + j]);
                  pvv[k] = bf2f(RAWH[(tl + 1) * 192 + 128 + j]); pvp[k] = bf2f(RAWH[tl * 192 + 128 + j]);
                  vfv[k] = bf2f(VFS[tl * 64 + j]);
                  gt[k] = GCS[tl * 64 + j]; gp[k] = GCS[(tl > 0 ? tl - 1 : 0) * 64 + j]; }
              float o_at[2], o_bt[2], o_kt[2], o_v[2], o_rt[2], o_rk[2];
#pragma unroll
              for (int k = 0; k < 2; ++k) {
                  const float r = pr[k] + (prp[k] - pr[k]) * c_mr, kx = pk[k] + (pkp[k] - pk[k]) * c_mk; float v = pvv[k] + (pvp[k] - pvv[k]) * c_mv;
                  const float asig = fsig(apre[k] + c_a0);
                  if (l == 1) v = v + (vfv[k] - v) * fsig(vpre[k] + c_v0);
                  const float kk = kx * c_kk; const float ss = wave_sum_dpp(kk * kk); const float kkn = kk * __builtin_amdgcn_rsqf(fmaxf(ss, 1e-24f));
                  const float k2 = kx * (1.f + (asig - 1.f) * c_ka); const float av = -kkn, bv = kkn * asig;
                  const float eg = __expf(gt[k]), egp = (wave + 8 * (kb + k) > 0) ? __expf(gp[k]) : 1.f, einv = __expf(-gt[k]);
                  o_at[k] = av * egp; o_bt[k] = bv * einv; o_kt[k] = k2 * einv; o_v[k] = v; o_rt[k] = r * eg;
                  o_rk[k] = (PASS == 3) ? wave_sum_dpp(r * k2 * c_rk) : 0.f; }
#pragma unroll
              for (int k = 0; k < 2; ++k) { const int tl = wave + 8 * (kb + k), o = tl * AST + j;
                  st_bf(ARR(AR_AT), o, o_at[k]); st_bf(ARR(AR_BT), o, o_bt[k]); st_bf(ARR(AR_KT), o, o_kt[k]); st_bf(ARR(AR_V), o, o_v[k]);
                  if (PASS == 3) { st_bf(ARR(AR_RT), o, o_rt[k]); if (lane == 0) RK[tl] = o_rk[k]; }
                  if (l == 0 && PASS == 1) VF[(size_t)(b * SEQ + t0 + tl) * 1024 + h * 64 + j] = (bf16)pk2(o_v[k], 0.f); } } }
            LDSBAR();
            }
            for (int rep_ = 0; rep_ < ((PASS == 3 && RDUP == 5) ? 2 : 1); ++rep_) {
            STG_MARK(5);
            { f32x4 acc7[2];
#pragma unroll
              for (int q = 0; q < 2; ++q) { const int tile = wave * 2 + q, rt = tile >> 2, ct = tile & 3, tt = rt & 1, st = ct & 1;
                f32x4 acc = (f32x4){0.f, 0.f, 0.f, 0.f};
                if (!(PASS == 1 && rt >= 2) && st <= tt) { const LAS unsigned char* Ab = ARR(rt < 2 ? AR_AT : AR_RT) + ((16 * tt + c) * AST + 8 * g) * 2; const LAS unsigned char* Bb = ARR(ct < 2 ? AR_BT : AR_KT) + ((16 * st + c) * AST + 8 * g) * 2;
                    acc = MFMA16(ld_b128(Ab), ld_b128(Bb), acc); acc = MFMA16(ld_b128(Ab + 64), ld_b128(Bb + 64), acc); }
                acc7[q] = acc; }
#pragma unroll
              for (int q = 0; q < 2; ++q) { const int tile = wave * 2 + q, rt = tile >> 2, ct = tile & 3, tt = rt & 1, st = ct & 1;
                if (PASS == 1 && rt >= 2) continue;
                const int s = 16 * st + c;
#pragma unroll
                for (int r = 0; r < 4; ++r) { const int t = 16 * tt + 4 * g + r; const bool keep = (rt < 2) ? (s < t) : (s <= t); const float v = keep ? acc7[q][r] : 0.f;
                    if (rt < 2 && ct < 2) { Ts[t * T_ST + s] = v; if (tt == 1 && st == 0) st_bf(F.lds + OFF_M, t * MST + s, v); } else st_bf(F.lds + (rt < 2 ? OFF_MK : (ct < 2 ? OFF_QB : OFF_QK)), t * MST + s, v); } } }
            LDSBAR();
            }
            f32x4 mkv[2], Ureg[2];
            for (int rep_ = 0; rep_ < ((PASS == 3 && RDUP == 7) ? 2 : 1); ++rep_) {
            STG_MARK(6);
            mkv[0] = (f32x4){0.f, 0.f, 0.f, 0.f}; mkv[1] = mkv[0];
            if (wave == 4 || wave == 5) { const int bb = 16 * (wave - 4), s = lane & 15; float x[16]; float trow[16];
#pragma unroll
                for (int t = 0; t < 16; ++t) trow[t] = Ts[(bb + t) * T_ST + bb + s];
#pragma unroll
                for (int t = 0; t < 16; ++t) { float a0 = (t == s) ? 1.f : 0.f, a1 = 0.f;
#pragma unroll
                    for (int u = 0; u < t; ++u) { const float tv = __int_as_float(__builtin_amdgcn_readlane(__float_as_int(trow[t]), u)); if (u & 1) a1 += tv * x[u]; else a0 += tv * x[u]; }
                    x[t] = a0 + a1; }
#pragma unroll
                for (int t = 0; t < 16; ++t) { if (lane < 16) st_bf(F.lds + OFF_M, (bb + t) * MST + bb + s, x[t]); } }
            else if (wave < 4) { const int q4 = c >> 2, p4 = c & 3;
                const LAS unsigned char* vb = ARR(AR_V) + ((8 * g + q4) * AST + 16 * wave + 4 * p4) * 2; const bf16x8 vfr = cat8(ld_tr(vb), ld_tr(vb + 4 * AST * 2));
#pragma unroll
                for (int st = 0; st < 2; ++st) mkv[st] = MFMA16(ld_b128(F.lds + OFF_MK + ((16 * st + c) * MST + 8 * g) * 2), vfr, mkv[st]); }
            LDSBAR();
            STG_MARK(8);
            { const s16x4 z4 = (s16x4){0, 0, 0, 0};
              const bf16x8 m00 = cat8(ld_b64(F.lds + OFF_M + (c * MST + 4 * g) * 2), z4), t10 = cat8(ld_b64(F.lds + OFF_M + ((16 + c) * MST + 4 * g) * 2), z4), m11 = cat8(ld_b64(F.lds + OFF_M + ((16 + c) * MST + 16 + 4 * g) * 2), z4);
              bf16x8 r0; f32x4 r1;
              if (wave < 4) { r0 = pack8(mkv[0], (f32x4){0.f, 0.f, 0.f, 0.f}); r1 = mkv[1]; }
              else { const int jt = wave - 4, q4 = c >> 2, p4 = c & 3;
                  r0 = cat8(ld_tr(ARR(AR_AT) + ((4 * g + q4) * AST + 16 * jt + 4 * p4) * 2), z4);
#pragma unroll
                  for (int r = 0; r < 4; ++r) r1[r] = bf2f(((const LAS bf16*)ARR(AR_AT))[(16 + 4 * g + r) * AST + 16 * jt + c]); }
              const f32x4 zero4 = (f32x4){0.f, 0.f, 0.f, 0.f};
              const f32x4 x0 = MFMA16(m00, r0, zero4);
              const f32x4 yv = MFMA16(t10, pack8(x0, zero4), r1);
              const f32x4 x1 = MFMA16(m11, pack8(yv, zero4), zero4);
              Ureg[0] = x0; Ureg[1] = x1;
              if (wave >= 4) { const int jt = wave - 4;
#pragma unroll
                  for (int r = 0; r < 4; ++r) { st_bf(ARR(AR_W), (4 * g + r) * AST + 16 * jt + c, x0[r]); st_bf(ARR(AR_W), (16 + 4 * g + r) * AST + 16 * jt + c, x1[r]); } } }
            LDSBAR();
            }
            STG_MARK(9);
            const bool active = (PASS == 1) ? true : (wave < 4);
            const bool inhom = (PASS == 1) ? (wave < 4) : true;
            const int cw = wave & 3;
            if (active) {
                bf16x8 xf[2];
                xf[0] = pack8(X[0], X[1]); xf[1] = pack8(X[2], X[3]);
                f32x4 Z[2];
#pragma unroll
                for (int tt = 0; tt < 2; ++tt) { f32x4 z = (f32x4){0.f, 0.f, 0.f, 0.f};
                    if (inhom) z = Ureg[tt];
#pragma unroll
                    for (int ks = 0; ks < 2; ++ks) { const LAS unsigned char* wb = ARR(AR_W) + ((16 * tt + c) * AST + 32 * ks + 4 * g) * 2;
                        z = MFMA16(cat8(ld_b64(wb), ld_b64(wb + 32)), xf[ks], z); }
                    Z[tt] = z; }
                const bf16x8 zf = pack8(Z[0], Z[1]);
                bf16x8 vf = zf;
                if (inhom) { const int q = c >> 2, p = c & 3; const LAS unsigned char* vb = ARR(AR_V) + ((4 * g + q) * AST + 16 * cw + 4 * p) * 2; vf = cat8(ld_tr(vb), ld_tr(vb + 16 * AST * 2)); }
                f32x4 Yt[2]; Yt[0] = (f32x4){0.f, 0.f, 0.f, 0.f}; Yt[1] = Yt[0];
                if (PASS == 3) {
#pragma unroll
                    for (int tt = 0; tt < 2; ++tt) { f32x4 y = (f32x4){0.f, 0.f, 0.f, 0.f};
#pragma unroll
                        for (int ks = 0; ks < 2; ++ks) { const LAS unsigned char* rb = ARR(AR_RT) + ((16 * tt + c) * AST + 32 * ks + 4 * g) * 2;
                            y = MFMA16(cat8(ld_b64(rb), ld_b64(rb + 32)), xf[ks], y); }
                        const LAS unsigned char* qb = F.lds + OFF_QB + ((16 * tt + c) * MST + 4 * g) * 2; const LAS unsigned char* qk = F.lds + OFF_QK + ((16 * tt + c) * MST + 4 * g) * 2;
                        y = MFMA16(cat8(ld_b64(qb), ld_b64(qb + 32)), zf, y);
                        y = MFMA16(cat8(ld_b64(qk), ld_b64(qk + 32)), vf, y);
                        Yt[tt] = y; } }
                { const int q = c >> 2, p = c & 3;
#pragma unroll
                  for (int jt = 0; jt < 4; ++jt) { f32x4 xn = X[jt];
                      const LAS unsigned char* bb = ARR(AR_BT) + ((4 * g + q) * AST + 16 * jt + 4 * p) * 2;
                      xn = MFMA16(cat8(ld_tr(bb), ld_tr(bb + 16 * AST * 2)), zf, xn);
                      if (inhom) { const LAS unsigned char* kb = ARR(AR_KT) + ((4 * g + q) * AST + 16 * jt + 4 * p) * 2; xn = MFMA16(cat8(ld_tr(kb), ld_tr(kb + 16 * AST * 2)), vf, xn); }
#pragma unroll
                      for (int r = 0; r < 4; ++r) xn[r] *= GAM[16 * jt + 4 * g + r];
                      X[jt] = xn; } }
                if (PASS == 3) {
#pragma unroll
                    for (int tt = 0; tt < 2; ++tt)
#pragma unroll
                        for (int r = 0; r < 4; ++r) YS[(16 * tt + 4 * g + r) * YS_ST + 16 * cw + c] = Yt[tt][r]; }
            }
            STG_MARK(10);
            if (PASS == 3) {
                LDSBAR();
                STG_MARK(11);
                { const int i = lane; float y[4], rk[4], vv[4], ga[4];
#pragma unroll
                  for (int k = 0; k < 4; ++k) { const int tl = wave + 8 * k; y[k] = YS[tl * YS_ST + i]; rk[k] = RK[tl]; vv[k] = bf2f(((const LAS bf16*)ARR(AR_V))[tl * AST + i]); ga[k] = bf2f(((const LAS bf16*)(F.lds + OFF_GAS))[tl * 64 + i]); }
                  const float c_g = CV[6 * 64 + i], c_b = CV[7 * 64 + i];
#pragma unroll
                  for (int k = 0; k < 4; ++k) { const int tl = wave + 8 * k; const size_t row = (size_t)(b * SEQ + t0 + tl);
                      const float mean = wave_sum_dpp(y[k]) * (1.f / 64.f); const float dd = y[k] - mean; const float var = wave_sum_dpp(dd * dd) * (1.f / 64.f);
                      const float o = (dd * __builtin_amdgcn_rsqf(var + 64e-5f) * c_g + c_b + rk[k] * vv[k]) * ga[k];
                      YA[row * 1024 + h * 64 + i] = (bf16)pg8::cvt_pk_bf16(o, o); } }
            }
            STG_MARK(12);
        }
        if (PASS == 1) { int lz = lane; asm volatile("" : "+v"(lz));
            float* pd = PD + (size_t)it * 8192 + (4 * (lz >> 4)) * 128 + 16 * wave + (lz & 15);
#pragma unroll
            for (int jt = 0; jt < 4; ++jt)
#pragma unroll
                for (int r = 0; r < 4; ++r) pd[(16 * jt + r) * 128] = X[jt][r]; }
    }
#ifdef STGPROBE
    if (PASS == 3 && F.bid == 0 && F.tid == 0) { unsigned long long* ts_ = (unsigned long long*)(F.ws + WS_CTL + 8192); ts_[0] += stg_acc; }
#endif
}
#define R2_LOAD(SET_, ITEM) do { const f32x4* pd_ = (const f32x4*)(PD + (size_t)(ITEM) * 8192); _Pragma("unroll") for (int q = 0; q < 4; ++q) SET_[q] = pd_[F.tid + NTHREADS * q]; } while (0)
#define R2_STEP(SET_, SC) do { const size_t it_ = (size_t)F.bid * RNSC + (SC); \
    _Pragma("unroll") for (int q = 0; q < 4; ++q) { const int e = F.tid + NTHREADS * q; *(LAS f32x4*)(PL + (e >> 5) * 132 + (e & 31) * 4) = SET_[q]; } \
    if ((SC) + 2 < RNSC) R2_LOAD(SET_, it_ + 2); \
    LDSBAR(); \
    { float* so = SST + it_ * 4096; for (int e = F.tid; e < 1024; e += NTHREADS) { const int j = e >> 4, i4 = (e & 15) * 4; *(f32x4*)(so + j * 64 + i4) = *(const LAS f32x4*)(S + j * 68 + i4); } } \
    f32x4 acc[2]; float pc[16], sb[2][16]; \
    _Pragma("unroll") for (int q = 0; q < 2; ++q) _Pragma("unroll") for (int r = 0; r < 4; ++r) acc[q][r] = PL[(16 * jt + 4 * g + r) * 132 + 16 * (it0 + q) + c]; \
    _Pragma("unroll") for (int ks = 0; ks < 16; ++ks) { pc[ks] = PL[(16 * jt + c) * 132 + 64 + 4 * ks + g]; _Pragma("unroll") for (int q = 0; q < 2; ++q) sb[q][ks] = S[(4 * ks + g) * 68 + 16 * (it0 + q) + c]; } \
    _Pragma("unroll") for (int ks = 0; ks < 16; ++ks) { _Pragma("unroll") for (int q = 0; q < 2; ++q) acc[q] = __builtin_amdgcn_mfma_f32_16x16x4f32(pc[ks], sb[q][ks], acc[q], 0, 0, 0); } \
    LDSBAR(); \
    _Pragma("unroll") for (int q = 0; q < 2; ++q) _Pragma("unroll") for (int r = 0; r < 4; ++r) S[(16 * jt + 4 * g + r) * 68 + 16 * (it0 + q) + c] = acc[q][r]; \
    } while (0)
__device__ __forceinline__ void rwkv_pass2(Frame& F) {
    if (F.bid >= 32) return;
    const float* PD = (const float*)(F.ws + WS_SC); float* SST = (float*)(F.ws + WS_SC + 16 * MiB);
    LAS float* S = (LAS float*)F.lds; LAS float* PL = S + 64 * 68;
    const int lane = F.lane, wave = F.wave, g = lane >> 4, c = lane & 15, jt = wave >> 1, it0 = 2 * (wave & 1);
    for (int e = F.tid; e < 64 * 68; e += NTHREADS) S[e] = 0.f;
    f32x4 set0[4], set1[4];
    R2_LOAD(set0, (size_t)F.bid * RNSC); R2_LOAD(set1, (size_t)F.bid * RNSC + 1);
    for (int sc = 0; sc < RNSC; sc += 2) { R2_STEP(set0, sc); R2_STEP(set1, sc + 1); }
}
#ifndef ATTN_PROBE
#define ATTN_PROBE 0
#endif
constexpr size_t WS_LSE = 330 * MiB;
constexpr int AT_KS = 0, AT_VS = 36864, AT_BIAS = 76032, AT_OST = 76800, KVST = 72;
__device__ __forceinline__ void attn_decode_run(int ridx, int& b, int& gatt, int& h, int& dil, int& r, int& n0) {
    const int bgh = ridx >> 4, k16 = ridx & 15; h = bgh & 7; const int bg = bgh >> 3; gatt = bg % 3; b = bg / 3;
    dil = (gatt == 0) ? 1 : (gatt == 1 ? 4 : 16); const int rpr = 16 / dil; r = k16 / rpr; n0 = (k16 % rpr) * 4;
}
__device__ __forceinline__ u32x4 attn_kv_piece(const bf16* QKV, int b, int gatt, int h, int dil, int r, int which, int lk, int chn, bool wrap = false) {
    u32x4 v = (u32x4){0u, 0u, 0u, 0u};
#ifdef ATTN_WRAP_PROBE
    if (wrap && lk >= 256) lk &= 255;
#endif
    if (lk >= 0) v = *(const u32x4*)(QKV + (size_t)(b * SEQ + lk * dil + r) * NQKV + 1536 + which * 1536 + gatt * 512 + h * 64 + chn * 8);
    return v;
}
constexpr int AT_SLOT = 128 * KVST * 2;
template <bool STORE> __device__ __forceinline__ void phase_attn_mfma(Frame& F) {
    bf16* QKV = (bf16*)(F.ws + WS_QKV); float* LSE = (float*)(F.ws + WS_LSE); const float* rel_bias = F.in[26];
    const int tid = F.tid, lane = F.lane, w = F.wave, g = lane >> 4, c = lane & 15, q4 = c >> 2, p4 = c & 3;
    LAS float* BIAS = (LAS float*)(F.lds + AT_BIAS);
    LAS bf16* OST = (LAS bf16*)(F.lds + AT_OST) + w * 16 * 72;
    for (int e = tid; e < 16 * KVST / 2; e += NTHREADS) ((LAS unsigned*)(F.lds + AT_VS + 256 * KVST * 2))[e] = 0u;
    int b, gatt, h, dil, r, n0;
    u32x4 kv[8], qnext[2];
    { attn_decode_run(F.bid, b, gatt, h, dil, r, n0);
#pragma unroll
      for (int i = 0; i < 8; ++i) { const int e = tid + NTHREADS * i; kv[i] = attn_kv_piece(QKV, b, gatt, h, dil, r, e >> 11, 128 * n0 - 128 + ((e >> 3) & 255), e & 7, !STORE); }
#pragma unroll
      for (int ks = 0; ks < 2; ++ks) qnext[ks] = *(const u32x4*)(QKV + (size_t)(b * SEQ + (128 * n0 + 16 * w + c) * dil + r) * NQKV + gatt * 512 + h * 64 + 32 * ks + 8 * g); }
    for (int ridx = F.bid; ridx < 768; ridx += F.G) {
        attn_decode_run(ridx, b, gatt, h, dil, r, n0);
        for (int i = 0; i < 4; ++i) { const int n = n0 + i, par = i & 1;
            const int prevK = par ? AT_KS + AT_SLOT : AT_KS, curK = par ? AT_KS : AT_KS + AT_SLOT, prevV = par ? AT_VS + AT_SLOT : AT_VS, curV = par ? AT_VS : AT_VS + AT_SLOT;
            LDSBAR();
            if (i == 0 && tid < 129) BIAS[tid] = rel_bias[(int)T5BUCKET[gatt][tid] * 24 + gatt * 8 + h];
            { int tz = tid; asm volatile("" : "+v"(tz));
              if (i == 0) {
#pragma unroll
                  for (int q = 0; q < 8; ++q) { const int e = tz + NTHREADS * q, which = e >> 11, rowi = (e >> 3) & 255, chn = e & 7;
                      *(LAS u32x4*)(F.lds + (which ? AT_VS : AT_KS) + (rowi * KVST + chn * 8) * 2) = kv[q]; } }
              else {
#pragma unroll
                  for (int q = 0; q < 4; ++q) { const int e = tz + NTHREADS * q, which = e >> 10, rowi = (e >> 3) & 127, chn = e & 7;
                      *(LAS u32x4*)(F.lds + (which ? curV : curK) + (rowi * KVST + chn * 8) * 2) = kv[q]; } } }
            const size_t qrow = (size_t)(b * SEQ + (128 * n + 16 * w + c) * dil + r);
            u32x4 qraw[2]; qraw[0] = qnext[0]; qraw[1] = qnext[1];
            { int tz = tid; asm volatile("" : "+v"(tz)); const int lz = tz & 63;
              const bool same = (i < 3), more = same || (ridx + F.G < 768);
              int b2 = b, g2 = gatt, h2 = h, d2 = dil, r2 = r, m0 = n0;
              if (!same && more) attn_decode_run(ridx + F.G, b2, g2, h2, d2, r2, m0);
              const int nn = same ? n + 1 : m0, lb = same ? 128 * nn : 128 * nn - 128, sh = same ? 10 : 11, msk = same ? 127 : 255, npc = same ? 4 : 8;
              if (more) {
#pragma unroll
                  for (int ks = 0; ks < 2; ++ks) qnext[ks] = *(const u32x4*)(QKV + (size_t)(b2 * SEQ + (128 * nn + 16 * w + (lz & 15)) * d2 + r2) * NQKV + g2 * 512 + h2 * 64 + 32 * ks + 8 * (lz >> 4));
#pragma unroll
                  for (int q = 0; q < 8; ++q) { const int e = tz + NTHREADS * q; if (q < npc) kv[q] = attn_kv_piece(QKV, b2, g2, h2, d2, r2, e >> sh, lb + ((e >> 3) & msk), e & 7, !STORE); } } }
            bf16x8 qf[2];
#pragma unroll
            for (int ks = 0; ks < 2; ++ks) { const u32x4 v = qraw[ks]; u32x4 o;
                o.x = pk2(bflo(v.x) * 0.125f, bfhi(v.x) * 0.125f); o.y = pk2(bflo(v.y) * 0.125f, bfhi(v.y) * 0.125f); o.z = pk2(bflo(v.z) * 0.125f, bfhi(v.z) * 0.125f); o.w = pk2(bflo(v.w) * 0.125f, bfhi(v.w) * 0.125f);
                qf[ks] = __builtin_bit_cast(bf16x8, o); }
            LDSBAR();
            f32x4 S[9];
#pragma unroll
            for (int j = 0; j < 9; ++j) { const int tau = w + j; const LAS unsigned char* kb = F.lds + ((tau < 8) ? prevK + tau * 16 * KVST * 2 : curK + (tau - 8) * 16 * KVST * 2) + (c * KVST + 8 * g) * 2;
                f32x4 a = (f32x4){0.f, 0.f, 0.f, 0.f}; a = MFMA16(ld_b128(kb), qf[0], a); a = MFMA16(ld_b128(kb + 64), qf[1], a); S[j] = a; }
            float mx = -1e30f;
#if ATTN_PROBE == 1
            if (STORE)
#endif
            { float bv[9][4];
#pragma unroll
              for (int j = 0; j < 9; ++j)
#pragma unroll
                  for (int rr = 0; rr < 4; ++rr) { const int delta = 128 - 16 * j + c - 4 * g - rr; bv[j][rr] = BIAS[min(max(delta, 0), 128)]; }
              asm volatile("s_waitcnt lgkmcnt(0)" ::: "memory");
#pragma unroll
              for (int j = 0; j < 9; ++j)
#pragma unroll
                  for (int rr = 0; rr < 4; ++rr) { const int delta = 128 - 16 * j + c - 4 * g - rr, ki = 16 * (w + j) + 4 * g + rr;
                      const bool valid = (delta >= 0) && (delta <= 128) && (n > 0 || ki >= 128);
                      const float s = valid ? S[j][rr] + bv[j][rr] : -1e30f; S[j][rr] = s; mx = fmaxf(mx, s); } }
#if ATTN_PROBE == 1
            float lsum = 1.f;
            if (STORE) {
            mx = fmaxf(mx, bperm_f(lane ^ 16, mx)); mx = fmaxf(mx, bperm_f(lane ^ 32, mx)); lsum = 0.f;
#else
            mx = fmaxf(mx, bperm_f(lane ^ 16, mx)); mx = fmaxf(mx, bperm_f(lane ^ 32, mx));
            float lsum = 0.f;
#endif
#pragma unroll
            for (int j = 0; j < 9; ++j)
#pragma unroll
                for (int rr = 0; rr < 4; ++rr) { const float p = (S[j][rr] > -1e29f) ? __expf(S[j][rr] - mx) : 0.f; S[j][rr] = p; lsum += p; }
            lsum += bperm_f(lane ^ 16, lsum); lsum += bperm_f(lane ^ 32, lsum);
#if ATTN_PROBE == 1
            }
#endif
            f32x4 O[4];
#pragma unroll
            for (int dt = 0; dt < 4; ++dt) O[dt] = (f32x4){0.f, 0.f, 0.f, 0.f};
#if ATTN_PROBE == 2
            if (STORE)
#endif
#pragma unroll
            for (int m5 = 0; m5 < 5; ++m5) { const f32x4 z4 = (f32x4){0.f, 0.f, 0.f, 0.f};
                const bf16x8 pf = pack8(S[2 * m5], (2 * m5 + 1 < 9) ? S[(2 * m5 + 1 < 9) ? 2 * m5 + 1 : 0] : z4);
                const int t1 = w + 2 * m5, t2 = t1 + 1;
                const LAS unsigned char* v1 = F.lds + ((t1 < 8) ? prevV + t1 * 16 * KVST * 2 : curV + (t1 - 8) * 16 * KVST * 2) + ((4 * g + q4) * KVST + 4 * p4) * 2;
                const LAS unsigned char* v2 = F.lds + ((t2 < 8) ? prevV + t2 * 16 * KVST * 2 : curV + (t2 - 8) * 16 * KVST * 2) + ((4 * g + q4) * KVST + 4 * p4) * 2;
#pragma unroll
                for (int dt = 0; dt < 4; ++dt) O[dt] = MFMA16(pf, cat8(ld_tr(v1 + dt * 32), ld_tr(v2 + dt * 32)), O[dt]); }
            const float linv = __builtin_amdgcn_rcpf(lsum);
            if (STORE && g == 0) LSE[qrow * 24 + gatt * 8 + h] = mx + __logf(lsum);
#pragma unroll
            for (int rr = 0; rr < 4; ++rr) { const float li = bperm_f(4 * g + rr, linv);
#pragma unroll
                for (int dt = 0; dt < 4; ++dt) OST[(4 * g + rr) * 72 + 16 * dt + c] = (bf16)pk2(O[dt][rr] * li, 0.f); }
#pragma unroll
            for (int q = 0; q < 2; ++q) { const int row = q * 8 + (lane >> 3), ch = lane & 7; const u32x4 v = *(const LAS u32x4*)(OST + row * 72 + ch * 8);
                if (STORE) *(u32x4*)(QKV + (size_t)(b * SEQ + (128 * n + 16 * w + row) * dil + r) * NQKV + gatt * 512 + h * 64 + ch * 8) = v; else asm volatile("" :: "v"(v)); }
        }
    }
}
__device__ __forceinline__ void phase_attn_merge(Frame& F) {
    const bf16* QKV = (const bf16*)(F.ws + WS_QKV); const float* LSE = (const float*)(F.ws + WS_LSE); bf16* YB = (bf16*)(F.ws + WS_YB);
    const size_t gt = (size_t)F.bid * NTHREADS + F.tid, NGT = (size_t)F.G * NTHREADS;
    for (size_t e = gt; e < (size_t)MROWS * 64; e += NGT) { const size_t row = e >> 6; const int h = (int)(e >> 3) & 7, d8 = (int)e & 7;
        const float l0 = LSE[row * 24 + h], l1 = LSE[row * 24 + 8 + h], l2 = LSE[row * 24 + 16 + h]; const float m = fmaxf(l0, fmaxf(l1, l2));
        float w0 = __expf(l0 - m), w1 = __expf(l1 - m), w2 = __expf(l2 - m); const float inv = 1.f / (w0 + w1 + w2); w0 *= inv; w1 *= inv; w2 *= inv;
        const bf16* qp = QKV + row * NQKV + h * 64 + d8 * 8;
        const u32x4 a = *(const u32x4*)qp, bq = *(const u32x4*)(qp + 512), cq = *(const u32x4*)(qp + 1024); u32x4 o;
        o.x = pk2(w0 * bflo(a.x) + w1 * bflo(bq.x) + w2 * bflo(cq.x), w0 * bfhi(a.x) + w1 * bfhi(bq.x) + w2 * bfhi(cq.x));
        o.y = pk2(w0 * bflo(a.y) + w1 * bflo(bq.y) + w2 * bflo(cq.y), w0 * bfhi(a.y) + w1 * bfhi(bq.y) + w2 * bfhi(cq.y));
        o.z = pk2(w0 * bflo(a.z) + w1 * bflo(bq.z) + w2 * bflo(cq.z), w0 * bfhi(a.z) + w1 * bfhi(bq.z) + w2 * bfhi(cq.z));
        o.w = pk2(w0 * bflo(a.w) + w1 * bflo(bq.w) + w2 * bflo(cq.w), w0 * bfhi(a.w) + w1 * bfhi(bq.w) + w2 * bfhi(cq.w));
        *(u32x4*)(YB + row * 512 + h * 64 + d8 * 8) = o; }
}
#define GEMM_LDS ((PG8_LAS unsigned char*)F.lds)
template <class Epi> __device__ __forceinline__ void run_gemm(Frame& F, const bf16* A, const bf16* Bt, int N, int K, const Epi& E) {
    pg8::Gemm g{A, Bt, MROWS, N, K}; pg8::StaticOrder S; S.init(MROWS, N, F.G, F.bid);
    pg8::gemm_phase<Epi, pg8::StaticOrder, true, true>(GEMM_LDS, g, S, E, F.tid);
}
#ifdef TPROBE
#define STAMP(cls) do { if (blockIdx.x == 0 && (cur_tid(wv)) == 0) { unsigned long long* ts_ = (unsigned long long*)(ka->ws + WS_CTL + 4096); const unsigned long long t_ = __builtin_amdgcn_s_memrealtime(); ts_[1 + (cls)] += t_ - ts_[0]; ts_[0] = t_; } } while (0)
#else
#define STAMP(cls) do {} while (0)
#endif
#ifndef PROBE_DUP
#define PROBE_DUP 0
#endif
#ifdef USE_CG_SYNC
#define GSYNC(cls) do { grid.sync(); STAMP(cls); } while (0)
#else
#define GSYNC(cls) do { xcd_barrier(xbar, cur_tid(wv)); STAMP(cls); } while (0)
#endif
struct PairOrder {
    pg8::StaticOrder base;
    __device__ bool next(int i, pg8::Unit& u) const { if (i >= 2) return false; pg8::Unit u0; if (!base.next(0, u0)) return false; u.pm = u0.pm; u.pn = u0.pn + 4 * i; return true; }
    __device__ __forceinline__ void a_ready(const pg8::Unit&) const {}
    __device__ __forceinline__ void done(const pg8::Unit&) const {}
};
__global__ void __launch_bounds__(NTHREADS, 2) fwd_kernel(Args a) {
    extern __shared__ __attribute__((aligned(16))) unsigned char lds[];
    cg::grid_group grid = cg::this_grid();
    const int wv = __builtin_amdgcn_readfirstlane((int)threadIdx.x >> 6);
    const KArgs ka = (KArgs)__builtin_amdgcn_kernarg_segment_ptr();
#ifdef TPROBE
    if (blockIdx.x == 0 && (cur_tid(wv)) == 0) { unsigned long long* ts_ = (unsigned long long*)(ka->ws + WS_CTL + 4096); for (int i = 1; i < 16; ++i) ts_[i] = 0ull; ts_[0] = __builtin_amdgcn_s_memrealtime(); }
#endif
    { const int t0_ = cur_tid(wv); if (t0_ < 16) ((LAS unsigned*)lds)[(LDS_BYTES - 64) / 4 + t0_] = 0u; }
    __syncthreads();
    XcdBarrier xbar = xcd_barrier_post((unsigned*)(ka->ws + WS_CTL + 65536), (volatile LAS unsigned*)((LAS unsigned char*)lds + LDS_BYTES - 64), cur_tid(wv));
    { Frame F; make_frame(F, ka, lds, wv); p0_mod(F); p0_weights(F); }
#if PROBE_DUP == 7
    __syncthreads();
    { Frame F; make_frame(F, ka, lds, wv); p0_mod(F); p0_weights(F); }
#endif
    grid.sync(); STAMP(0);
    for (int l = 0; l < 2; ++l) {
        { Frame F; make_frame(F, ka, lds, wv); phase_modnorm(F, l, (l == 0) ? F.in[0] : F.out); }
#if PROBE_DUP == 8
        __syncthreads();
        { Frame F; make_frame(F, ka, lds, wv); phase_modnorm(F, l, (l == 0) ? F.in[0] : F.out); }
#endif
        GSYNC(1);
        { Frame F; make_frame(F, ka, lds, wv); run_gemm(F, (const bf16*)(F.ws + WS_XN), (const bf16*)(F.ws + WS_WQKV) + (size_t)l * NQKV * 1024, NQKV, 1024, pg8::EpiStore{(bf16*)(F.ws + WS_QKV), NQKV}); }
        GSYNC(2);
#if PROBE_DUP == 1
        { Frame F; make_frame(F, ka, lds, wv); run_gemm(F, (const bf16*)(F.ws + WS_XN), (const bf16*)(F.ws + WS_WQKV) + (size_t)l * NQKV * 1024, NQKV, 1024, pg8::EpiStore{(bf16*)(F.ws + WS_QKV), NQKV}); }
        GSYNC(2);
#endif
#ifdef ATTN_NAIVE
        { Frame F; make_frame(F, ka, lds, wv); phase_attn_naive(F); }
        GSYNC(3);
#else
#if PROBE_DUP == 9
        { Frame F; make_frame(F, ka, lds, wv); phase_attn_mfma<false>(F); }
        __syncthreads();
#endif
        { Frame F; make_frame(F, ka, lds, wv); phase_attn_mfma<true>(F); }
        GSYNC(3);
        { Frame F; make_frame(F, ka, lds, wv); phase_attn_merge(F); }
        GSYNC(4);
#if PROBE_DUP == 2
        { Frame F; make_frame(F, ka, lds, wv); run_gemm(F, (const bf16*)(F.ws + WS_XN), (const bf16*)(F.ws + WS_WQKV) + (size_t)l * NQKV * 1024, NQKV, 1024, pg8::EpiStore{(bf16*)(F.ws + WS_QKV), NQKV}); }
        GSYNC(2);
        { Frame F; make_frame(F, ka, lds, wv); phase_attn_mfma<true>(F); }
        GSYNC(3);
        { Frame F; make_frame(F, ka, lds, wv); phase_attn_merge(F); }
        GSYNC(4);
#endif
#endif
        { Frame F; make_frame(F, ka, lds, wv); run_gemm(F, (const bf16*)(F.ws + WS_XN), (const bf16*)(F.ws + WS_WA) + (size_t)l * NAG * 1024, NAG, 1024, pg8::EpiD{(bf16*)(F.ws + WS_PA), (bf16*)(F.ws + WS_GA), (bf16*)(F.ws + WS_YB)}); }
        GSYNC(2);
#ifdef RWKV_NAIVE
        { Frame F; make_frame(F, ka, lds, wv); phase_rwkv_naive(F, l); }
        GSYNC(5);
#else
        { Frame F; make_frame(F, ka, lds, wv); rwkv_pass<1>(F, l); }
        GSYNC(5);
#if PROBE_DUP == 3
        { Frame F; make_frame(F, ka, lds, wv); rwkv_pass<1>(F, l); }
        GSYNC(5);
#endif
        { Frame F; make_frame(F, ka, lds, wv); rwkv_pass2(F); }
        GSYNC(6);
#if PROBE_DUP == 6
        { Frame F; make_frame(F, ka, lds, wv); rwkv_pass2(F); }
        GSYNC(6);
#endif
        { Frame F; make_frame(F, ka, lds, wv); rwkv_pass<3>(F, l); }
        GSYNC(7);
#if PROBE_DUP == 4
        { Frame F; make_frame(F, ka, lds, wv); rwkv_pass<3>(F, l); }
        GSYNC(7);
#endif
#if PROBE_DUP == 5
        for (int q_ = 0; q_ < 10; ++q_) grid.sync();
#endif
#endif
        { Frame F; make_frame(F, ka, lds, wv); pg8::Gemm g{(const bf16*)(F.ws + WS_XN), (const bf16*)(F.ws + WS_WM) + (size_t)l * 2048 * 1024, MROWS, 2048, 1024}; PairOrder S; S.base.init(MROWS, 1024, F.G, F.bid);
          pg8::gemm_phase<pg8::EpiSig, PairOrder, true, true>(GEMM_LDS, g, S, pg8::EpiSig{(bf16*)(F.ws + WS_MG), 0}, F.tid); }
        { Frame F; make_frame(F, ka, lds, wv); run_gemm(F, (const bf16*)(F.ws + WS_YA), (const bf16*)(F.ws + WS_WBA) + (size_t)l * 1024 * 1024, 1024, 1024, pg8::EpiMerge<false>{(bf16*)(F.ws + WS_MERGED), (const bf16*)(F.ws + WS_MG)}); }
        { Frame F; make_frame(F, ka, lds, wv); run_gemm(F, (const bf16*)(F.ws + WS_YB), (const bf16*)(F.ws + WS_WBB) + (size_t)l * 1024 * 512, 1024, 512, pg8::EpiMerge<true>{(bf16*)(F.ws + WS_MERGED), (const bf16*)(F.ws + WS_MG)}); }
        GSYNC(2);
        { Frame F; make_frame(F, ka, lds, wv); run_gemm(F, (const bf16*)(F.ws + WS_MERGED), (const bf16*)(F.ws + WS_WO) + (size_t)l * 1024 * 1024, 1024, 1024,
              pg8::EpiResid{(l == 0) ? F.in[0] : F.out, F.out, (const float*)(F.ws + WS_MOD) + (size_t)l * 2 * 3072 + 2048}); }
        GSYNC(2);
    }
    { Frame F; make_frame(F, ka, lds, wv); phase_final(F); }
#ifdef STGPROBE
    if (blockIdx.x == 0 && cur_tid(wv) == 0) { const unsigned long long* ts_ = (const unsigned long long*)(ka->ws + WS_CTL + 8192); ka->out[0] = (float)ts_[0] * 0.01f; }
#endif
#ifdef TPROBE
    if (blockIdx.x == 0 && (cur_tid(wv)) == 0) { STAMP(8); const unsigned long long* ts_ = (const unsigned long long*)(ka->ws + WS_CTL + 4096); ka->out[0] = (float)ts_[1 + TPROBE] * 0.01f; }
#endif
}
extern "C" void kernel_launch(void* const* d_in, const int* in_sizes, int n_in, void* d_out, int out_size, void* d_ws, size_t ws_size, hipStream_t stream) {
    static int grid = 0;
    if (grid == 0) {
        int dev = 0, cus = 0, per_cu = 0;
        (void)hipGetDevice(&dev); (void)hipDeviceGetAttribute(&cus, hipDeviceAttributeMultiprocessorCount, dev);
        (void)hipFuncSetAttribute((const void*)fwd_kernel, hipFuncAttributeMaxDynamicSharedMemorySize, LDS_BYTES);
        (void)hipOccupancyMaxActiveBlocksPerMultiprocessor(&per_cu, (const void*)fwd_kernel, NTHREADS, LDS_BYTES);
        if (n_in != 28 || out_size != MROWS * DM || ws_size < (size_t)352 * MiB || per_cu < 1) { fprintf(stderr, "kernel_launch: unexpected problem (n_in %d out %d ws %zu per_cu %d)\n", n_in, out_size, ws_size, per_cu); }
        grid = cus;
        (void)hipGetLastError();
    }
    (void)hipMemsetAsync((char*)d_ws + WS_CTL, 0, 1 * MiB, stream);
    Args a{};
    for (int i = 0; i < 28; ++i) a.in[i] = (const float*)d_in[i];
    a.out = (float*)d_out; a.ws = (unsigned char*)d_ws;
    void* args[] = {&a};
    hipError_t e = hipLaunchCooperativeKernel((void*)fwd_kernel, dim3(grid), dim3(NTHREADS), args, LDS_BYTES, stream);
    if (e != hipSuccess) fprintf(stderr, "cooperative launch failed: %s (grid %d)\n", hipGetErrorString(e), grid);
}
```

```cpp
#include <hip/hip_runtime.h>
#include <hip/hip_cooperative_groups.h>
#include <cstdio>
#include <cstdint>
namespace cg = cooperative_groups;
namespace pg8 {
#define PG8_LAS __attribute__((address_space(3)))
typedef unsigned short bf16_t;
typedef short bf16x8 __attribute__((ext_vector_type(8)));
typedef float f32x4 __attribute__((ext_vector_type(4)));
typedef unsigned u32x4 __attribute__((ext_vector_type(4)));
constexpr int BM = 256, BK = 64, HALF = 128, HTB = HALF * BK * 2  , STAGE_BYTES = 8 * HTB, NXCD = 8, WGM = 8;

__host__ __device__ __forceinline__ int lds_byte(int r, int c) { const int st = (r >> 4) * 2 + (c >> 5), rr = r & 15, cc = c & 31, ob = rr * 64 + cc * 2; return st * 1024 + (ob ^ (((ob >> 9) & 1) << 5)); }
__host__ __device__ __forceinline__ void stage_rc(int b, int& R, int& C) { const int st = b / 1024, sb = b % 1024, swz = sb ^ (((sb >> 9) & 1) << 5); R = (st >> 1) * 16 + swz / 64; C = (st & 1) * 32 + (swz % 64) / 2; }
__host__ __device__ __forceinline__ int perm32(int rho) { const int n = rho >> 4, i = rho & 15; return 8 * (i >> 2) + 4 * n + (i & 3); }

struct Unit { int pm, pn; };
struct Gemm { const bf16_t* A; const bf16_t* Bt; int M, N, K; };

struct StaticOrder {
    int nM, nN, nwg, G, c;
    __host__ __device__ void init(int M, int N, int G_, int c_) { nM = M / BM; nN = N / BM; nwg = nM * nN; G = G_; c = c_; }
    __host__ __device__ bool next(int i, Unit& u) const {
        const long L = (long)i * G + c; if (L >= nwg) return false;
        int wgid = (int)L; { const int q = nwg / NXCD, r = nwg % NXCD, xcd = wgid % NXCD, off = wgid / NXCD; wgid = (xcd < r ? xcd * (q + 1) : r * (q + 1) + (xcd - r) * q) + off; }
        const int nig = WGM * nN, gid = wgid / nig, fm = gid * WGM, gsz = (nM - fm) < WGM ? (nM - fm) : WGM;
        u.pm = fm + ((wgid % nig) % gsz); u.pn = (wgid % nig) / gsz; return true;
    }
    __device__ __forceinline__ void a_ready(const Unit&) const {}
    __device__ __forceinline__ void done(const Unit&) const {}
};

typedef float f32x2c_t __attribute__((ext_vector_type(2))); typedef __bf16 bf16x2c_t __attribute__((ext_vector_type(2)));
__device__ __forceinline__ unsigned cvt_pk_bf16(float lo, float hi) { const f32x2c_t v = {lo, hi}; const bf16x2c_t b = __builtin_convertvector(v, bf16x2c_t); return __builtin_bit_cast(unsigned, b); }
typedef float f32x2 __attribute__((ext_vector_type(2)));
template <class Epi, class Sched, bool ALIGN_EPI = false, bool SP2 = false>
__device__ __forceinline__ void gemm_phase(PG8_LAS unsigned char* lds, const Gemm g, const Sched& S, const Epi& E, int tid_in) {
    int tid_ = tid_in; asm volatile("" : "+v"(tid_));
    const int tid = tid_, wid = __builtin_amdgcn_readfirstlane(tid >> 6), lane = tid & 63, wr = wid >> 2, wc = wid & 3, fr = lane & 15, fq = lane >> 4;
    const int K = g.K, nt = K / BK;
    unsigned voffA[2], voffB[2];
#pragma unroll
    for (int i = 0; i < 2; ++i) { int R, C; stage_rc(tid * 16 + i * 8192, R, C); const int Rb = Epi::PERM ? ((R & ~31) + perm32(R & 31)) : R;
        voffA[i] = (unsigned)(R * K + C) * 2u; voffB[i] = (unsigned)(Rb * K + C) * 2u; }
    const size_t kstep = (size_t)(BK * 2);
    const size_t hstep = (size_t)HALF * K * 2;
    const size_t tstep = 2 * hstep;
    const unsigned ldsw = (unsigned)wid * 1024u;
    const int aoff = lds_byte(wr * 64 + fr, fq * 8), boff = lds_byte(wc * 32 + fr, fq * 8);
#define PG8_SA(b, h) (((b) * 2 + (h)) * HTB)
#define PG8_SB(b, h) ((4 + (b) * 2 + (h)) * HTB)
#define PG8_STAGE(bufoff, gbase, voff) do { _Pragma("unroll") for (int _i = 0; _i < 2; ++_i) \
        __builtin_amdgcn_global_load_lds((const unsigned*)((const char*)(gbase) + (voff)[_i]), (PG8_LAS unsigned*)(lds + (bufoff) + ldsw + _i * 8192), 16, 0, 0); } while (0)
#define PG8_LDA(dst, b, h) do { _Pragma("unroll") for (int m = 0; m < 4; ++m) _Pragma("unroll") for (int k = 0; k < 2; ++k) dst[m][k] = *(const PG8_LAS bf16x8*)(lds + PG8_SA(b, h) + aoff + m * 2048 + k * 1024); } while (0)
#define PG8_LDB(dst, b, h) do { _Pragma("unroll") for (int n = 0; n < 2; ++n) _Pragma("unroll") for (int k = 0; k < 2; ++k) dst[n][k] = *(const PG8_LAS bf16x8*)(lds + PG8_SB(b, h) + boff + n * 2048 + k * 1024); } while (0)
#define PG8_MMA(ai, bj, At, Bt) do { __builtin_amdgcn_s_setprio(1); _Pragma("unroll") for (int m = 0; m < 4; ++m) _Pragma("unroll") for (int n = 0; n < 2; ++n) _Pragma("unroll") for (int k = 0; k < 2; ++k) \
        acc[ai][bj][m][n] = __builtin_amdgcn_mfma_f32_16x16x32_bf16(Bt[n][k], At[m][k], acc[ai][bj][m][n], 0, 0, 0); __builtin_amdgcn_s_setprio(0); } while (0)
#define PG8_WAIT_V(n) asm volatile("s_waitcnt vmcnt(" #n ")" ::: "memory")
#define PG8_WAIT_L(n) asm volatile("s_waitcnt lgkmcnt(" #n ")" ::: "memory")
#define PG8_BAR __builtin_amdgcn_s_barrier()
#define PG8_SCHED __builtin_amdgcn_sched_barrier(0)
    Unit cur, nxt; int ui = 0;
    if (!S.next(0, cur)) return;
    f32x4 acc[2][2][4][2];
#pragma unroll
    for (int a = 0; a < 2; ++a)
#pragma unroll
        for (int b = 0; b < 2; ++b)
#pragma unroll
            for (int m = 0; m < 4; ++m)
#pragma unroll
                for (int n = 0; n < 2; ++n) acc[a][b][m][n] = (f32x4){0.f, 0.f, 0.f, 0.f};
    bf16x8 At[4][2], B0[2][2], B1[2][2];
    const char* cA = (const char*)g.A + (size_t)cur.pm * tstep; const char* cB = (const char*)g.Bt + (size_t)cur.pn * tstep;
    S.a_ready(cur);
    if constexpr (SP2) {
        PG8_STAGE(PG8_SB(0, 0), cB, voffB); PG8_STAGE(PG8_SB(0, 1), cB + hstep, voffB); PG8_STAGE(PG8_SA(0, 0), cA, voffA); PG8_STAGE(PG8_SA(0, 1), cA + hstep, voffA);
        if (wr == 1) PG8_BAR;
        PG8_WAIT_V(2); PG8_BAR;
        PG8_STAGE(PG8_SB(1, 0), cB + kstep, voffB); PG8_STAGE(PG8_SA(1, 0), cA + kstep, voffA); PG8_STAGE(PG8_SB(1, 1), cB + hstep + kstep, voffB);
        PG8_WAIT_V(6); PG8_BAR;
    } else {
        PG8_STAGE(PG8_SB(0, 0), cB, voffB); PG8_STAGE(PG8_SA(0, 0), cA, voffA); PG8_STAGE(PG8_SB(0, 1), cB + hstep, voffB); PG8_STAGE(PG8_SA(0, 1), cA + hstep, voffA);
        if (wr == 1) PG8_BAR;
        PG8_WAIT_V(4); PG8_BAR;
        PG8_STAGE(PG8_SB(1, 0), cB + kstep, voffB); PG8_STAGE(PG8_SA(1, 0), cA + kstep, voffA); PG8_STAGE(PG8_SB(1, 1), cB + hstep + kstep, voffB);
        PG8_WAIT_V(6); PG8_BAR;
    }
    for (;;) {
        const bool has_next = S.next(ui + 1, nxt);
        const char* nA = has_next ? (const char*)g.A + (size_t)nxt.pm * tstep : cA; const char* nB = has_next ? (const char*)g.Bt + (size_t)nxt.pn * tstep : cB;
        for (int t = 0; t < nt; t += 2) {
            const bool last = (t == nt - 2);
            const char* a1 = cA + (size_t)(t + 1) * kstep;
            const char* a2 = last ? nA : cA + (size_t)(t + 2) * kstep; const char* b2 = last ? nB : cB + (size_t)(t + 2) * kstep;
            const char* a3 = a2 + kstep; const char* b3 = b2 + kstep;
            if (last && has_next) S.a_ready(nxt);
            if constexpr (SP2) {
            PG8_LDB(B0, 0, 0); PG8_LDB(B1, 0, 1); PG8_SCHED; PG8_LDA(At, 0, 0); PG8_STAGE(PG8_SA(1, 1), a1 + hstep, voffA);
            PG8_WAIT_V(8); PG8_WAIT_L(0); PG8_BAR; PG8_MMA(0, 0, At, B0); PG8_MMA(0, 1, At, B1); PG8_BAR; PG8_SCHED;
            PG8_LDA(At, 0, 1); PG8_STAGE(PG8_SB(0, 0), b2, voffB); PG8_STAGE(PG8_SB(0, 1), b2 + hstep, voffB); PG8_STAGE(PG8_SA(0, 0), a2, voffA);
            PG8_WAIT_V(8); PG8_WAIT_L(0); PG8_BAR; PG8_MMA(1, 0, At, B0); PG8_MMA(1, 1, At, B1); PG8_BAR; PG8_SCHED;
            PG8_LDB(B0, 1, 0); PG8_LDB(B1, 1, 1); PG8_SCHED; PG8_LDA(At, 1, 0); PG8_STAGE(PG8_SA(0, 1), a2 + hstep, voffA);
            PG8_WAIT_V(8); PG8_WAIT_L(0); PG8_BAR; PG8_MMA(0, 0, At, B0); PG8_MMA(0, 1, At, B1); PG8_BAR; PG8_SCHED;
            PG8_LDA(At, 1, 1); PG8_STAGE(PG8_SB(1, 0), b3, voffB); PG8_STAGE(PG8_SB(1, 1), b3 + hstep, voffB); PG8_STAGE(PG8_SA(1, 0), a3, voffA);
            PG8_WAIT_V(8); PG8_WAIT_L(0); PG8_BAR; PG8_MMA(1, 0, At, B0); PG8_MMA(1, 1, At, B1); PG8_BAR; PG8_SCHED;
            } else {
            PG8_LDB(B0, 0, 0); PG8_SCHED; PG8_LDA(At, 0, 0); PG8_STAGE(PG8_SA(1, 1), a1 + hstep, voffA);
            PG8_WAIT_L(8); PG8_BAR; PG8_WAIT_L(0); PG8_MMA(0, 0, At, B0); PG8_BAR; PG8_SCHED;
            PG8_LDB(B1, 0, 1); PG8_STAGE(PG8_SB(0, 0), b2, voffB);
            PG8_BAR; PG8_WAIT_L(0); PG8_MMA(0, 1, At, B1); PG8_BAR;
            PG8_LDA(At, 0, 1); PG8_STAGE(PG8_SA(0, 0), a2, voffA);
            PG8_BAR; PG8_WAIT_L(0); PG8_MMA(1, 0, At, B0); PG8_BAR; PG8_SCHED;
            PG8_STAGE(PG8_SB(0, 1), b2 + hstep, voffB);
            PG8_WAIT_V(6); PG8_BAR; PG8_MMA(1, 1, At, B1); PG8_BAR;
            PG8_LDB(B0, 1, 0); PG8_SCHED; PG8_LDA(At, 1, 0); PG8_STAGE(PG8_SA(0, 1), a2 + hstep, voffA);
            PG8_WAIT_L(8); PG8_BAR; PG8_WAIT_L(0); PG8_MMA(0, 0, At, B0); PG8_BAR; PG8_SCHED;
            PG8_LDB(B1, 1, 1); PG8_STAGE(PG8_SB(1, 0), b3, voffB);
            PG8_BAR; PG8_WAIT_L(0); PG8_MMA(0, 1, At, B1); PG8_BAR;
            PG8_LDA(At, 1, 1); PG8_STAGE(PG8_SA(1, 0), a3, voffA);
            PG8_BAR; PG8_WAIT_L(0); PG8_MMA(1, 0, At, B0); PG8_BAR; PG8_SCHED;
            PG8_STAGE(PG8_SB(1, 1), b3 + hstep, voffB);
            PG8_WAIT_V(6); PG8_BAR; PG8_MMA(1, 1, At, B1); PG8_BAR;
            }
        }
        if constexpr (ALIGN_EPI) { if (wr == 0) PG8_BAR; }
        if constexpr (!Epi::AFTER_DRAIN) { E(acc, cur, wr, wc, fr, fq); S.done(cur); }
        if (!has_next) break;
#pragma unroll
        for (int a = 0; a < 2; ++a)
#pragma unroll
            for (int b = 0; b < 2; ++b)
#pragma unroll
                for (int m = 0; m < 4; ++m)
#pragma unroll
                    for (int n = 0; n < 2; ++n) acc[a][b][m][n] = (f32x4){0.f, 0.f, 0.f, 0.f};
        cur = nxt; cA = nA; cB = nB; ++ui;
        if constexpr (ALIGN_EPI) { if (wr == 1) PG8_BAR; }
    }
    PG8_WAIT_V(0);
    if constexpr (!ALIGN_EPI) { if (wr == 0) PG8_BAR; }
    PG8_BAR;
    if constexpr (Epi::AFTER_DRAIN) { E.fused(acc, cur, wr, wc, fr, fq, lds, wid, lane); S.done(cur); }
#undef PG8_SA
#undef PG8_SB
#undef PG8_STAGE
#undef PG8_LDA
#undef PG8_LDB
#undef PG8_MMA
#undef PG8_WAIT_V
#undef PG8_WAIT_L
#undef PG8_BAR
#undef PG8_SCHED
}
}
namespace pg8 {
__device__ __forceinline__ float ep_bflo(unsigned w) { return __uint_as_float(w << 16); }
__device__ __forceinline__ float ep_bfhi(unsigned w) { return __uint_as_float(w & 0xffff0000u); }
__device__ __forceinline__ float ep_sigmoid(float x) { return 1.f / (1.f + __expf(-x)); }
struct EpiStore {
    static constexpr bool PERM = true, AFTER_DRAIN = false;
    bf16_t* O; int ldc;
    __device__ __forceinline__ void operator()(const f32x4 (&acc)[2][2][4][2], const Unit& u, int wr, int wc, int fr, int fq) const {
        const int row0 = u.pm * BM + wr * 64 + fr, col0 = u.pn * BM + wc * 32 + 8 * fq;
#pragma unroll
        for (int ai = 0; ai < 2; ++ai)
#pragma unroll
            for (int m = 0; m < 4; ++m) { bf16_t* rowp = O + (size_t)(row0 + ai * HALF + m * 16) * ldc + col0;
#pragma unroll
                for (int bj = 0; bj < 2; ++bj) { const f32x4 v0 = acc[ai][bj][m][0], v1 = acc[ai][bj][m][1]; u32x4 w;
                    w.x = cvt_pk_bf16(v0[0], v0[1]); w.y = cvt_pk_bf16(v0[2], v0[3]); w.z = cvt_pk_bf16(v1[0], v1[1]); w.w = cvt_pk_bf16(v1[2], v1[3]);
                    *(u32x4*)(rowp + bj * HALF) = w; } }
    }
};
struct EpiD {
    static constexpr bool PERM = true, AFTER_DRAIN = false;
    bf16_t* PA; bf16_t* GA; bf16_t* YB;
    __device__ __forceinline__ void operator()(const f32x4 (&acc)[2][2][4][2], const Unit& u, int wr, int wc, int fr, int fq) const {
        const int colt = u.pn * BM; int mode, ld, cb; bf16_t* P;
        if (colt < 3584) { mode = 0; P = PA; ld = 3584; cb = colt; } else if (colt < 4608) { mode = 1; P = GA; ld = 1024; cb = colt - 3584; } else { mode = 2; P = YB; ld = 512; cb = colt - 4608; }
        const int row0 = u.pm * BM + wr * 64 + fr, col0 = cb + wc * 32 + 8 * fq;
#pragma unroll
        for (int ai = 0; ai < 2; ++ai)
#pragma unroll
            for (int m = 0; m < 4; ++m) { bf16_t* rowp = P + (size_t)(row0 + ai * HALF + m * 16) * ld + col0;
#pragma unroll
                for (int bj = 0; bj < 2; ++bj) { const f32x4 v0 = acc[ai][bj][m][0], v1 = acc[ai][bj][m][1]; float g[8] = {v0[0], v0[1], v0[2], v0[3], v1[0], v1[1], v1[2], v1[3]};
                    if (mode == 1) {
#pragma unroll
                        for (int e = 0; e < 8; ++e) g[e] = g[e] * ep_sigmoid(g[e]);
                    } else if (mode == 2) {
                        const u32x4 y = *(const u32x4*)(rowp + bj * HALF);
                        const float yv[8] = {ep_bflo(y.x), ep_bfhi(y.x), ep_bflo(y.y), ep_bfhi(y.y), ep_bflo(y.z), ep_bfhi(y.z), ep_bflo(y.w), ep_bfhi(y.w)};
#pragma unroll
                        for (int e = 0; e < 8; ++e) g[e] = yv[e] * g[e] * ep_sigmoid(g[e]);
                    }
                    u32x4 w; w.x = cvt_pk_bf16(g[0], g[1]); w.y = cvt_pk_bf16(g[2], g[3]); w.z = cvt_pk_bf16(g[4], g[5]); w.w = cvt_pk_bf16(g[6], g[7]);
                    *(u32x4*)(rowp + bj * HALF) = w; } }
    }
};
struct EpiSig {
    static constexpr bool PERM = true, AFTER_DRAIN = false;
    bf16_t* MG; int coff;
    __device__ __forceinline__ void operator()(const f32x4 (&acc)[2][2][4][2], const Unit& u, int wr, int wc, int fr, int fq) const {
        const int row0 = u.pm * BM + wr * 64 + fr, col0 = coff + u.pn * BM + wc * 32 + 8 * fq;
#pragma unroll
        for (int ai = 0; ai < 2; ++ai)
#pragma unroll
            for (int m = 0; m < 4; ++m) { bf16_t* rowp = MG + (size_t)(row0 + ai * HALF + m * 16) * 2048 + col0;
#pragma unroll
                for (int bj = 0; bj < 2; ++bj) { const f32x4 v0 = acc[ai][bj][m][0], v1 = acc[ai][bj][m][1]; u32x4 w;
                    w.x = cvt_pk_bf16(ep_sigmoid(v0[0]), ep_sigmoid(v0[1])); w.y = cvt_pk_bf16(ep_sigmoid(v0[2]), ep_sigmoid(v0[3])); w.z = cvt_pk_bf16(ep_sigmoid(v1[0]), ep_sigmoid(v1[1])); w.w = cvt_pk_bf16(ep_sigmoid(v1[2]), ep_sigmoid(v1[3]));
                    *(u32x4*)(rowp + bj * HALF) = w; } }
    }
};
template <bool SECOND> struct EpiMerge {
    static constexpr bool PERM = true, AFTER_DRAIN = false;
    bf16_t* MERGED; const bf16_t* MG;
    __device__ __forceinline__ void operator()(const f32x4 (&acc)[2][2][4][2], const Unit& u, int wr, int wc, int fr, int fq) const {
        const int row0 = u.pm * BM + wr * 64 + fr, col0 = u.pn * BM + wc * 32 + 8 * fq;
#pragma unroll
        for (int ai = 0; ai < 2; ++ai)
#pragma unroll
            for (int m = 0; m < 4; ++m) { const size_t r = (size_t)(row0 + ai * HALF + m * 16);
#pragma unroll
                for (int bj = 0; bj < 2; ++bj) { const f32x4 v0 = acc[ai][bj][m][0], v1 = acc[ai][bj][m][1]; float g[8] = {v0[0], v0[1], v0[2], v0[3], v1[0], v1[1], v1[2], v1[3]};
                    const int c = col0 + bj * HALF;
                    const u32x4 s = *(const u32x4*)(MG + r * 2048 + (SECOND ? 1024 : 0) + c);
                    const float sv[8] = {ep_bflo(s.x), ep_bfhi(s.x), ep_bflo(s.y), ep_bfhi(s.y), ep_bflo(s.z), ep_bfhi(s.z), ep_bflo(s.w), ep_bfhi(s.w)};
                    bf16_t* dst = MERGED + r * 1024 + c;
                    if (SECOND) { const u32x4 p = *(const u32x4*)dst;
                        const float pv[8] = {ep_bflo(p.x), ep_bfhi(p.x), ep_bflo(p.y), ep_bfhi(p.y), ep_bflo(p.z), ep_bfhi(p.z), ep_bflo(p.w), ep_bfhi(p.w)};
#pragma unroll
                        for (int e = 0; e < 8; ++e) g[e] = pv[e] + sv[e] * g[e];
                    } else {
#pragma unroll
                        for (int e = 0; e < 8; ++e) g[e] = sv[e] * g[e];
                    }
                    u32x4 w; w.x = cvt_pk_bf16(g[0], g[1]); w.y = cvt_pk_bf16(g[2], g[3]); w.z = cvt_pk_bf16(g[4], g[5]); w.w = cvt_pk_bf16(g[6], g[7]);
                    *(u32x4*)dst = w; } }
    }
};
struct EpiResid {
    static constexpr bool PERM = false, AFTER_DRAIN = false;
    const float* xin; float* xout; const float* gate;
    __device__ __forceinline__ void operator()(const f32x4 (&acc)[2][2][4][2], const Unit& u, int wr, int wc, int fr, int fq) const {
        const int b = (u.pm * BM) / 8192; const float* gp = gate + b * 3072;
        const int row0 = u.pm * BM + wr * 64 + fr, col0 = u.pn * BM + wc * 32 + 4 * fq;
#pragma unroll
        for (int bj = 0; bj < 2; ++bj)
#pragma unroll
            for (int n = 0; n < 2; ++n) { const int c = col0 + bj * HALF + n * 16; const f32x4 gv = *(const f32x4*)(gp + c);
#pragma unroll
                for (int ai = 0; ai < 2; ++ai)
#pragma unroll
                    for (int m = 0; m < 4; ++m) { const size_t off = (size_t)(row0 + ai * HALF + m * 16) * 1024 + c;
                        const f32x4 xi = *(const f32x4*)(xin + off); *(f32x4*)(xout + off) = xi + gv * acc[ai][bj][m][n]; } }
    }
};
}
constexpr int BATCH = 2, SEQ = 8192, DM = 1024, MROWS = BATCH * SEQ, PROJW = 11264;
constexpr int NQKV = 4608, NA = 3584, NAG = 5120, NLORA = 320;
constexpr size_t MiB = 1u << 20;
constexpr size_t WS_CTL = 0, WS_MOD = 1 * MiB;
constexpr size_t WS_WQKV = 2 * MiB, WS_WA = 20 * MiB, WS_WM = 40 * MiB, WS_WBA = 48 * MiB, WS_WBB = 52 * MiB, WS_WO = 54 * MiB;
constexpr size_t WS_VFIRST = 58 * MiB, WS_XN = 90 * MiB, WS_YB = 122 * MiB;
constexpr size_t WS_QKV = 138 * MiB, WS_PA = 138 * MiB, WS_YA = 250 * MiB, WS_MG = 138 * MiB, WS_MERGED = 202 * MiB, WS_SC = 282 * MiB, WS_GA = 314 * MiB;
constexpr int LDS_BYTES = 147456;
constexpr int NTHREADS = 512, NWAVES = 8;
#define LAS __attribute__((address_space(3)))
typedef unsigned short bf16;
typedef float f32x4 __attribute__((ext_vector_type(4)));
typedef unsigned u32x4 __attribute__((ext_vector_type(4)));
typedef unsigned u32x2 __attribute__((ext_vector_type(2)));

__device__ const unsigned char T5BUCKET[3][132] = {
 {0,1,2,3,4,5,6,7,8,9,10,11,12,13,14,15,16,16,16,16,16,16,17,17,17,17,17,17,17,17,18,18,18,18,18,18,18,18,18,18,19,19,19,19,19,19,19,19,19,19,19,19,19,19,20,20,20,20,20,20,20,20,20,20,20,20,20,20,20,20,20,20,20,21,21,21,21,21,21,21,21,21,21,21,21,21,21,21,21,21,21,21,21,21,21,21,21,21,21,22,22,22,22,22,22,22,22,22,22,22,22,22,22,22,22,22,22,22,22,22,22,22,22,22,22,22,22,22,22,0,0,0},
 {0,4,8,12,16,16,17,17,18,18,19,19,19,19,20,20,20,20,20,21,21,21,21,21,21,22,22,22,22,22,22,22,22,22,23,23,23,23,23,23,23,23,23,23,23,23,24,24,24,24,24,24,24,24,24,24,24,24,24,24,24,24,25,25,25,25,25,25,25,25,25,25,25,25,25,25,25,25,25,25,25,25,25,26,26,26,26,26,26,26,26,26,26,26,26,26,26,26,26,26,26,26,26,26,26,26,26,26,26,26,26,26,26,27,27,27,27,27,27,27,27,27,27,27,27,27,27,27,27,0,0,0},
 {0,16,18,19,20,21,21,22,22,23,23,23,24,24,24,24,25,25,25,25,25,26,26,26,26,26,26,26,26,27,27,27,27,27,27,27,27,27,27,28,28,28,28,28,28,28,28,28,28,28,28,28,29,29,29,29,29,29,29,29,29,29,29,29,29,29,29,29,29,29,30,30,30,30,30,30,30,30,30,30,30,30,30,30,30,30,30,30,30,30,30,30,30,30,30,31,31,31,31,31,31,31,31,31,31,31,31,31,31,31,31,31,31,31,31,31,31,31,31,31,31,31,31,31,31,31,31,31,31,0,0,0}};

__device__ __forceinline__ unsigned f2bf(float f) { unsigned u = __builtin_bit_cast(unsigned, f); return (u + 0x7fffu + ((u >> 16) & 1u)) >> 16; }
__device__ __forceinline__ unsigned pk2(float lo, float hi) { return pg8::cvt_pk_bf16(lo, hi); }
__device__ __forceinline__ float bflo(unsigned w) { return __uint_as_float(w << 16); }
__device__ __forceinline__ float bfhi(unsigned w) { return __uint_as_float(w & 0xffff0000u); }
__device__ __forceinline__ float bf2f(bf16 h) { return __uint_as_float(((unsigned)h) << 16); }
template <int CTRL, int RMASK> __device__ __forceinline__ float dpp_f(float v) { return __int_as_float(__builtin_amdgcn_update_dpp(0, __float_as_int(v), CTRL, RMASK, 0xF, false)); }
template <int CTRL, int RMASK> __device__ __forceinline__ float dpp_keep(float v) { return __int_as_float(__builtin_amdgcn_update_dpp(__float_as_int(v), __float_as_int(v), CTRL, RMASK, 0xF, false)); }
__device__ __forceinline__ float wave_sum_dpp(float v) {
    v += dpp_f<0xB1, 0xF>(v); v += dpp_f<0x4E, 0xF>(v); v += dpp_f<0x141, 0xF>(v); v += dpp_f<0x140, 0xF>(v);
    v += dpp_f<0x142, 0xA>(v); v += dpp_f<0x143, 0xC>(v);
    return __int_as_float(__builtin_amdgcn_readlane(__float_as_int(v), 63));
}
__device__ __forceinline__ float wave_max_dpp(float v) {
    v = fmaxf(v, dpp_keep<0xB1, 0xF>(v)); v = fmaxf(v, dpp_keep<0x4E, 0xF>(v)); v = fmaxf(v, dpp_keep<0x141, 0xF>(v)); v = fmaxf(v, dpp_keep<0x140, 0xF>(v));
    v = fmaxf(v, dpp_keep<0x142, 0xA>(v)); v = fmaxf(v, dpp_keep<0x143, 0xC>(v));
    return __int_as_float(__builtin_amdgcn_readlane(__float_as_int(v), 63));
}
__device__ __forceinline__ float wave_sum(float v) { return wave_sum_dpp(v); }
__device__ __forceinline__ float wave_max(float v) { return wave_max_dpp(v); }
__device__ __forceinline__ float bperm_f(int src_lane, float v) { return __int_as_float(__builtin_amdgcn_ds_bpermute(src_lane << 2, __float_as_int(v))); }
__device__ __forceinline__ float sigmoidf_(float x) { return 1.f / (1.f + __expf(-x)); }
__device__ __forceinline__ float siluf_(float x) { return x / (1.f + __expf(-x)); }

struct Args { const float* in[28]; float* out; unsigned char* ws; };
typedef const __attribute__((address_space(4))) Args* KArgs;
struct Frame {
    LAS unsigned char* lds;
    int tid, lane, wave, G, bid;
    const float* in[28]; float* out; unsigned char* ws;
};
__device__ __forceinline__ int lane_id_() { return (int)__builtin_amdgcn_mbcnt_hi(~0u, __builtin_amdgcn_mbcnt_lo(~0u, 0u)); }
__device__ __forceinline__ int cur_tid(int wv) { int w2 = wv; asm volatile("" : "+s"(w2)); unsigned z = 0u; asm volatile("" : "+v"(z)); return w2 * 64 + (int)__builtin_amdgcn_mbcnt_hi(~0u, __builtin_amdgcn_mbcnt_lo(~0u, z)); }
__device__ __forceinline__ void make_frame(Frame& F, KArgs ka, unsigned char* lds, int wv) {
    asm volatile("" : "+s"(ka));
    int t = cur_tid(wv);
    F.lds = (LAS unsigned char*)lds; F.tid = t; F.lane = t & 63; F.wave = __builtin_amdgcn_readfirstlane(t >> 6); F.G = gridDim.x; F.bid = blockIdx.x;
    const __attribute__((address_space(4))) unsigned long long* kr = (const __attribute__((address_space(4))) unsigned long long*)ka;
#pragma unroll
    for (int i = 0; i < 28; ++i) F.in[i] = (const float*)(const __attribute__((address_space(1))) float*)kr[i];
    F.out = (float*)(__attribute__((address_space(1))) float*)kr[28]; F.ws = (unsigned char*)(__attribute__((address_space(1))) unsigned char*)kr[29];
}
#define XB_TMO      128
#define XB_XCNT(j)  (256  + 64 * (j))
#define XB_XSUB(j)  (1280 + 64 * (j))
#define XB_XGEN(j)  (2304 + 64 * (j))
#define XB_TOP      3328
#define XB_TOPGEN   3392
#define XCD_BAR_WORDS 3456
#define XB_SPIN_CAP (1u << 18)

__device__ __forceinline__ unsigned xb_ld(unsigned* p)              { return __hip_atomic_load(p, __ATOMIC_RELAXED, __HIP_MEMORY_SCOPE_AGENT); }
__device__ __forceinline__ unsigned xb_add(unsigned* p, unsigned v) { return __hip_atomic_fetch_add(p, v, __ATOMIC_RELAXED, __HIP_MEMORY_SCOPE_AGENT); }
__device__ __forceinline__ unsigned xb_xcc_id() { return (unsigned)__builtin_amdgcn_s_getreg((3 << 11) | 20) & 0xFu; }
#define XB_SPIN(cond, bar) do { unsigned _sp = 0; while (cond) { __builtin_amdgcn_s_sleep(1); \
    if ((++_sp & 255u) == 0u) { if (xb_ld(&(bar)[XB_TMO])) break; if (_sp > XB_SPIN_CAP) { atomicAdd(&(bar)[XB_TMO], 1u); break; } } } } while (0)

struct XcdBarrier {
    unsigned* bar; unsigned x;
    volatile LAS unsigned* st;
};

__device__ __forceinline__ XcdBarrier xcd_barrier_post(unsigned* bar, volatile LAS unsigned* st, int tid) {
    XcdBarrier b; b.bar = bar; b.x = xb_xcc_id(); b.st = st;
    if (tid == 0) (void)xb_add(&bar[XB_XCNT(b.x)], 1u);
    return b;
}
__device__ __forceinline__ void xcd_barrier_complete(unsigned* bar, unsigned x, unsigned& nloc, unsigned& nx) {
    const unsigned G = gridDim.x * gridDim.y * gridDim.z;
    unsigned sum, cnt, mine, sp = 0u;
    for (;;) {
        sum = 0u; cnt = 0u; mine = 0u;
#pragma unroll
        for (unsigned j = 0; j < 16; ++j) { const unsigned c = xb_ld(&bar[XB_XCNT(j)]); sum += c; cnt += (c > 0u) ? 1u : 0u; mine = (j == x) ? c : mine; }
        if (sum == G) break;
        __builtin_amdgcn_s_sleep(1);
        if ((++sp & 255u) == 0u) { if (xb_ld(&bar[XB_TMO])) break; if (sp > XB_SPIN_CAP) { atomicAdd(&bar[XB_TMO], 1u); break; } }
    }
    nloc = mine > 0u ? mine : 1u; nx = cnt > 0u ? cnt : 1u;
}

__device__ __forceinline__ void xcd_barrier(const XcdBarrier& b, int tid) {
    asm volatile("s_waitcnt vmcnt(0)" ::: "memory");
    __syncthreads();
    if (tid == 0) {
        unsigned* bar = b.bar; asm volatile("" : "+s"(bar));
        __builtin_amdgcn_s_waitcnt(0);
        unsigned nloc = b.st[0], nx = b.st[1];
        if (nloc == 0u) { xcd_barrier_complete(bar, b.x, nloc, nx); b.st[0] = nloc; b.st[1] = nx; }
        const unsigned old = xb_add(&bar[XB_XSUB(b.x)], 1u);
        const unsigned gen = old / nloc;
        if (old + 1u == (gen + 1u) * nloc) {
            __builtin_amdgcn_fence(__ATOMIC_RELEASE, "agent");
            asm volatile("s_waitcnt vmcnt(0)" ::: "memory");
            const unsigned og = xb_add(&bar[XB_TOP], 1u);
            const unsigned tg = og / nx;
            if (og + 1u == (tg + 1u) * nx) xb_add(&bar[XB_TOPGEN], 1u);
            else XB_SPIN(xb_ld(&bar[XB_TOPGEN]) == tg, bar);
            __builtin_amdgcn_fence(__ATOMIC_ACQUIRE, "agent");
            xb_add(&bar[XB_XGEN(b.x)], 1u);
            asm volatile("s_waitcnt vmcnt(0)" ::: "memory");
        } else {
            XB_SPIN(xb_ld(&bar[XB_XGEN(b.x)]) == gen, bar);
            __builtin_amdgcn_fence(__ATOMIC_ACQUIRE, "agent");
            asm volatile("s_waitcnt vmcnt(0)" ::: "memory");
        }
    }
    __syncthreads();
}
__device__ __forceinline__ void p0_mod(Frame& F) {
    const float* c = F.in[1]; const float* ada_w = F.in[3]; const float* ada_b = F.in[4];
    float* mod = (float*)(F.ws + WS_MOD);
    LAS float* red = (LAS float*)F.lds;
    const int col = F.tid & 31, kg = F.tid >> 5;
    for (int ch = F.bid; ch < 192; ch += F.G) {
        const int l = ch / 96, n = (ch % 96) * 32 + col;
        const float* W = ada_w + (size_t)l * 1024 * 3072 + n;
        float a0 = 0.f, a1 = 0.f;
        for (int i = 0; i < 64; ++i) { const int k = kg + 16 * i; const float w = W[(size_t)k * 3072]; a0 += siluf_(c[k]) * w; a1 += siluf_(c[1024 + k]) * w; }
        red[kg * 32 + col] = a0; red[512 + kg * 32 + col] = a1;
        __syncthreads();
        if (F.tid < 64) { const int b = F.tid >> 5; float s = 0.f;
            for (int g = 0; g < 16; ++g) s += red[b * 512 + g * 32 + col];
            mod[(size_t)(l * 2 + b) * 3072 + n] = s + ada_b[l * 3072 + n]; }
        __syncthreads();
    }
}
__device__ __forceinline__ void transpose_item(const float* W, int ldw, int col0, int K, int ncols, bf16* WT, LAS float* scr, int item, int lane) {
    const int nblk = ncols / 32, kb = item / nblk, nb = item % nblk, k0 = 64 * kb, n0 = 32 * nb;
#pragma unroll 8
    for (int i = 0; i < 32; ++i) { const int kk = 2 * i + (lane >> 5); scr[kk * 33 + (lane & 31)] = W[(size_t)(k0 + kk) * ldw + col0 + n0 + (lane & 31)]; }
    asm volatile("s_waitcnt lgkmcnt(0)" ::: "memory");
    const int c = lane & 7;
#pragma unroll
    for (int j = 0; j < 4; ++j) { const int n = (lane >> 3) + 8 * j; const LAS float* s = scr + (8 * c) * 33 + n;
        u32x4 o; o.x = pk2(s[0 * 33], s[1 * 33]); o.y = pk2(s[2 * 33], s[3 * 33]); o.z = pk2(s[4 * 33], s[5 * 33]); o.w = pk2(s[6 * 33], s[7 * 33]);
        *(u32x4*)(WT + (size_t)(n0 + n) * K + k0 + 8 * c) = o; }
    asm volatile("s_waitcnt lgkmcnt(0)" ::: "memory");
}
__device__ __forceinline__ void p0_weights(Frame& F) {
    LAS float* scr = (LAS float*)(F.lds + 16384 + F.wave * 16384);
    const int gw = F.bid * NWAVES + F.wave, NGW = F.G * NWAVES;
    constexpr int I_QKV = 16 * 144, I_A = 16 * 96, I_GA = 16 * 32, I_GB = 16 * 16, I_M = 16 * 64, I_BA = 16 * 32, I_BB = 8 * 32, I_O = 16 * 32;
    constexpr int PER_L = I_QKV + I_A + I_GA + I_GB + I_M + I_BA + I_BB + I_O;
    for (int it = gw; it < 2 * PER_L; it += NGW) {
        const int l = it / PER_L; int r = it % PER_L;
        const float* win = F.in[5] + (size_t)l * 1024 * PROJW;
        bf16* wqkv = (bf16*)(F.ws + WS_WQKV) + (size_t)l * NQKV * 1024;
        bf16* wa = (bf16*)(F.ws + WS_WA) + (size_t)l * NAG * 1024;
        bf16* wm = (bf16*)(F.ws + WS_WM) + (size_t)l * 2048 * 1024;
        const float* W; int ldw, col0, K, ncols; bf16* WT;
        if (r < I_QKV) { W = win; ldw = PROJW; col0 = 4096; K = 1024; ncols = 4608; WT = wqkv; }
        else if ((r -= I_QKV) < I_A) { W = win; ldw = PROJW; col0 = 0; K = 1024; ncols = 3072; WT = wa; }
        else if ((r -= I_A) < I_GA) { W = win; ldw = PROJW; col0 = 3072; K = 1024; ncols = 1024; WT = wa + (size_t)3584 * 1024; }
        else if ((r -= I_GA) < I_GB) { W = win; ldw = PROJW; col0 = 8704; K = 1024; ncols = 512; WT = wa + (size_t)4608 * 1024; }
        else if ((r -= I_GB) < I_M) { W = win; ldw = PROJW; col0 = 9216; K = 1024; ncols = 2048; WT = wm; }
        else if ((r -= I_M) < I_BA) { W = F.in[23] + (size_t)l * 1024 * 1024; ldw = 1024; col0 = 0; K = 1024; ncols = 1024; WT = (bf16*)(F.ws + WS_WBA) + (size_t)l * 1024 * 1024; }
        else if ((r -= I_BA) < I_BB) { W = F.in[24] + (size_t)l * 512 * 1024; ldw = 1024; col0 = 0; K = 512; ncols = 1024; WT = (bf16*)(F.ws + WS_WBB) + (size_t)l * 1024 * 512; }
        else { r -= I_BB; W = F.in[25] + (size_t)l * 1024 * 1024; ldw = 1024; col0 = 0; K = 1024; ncols = 1024; WT = (bf16*)(F.ws + WS_WO) + (size_t)l * 1024 * 1024; }
        transpose_item(W, ldw, col0, K, ncols, WT, scr, r, F.lane);
    }
    const size_t gt = (size_t)F.bid * NTHREADS + F.tid, NGT = (size_t)F.G * NTHREADS;
    for (size_t e = gt; e < (size_t)2 * 512 * 1024; e += NGT) {
        const int l = (int)(e / (512 * 1024)), n = (int)((e / 1024) % 512), k = (int)(e % 1024);
        const float muw = F.in[7][(size_t)(l * 2 + 0) * 1024 + k], mua = F.in[7][(size_t)(l * 2 + 1) * 1024 + k];
        float v = 0.f;
        if (n < 64) v = F.in[9][((size_t)l * 1024 + k) * 64 + n] * (1.f - muw);
        else if (n < 128) v = F.in[9][((size_t)l * 1024 + k) * 64 + (n - 64)] * muw;
        else if (n < 192) v = F.in[12][((size_t)l * 1024 + k) * 64 + (n - 128)] * (1.f - mua);
        else if (n < 256) v = F.in[12][((size_t)l * 1024 + k) * 64 + (n - 192)] * mua;
        else if (n < 320 && l == 1) { const float muv = F.in[19][k]; const int m = (n - 256) & 31; const float w = F.in[21][(size_t)k * 32 + m]; v = (n < 288) ? w * (1.f - muv) : w * muv; }
        ((bf16*)(F.ws + WS_WA))[((size_t)l * NAG + 3072 + n) * 1024 + k] = (bf16)f2bf(v);
    }
}
__device__ __forceinline__ void phase_modnorm(Frame& F, int l, const float* xin) {
    const float* mod = (const float*)(F.ws + WS_MOD) + (size_t)l * 2 * 3072;
    const float* g = F.in[2] + l * 1024;
    bf16* XN = (bf16*)(F.ws + WS_XN);
    const int gw = F.bid * NWAVES + F.wave, NGW = F.G * NWAVES;
    for (int m = gw; m < MROWS; m += NGW) {
        const int b = m / SEQ; const f32x4* xr = (const f32x4*)(xin + (size_t)m * 1024) + F.lane;
        f32x4 v[4]; float s = 0.f;
#pragma unroll
        for (int j = 0; j < 4; ++j) { v[j] = xr[64 * j]; s += (v[j].x * v[j].x + v[j].y * v[j].y) + (v[j].z * v[j].z + v[j].w * v[j].w); }
        const float rs = 1.f / sqrtf(wave_sum(s) * (1.f / 1024.f) + 1e-6f);
        u32x2* o = (u32x2*)(XN + (size_t)m * 1024) + F.lane;
#pragma unroll
        for (int j = 0; j < 4; ++j) { const int c = 4 * F.lane + 256 * j;
            const f32x4 gg = *(const f32x4*)(g + c), sh = *(const f32x4*)(mod + b * 3072 + c), sc = *(const f32x4*)(mod + b * 3072 + 1024 + c);
            const f32x4 h = v[j] * rs * gg * (sc + 1.f) + sh; u32x2 w; w.x = pk2(h.x, h.y); w.y = pk2(h.z, h.w); o[64 * j] = w; }
    }
}
__device__ __forceinline__ void phase_final(Frame& F) {
    const float* g = F.in[27]; const int gw = F.bid * NWAVES + F.wave, NGW = F.G * NWAVES;
    for (int m = gw; m < MROWS; m += NGW) {
        f32x4* xr = (f32x4*)(F.out + (size_t)m * 1024) + F.lane; f32x4 v[4]; float s = 0.f;
#pragma unroll
        for (int j = 0; j < 4; ++j) { v[j] = xr[64 * j]; s += (v[j].x * v[j].x + v[j].y * v[j].y) + (v[j].z * v[j].z + v[j].w * v[j].w); }
        const float rs = 1.f / sqrtf(wave_sum(s) * (1.f / 1024.f) + 1e-6f);
#pragma unroll
        for (int j = 0; j < 4; ++j) { const f32x4 gg = *(const f32x4*)(g + 4 * F.lane + 256 * j); xr[64 * j] = v[j] * rs * gg; }
    }
}
#define LDSBAR() do { asm volatile("s_waitcnt lgkmcnt(0)" ::: "memory"); __builtin_amdgcn_s_barrier(); asm volatile("" ::: "memory"); } while (0)
typedef short bf16x8 __attribute__((ext_vector_type(8)));
typedef short s16x4 __attribute__((ext_vector_type(4)));
typedef short v4i16_t __attribute__((ext_vector_type(4)));
constexpr int RC = 32, RLS = 512, RNSC = SEQ / RLS, RNCH = RLS / RC, RITEMS = BATCH * 16 * RNSC;
constexpr int AST = 72;
constexpr int MST = 40;
constexpr int OFF_RAWH = 0, OFF_RAWL = 12800, OFF_GCS = 12800, OFF_MK = 12800, OFF_QB = 15360, OFF_QK = 17920, OFF_YS = 20480, OFF_M = 28928, OFF_MMK = 31488;
constexpr int OFF_LW = 34048, OFF_LA = OFF_LW + 4608, OFF_LV = OFF_LA + 4608;
constexpr int OFF_W2T = 45824, OFF_A2T = OFF_W2T + 9216, OFF_V2T = OFF_A2T + 9216;
constexpr int OFF_CV = 69376, OFF_GAM = 72192, OFF_RK = 72448;
constexpr int OFF_PRE = 72576, OFF_U = 72576, OFF_T = OFF_U + 8704;
constexpr int OFF_LWG = 97664, OFF_ARR = 105856, OFF_VFS = 142720, OFF_GAS = OFF_ARR + 4 * (32 * AST * 2);
constexpr int PRE_ST = 196, U_ST = 68, T_ST = 36, YS_ST = 66;
enum { AR_RT = 0, AR_AT, AR_BT, AR_KT, AR_BH, AR_KH, AR_V, AR_W };
static_assert(OFF_VFS + 4096 <= LDS_BYTES - 64 && OFF_MMK + 2560 <= OFF_LW && OFF_YS + 32 * YS_ST * 4 <= OFF_M, "rwkv LDS map");
#define ARR(k) (F.lds + OFF_ARR + (k) * (32 * AST * 2))

__device__ __forceinline__ bf16x8 ld_b128(const LAS unsigned char* p) { return *(const LAS bf16x8*)p; }
__device__ __forceinline__ s16x4 ld_b64(const LAS unsigned char* p) { return *(const LAS s16x4*)p; }
__device__ __forceinline__ s16x4 ld_tr(const LAS unsigned char* p) { return __builtin_bit_cast(s16x4, __builtin_amdgcn_ds_read_tr16_b64_v4i16((LAS v4i16_t*)p)); }
__device__ __forceinline__ bf16x8 cat8(s16x4 a, s16x4 b) { return (bf16x8){a[0], a[1], a[2], a[3], b[0], b[1], b[2], b[3]}; }
__device__ __forceinline__ bf16x8 pack8(f32x4 a, f32x4 b) { u32x4 w; w.x = pk2(a[0], a[1]); w.y = pk2(a[2], a[3]); w.z = pk2(b[0], b[1]); w.w = pk2(b[2], b[3]); return __builtin_bit_cast(bf16x8, w); }
#define MFMA16(a, b, c) __builtin_amdgcn_mfma_f32_16x16x32_bf16((a), (b), (c), 0, 0, 0)
__device__ __forceinline__ void st_bf(LAS unsigned char* base, int idx, float v) { ((LAS bf16*)base)[idx] = (bf16)pg8::cvt_pk_bf16(v, v); }
__device__ __forceinline__ float fsig(float x) { return __builtin_amdgcn_rcpf(1.f + __expf(-x)); }
__device__ __forceinline__ float fast_tanh(float x) { return 1.f - 2.f * __builtin_amdgcn_rcpf(1.f + __expf(2.f * x)); }

__device__ __forceinline__ u32x4 rwkv_raw_load(const bf16* PA, const bf16* VF, int l, int b, int h, int t0, int i, int tid) {
    u32x4 v = (u32x4){0u, 0u, 0u, 0u};
    if (i == 5) { if (tid < 256) v = *(const u32x4*)(VF + (size_t)(b * SEQ + t0 + (tid >> 3)) * 1024 + h * 64 + (tid & 7) * 8); return v; }
    const int e = tid + NTHREADS * i, rr = (i < 4) ? (e >> 6) : 32, k = tid & 63, t = t0 - 1 + rr;
    const int col = (k < 24) ? ((k >> 3) * 1024 + h * 64 + (k & 7) * 8) : (3072 + (k - 24) * 8);
    if (i < 4 || tid < 64) { if (t >= 0) v = *(const u32x4*)(PA + (size_t)(b * SEQ + t) * NA + col); }
    else if (l == 1 && tid < 320) { const int q = tid - 64; v = *(const u32x4*)(VF + (size_t)(b * SEQ + t0 + (q >> 3)) * 1024 + h * 64 + (q & 7) * 8); }
    return v;
}
__device__ __forceinline__ void rwkv_raw_store(Frame& F, int i, int tid, u32x4 v) {
    if (i == 5) { if (tid < 256) *(LAS u32x4*)(F.lds + OFF_GAS + tid * 16) = v; return; }
    const int e = tid + NTHREADS * i, rr = (i < 4) ? (e >> 6) : 32, k = tid & 63;
    const int off = (k < 24) ? (OFF_RAWH + (rr * 192 + k * 8) * 2) : (OFF_RAWL + (rr * 320 + (k - 24) * 8) * 2);
    if (i < 4 || tid < 64) *(LAS u32x4*)(F.lds + off) = v;
    else if (tid < 320) *(LAS u32x4*)(F.lds + OFF_VFS + (tid - 64) * 16) = v;
}

__device__ __forceinline__ void rwkv_chain_scan(Frame& F, int chain, int sc_lo, int sc_hi);
template <int PASS> __device__ __forceinline__ void rwkv_pass(Frame& F, int l) {
    const int tid = F.tid, lane = F.lane, wave = F.wave, g = lane >> 4, c = lane & 15;
    const bf16* PA = (const bf16*)(F.ws + WS_PA); bf16* YA = (bf16*)(F.ws + WS_YA); bf16* VF = (bf16*)(F.ws + WS_VFIRST);
    float* PD = (float*)(F.ws + WS_SC); float* SST = (float*)(F.ws + WS_SC + 16 * MiB);
    LAS float* CV = (LAS float*)(F.lds + OFF_CV); LAS float* GAM = (LAS float*)(F.lds + OFF_GAM); LAS float* RK = (LAS float*)(F.lds + OFF_RK);
    LAS float* PRE = (LAS float*)(F.lds + OFF_PRE); LAS float* Us = (LAS float*)(F.lds + OFF_U); LAS float* Ts = (LAS float*)(F.lds + OFF_T);
    LAS float* LWG = (LAS float*)(F.lds + OFF_LWG); LAS float* GCS = (LAS float*)(F.lds + OFF_GCS); LAS float* YS = (LAS float*)(F.lds + OFF_YS);
    LAS bf16* RAWH = (LAS bf16*)(F.lds + OFF_RAWH); LAS bf16* RAWL = (LAS bf16*)(F.lds + OFF_RAWL); LAS bf16* VFS = (LAS bf16*)(F.lds + OFF_VFS);
    const int chain = F.bid >> 3, b = chain >> 4, h = chain & 15, NIT = RNSC / 8;
    if (F.G != 256) return;
    if (PASS == 3) rwkv_chain_scan(F, chain, (F.bid & 7) * NIT, (F.bid & 7) * NIT + NIT - 1);
    for (int e = tid; e < 4096; e += NTHREADS) { const int m = e >> 6, j = e & 63;
        st_bf(F.lds + OFF_W2T, j * AST + m, F.in[10][((size_t)l * 64 + m) * 1024 + h * 64 + j]);
        st_bf(F.lds + OFF_A2T, j * AST + m, F.in[13][((size_t)l * 64 + m) * 1024 + h * 64 + j]);
        if (m < 32) st_bf(F.lds + OFF_V2T, j * MST + m, (l == 1) ? F.in[22][(size_t)m * 1024 + h * 64 + j] : 0.f); }
    if (tid < 64) { const int cc = h * 64 + tid;
        CV[0 * 64 + tid] = F.in[8][l * 1024 + cc];  CV[1 * 64 + tid] = F.in[11][l * 1024 + cc]; CV[2 * 64 + tid] = (l == 1) ? F.in[20][cc] : 0.f;
        CV[3 * 64 + tid] = F.in[14][l * 1024 + cc]; CV[4 * 64 + tid] = F.in[15][l * 1024 + cc]; CV[5 * 64 + tid] = F.in[16][l * 1024 + cc];
        CV[6 * 64 + tid] = F.in[17][l * 1024 + cc]; CV[7 * 64 + tid] = F.in[18][l * 1024 + cc];
        CV[8 * 64 + tid] = F.in[6][(size_t)(l * 3 + 0) * 1024 + cc]; CV[9 * 64 + tid] = F.in[6][(size_t)(l * 3 + 1) * 1024 + cc]; CV[10 * 64 + tid] = F.in[6][(size_t)(l * 3 + 2) * 1024 + cc]; }
    const bf16* GAp = (const bf16*)(F.ws + WS_GA);
    u32x4 pre[5], preg = (u32x4){0u, 0u, 0u, 0u};
#pragma unroll
    for (int i = 0; i < 5; ++i) pre[i] = rwkv_raw_load(PA, VF, l, b, h, ((F.bid & 7) * NIT) * RLS, i, tid);
    if (PASS == 3) preg = rwkv_raw_load(PA, GAp, l, b, h, ((F.bid & 7) * NIT) * RLS, 5, tid);
    for (int ii = 0; ii < NIT; ++ii) {
        const int sc = (F.bid & 7) * NIT + ii, it = chain * RNSC + sc;
        f32x4 X[4];
#pragma unroll
        for (int jt = 0; jt < 4; ++jt) X[jt] = (f32x4){0.f, 0.f, 0.f, 0.f};
        if (PASS == 1) { if (wave >= 4) {
#pragma unroll
                for (int jt = 0; jt < 4; ++jt)
#pragma unroll
                    for (int r = 0; r < 4; ++r) X[jt][r] = (16 * jt + 4 * g + r == 16 * (wave - 4) + c) ? 1.f : 0.f; } }
        else if (wave < 4) { int lz = lane; asm volatile("" : "+v"(lz));
            const float* s0 = SST + (size_t)it * 4096 + (4 * (lz >> 4)) * 64 + 16 * wave + (lz & 15);
#pragma unroll
            for (int jt = 0; jt < 4; ++jt)
#pragma unroll
                for (int r = 0; r < 4; ++r) X[jt][r] = s0[(16 * jt + r) * 64]; }
        for (int ch = 0; ch < RNCH; ++ch) {
            const int t0 = sc * RLS + ch * RC;
            LDSBAR();
            {
            { int tz = tid; asm volatile("" : "+v"(tz));
#pragma unroll
              for (int i = 0; i < 5; ++i) rwkv_raw_store(F, i, tz, pre[i]);
              if (PASS == 3) rwkv_raw_store(F, 5, tz, preg);
              const bool last = (ch == RNCH - 1) && (ii == NIT - 1); const int t0n = last ? t0 : t0 + RC;
#pragma unroll
              for (int i = 0; i < 5; ++i) pre[i] = rwkv_raw_load(PA, VF, l, b, h, t0n, i, tz);
              if (PASS == 3) preg = rwkv_raw_load(PA, GAp, l, b, h, t0n, 5, tz); }
            LDSBAR();
            }
            {
            { const int tl = tid >> 4, mq = tid & 15; const LAS unsigned char* cur = F.lds + OFF_RAWL + (tl + 1) * 640 + mq * 8; const LAS unsigned char* prv = F.lds + OFF_RAWL + tl * 640 + mq * 8;
              const u32x2 cw = *(const LAS u32x2*)(cur), pw = *(const LAS u32x2*)(prv + 128), ca = *(const LAS u32x2*)(cur + 256), pa = *(const LAS u32x2*)(prv + 384);
              const unsigned cv2 = *(const LAS unsigned*)(F.lds + OFF_RAWL + (tl + 1) * 640 + 512 + mq * 4), pv2 = *(const LAS unsigned*)(F.lds + OFF_RAWL + tl * 640 + 576 + mq * 4);
              u32x2 lw, la;
              lw.x = pk2(fast_tanh(bflo(cw.x) + bflo(pw.x)), fast_tanh(bfhi(cw.x) + bfhi(pw.x))); lw.y = pk2(fast_tanh(bflo(cw.y) + bflo(pw.y)), fast_tanh(bfhi(cw.y) + bfhi(pw.y)));
              la.x = pk2(bflo(ca.x) + bflo(pa.x), bfhi(ca.x) + bfhi(pa.x)); la.y = pk2(bflo(ca.y) + bflo(pa.y), bfhi(ca.y) + bfhi(pa.y));
              const unsigned lv = pk2(bflo(cv2) + bflo(pv2), bfhi(cv2) + bfhi(pv2));
              *(LAS u32x2*)(F.lds + OFF_LW + (tl * AST + mq * 4) * 2) = lw; *(LAS u32x2*)(F.lds + OFF_LA + (tl * AST + mq * 4) * 2) = la; *(LAS unsigned*)(F.lds + OFF_LV + (tl * MST + mq * 2) * 2) = lv; }
            LDSBAR();
            }
            {
            { f32x4 acc3[3];
#pragma unroll
              for (int q = 0; q < 3; ++q) { const int o16 = 2 * wave + q - 1;
                const int tt = (q == 0) ? (wave >> 2) : (o16 >> 3), mat = (q == 0) ? 0 : 1 + ((o16 >> 2) & 1), jt = (q == 0) ? (wave & 3) : (o16 & 3);
                f32x4 acc = (f32x4){0.f, 0.f, 0.f, 0.f};
                if (mat < 2) { const LAS unsigned char* Ab = F.lds + (mat == 0 ? OFF_LW : OFF_LA) + ((16 * tt + c) * AST + 8 * g) * 2; const LAS unsigned char* Bb = F.lds + (mat == 0 ? OFF_W2T : OFF_A2T) + ((16 * jt + c) * AST + 8 * g) * 2;
                    acc = MFMA16(ld_b128(Ab), ld_b128(Bb), acc); acc = MFMA16(ld_b128(Ab + 64), ld_b128(Bb + 64), acc); }
                else { const LAS unsigned char* Ab = F.lds + OFF_LV + ((16 * tt + c) * MST + 8 * g) * 2; const LAS unsigned char* Bb = F.lds + OFF_V2T + ((16 * jt + c) * MST + 8 * g) * 2;
                    acc = MFMA16(ld_b128(Ab), ld_b128(Bb), acc); }
                acc3[q] = acc; }
              const float w0 = CV[16 * (wave & 3) + c];
#pragma unroll
              for (int q = 0; q < 3; ++q) { const int o16 = 2 * wave + q - 1;
                const int tt = (q == 0) ? (wave >> 2) : (o16 >> 3), mat = (q == 0) ? 0 : 1 + ((o16 >> 2) & 1), jt = (q == 0) ? (wave & 3) : (o16 & 3), nt = mat * 4 + jt;
                if (q == 0) {
#pragma unroll
                    for (int r = 0; r < 4; ++r) { const float x = -(acc3[0][r] + w0); const float sp = fmaxf(x, 0.f) + __logf(1.f + __expf(-fabsf(x))); LWG[(16 * tt + 4 * g + r) * 64 + 16 * jt + c] = -__expf(-sp - 0.5f); } }
                else {
#pragma unroll
                    for (int r = 0; r < 4; ++r) PRE[(16 * tt + 4 * g + r) * PRE_ST + 16 * nt + c] = acc3[q][r]; } } }
            LDSBAR();
            }
            {
            { const int tt = wave >> 2, jt = wave & 3; f32x4 acc = (f32x4){0.f, 0.f, 0.f, 0.f};
#pragma unroll
              for (int ks = 0; ks < 8; ++ks) { if (ks >= 4 && tt == 0) continue;
                  const float av = (4 * ks + g <= 16 * tt + c) ? 1.f : 0.f; const float bv = LWG[(4 * ks + g) * 64 + 16 * jt + c];
                  acc = __builtin_amdgcn_mfma_f32_16x16x4f32(av, bv, acc, 0, 0, 0); }
#pragma unroll
              for (int r = 0; r < 4; ++r) GCS[(16 * tt + 4 * g + r) * 64 + 16 * jt + c] = acc[r];
              if (tt == 1 && g == 3) GAM[16 * jt + c] = __expf(acc[3]); }
            LDSBAR();
            }
            {
            { const int j = lane;
              const float c_a0 = CV[64 + j], c_v0 = CV[128 + j], c_kk = CV[3 * 64 + j], c_ka = CV[4 * 64 + j], c_rk = CV[5 * 64 + j], c_mr = CV[8 * 64 + j], c_mk = CV[9 * 64 + j], c_mv = CV[10 * 64 + j];
#pragma unroll
              for (int kb = 0; kb < 4; kb += 2) {
              float apre[2], vpre[2], pr[2], prp[2], pk[2], pkp[2], pvv[2], pvp[2], vfv[2], gt[2], gp[2];
#pragma unroll
              for (int k = 0; k < 2; ++k) { const int tl = wave + 8 * (kb + k);
                  apre[k] = PRE[tl * PRE_ST + 64 + j]; vpre[k] = PRE[tl * PRE_ST + 128 + j];
                  pr[k] = bf2f(RAWH[(tl + 1) * 192 + j]); prp[k] = bf2f(RAWH[tl * 192 + j]); pk[k] = bf2f(RAWH[(tl + 1) * 192 + 64 + j]); pkp[k] = bf2f(RAWH[tl * 192 + 64 + j]);
                  pvv[k] = bf2f(RAWH[(tl + 1) * 192 + 128 + j]); pvp[k] = bf2f(RAWH[tl * 192 + 128 + j]);
                  vfv[k] = bf2f(VFS[tl * 64 + j]);
                  gt[k] = GCS[tl * 64 + j]; gp[k] = GCS[(tl > 0 ? tl - 1 : 0) * 64 + j]; }
              float o_at[2], o_bt[2], o_kt[2], o_v[2], o_rt[2], o_rk[2];
#pragma unroll
              for (int k = 0; k < 2; ++k) {
                  const float r = pr[k] + (prp[k] - pr[k]) * c_mr, kx = pk[k] + (pkp[k] - pk[k]) * c_mk; float v = pvv[k] + (pvp[k] - pvv[k]) * c_mv;
                  const float asig = fsig(apre[k] + c_a0);
                  if (l == 1) v = v + (vfv[k] - v) * fsig(vpre[k] + c_v0);
                  const float kk = kx * c_kk; const float ss = wave_sum_dpp(kk * kk); const float kkn = kk * __builtin_amdgcn_rsqf(fmaxf(ss, 1e-24f));
                  const float k2 = kx * (1.f + (asig - 1.f) * c_ka); const float av = -kkn, bv = kkn * asig;
                  const float eg = __expf(gt[k]), egp = (wave + 8 * (kb + k) > 0) ? __expf(gp[k]) : 1.f, einv = __expf(-gt[k]);
                  o_at[k] = av * egp; o_bt[k] = bv * einv; o_kt[k] = k2 * einv; o_v[k] = v; o_rt[k] = r * eg;
                  o_rk[k] = (PASS == 3) ? wave_sum_dpp(r * k2 * c_rk) : 0.f; }
#pragma unroll
              for (int k = 0; k < 2; ++k) { const int tl = wave + 8 * (kb + k), o = tl * AST + j;
                  st_bf(ARR(AR_AT), o, o_at[k]); st_bf(ARR(AR_BT), o, o_bt[k]); st_bf(ARR(AR_KT), o, o_kt[k]); st_bf(ARR(AR_V), o, o_v[k]);
                  if (PASS == 3) { st_bf(ARR(AR_RT), o, o_rt[k]); if (lane == 0) RK[tl] = o_rk[k]; }
                  if (l == 0 && PASS == 1) VF[(size_t)(b * SEQ + t0 + tl) * 1024 + h * 64 + j] = (bf16)pk2(o_v[k], 0.f); } } }
            LDSBAR();
            }
            {
            { f32x4 acc7[2];
#pragma unroll
              for (int q = 0; q < 2; ++q) { const int tile = wave * 2 + q, rt = tile >> 2, ct = tile & 3, tt = rt & 1, st = ct & 1;
                f32x4 acc = (f32x4){0.f, 0.f, 0.f, 0.f};
                if (!(PASS == 1 && rt >= 2) && st <= tt) { const LAS unsigned char* Ab = ARR(rt < 2 ? AR_AT : AR_RT) + ((16 * tt + c) * AST + 8 * g) * 2; const LAS unsigned char* Bb = ARR(ct < 2 ? AR_BT : AR_KT) + ((16 * st + c) * AST + 8 * g) * 2;
                    acc = MFMA16(ld_b128(Ab), ld_b128(Bb), acc); acc = MFMA16(ld_b128(Ab + 64), ld_b128(Bb + 64), acc); }
                acc7[q] = acc; }
#pragma unroll
              for (int q = 0; q < 2; ++q) { const int tile = wave * 2 + q, rt = tile >> 2, ct = tile & 3, tt = rt & 1, st = ct & 1;
                if (PASS == 1 && rt >= 2) continue;
                const int s = 16 * st + c;
#pragma unroll
                for (int r = 0; r < 4; ++r) { const int t = 16 * tt + 4 * g + r; const bool keep = (rt < 2) ? (s < t) : (s <= t); const float v = keep ? acc7[q][r] : 0.f;
                    if (rt < 2 && ct < 2) { Ts[t * T_ST + s] = v; if (tt == 1 && st == 0) st_bf(F.lds + OFF_M, t * MST + s, v); } else st_bf(F.lds + (rt < 2 ? OFF_MK : (ct < 2 ? OFF_QB : OFF_QK)), t * MST + s, v); } } }
            LDSBAR();
            }
            f32x4 mkv[2], Ureg[2];
            {
            mkv[0] = (f32x4){0.f, 0.f, 0.f, 0.f}; mkv[1] = mkv[0];
            if (wave == 4 || wave == 5) { const int bb = 16 * (wave - 4), s = lane & 15; float x[16]; float trow[16];
#pragma unroll
                for (int t = 0; t < 16; ++t) trow[t] = Ts[(bb + t) * T_ST + bb + s];
#pragma unroll
                for (int t = 0; t < 16; ++t) { float a0 = (t == s) ? 1.f : 0.f, a1 = 0.f;
#pragma unroll
                    for (int u = 0; u < t; ++u) { const float tv = __int_as_float(__builtin_amdgcn_readlane(__float_as_int(trow[t]), u)); if (u & 1) a1 += tv * x[u]; else a0 += tv * x[u]; }
                    x[t] = a0 + a1; }
#pragma unroll
                for (int t = 0; t < 16; ++t) { if (lane < 16) st_bf(F.lds + OFF_M, (bb + t) * MST + bb + s, x[t]); } }
            else if (wave < 4) { const int q4 = c >> 2, p4 = c & 3;
                const LAS unsigned char* vb = ARR(AR_V) + ((8 * g + q4) * AST + 16 * wave + 4 * p4) * 2; const bf16x8 vfr = cat8(ld_tr(vb), ld_tr(vb + 4 * AST * 2));
#pragma unroll
                for (int st = 0; st < 2; ++st) mkv[st] = MFMA16(ld_b128(F.lds + OFF_MK + ((16 * st + c) * MST + 8 * g) * 2), vfr, mkv[st]); }
            LDSBAR();
            { const s16x4 z4 = (s16x4){0, 0, 0, 0};
              const bf16x8 m00 = cat8(ld_b64(F.lds + OFF_M + (c * MST + 4 * g) * 2), z4), t10 = cat8(ld_b64(F.lds + OFF_M + ((16 + c) * MST + 4 * g) * 2), z4), m11 = cat8(ld_b64(F.lds + OFF_M + ((16 + c) * MST + 16 + 4 * g) * 2), z4);
              bf16x8 r0; f32x4 r1;
              if (wave < 4) { r0 = pack8(mkv[0], (f32x4){0.f, 0.f, 0.f, 0.f}); r1 = mkv[1]; }
              else { const int jt = wave - 4, q4 = c >> 2, p4 = c & 3;
                  r0 = cat8(ld_tr(ARR(AR_AT) + ((4 * g + q4) * AST + 16 * jt + 4 * p4) * 2), z4);
#pragma unroll
                  for (int r = 0; r < 4; ++r) r1[r] = bf2f(((const LAS bf16*)ARR(AR_AT))[(16 + 4 * g + r) * AST + 16 * jt + c]); }
              const f32x4 zero4 = (f32x4){0.f, 0.f, 0.f, 0.f};
              const f32x4 x0 = MFMA16(m00, r0, zero4);
              const f32x4 yv = MFMA16(t10, pack8(x0, zero4), r1);
              const f32x4 x1 = MFMA16(m11, pack8(yv, zero4), zero4);
              Ureg[0] = x0; Ureg[1] = x1;
              if (wave >= 4) { const int jt = wave - 4;
#pragma unroll
                  for (int r = 0; r < 4; ++r) { st_bf(ARR(AR_W), (4 * g + r) * AST + 16 * jt + c, x0[r]); st_bf(ARR(AR_W), (16 + 4 * g + r) * AST + 16 * jt + c, x1[r]); } } }
            LDSBAR();
            }
            const bool active = (PASS == 1) ? true : (wave < 4);
            const bool inhom = (PASS == 1) ? (wave < 4) : true;
            const int cw = wave & 3;
            if (active) {
                bf16x8 xf[2];
                xf[0] = pack8(X[0], X[1]); xf[1] = pack8(X[2], X[3]);
                f32x4 Z[2];
#pragma unroll
                for (int tt = 0; tt < 2; ++tt) { f32x4 z = (f32x4){0.f, 0.f, 0.f, 0.f};
                    if (inhom) z = Ureg[tt];
#pragma unroll
                    for (int ks = 0; ks < 2; ++ks) { const LAS unsigned char* wb = ARR(AR_W) + ((16 * tt + c) * AST + 32 * ks + 4 * g) * 2;
                        z = MFMA16(cat8(ld_b64(wb), ld_b64(wb + 32)), xf[ks], z); }
                    Z[tt] = z; }
                const bf16x8 zf = pack8(Z[0], Z[1]);
                bf16x8 vf = zf;
                if (inhom) { const int q = c >> 2, p = c & 3; const LAS unsigned char* vb = ARR(AR_V) + ((4 * g + q) * AST + 16 * cw + 4 * p) * 2; vf = cat8(ld_tr(vb), ld_tr(vb + 16 * AST * 2)); }
                f32x4 Yt[2]; Yt[0] = (f32x4){0.f, 0.f, 0.f, 0.f}; Yt[1] = Yt[0];
                if (PASS == 3) {
#pragma unroll
                    for (int tt = 0; tt < 2; ++tt) { f32x4 y = (f32x4){0.f, 0.f, 0.f, 0.f};
#pragma unroll
                        for (int ks = 0; ks < 2; ++ks) { const LAS unsigned char* rb = ARR(AR_RT) + ((16 * tt + c) * AST + 32 * ks + 4 * g) * 2;
                            y = MFMA16(cat8(ld_b64(rb), ld_b64(rb + 32)), xf[ks], y); }
                        const LAS unsigned char* qb = F.lds + OFF_QB + ((16 * tt + c) * MST + 4 * g) * 2; const LAS unsigned char* qk = F.lds + OFF_QK + ((16 * tt + c) * MST + 4 * g) * 2;
                        y = MFMA16(cat8(ld_b64(qb), ld_b64(qb + 32)), zf, y);
                        y = MFMA16(cat8(ld_b64(qk), ld_b64(qk + 32)), vf, y);
                        Yt[tt] = y; } }
                { const int q = c >> 2, p = c & 3;
#pragma unroll
                  for (int jt = 0; jt < 4; ++jt) { f32x4 xn = X[jt];
                      const LAS unsigned char* bb = ARR(AR_BT) + ((4 * g + q) * AST + 16 * jt + 4 * p) * 2;
                      xn = MFMA16(cat8(ld_tr(bb), ld_tr(bb + 16 * AST * 2)), zf, xn);
                      if (inhom) { const LAS unsigned char* kb = ARR(AR_KT) + ((4 * g + q) * AST + 16 * jt + 4 * p) * 2; xn = MFMA16(cat8(ld_tr(kb), ld_tr(kb + 16 * AST * 2)), vf, xn); }
#pragma unroll
                      for (int r = 0; r < 4; ++r) xn[r] *= GAM[16 * jt + 4 * g + r];
                      X[jt] = xn; } }
                if (PASS == 3) {
#pragma unroll
                    for (int tt = 0; tt < 2; ++tt)
#pragma unroll
                        for (int r = 0; r < 4; ++r) YS[(16 * tt + 4 * g + r) * YS_ST + 16 * cw + c] = Yt[tt][r]; }
            }
            if (PASS == 3) {
                LDSBAR();
                { const int i = lane; float y[4], rk[4], vv[4], ga[4];
#pragma unroll
                  for (int k = 0; k < 4; ++k) { const int tl = wave + 8 * k; y[k] = YS[tl * YS_ST + i]; rk[k] = RK[tl]; vv[k] = bf2f(((const LAS bf16*)ARR(AR_V))[tl * AST + i]); ga[k] = bf2f(((const LAS bf16*)(F.lds + OFF_GAS))[tl * 64 + i]); }
                  const float c_g = CV[6 * 64 + i], c_b = CV[7 * 64 + i];
#pragma unroll
                  for (int k = 0; k < 4; ++k) { const int tl = wave + 8 * k; const size_t row = (size_t)(b * SEQ + t0 + tl);
                      const float mean = wave_sum_dpp(y[k]) * (1.f / 64.f); const float dd = y[k] - mean; const float var = wave_sum_dpp(dd * dd) * (1.f / 64.f);
                      const float o = (dd * __builtin_amdgcn_rsqf(var + 64e-5f) * c_g + c_b + rk[k] * vv[k]) * ga[k];
                      YA[row * 1024 + h * 64 + i] = (bf16)pg8::cvt_pk_bf16(o, o); } }
            }
        }
        if (PASS == 1) { int lz = lane; asm volatile("" : "+v"(lz));
            float* pd = PD + (size_t)it * 8192 + (4 * (lz >> 4)) * 128 + 16 * wave + (lz & 15);
#pragma unroll
            for (int jt = 0; jt < 4; ++jt)
#pragma unroll
                for (int r = 0; r < 4; ++r) pd[(16 * jt + r) * 128] = X[jt][r]; }
    }
}
#define R2_LOAD(SET_, ITEM) do { const f32x4* pd_ = (const f32x4*)(PD + (size_t)(ITEM) * 8192); _Pragma("unroll") for (int q = 0; q < 4; ++q) SET_[q] = pd_[F.tid + NTHREADS * q]; } while (0)
#define R2_STEP(SET_, SC) do { const size_t it_ = (size_t)F.bid * RNSC + (SC); \
    _Pragma("unroll") for (int q = 0; q < 4; ++q) { const int e = F.tid + NTHREADS * q; *(LAS f32x4*)(PL + (e >> 5) * 132 + (e & 31) * 4) = SET_[q]; } \
    if ((SC) + 2 < RNSC) R2_LOAD(SET_, it_ + 2); \
    LDSBAR(); \
    { float* so = SST + it_ * 4096; for (int e = F.tid; e < 1024; e += NTHREADS) { const int j = e >> 4, i4 = (e & 15) * 4; *(f32x4*)(so + j * 64 + i4) = *(const LAS f32x4*)(S + j * 68 + i4); } } \
    f32x4 acc[2]; float pc[16], sb[2][16]; \
    _Pragma("unroll") for (int q = 0; q < 2; ++q) _Pragma("unroll") for (int r = 0; r < 4; ++r) acc[q][r] = PL[(16 * jt + 4 * g + r) * 132 + 16 * (it0 + q) + c]; \
    _Pragma("unroll") for (int ks = 0; ks < 16; ++ks) { pc[ks] = PL[(16 * jt + c) * 132 + 64 + 4 * ks + g]; _Pragma("unroll") for (int q = 0; q < 2; ++q) sb[q][ks] = S[(4 * ks + g) * 68 + 16 * (it0 + q) + c]; } \
    _Pragma("unroll") for (int ks = 0; ks < 16; ++ks) { _Pragma("unroll") for (int q = 0; q < 2; ++q) acc[q] = __builtin_amdgcn_mfma_f32_16x16x4f32(pc[ks], sb[q][ks], acc[q], 0, 0, 0); } \
    LDSBAR(); \
    _Pragma("unroll") for (int q = 0; q < 2; ++q) _Pragma("unroll") for (int r = 0; r < 4; ++r) S[(16 * jt + 4 * g + r) * 68 + 16 * (it0 + q) + c] = acc[q][r]; \
    } while (0)
#define CS_LOAD(SET_, STEP_) do { const f32x4* pd_ = (const f32x4*)(PD + (item0 + (STEP_)) * 8192); _Pragma("unroll") for (int q = 0; q < 4; ++q) SET_[q] = pd_[F.tid + NTHREADS * q]; } while (0)
#define CS_STEP(SET_, SC) do { if (!done) { const int sc_ = (SC); \
    LDSBAR(); \
    if (sc_ >= sc_lo) { float* so = SST + (item0 + sc_) * 4096; for (int e = F.tid; e < 1024; e += NTHREADS) { const int j = e >> 4, i4 = (e & 15) * 4; *(f32x4*)(so + j * 64 + i4) = *(const LAS f32x4*)(S + j * 68 + i4); } } \
    if (sc_ >= sc_hi) done = true; else { \
    _Pragma("unroll") for (int q = 0; q < 4; ++q) { const int e = F.tid + NTHREADS * q; *(LAS f32x4*)(PL + (e >> 5) * 132 + (e & 31) * 4) = SET_[q]; } \
    if (sc_ + 2 < sc_hi) CS_LOAD(SET_, sc_ + 2); \
    LDSBAR(); \
    f32x4 acc[2]; float pc[16], sb[2][16]; \
    _Pragma("unroll") for (int q = 0; q < 2; ++q) _Pragma("unroll") for (int r = 0; r < 4; ++r) acc[q][r] = PL[(16 * jt + 4 * g + r) * 132 + 16 * (it0 + q) + c]; \
    _Pragma("unroll") for (int ks = 0; ks < 16; ++ks) { pc[ks] = PL[(16 * jt + c) * 132 + 64 + 4 * ks + g]; _Pragma("unroll") for (int q = 0; q < 2; ++q) sb[q][ks] = S[(4 * ks + g) * 68 + 16 * (it0 + q) + c]; } \
    _Pragma("unroll") for (int ks = 0; ks < 16; ++ks) { _Pragma("unroll") for (int q = 0; q < 2; ++q) acc[q] = __builtin_amdgcn_mfma_f32_16x16x4f32(pc[ks], sb[q][ks], acc[q], 0, 0, 0); } \
    LDSBAR(); \
    _Pragma("unroll") for (int q = 0; q < 2; ++q) _Pragma("unroll") for (int r = 0; r < 4; ++r) S[(16 * jt + 4 * g + r) * 68 + 16 * (it0 + q) + c] = acc[q][r]; } } } while (0)
__device__ __forceinline__ void rwkv_chain_scan(Frame& F, int chain, int sc_lo, int sc_hi) {
    const float* PD = (const float*)(F.ws + WS_SC); float* SST = (float*)(F.ws + WS_SC + 16 * MiB);
    LAS float* S = (LAS float*)F.lds; LAS float* PL = S + 64 * 68;
    const int lane = F.lane, wave = F.wave, g = lane >> 4, c = lane & 15, jt = wave >> 1, it0 = 2 * (wave & 1);
    for (int e = F.tid; e < 64 * 68; e += NTHREADS) S[e] = 0.f;
    f32x4 set0[4], set1[4];
    const size_t item0 = (size_t)chain * RNSC;
    if (0 < sc_hi) CS_LOAD(set0, 0);
    if (1 < sc_hi) CS_LOAD(set1, 1);
    bool done = false;
    for (int sc = 0; sc <= sc_hi; sc += 2) { CS_STEP(set0, sc); CS_STEP(set1, sc + 1); }
    asm volatile("s_waitcnt vmcnt(0)" ::: "memory"); __syncthreads();
}
constexpr size_t WS_LSE = 330 * MiB;
constexpr int AT_KS = 0, AT_VS = 36864, AT_BIAS = 76032, AT_OST = 76800, KVST = 72;
__device__ __forceinline__ void attn_decode_run(int ridx, int& b, int& gatt, int& h, int& dil, int& r, int& n0) {
    const int bgh = ridx >> 4, k16 = ridx & 15; h = bgh & 7; const int bg = bgh >> 3; gatt = bg % 3; b = bg / 3;
    dil = (gatt == 0) ? 1 : (gatt == 1 ? 4 : 16); const int rpr = 16 / dil; r = k16 / rpr; n0 = (k16 % rpr) * 4;
}
__device__ __forceinline__ u32x4 attn_kv_piece(const bf16* QKV, int b, int gatt, int h, int dil, int r, int which, int lk, int chn, bool wrap = false) {
    u32x4 v = (u32x4){0u, 0u, 0u, 0u};
    if (lk >= 0) v = *(const u32x4*)(QKV + (size_t)(b * SEQ + lk * dil + r) * NQKV + 1536 + which * 1536 + gatt * 512 + h * 64 + chn * 8);
    return v;
}
constexpr int AT_SLOT = 128 * KVST * 2;
template <bool STORE> __device__ __forceinline__ void phase_attn_mfma(Frame& F) {
    bf16* QKV = (bf16*)(F.ws + WS_QKV); float* LSE = (float*)(F.ws + WS_LSE); const float* rel_bias = F.in[26];
    const int tid = F.tid, lane = F.lane, w = F.wave, g = lane >> 4, c = lane & 15, q4 = c >> 2, p4 = c & 3;
    LAS float* BIAS = (LAS float*)(F.lds + AT_BIAS);
    LAS bf16* OST = (LAS bf16*)(F.lds + AT_OST) + w * 16 * 72;
    for (int e = tid; e < 16 * KVST / 2; e += NTHREADS) ((LAS unsigned*)(F.lds + AT_VS + 256 * KVST * 2))[e] = 0u;
    int b, gatt, h, dil, r, n0;
    u32x4 kv[8], qnext[2];
    { attn_decode_run(F.bid, b, gatt, h, dil, r, n0);
#pragma unroll
      for (int i = 0; i < 8; ++i) { const int e = tid + NTHREADS * i; kv[i] = attn_kv_piece(QKV, b, gatt, h, dil, r, e >> 11, 128 * n0 - 128 + ((e >> 3) & 255), e & 7, !STORE); }
#pragma unroll
      for (int ks = 0; ks < 2; ++ks) qnext[ks] = *(const u32x4*)(QKV + (size_t)(b * SEQ + (128 * n0 + 16 * w + c) * dil + r) * NQKV + gatt * 512 + h * 64 + 32 * ks + 8 * g); }
    for (int ridx = F.bid; ridx < 768; ridx += F.G) {
        attn_decode_run(ridx, b, gatt, h, dil, r, n0);
        for (int i = 0; i < 4; ++i) { const int n = n0 + i, par = i & 1;
            const int prevK = par ? AT_KS + AT_SLOT : AT_KS, curK = par ? AT_KS : AT_KS + AT_SLOT, prevV = par ? AT_VS + AT_SLOT : AT_VS, curV = par ? AT_VS : AT_VS + AT_SLOT;
            LDSBAR();
            if (i == 0 && tid < 129) BIAS[tid] = rel_bias[(int)T5BUCKET[gatt][tid] * 24 + gatt * 8 + h];
            { int tz = tid; asm volatile("" : "+v"(tz));
              if (i == 0) {
#pragma unroll
                  for (int q = 0; q < 8; ++q) { const int e = tz + NTHREADS * q, which = e >> 11, rowi = (e >> 3) & 255, chn = e & 7;
                      *(LAS u32x4*)(F.lds + (which ? AT_VS : AT_KS) + (rowi * KVST + chn * 8) * 2) = kv[q]; } }
              else {
#pragma unroll
                  for (int q = 0; q < 4; ++q) { const int e = tz + NTHREADS * q, which = e >> 10, rowi = (e >> 3) & 127, chn = e & 7;
                      *(LAS u32x4*)(F.lds + (which ? curV : curK) + (rowi * KVST + chn * 8) * 2) = kv[q]; } } }
            const size_t qrow = (size_t)(b * SEQ + (128 * n + 16 * w + c) * dil + r);
            u32x4 qraw[2]; qraw[0] = qnext[0]; qraw[1] = qnext[1];
            { int tz = tid; asm volatile("" : "+v"(tz)); const int lz = tz & 63;
              const bool same = (i < 3), more = same || (ridx + F.G < 768);
              int b2 = b, g2 = gatt, h2 = h, d2 = dil, r2 = r, m0 = n0;
              if (!same && more) attn_decode_run(ridx + F.G, b2, g2, h2, d2, r2, m0);
              const int nn = same ? n + 1 : m0, lb = same ? 128 * nn : 128 * nn - 128, sh = same ? 10 : 11, msk = same ? 127 : 255, npc = same ? 4 : 8;
              if (more) {
#pragma unroll
                  for (int ks = 0; ks < 2; ++ks) qnext[ks] = *(const u32x4*)(QKV + (size_t)(b2 * SEQ + (128 * nn + 16 * w + (lz & 15)) * d2 + r2) * NQKV + g2 * 512 + h2 * 64 + 32 * ks + 8 * (lz >> 4));
#pragma unroll
                  for (int q = 0; q < 8; ++q) { const int e = tz + NTHREADS * q; if (q < npc) kv[q] = attn_kv_piece(QKV, b2, g2, h2, d2, r2, e >> sh, lb + ((e >> 3) & msk), e & 7, !STORE); } } }
            bf16x8 qf[2];
#pragma unroll
            for (int ks = 0; ks < 2; ++ks) { const u32x4 v = qraw[ks]; u32x4 o;
                o.x = pk2(bflo(v.x) * 0.125f, bfhi(v.x) * 0.125f); o.y = pk2(bflo(v.y) * 0.125f, bfhi(v.y) * 0.125f); o.z = pk2(bflo(v.z) * 0.125f, bfhi(v.z) * 0.125f); o.w = pk2(bflo(v.w) * 0.125f, bfhi(v.w) * 0.125f);
                qf[ks] = __builtin_bit_cast(bf16x8, o); }
            LDSBAR();
            f32x4 S[9];
#pragma unroll
            for (int j = 0; j < 9; ++j) { const int tau = w + j; const LAS unsigned char* kb = F.lds + ((tau < 8) ? prevK + tau * 16 * KVST * 2 : curK + (tau - 8) * 16 * KVST * 2) + (c * KVST + 8 * g) * 2;
                f32x4 a = (f32x4){0.f, 0.f, 0.f, 0.f}; a = MFMA16(ld_b128(kb), qf[0], a); a = MFMA16(ld_b128(kb + 64), qf[1], a); S[j] = a; }
            float mx = -1e30f;
            { float bv[9][4];
#pragma unroll
              for (int j = 0; j < 9; ++j)
#pragma unroll
                  for (int rr = 0; rr < 4; ++rr) { const int delta = 128 - 16 * j + c - 4 * g - rr; bv[j][rr] = BIAS[min(max(delta, 0), 128)]; }
              asm volatile("s_waitcnt lgkmcnt(0)" ::: "memory");
#pragma unroll
              for (int j = 0; j < 9; ++j)
#pragma unroll
                  for (int rr = 0; rr < 4; ++rr) { const int delta = 128 - 16 * j + c - 4 * g - rr, ki = 16 * (w + j) + 4 * g + rr;
                      const bool valid = (delta >= 0) && (delta <= 128) && (n > 0 || ki >= 128);
                      const float s = valid ? S[j][rr] + bv[j][rr] : -1e30f; S[j][rr] = s; mx = fmaxf(mx, s); } }
            mx = fmaxf(mx, bperm_f(lane ^ 16, mx)); mx = fmaxf(mx, bperm_f(lane ^ 32, mx));
            float lsum = 0.f;
#pragma unroll
            for (int j = 0; j < 9; ++j)
#pragma unroll
                for (int rr = 0; rr < 4; ++rr) { const float p = (S[j][rr] > -1e29f) ? __expf(S[j][rr] - mx) : 0.f; S[j][rr] = p; lsum += p; }
            lsum += bperm_f(lane ^ 16, lsum); lsum += bperm_f(lane ^ 32, lsum);
            f32x4 O[4];
#pragma unroll
            for (int dt = 0; dt < 4; ++dt) O[dt] = (f32x4){0.f, 0.f, 0.f, 0.f};
#pragma unroll
            for (int m5 = 0; m5 < 5; ++m5) { const f32x4 z4 = (f32x4){0.f, 0.f, 0.f, 0.f};
                const bf16x8 pf = pack8(S[2 * m5], (2 * m5 + 1 < 9) ? S[(2 * m5 + 1 < 9) ? 2 * m5 + 1 : 0] : z4);
                const int t1 = w + 2 * m5, t2 = t1 + 1;
                const LAS unsigned char* v1 = F.lds + ((t1 < 8) ? prevV + t1 * 16 * KVST * 2 : curV + (t1 - 8) * 16 * KVST * 2) + ((4 * g + q4) * KVST + 4 * p4) * 2;
                const LAS unsigned char* v2 = F.lds + ((t2 < 8) ? prevV + t2 * 16 * KVST * 2 : curV + (t2 - 8) * 16 * KVST * 2) + ((4 * g + q4) * KVST + 4 * p4) * 2;
#pragma unroll
                for (int dt = 0; dt < 4; ++dt) O[dt] = MFMA16(pf, cat8(ld_tr(v1 + dt * 32), ld_tr(v2 + dt * 32)), O[dt]); }
            const float linv = __builtin_amdgcn_rcpf(lsum);
            if (STORE && g == 0) LSE[qrow * 24 + gatt * 8 + h] = mx + __logf(lsum);
#pragma unroll
            for (int rr = 0; rr < 4; ++rr) { const float li = bperm_f(4 * g + rr, linv);
#pragma unroll
                for (int dt = 0; dt < 4; ++dt) OST[(4 * g + rr) * 72 + 16 * dt + c] = (bf16)pk2(O[dt][rr] * li, 0.f); }
#pragma unroll
            for (int q = 0; q < 2; ++q) { const int row = q * 8 + (lane >> 3), ch = lane & 7; const u32x4 v = *(const LAS u32x4*)(OST + row * 72 + ch * 8);
                if (STORE) *(u32x4*)(QKV + (size_t)(b * SEQ + (128 * n + 16 * w + row) * dil + r) * NQKV + gatt * 512 + h * 64 + ch * 8) = v; else asm volatile("" :: "v"(v)); }
        }
    }
}
__device__ __forceinline__ void phase_attn_merge(Frame& F) {
    const bf16* QKV = (const bf16*)(F.ws + WS_QKV); const float* LSE = (const float*)(F.ws + WS_LSE); bf16* YB = (bf16*)(F.ws + WS_YB);
    const size_t gt = (size_t)F.bid * NTHREADS + F.tid, NGT = (size_t)F.G * NTHREADS;
    for (size_t e = gt; e < (size_t)MROWS * 64; e += NGT) { const size_t row = e >> 6; const int h = (int)(e >> 3) & 7, d8 = (int)e & 7;
        const float l0 = LSE[row * 24 + h], l1 = LSE[row * 24 + 8 + h], l2 = LSE[row * 24 + 16 + h]; const float m = fmaxf(l0, fmaxf(l1, l2));
        float w0 = __expf(l0 - m), w1 = __expf(l1 - m), w2 = __expf(l2 - m); const float inv = 1.f / (w0 + w1 + w2); w0 *= inv; w1 *= inv; w2 *= inv;
        const bf16* qp = QKV + row * NQKV + h * 64 + d8 * 8;
        const u32x4 a = *(const u32x4*)qp, bq = *(const u32x4*)(qp + 512), cq = *(const u32x4*)(qp + 1024); u32x4 o;
        o.x = pk2(w0 * bflo(a.x) + w1 * bflo(bq.x) + w2 * bflo(cq.x), w0 * bfhi(a.x) + w1 * bfhi(bq.x) + w2 * bfhi(cq.x));
        o.y = pk2(w0 * bflo(a.y) + w1 * bflo(bq.y) + w2 * bflo(cq.y), w0 * bfhi(a.y) + w1 * bfhi(bq.y) + w2 * bfhi(cq.y));
        o.z = pk2(w0 * bflo(a.z) + w1 * bflo(bq.z) + w2 * bflo(cq.z), w0 * bfhi(a.z) + w1 * bfhi(bq.z) + w2 * bfhi(cq.z));
        o.w = pk2(w0 * bflo(a.w) + w1 * bflo(bq.w) + w2 * bflo(cq.w), w0 * bfhi(a.w) + w1 * bfhi(bq.w) + w2 * bfhi(cq.w));
        *(u32x4*)(YB + row * 512 + h * 64 + d8 * 8) = o; }
}
#define GEMM_LDS ((PG8_LAS unsigned char*)F.lds)
template <class Epi> __device__ __forceinline__ void run_gemm(Frame& F, const bf16* A, const bf16* Bt, int N, int K, const Epi& E) {
    pg8::Gemm g{A, Bt, MROWS, N, K}; pg8::StaticOrder S; S.init(MROWS, N, F.G, F.bid);
    pg8::gemm_phase<Epi, pg8::StaticOrder, true, true>(GEMM_LDS, g, S, E, F.tid);
}
#define GSYNC(cls) do { xcd_barrier(xbar, cur_tid(wv)); } while (0)
struct PairOrder {
    pg8::StaticOrder base;
    __device__ bool next(int i, pg8::Unit& u) const { if (i >= 2) return false; pg8::Unit u0; if (!base.next(0, u0)) return false; u.pm = u0.pm; u.pn = u0.pn + 4 * i; return true; }
    __device__ __forceinline__ void a_ready(const pg8::Unit&) const {}
    __device__ __forceinline__ void done(const pg8::Unit&) const {}
};
__global__ void __launch_bounds__(NTHREADS, 2) fwd_kernel(Args a) {
    extern __shared__ __attribute__((aligned(16))) unsigned char lds[];
    cg::grid_group grid = cg::this_grid();
    const int wv = __builtin_amdgcn_readfirstlane((int)threadIdx.x >> 6);
    const KArgs ka = (KArgs)__builtin_amdgcn_kernarg_segment_ptr();
    { const int t0_ = cur_tid(wv); if (t0_ < 16) ((LAS unsigned*)lds)[(LDS_BYTES - 64) / 4 + t0_] = 0u; }
    __syncthreads();
    XcdBarrier xbar = xcd_barrier_post((unsigned*)(ka->ws + WS_CTL + 65536), (volatile LAS unsigned*)((LAS unsigned char*)lds + LDS_BYTES - 64), cur_tid(wv));
    { Frame F; make_frame(F, ka, lds, wv); p0_mod(F); p0_weights(F); }
    grid.sync();
    for (int l = 0; l < 2; ++l) {
        { Frame F; make_frame(F, ka, lds, wv); phase_modnorm(F, l, (l == 0) ? F.in[0] : F.out); }
        GSYNC(1);
        { Frame F; make_frame(F, ka, lds, wv); run_gemm(F, (const bf16*)(F.ws + WS_XN), (const bf16*)(F.ws + WS_WQKV) + (size_t)l * NQKV * 1024, NQKV, 1024, pg8::EpiStore{(bf16*)(F.ws + WS_QKV), NQKV}); }
        GSYNC(2);
        { Frame F; make_frame(F, ka, lds, wv); phase_attn_mfma<true>(F); }
        GSYNC(3);
        { Frame F; make_frame(F, ka, lds, wv); phase_attn_merge(F); }
        GSYNC(4);
        { Frame F; make_frame(F, ka, lds, wv); run_gemm(F, (const bf16*)(F.ws + WS_XN), (const bf16*)(F.ws + WS_WA) + (size_t)l * NAG * 1024, NAG, 1024, pg8::EpiD{(bf16*)(F.ws + WS_PA), (bf16*)(F.ws + WS_GA), (bf16*)(F.ws + WS_YB)}); }
        GSYNC(2);
        { Frame F; make_frame(F, ka, lds, wv); rwkv_pass<1>(F, l); }
        GSYNC(5);
        { Frame F; make_frame(F, ka, lds, wv); rwkv_pass<3>(F, l); }
        GSYNC(7);
        { Frame F; make_frame(F, ka, lds, wv); pg8::Gemm g{(const bf16*)(F.ws + WS_XN), (const bf16*)(F.ws + WS_WM) + (size_t)l * 2048 * 1024, MROWS, 2048, 1024}; PairOrder S; S.base.init(MROWS, 1024, F.G, F.bid);
          pg8::gemm_phase<pg8::EpiSig, PairOrder, true, true>(GEMM_LDS, g, S, pg8::EpiSig{(bf16*)(F.ws + WS_MG), 0}, F.tid); }
        { Frame F; make_frame(F, ka, lds, wv); run_gemm(F, (const bf16*)(F.ws + WS_YA), (const bf16*)(F.ws + WS_WBA) + (size_t)l * 1024 * 1024, 1024, 1024, pg8::EpiMerge<false>{(bf16*)(F.ws + WS_MERGED), (const bf16*)(F.ws + WS_MG)}); }
        { Frame F; make_frame(F, ka, lds, wv); run_gemm(F, (const bf16*)(F.ws + WS_YB), (const bf16*)(F.ws + WS_WBB) + (size_t)l * 1024 * 512, 1024, 512, pg8::EpiMerge<true>{(bf16*)(F.ws + WS_MERGED), (const bf16*)(F.ws + WS_MG)}); }
        GSYNC(2);
        { Frame F; make_frame(F, ka, lds, wv); run_gemm(F, (const bf16*)(F.ws + WS_MERGED), (const bf16*)(F.ws + WS_WO) + (size_t)l * 1024 * 1024, 1024, 1024,
              pg8::EpiResid{(l == 0) ? F.in[0] : F.out, F.out, (const float*)(F.ws + WS_MOD) + (size_t)l * 2 * 3072 + 2048}); }
        GSYNC(2);
    }
    { Frame F; make_frame(F, ka, lds, wv); phase_final(F); }
}
extern "C" void kernel_launch(void* const* d_in, const int* in_sizes, int n_in, void* d_out, int out_size, void* d_ws, size_t ws_size, hipStream_t stream) {
    static int grid = 0;
    if (grid == 0) {
        int dev = 0, cus = 0, per_cu = 0;
        (void)hipGetDevice(&dev); (void)hipDeviceGetAttribute(&cus, hipDeviceAttributeMultiprocessorCount, dev);
        (void)hipFuncSetAttribute((const void*)fwd_kernel, hipFuncAttributeMaxDynamicSharedMemorySize, LDS_BYTES);
        (void)hipOccupancyMaxActiveBlocksPerMultiprocessor(&per_cu, (const void*)fwd_kernel, NTHREADS, LDS_BYTES);
        if (n_in != 28 || out_size != MROWS * DM || ws_size < (size_t)352 * MiB || per_cu < 1) { fprintf(stderr, "kernel_launch: unexpected problem (n_in %d out %d ws %zu per_cu %d)\n", n_in, out_size, ws_size, per_cu); }
        grid = cus;
        (void)hipGetLastError();
    }
    (void)hipMemsetAsync((char*)d_ws + WS_CTL, 0, 1 * MiB, stream);
    Args a{};
    for (int i = 0; i < 28; ++i) a.in[i] = (const float*)d_in[i];
    a.out = (float*)d_out; a.ws = (unsigned char*)d_ws;
    void* args[] = {&a};
    hipError_t e = hipLaunchCooperativeKernel((void*)fwd_kernel, dim3(grid), dim3(NTHREADS), args, LDS_BYTES, stream);
    if (e != hipSuccess) fprintf(stderr, "cooperative launch failed: %s (grid %d)\n", hipGetErrorString(e), grid);
}
```

```cpp
#include <hip/hip_runtime.h>
#include <hip/hip_cooperative_groups.h>
#include <cstdio>
#include <cstdint>
namespace cg = cooperative_groups;
namespace pg8 {
#define PG8_LAS __attribute__((address_space(3)))
typedef unsigned short bf16_t;
typedef short bf16x8 __attribute__((ext_vector_type(8)));
typedef float f32x4 __attribute__((ext_vector_type(4)));
typedef unsigned u32x4 __attribute__((ext_vector_type(4)));
constexpr int BM = 256, BK = 64, HALF = 128, HTB = HALF * BK * 2  , STAGE_BYTES = 8 * HTB, NXCD = 8, WGM = 8;

__host__ __device__ __forceinline__ int lds_byte(int r, int c) { const int st = (r >> 4) * 2 + (c >> 5), rr = r & 15, cc = c & 31, ob = rr * 64 + cc * 2; return st * 1024 + (ob ^ (((ob >> 9) & 1) << 5)); }
__host__ __device__ __forceinline__ void stage_rc(int b, int& R, int& C) { const int st = b / 1024, sb = b % 1024, swz = sb ^ (((sb >> 9) & 1) << 5); R = (st >> 1) * 16 + swz / 64; C = (st & 1) * 32 + (swz % 64) / 2; }
__host__ __device__ __forceinline__ int perm32(int rho) { const int n = rho >> 4, i = rho & 15; return 8 * (i >> 2) + 4 * n + (i & 3); }

struct Unit { int pm, pn; };
struct Gemm { const bf16_t* A; const bf16_t* Bt; int M, N, K; };

struct StaticOrder {
    int nM, nN, nwg, G, c;
    __host__ __device__ void init(int M, int N, int G_, int c_) { nM = M / BM; nN = N / BM; nwg = nM * nN; G = G_; c = c_; }
    __host__ __device__ bool next(int i, Unit& u) const {
        const long L = (long)i * G + c; if (L >= nwg) return false;
        int wgid = (int)L; { const int q = nwg / NXCD, r = nwg % NXCD, xcd = wgid % NXCD, off = wgid / NXCD; wgid = (xcd < r ? xcd * (q + 1) : r * (q + 1) + (xcd - r) * q) + off; }
        const int nig = WGM * nN, gid = wgid / nig, fm = gid * WGM, gsz = (nM - fm) < WGM ? (nM - fm) : WGM;
        u.pm = fm + ((wgid % nig) % gsz); u.pn = (wgid % nig) / gsz; return true;
    }
    __device__ __forceinline__ void a_ready(const Unit&) const {}
    __device__ __forceinline__ void done(const Unit&) const {}
};

typedef float f32x2c_t __attribute__((ext_vector_type(2))); typedef __bf16 bf16x2c_t __attribute__((ext_vector_type(2)));
__device__ __forceinline__ unsigned cvt_pk_bf16(float lo, float hi) { const f32x2c_t v = {lo, hi}; const bf16x2c_t b = __builtin_convertvector(v, bf16x2c_t); return __builtin_bit_cast(unsigned, b); }
typedef float f32x2 __attribute__((ext_vector_type(2)));
template <class Epi, class Sched, bool ALIGN_EPI = false, bool SP2 = false>
__device__ __forceinline__ void gemm_phase(PG8_LAS unsigned char* lds, const Gemm g, const Sched& S, const Epi& E, int tid_in) {
    int tid_ = tid_in; asm volatile("" : "+v"(tid_));
    const int tid = tid_, wid = __builtin_amdgcn_readfirstlane(tid >> 6), lane = tid & 63, wr = wid >> 2, wc = wid & 3, fr = lane & 15, fq = lane >> 4;
    const int K = g.K, nt = K / BK;
    unsigned voffA[2], voffB[2];
#pragma unroll
    for (int i = 0; i < 2; ++i) { int R, C; stage_rc(tid * 16 + i * 8192, R, C); const int Rb = Epi::PERM ? ((R & ~31) + perm32(R & 31)) : R;
        voffA[i] = (unsigned)(R * K + C) * 2u; voffB[i] = (unsigned)(Rb * K + C) * 2u; }
    const size_t kstep = (size_t)(BK * 2);
    const size_t hstep = (size_t)HALF * K * 2;
    const size_t tstep = 2 * hstep;
    const unsigned ldsw = (unsigned)wid * 1024u;
    const int aoff = lds_byte(wr * 64 + fr, fq * 8), boff = lds_byte(wc * 32 + fr, fq * 8);
#define PG8_SA(b, h) (((b) * 2 + (h)) * HTB)
#define PG8_SB(b, h) ((4 + (b) * 2 + (h)) * HTB)
#define PG8_STAGE(bufoff, gbase, voff) do { _Pragma("unroll") for (int _i = 0; _i < 2; ++_i) \
        __builtin_amdgcn_global_load_lds((const unsigned*)((const char*)(gbase) + (voff)[_i]), (PG8_LAS unsigned*)(lds + (bufoff) + ldsw + _i * 8192), 16, 0, 0); } while (0)
#define PG8_LDA(dst, b, h) do { _Pragma("unroll") for (int m = 0; m < 4; ++m) _Pragma("unroll") for (int k = 0; k < 2; ++k) dst[m][k] = *(const PG8_LAS bf16x8*)(lds + PG8_SA(b, h) + aoff + m * 2048 + k * 1024); } while (0)
#define PG8_LDB(dst, b, h) do { _Pragma("unroll") for (int n = 0; n < 2; ++n) _Pragma("unroll") for (int k = 0; k < 2; ++k) dst[n][k] = *(const PG8_LAS bf16x8*)(lds + PG8_SB(b, h) + boff + n * 2048 + k * 1024); } while (0)
#define PG8_MMA(ai, bj, At, Bt) do { __builtin_amdgcn_s_setprio(1); _Pragma("unroll") for (int m = 0; m < 4; ++m) _Pragma("unroll") for (int n = 0; n < 2; ++n) _Pragma("unroll") for (int k = 0; k < 2; ++k) \
        acc[ai][bj][m][n] = __builtin_amdgcn_mfma_f32_16x16x32_bf16(Bt[n][k], At[m][k], acc[ai][bj][m][n], 0, 0, 0); __builtin_amdgcn_s_setprio(0); } while (0)
#define PG8_WAIT_V(n) asm volatile("s_waitcnt vmcnt(" #n ")" ::: "memory")
#define PG8_WAIT_L(n) asm volatile("s_waitcnt lgkmcnt(" #n ")" ::: "memory")
#define PG8_BAR __builtin_amdgcn_s_barrier()
#define PG8_SCHED __builtin_amdgcn_sched_barrier(0)
    Unit cur, nxt; int ui = 0;
    if (!S.next(0, cur)) return;
    f32x4 acc[2][2][4][2];
#pragma unroll
    for (int a = 0; a < 2; ++a)
#pragma unroll
        for (int b = 0; b < 2; ++b)
#pragma unroll
            for (int m = 0; m < 4; ++m)
#pragma unroll
                for (int n = 0; n < 2; ++n) acc[a][b][m][n] = (f32x4){0.f, 0.f, 0.f, 0.f};
    bf16x8 At[4][2], B0[2][2], B1[2][2];
    const char* cA = (const char*)g.A + (size_t)cur.pm * tstep; const char* cB = (const char*)g.Bt + (size_t)cur.pn * tstep;
    S.a_ready(cur);
    if constexpr (SP2) {
        PG8_STAGE(PG8_SB(0, 0), cB, voffB); PG8_STAGE(PG8_SB(0, 1), cB + hstep, voffB); PG8_STAGE(PG8_SA(0, 0), cA, voffA); PG8_STAGE(PG8_SA(0, 1), cA + hstep, voffA);
        if (wr == 1) PG8_BAR;
        PG8_WAIT_V(2); PG8_BAR;
        PG8_STAGE(PG8_SB(1, 0), cB + kstep, voffB); PG8_STAGE(PG8_SA(1, 0), cA + kstep, voffA); PG8_STAGE(PG8_SB(1, 1), cB + hstep + kstep, voffB);
        PG8_WAIT_V(6); PG8_BAR;
    } else {
        PG8_STAGE(PG8_SB(0, 0), cB, voffB); PG8_STAGE(PG8_SA(0, 0), cA, voffA); PG8_STAGE(PG8_SB(0, 1), cB + hstep, voffB); PG8_STAGE(PG8_SA(0, 1), cA + hstep, voffA);
        if (wr == 1) PG8_BAR;
        PG8_WAIT_V(4); PG8_BAR;
        PG8_STAGE(PG8_SB(1, 0), cB + kstep, voffB); PG8_STAGE(PG8_SA(1, 0), cA + kstep, voffA); PG8_STAGE(PG8_SB(1, 1), cB + hstep + kstep, voffB);
        PG8_WAIT_V(6); PG8_BAR;
    }
    for (;;) {
        const bool has_next = S.next(ui + 1, nxt);
        const char* nA = has_next ? (const char*)g.A + (size_t)nxt.pm * tstep : cA; const char* nB = has_next ? (const char*)g.Bt + (size_t)nxt.pn * tstep : cB;
        for (int t = 0; t < nt; t += 2) {
            const bool last = (t == nt - 2);
            const char* a1 = cA + (size_t)(t + 1) * kstep;
            const char* a2 = last ? nA : cA + (size_t)(t + 2) * kstep; const char* b2 = last ? nB : cB + (size_t)(t + 2) * kstep;
            const char* a3 = a2 + kstep; const char* b3 = b2 + kstep;
            if (last && has_next) S.a_ready(nxt);
            if constexpr (SP2) {
            PG8_LDB(B0, 0, 0); PG8_LDB(B1, 0, 1); PG8_SCHED; PG8_LDA(At, 0, 0); PG8_STAGE(PG8_SA(1, 1), a1 + hstep, voffA);
            PG8_WAIT_V(8); PG8_WAIT_L(0); PG8_BAR; PG8_MMA(0, 0, At, B0); PG8_MMA(0, 1, At, B1); PG8_BAR; PG8_SCHED;
            PG8_LDA(At, 0, 1); PG8_STAGE(PG8_SB(0, 0), b2, voffB); PG8_STAGE(PG8_SB(0, 1), b2 + hstep, voffB); PG8_STAGE(PG8_SA(0, 0), a2, voffA);
            PG8_WAIT_V(8); PG8_WAIT_L(0); PG8_BAR; PG8_MMA(1, 0, At, B0); PG8_MMA(1, 1, At, B1); PG8_BAR; PG8_SCHED;
            PG8_LDB(B0, 1, 0); PG8_LDB(B1, 1, 1); PG8_SCHED; PG8_LDA(At, 1, 0); PG8_STAGE(PG8_SA(0, 1), a2 + hstep, voffA);
            PG8_WAIT_V(8); PG8_WAIT_L(0); PG8_BAR; PG8_MMA(0, 0, At, B0); PG8_MMA(0, 1, At, B1); PG8_BAR; PG8_SCHED;
            PG8_LDA(At, 1, 1); PG8_STAGE(PG8_SB(1, 0), b3, voffB); PG8_STAGE(PG8_SB(1, 1), b3 + hstep, voffB); PG8_STAGE(PG8_SA(1, 0), a3, voffA);
            PG8_WAIT_V(8); PG8_WAIT_L(0); PG8_BAR; PG8_MMA(1, 0, At, B0); PG8_MMA(1, 1, At, B1); PG8_BAR; PG8_SCHED;
            } else {
            PG8_LDB(B0, 0, 0); PG8_SCHED; PG8_LDA(At, 0, 0); PG8_STAGE(PG8_SA(1, 1), a1 + hstep, voffA);
            PG8_WAIT_L(8); PG8_BAR; PG8_WAIT_L(0); PG8_MMA(0, 0, At, B0); PG8_BAR; PG8_SCHED;
            PG8_LDB(B1, 0, 1); PG8_STAGE(PG8_SB(0, 0), b2, voffB);
            PG8_BAR; PG8_WAIT_L(0); PG8_MMA(0, 1, At, B1); PG8_BAR;
            PG8_LDA(At, 0, 1); PG8_STAGE(PG8_SA(0, 0), a2, voffA);
            PG8_BAR; PG8_WAIT_L(0); PG8_MMA(1, 0, At, B0); PG8_BAR; PG8_SCHED;
            PG8_STAGE(PG8_SB(0, 1), b2 + hstep, voffB);
            PG8_WAIT_V(6); PG8_BAR; PG8_MMA(1, 1, At, B1); PG8_BAR;
            PG8_LDB(B0, 1, 0); PG8_SCHED; PG8_LDA(At, 1, 0); PG8_STAGE(PG8_SA(0, 1), a2 + hstep, voffA);
            PG8_WAIT_L(8); PG8_BAR; PG8_WAIT_L(0); PG8_MMA(0, 0, At, B0); PG8_BAR; PG8_SCHED;
            PG8_LDB(B1, 1, 1); PG8_STAGE(PG8_SB(1, 0), b3, voffB);
            PG8_BAR; PG8_WAIT_L(0); PG8_MMA(0, 1, At, B1); PG8_BAR;
            PG8_LDA(At, 1, 1); PG8_STAGE(PG8_SA(1, 0), a3, voffA);
            PG8_BAR; PG8_WAIT_L(0); PG8_MMA(1, 0, At, B0); PG8_BAR; PG8_SCHED;
            PG8_STAGE(PG8_SB(1, 1), b3 + hstep, voffB);
            PG8_WAIT_V(6); PG8_BAR; PG8_MMA(1, 1, At, B1); PG8_BAR;
            }
        }
        if constexpr (ALIGN_EPI) { if (wr == 0) PG8_BAR; }
        if constexpr (!Epi::AFTER_DRAIN) { E(acc, cur, wr, wc, fr, fq); S.done(cur); }
        if (!has_next) break;
#pragma unroll
        for (int a = 0; a < 2; ++a)
#pragma unroll
            for (int b = 0; b < 2; ++b)
#pragma unroll
                for (int m = 0; m < 4; ++m)
#pragma unroll
                    for (int n = 0; n < 2; ++n) acc[a][b][m][n] = (f32x4){0.f, 0.f, 0.f, 0.f};
        cur = nxt; cA = nA; cB = nB; ++ui;
        if constexpr (ALIGN_EPI) { if (wr == 1) PG8_BAR; }
    }
    PG8_WAIT_V(0);
    if constexpr (!ALIGN_EPI) { if (wr == 0) PG8_BAR; }
    PG8_BAR;
    if constexpr (Epi::AFTER_DRAIN) { E.fused(acc, cur, wr, wc, fr, fq, lds, wid, lane); S.done(cur); }
#undef PG8_SA
#undef PG8_SB
#undef PG8_STAGE
#undef PG8_LDA
#undef PG8_LDB
#undef PG8_MMA
#undef PG8_WAIT_V
#undef PG8_WAIT_L
#undef PG8_BAR
#undef PG8_SCHED
}
}
namespace pg8 {
__device__ __forceinline__ float ep_bflo(unsigned w) { return __uint_as_float(w << 16); }
__device__ __forceinline__ float ep_bfhi(unsigned w) { return __uint_as_float(w & 0xffff0000u); }
__device__ __forceinline__ float ep_sigmoid(float x) { return 1.f / (1.f + __expf(-x)); }
struct EpiStore {
    static constexpr bool PERM = true, AFTER_DRAIN = false;
    bf16_t* O; int ldc;
    __device__ __forceinline__ void operator()(const f32x4 (&acc)[2][2][4][2], const Unit& u, int wr, int wc, int fr, int fq) const {
        const int row0 = u.pm * BM + wr * 64 + fr, col0 = u.pn * BM + wc * 32 + 8 * fq;
#pragma unroll
        for (int ai = 0; ai < 2; ++ai)
#pragma unroll
            for (int m = 0; m < 4; ++m) { bf16_t* rowp = O + (size_t)(row0 + ai * HALF + m * 16) * ldc + col0;
#pragma unroll
                for (int bj = 0; bj < 2; ++bj) { const f32x4 v0 = acc[ai][bj][m][0], v1 = acc[ai][bj][m][1]; u32x4 w;
                    w.x = cvt_pk_bf16(v0[0], v0[1]); w.y = cvt_pk_bf16(v0[2], v0[3]); w.z = cvt_pk_bf16(v1[0], v1[1]); w.w = cvt_pk_bf16(v1[2], v1[3]);
                    *(u32x4*)(rowp + bj * HALF) = w; } }
    }
};
struct EpiD {
    static constexpr bool PERM = true, AFTER_DRAIN = false;
    bf16_t* PA; bf16_t* GA; bf16_t* YB;
    __device__ __forceinline__ void operator()(const f32x4 (&acc)[2][2][4][2], const Unit& u, int wr, int wc, int fr, int fq) const {
        const int colt = u.pn * BM; int mode, ld, cb; bf16_t* P;
        if (colt < 3584) { mode = 0; P = PA; ld = 3584; cb = colt; } else if (colt < 4608) { mode = 1; P = GA; ld = 1024; cb = colt - 3584; } else { mode = 2; P = YB; ld = 512; cb = colt - 4608; }
        const int row0 = u.pm * BM + wr * 64 + fr, col0 = cb + wc * 32 + 8 * fq;
#pragma unroll
        for (int ai = 0; ai < 2; ++ai)
#pragma unroll
            for (int m = 0; m < 4; ++m) { bf16_t* rowp = P + (size_t)(row0 + ai * HALF + m * 16) * ld + col0;
#pragma unroll
                for (int bj = 0; bj < 2; ++bj) { const f32x4 v0 = acc[ai][bj][m][0], v1 = acc[ai][bj][m][1]; float g[8] = {v0[0], v0[1], v0[2], v0[3], v1[0], v1[1], v1[2], v1[3]};
                    if (mode == 1) {
#pragma unroll
                        for (int e = 0; e < 8; ++e) g[e] = g[e] * ep_sigmoid(g[e]);
                    } else if (mode == 2) {
                        const u32x4 y = *(const u32x4*)(rowp + bj * HALF);
                        const float yv[8] = {ep_bflo(y.x), ep_bfhi(y.x), ep_bflo(y.y), ep_bfhi(y.y), ep_bflo(y.z), ep_bfhi(y.z), ep_bflo(y.w), ep_bfhi(y.w)};
#pragma unroll
                        for (int e = 0; e < 8; ++e) g[e] = yv[e] * g[e] * ep_sigmoid(g[e]);
                    }
                    u32x4 w; w.x = cvt_pk_bf16(g[0], g[1]); w.y = cvt_pk_bf16(g[2], g[3]); w.z = cvt_pk_bf16(g[4], g[5]); w.w = cvt_pk_bf16(g[6], g[7]);
                    *(u32x4*)(rowp + bj * HALF) = w; } }
    }
};
struct EpiSig {
    static constexpr bool PERM = true, AFTER_DRAIN = false;
    bf16_t* MG; int coff;
    __device__ __forceinline__ void operator()(const f32x4 (&acc)[2][2][4][2], const Unit& u, int wr, int wc, int fr, int fq) const {
        const int row0 = u.pm * BM + wr * 64 + fr, col0 = coff + u.pn * BM + wc * 32 + 8 * fq;
#pragma unroll
        for (int ai = 0; ai < 2; ++ai)
#pragma unroll
            for (int m = 0; m < 4; ++m) { bf16_t* rowp = MG + (size_t)(row0 + ai * HALF + m * 16) * 2048 + col0;
#pragma unroll
                for (int bj = 0; bj < 2; ++bj) { const f32x4 v0 = acc[ai][bj][m][0], v1 = acc[ai][bj][m][1]; u32x4 w;
                    w.x = cvt_pk_bf16(ep_sigmoid(v0[0]), ep_sigmoid(v0[1])); w.y = cvt_pk_bf16(ep_sigmoid(v0[2]), ep_sigmoid(v0[3])); w.z = cvt_pk_bf16(ep_sigmoid(v1[0]), ep_sigmoid(v1[1])); w.w = cvt_pk_bf16(ep_sigmoid(v1[2]), ep_sigmoid(v1[3]));
                    *(u32x4*)(rowp + bj * HALF) = w; } }
    }
};
template <bool SECOND> struct EpiMerge {
    static constexpr bool PERM = true, AFTER_DRAIN = false;
    bf16_t* MERGED; const bf16_t* MG;
    __device__ __forceinline__ void operator()(const f32x4 (&acc)[2][2][4][2], const Unit& u, int wr, int wc, int fr, int fq) const {
        const int row0 = u.pm * BM + wr * 64 + fr, col0 = u.pn * BM + wc * 32 + 8 * fq;
#pragma unroll
        for (int ai = 0; ai < 2; ++ai)
#pragma unroll
            for (int m = 0; m < 4; ++m) { const size_t r = (size_t)(row0 + ai * HALF + m * 16);
#pragma unroll
                for (int bj = 0; bj < 2; ++bj) { const f32x4 v0 = acc[ai][bj][m][0], v1 = acc[ai][bj][m][1]; float g[8] = {v0[0], v0[1], v0[2], v0[3], v1[0], v1[1], v1[2], v1[3]};
                    const int c = col0 + bj * HALF;
                    const u32x4 s = *(const u32x4*)(MG + r * 2048 + (SECOND ? 1024 : 0) + c);
                    const float sv[8] = {ep_bflo(s.x), ep_bfhi(s.x), ep_bflo(s.y), ep_bfhi(s.y), ep_bflo(s.z), ep_bfhi(s.z), ep_bflo(s.w), ep_bfhi(s.w)};
                    bf16_t* dst = MERGED + r * 1024 + c;
                    if (SECOND) { const u32x4 p = *(const u32x4*)dst;
                        const float pv[8] = {ep_bflo(p.x), ep_bfhi(p.x), ep_bflo(p.y), ep_bfhi(p.y), ep_bflo(p.z), ep_bfhi(p.z), ep_bflo(p.w), ep_bfhi(p.w)};
#pragma unroll
                        for (int e = 0; e < 8; ++e) g[e] = pv[e] + sv[e] * g[e];
                    } else {
#pragma unroll
                        for (int e = 0; e < 8; ++e) g[e] = sv[e] * g[e];
                    }
                    u32x4 w; w.x = cvt_pk_bf16(g[0], g[1]); w.y = cvt_pk_bf16(g[2], g[3]); w.z = cvt_pk_bf16(g[4], g[5]); w.w = cvt_pk_bf16(g[6], g[7]);
                    *(u32x4*)dst = w; } }
    }
};
struct EpiResid {
    static constexpr bool PERM = false, AFTER_DRAIN = false;
    const float* xin; float* xout; const float* gate;
    __device__ __forceinline__ void operator()(const f32x4 (&acc)[2][2][4][2], const Unit& u, int wr, int wc, int fr, int fq) const {
        const int b = (u.pm * BM) / 8192; const float* gp = gate + b * 3072;
        const int row0 = u.pm * BM + wr * 64 + fr, col0 = u.pn * BM + wc * 32 + 4 * fq;
#pragma unroll
        for (int bj = 0; bj < 2; ++bj)
#pragma unroll
            for (int n = 0; n < 2; ++n) { const int c = col0 + bj * HALF + n * 16; const f32x4 gv = *(const f32x4*)(gp + c);
#pragma unroll
                for (int ai = 0; ai < 2; ++ai)
#pragma unroll
                    for (int m = 0; m < 4; ++m) { const size_t off = (size_t)(row0 + ai * HALF + m * 16) * 1024 + c;
                        const f32x4 xi = *(const f32x4*)(xin + off); *(f32x4*)(xout + off) = xi + gv * acc[ai][bj][m][n]; } }
    }
};
}
constexpr int BATCH = 2, SEQ = 8192, DM = 1024, MROWS = BATCH * SEQ, PROJW = 11264;
constexpr int NQKV = 4608, NA = 3584, NAG = 5120, NLORA = 320;
constexpr size_t MiB = 1u << 20;
constexpr size_t WS_CTL = 0, WS_MOD = 1 * MiB;
constexpr size_t WS_WQKV = 2 * MiB, WS_WA = 20 * MiB, WS_WM = 40 * MiB, WS_WBA = 48 * MiB, WS_WBB = 52 * MiB, WS_WO = 54 * MiB;
constexpr size_t WS_VFIRST = 58 * MiB, WS_XN = 90 * MiB, WS_YB = 122 * MiB;
constexpr size_t WS_QKV = 138 * MiB, WS_PA = 138 * MiB, WS_YA = 250 * MiB, WS_MG = 138 * MiB, WS_MERGED = 202 * MiB, WS_SC = 282 * MiB, WS_GA = 314 * MiB;
constexpr int LDS_BYTES = 147456;
constexpr int NTHREADS = 512, NWAVES = 8;
#define LAS __attribute__((address_space(3)))
typedef unsigned short bf16;
typedef float f32x4 __attribute__((ext_vector_type(4)));
typedef unsigned u32x4 __attribute__((ext_vector_type(4)));
typedef unsigned u32x2 __attribute__((ext_vector_type(2)));

__device__ const unsigned char T5BUCKET[3][132] = {
 {0,1,2,3,4,5,6,7,8,9,10,11,12,13,14,15,16,16,16,16,16,16,17,17,17,17,17,17,17,17,18,18,18,18,18,18,18,18,18,18,19,19,19,19,19,19,19,19,19,19,19,19,19,19,20,20,20,20,20,20,20,20,20,20,20,20,20,20,20,20,20,20,20,21,21,21,21,21,21,21,21,21,21,21,21,21,21,21,21,21,21,21,21,21,21,21,21,21,21,22,22,22,22,22,22,22,22,22,22,22,22,22,22,22,22,22,22,22,22,22,22,22,22,22,22,22,22,22,22,0,0,0},
 {0,4,8,12,16,16,17,17,18,18,19,19,19,19,20,20,20,20,20,21,21,21,21,21,21,22,22,22,22,22,22,22,22,22,23,23,23,23,23,23,23,23,23,23,23,23,24,24,24,24,24,24,24,24,24,24,24,24,24,24,24,24,25,25,25,25,25,25,25,25,25,25,25,25,25,25,25,25,25,25,25,25,25,26,26,26,26,26,26,26,26,26,26,26,26,26,26,26,26,26,26,26,26,26,26,26,26,26,26,26,26,26,26,27,27,27,27,27,27,27,27,27,27,27,27,27,27,27,27,0,0,0},
 {0,16,18,19,20,21,21,22,22,23,23,23,24,24,24,24,25,25,25,25,25,26,26,26,26,26,26,26,26,27,27,27,27,27,27,27,27,27,27,28,28,28,28,28,28,28,28,28,28,28,28,28,29,29,29,29,29,29,29,29,29,29,29,29,29,29,29,29,29,29,30,30,30,30,30,30,30,30,30,30,30,30,30,30,30,30,30,30,30,30,30,30,30,30,30,31,31,31,31,31,31,31,31,31,31,31,31,31,31,31,31,31,31,31,31,31,31,31,31,31,31,31,31,31,31,31,31,31,31,0,0,0}};

__device__ __forceinline__ unsigned f2bf(float f) { unsigned u = __builtin_bit_cast(unsigned, f); return (u + 0x7fffu + ((u >> 16) & 1u)) >> 16; }
__device__ __forceinline__ unsigned pk2(float lo, float hi) { return pg8::cvt_pk_bf16(lo, hi); }
__device__ __forceinline__ float bflo(unsigned w) { return __uint_as_float(w << 16); }
__device__ __forceinline__ float bfhi(unsigned w) { return __uint_as_float(w & 0xffff0000u); }
__device__ __forceinline__ float bf2f(bf16 h) { return __uint_as_float(((unsigned)h) << 16); }
template <int CTRL, int RMASK> __device__ __forceinline__ float dpp_f(float v) { return __int_as_float(__builtin_amdgcn_update_dpp(0, __float_as_int(v), CTRL, RMASK, 0xF, false)); }
template <int CTRL, int RMASK> __device__ __forceinline__ float dpp_keep(float v) { return __int_as_float(__builtin_amdgcn_update_dpp(__float_as_int(v), __float_as_int(v), CTRL, RMASK, 0xF, false)); }
__device__ __forceinline__ float wave_sum_dpp(float v) {
    v += dpp_f<0xB1, 0xF>(v); v += dpp_f<0x4E, 0xF>(v); v += dpp_f<0x141, 0xF>(v); v += dpp_f<0x140, 0xF>(v);
    v += dpp_f<0x142, 0xA>(v); v += dpp_f<0x143, 0xC>(v);
    return __int_as_float(__builtin_amdgcn_readlane(__float_as_int(v), 63));
}
__device__ __forceinline__ float wave_max_dpp(float v) {
    v = fmaxf(v, dpp_keep<0xB1, 0xF>(v)); v = fmaxf(v, dpp_keep<0x4E, 0xF>(v)); v = fmaxf(v, dpp_keep<0x141, 0xF>(v)); v = fmaxf(v, dpp_keep<0x140, 0xF>(v));
    v = fmaxf(v, dpp_keep<0x142, 0xA>(v)); v = fmaxf(v, dpp_keep<0x143, 0xC>(v));
    return __int_as_float(__builtin_amdgcn_readlane(__float_as_int(v), 63));
}
__device__ __forceinline__ float half_sum_dpp(float v, bool upper) {
    v += dpp_f<0xB1, 0xF>(v); v += dpp_f<0x4E, 0xF>(v); v += dpp_f<0x141, 0xF>(v); v += dpp_f<0x140, 0xF>(v);
    v += dpp_f<0x142, 0xA>(v);
    const float lo = __int_as_float(__builtin_amdgcn_readlane(__float_as_int(v), 31)), hi = __int_as_float(__builtin_amdgcn_readlane(__float_as_int(v), 63));
    return upper ? hi : lo;
}
__device__ __forceinline__ float wave_sum(float v) { return wave_sum_dpp(v); }
__device__ __forceinline__ float wave_max(float v) { return wave_max_dpp(v); }
__device__ __forceinline__ float bperm_f(int src_lane, float v) { return __int_as_float(__builtin_amdgcn_ds_bpermute(src_lane << 2, __float_as_int(v))); }
__device__ __forceinline__ float sigmoidf_(float x) { return 1.f / (1.f + __expf(-x)); }
__device__ __forceinline__ float siluf_(float x) { return x / (1.f + __expf(-x)); }

struct Args { const float* in[28]; float* out; unsigned char* ws; };
typedef const __attribute__((address_space(4))) Args* KArgs;
struct Frame {
    LAS unsigned char* lds;
    int tid, lane, wave, G, bid;
    const float* in[28]; float* out; unsigned char* ws;
};
__device__ __forceinline__ int lane_id_() { return (int)__builtin_amdgcn_mbcnt_hi(~0u, __builtin_amdgcn_mbcnt_lo(~0u, 0u)); }
__device__ __forceinline__ int cur_tid(int wv) { int w2 = wv; asm volatile("" : "+s"(w2)); unsigned z = 0u; asm volatile("" : "+v"(z)); return w2 * 64 + (int)__builtin_amdgcn_mbcnt_hi(~0u, __builtin_amdgcn_mbcnt_lo(~0u, z)); }
__device__ __forceinline__ void make_frame(Frame& F, KArgs ka, unsigned char* lds, int wv) {
    asm volatile("" : "+s"(ka));
    int t = cur_tid(wv);
    F.lds = (LAS unsigned char*)lds; F.tid = t; F.lane = t & 63; F.wave = __builtin_amdgcn_readfirstlane(t >> 6); F.G = gridDim.x; F.bid = blockIdx.x;
    const __attribute__((address_space(4))) unsigned long long* kr = (const __attribute__((address_space(4))) unsigned long long*)ka;
#pragma unroll
    for (int i = 0; i < 28; ++i) F.in[i] = (const float*)(const __attribute__((address_space(1))) float*)kr[i];
    F.out = (float*)(__attribute__((address_space(1))) float*)kr[28]; F.ws = (unsigned char*)(__attribute__((address_space(1))) unsigned char*)kr[29];
}
#define XB_TMO      128
#define XB_XCNT(j)  (256  + 64 * (j))
#define XB_XSUB(j)  (1280 + 64 * (j))
#define XB_XGEN(j)  (2304 + 64 * (j))
#define XB_TOP      3328
#define XB_TOPGEN   3392
#define XCD_BAR_WORDS 3456
#define XB_SPIN_CAP (1u << 18)

__device__ __forceinline__ unsigned xb_ld(unsigned* p)              { return __hip_atomic_load(p, __ATOMIC_RELAXED, __HIP_MEMORY_SCOPE_AGENT); }
__device__ __forceinline__ unsigned xb_add(unsigned* p, unsigned v) { return __hip_atomic_fetch_add(p, v, __ATOMIC_RELAXED, __HIP_MEMORY_SCOPE_AGENT); }
__device__ __forceinline__ unsigned xb_xcc_id() { return (unsigned)__builtin_amdgcn_s_getreg((3 << 11) | 20) & 0xFu; }
#define XB_SPIN(cond, bar) do { unsigned _sp = 0; while (cond) { __builtin_amdgcn_s_sleep(1); \
    if ((++_sp & 255u) == 0u) { if (xb_ld(&(bar)[XB_TMO])) break; if (_sp > XB_SPIN_CAP) { atomicAdd(&(bar)[XB_TMO], 1u); break; } } } } while (0)

struct XcdBarrier {
    unsigned* bar; unsigned x;
    volatile LAS unsigned* st;
};

__device__ __forceinline__ XcdBarrier xcd_barrier_post(unsigned* bar, volatile LAS unsigned* st, int tid) {
    XcdBarrier b; b.bar = bar; b.x = xb_xcc_id(); b.st = st;
    if (tid == 0) (void)xb_add(&bar[XB_XCNT(b.x)], 1u);
    return b;
}
__device__ __forceinline__ void xcd_barrier_complete(unsigned* bar, unsigned x, unsigned& nloc, unsigned& nx) {
    const unsigned G = gridDim.x * gridDim.y * gridDim.z;
    unsigned sum, cnt, mine, sp = 0u;
    for (;;) {
        sum = 0u; cnt = 0u; mine = 0u;
#pragma unroll
        for (unsigned j = 0; j < 16; ++j) { const unsigned c = xb_ld(&bar[XB_XCNT(j)]); sum += c; cnt += (c > 0u) ? 1u : 0u; mine = (j == x) ? c : mine; }
        if (sum == G) break;
        __builtin_amdgcn_s_sleep(1);
        if ((++sp & 255u) == 0u) { if (xb_ld(&bar[XB_TMO])) break; if (sp > XB_SPIN_CAP) { atomicAdd(&bar[XB_TMO], 1u); break; } }
    }
    nloc = mine > 0u ? mine : 1u; nx = cnt > 0u ? cnt : 1u;
}

__device__ __forceinline__ void xcd_barrier(const XcdBarrier& b, int tid) {
    asm volatile("s_waitcnt vmcnt(0)" ::: "memory");
    __syncthreads();
    if (tid == 0) {
        unsigned* bar = b.bar; asm volatile("" : "+s"(bar));
        __builtin_amdgcn_s_waitcnt(0);
        unsigned nloc = b.st[0], nx = b.st[1];
        if (nloc == 0u) { xcd_barrier_complete(bar, b.x, nloc, nx); b.st[0] = nloc; b.st[1] = nx; }
        const unsigned old = xb_add(&bar[XB_XSUB(b.x)], 1u);
        const unsigned gen = old / nloc;
        if (old + 1u == (gen + 1u) * nloc) {
            __builtin_amdgcn_fence(__ATOMIC_RELEASE, "agent");
            asm volatile("s_waitcnt vmcnt(0)" ::: "memory");
            const unsigned og = xb_add(&bar[XB_TOP], 1u);
            const unsigned tg = og / nx;
            if (og + 1u == (tg + 1u) * nx) xb_add(&bar[XB_TOPGEN], 1u);
            else XB_SPIN(xb_ld(&bar[XB_TOPGEN]) == tg, bar);
            __builtin_amdgcn_fence(__ATOMIC_ACQUIRE, "agent");
            xb_add(&bar[XB_XGEN(b.x)], 1u);
            asm volatile("s_waitcnt vmcnt(0)" ::: "memory");
        } else {
            XB_SPIN(xb_ld(&bar[XB_XGEN(b.x)]) == gen, bar);
            __builtin_amdgcn_fence(__ATOMIC_ACQUIRE, "agent");
            asm volatile("s_waitcnt vmcnt(0)" ::: "memory");
        }
    }
    __syncthreads();
}
__device__ __forceinline__ void p0_mod(Frame& F) {
    const float* c = F.in[1]; const float* ada_w = F.in[3]; const float* ada_b = F.in[4];
    float* mod = (float*)(F.ws + WS_MOD);
    LAS float* red = (LAS float*)F.lds;
    const int col = F.tid & 31, kg = F.tid >> 5;
    for (int ch = F.bid; ch < 192; ch += F.G) {
        const int l = ch / 96, n = (ch % 96) * 32 + col;
        const float* W = ada_w + (size_t)l * 1024 * 3072 + n;
        float a0 = 0.f, a1 = 0.f;
        for (int i = 0; i < 64; ++i) { const int k = kg + 16 * i; const float w = W[(size_t)k * 3072]; a0 += siluf_(c[k]) * w; a1 += siluf_(c[1024 + k]) * w; }
        red[kg * 32 + col] = a0; red[512 + kg * 32 + col] = a1;
        __syncthreads();
        if (F.tid < 64) { const int b = F.tid >> 5; float s = 0.f;
            for (int g = 0; g < 16; ++g) s += red[b * 512 + g * 32 + col];
            mod[(size_t)(l * 2 + b) * 3072 + n] = s + ada_b[l * 3072 + n]; }
        __syncthreads();
    }
}
__device__ __forceinline__ void transpose_item(const float* W, int ldw, int col0, int K, int ncols, bf16* WT, LAS float* scr, int item, int lane) {
    const int nblk = ncols / 32, kb = item / nblk, nb = item % nblk, k0 = 64 * kb, n0 = 32 * nb;
#pragma unroll 8
    for (int i = 0; i < 32; ++i) { const int kk = 2 * i + (lane >> 5); scr[kk * 33 + (lane & 31)] = W[(size_t)(k0 + kk) * ldw + col0 + n0 + (lane & 31)]; }
    asm volatile("s_waitcnt lgkmcnt(0)" ::: "memory");
    const int c = lane & 7;
#pragma unroll
    for (int j = 0; j < 4; ++j) { const int n = (lane >> 3) + 8 * j; const LAS float* s = scr + (8 * c) * 33 + n;
        u32x4 o; o.x = pk2(s[0 * 33], s[1 * 33]); o.y = pk2(s[2 * 33], s[3 * 33]); o.z = pk2(s[4 * 33], s[5 * 33]); o.w = pk2(s[6 * 33], s[7 * 33]);
        *(u32x4*)(WT + (size_t)(n0 + n) * K + k0 + 8 * c) = o; }
    asm volatile("s_waitcnt lgkmcnt(0)" ::: "memory");
}
__device__ __forceinline__ void p0_weights(Frame& F) {
    LAS float* scr = (LAS float*)(F.lds + 16384 + F.wave * 16384);
    const int gw = F.bid * NWAVES + F.wave, NGW = F.G * NWAVES;
    constexpr int I_QKV = 16 * 144, I_A = 16 * 96, I_GA = 16 * 32, I_GB = 16 * 16, I_M = 16 * 64, I_BA = 16 * 32, I_BB = 8 * 32, I_O = 16 * 32;
    constexpr int PER_L = I_QKV + I_A + I_GA + I_GB + I_M + I_BA + I_BB + I_O;
    for (int it = gw; it < 2 * PER_L; it += NGW) {
        const int l = it / PER_L; int r = it % PER_L;
        const float* win = F.in[5] + (size_t)l * 1024 * PROJW;
        bf16* wqkv = (bf16*)(F.ws + WS_WQKV) + (size_t)l * NQKV * 1024;
        bf16* wa = (bf16*)(F.ws + WS_WA) + (size_t)l * NAG * 1024;
        bf16* wm = (bf16*)(F.ws + WS_WM) + (size_t)l * 2048 * 1024;
        const float* W; int ldw, col0, K, ncols; bf16* WT;
        if (r < I_QKV) { W = win; ldw = PROJW; col0 = 4096; K = 1024; ncols = 4608; WT = wqkv; }
        else if ((r -= I_QKV) < I_A) { W = win; ldw = PROJW; col0 = 0; K = 1024; ncols = 3072; WT = wa; }
        else if ((r -= I_A) < I_GA) { W = win; ldw = PROJW; col0 = 3072; K = 1024; ncols = 1024; WT = wa + (size_t)3584 * 1024; }
        else if ((r -= I_GA) < I_GB) { W = win; ldw = PROJW; col0 = 8704; K = 1024; ncols = 512; WT = wa + (size_t)4608 * 1024; }
        else if ((r -= I_GB) < I_M) { W = win; ldw = PROJW; col0 = 9216; K = 1024; ncols = 2048; WT = wm; }
        else if ((r -= I_M) < I_BA) { W = F.in[23] + (size_t)l * 1024 * 1024; ldw = 1024; col0 = 0; K = 1024; ncols = 1024; WT = (bf16*)(F.ws + WS_WBA) + (size_t)l * 1024 * 1024; }
        else if ((r -= I_BA) < I_BB) { W = F.in[24] + (size_t)l * 512 * 1024; ldw = 1024; col0 = 0; K = 512; ncols = 1024; WT = (bf16*)(F.ws + WS_WBB) + (size_t)l * 1024 * 512; }
        else { r -= I_BB; W = F.in[25] + (size_t)l * 1024 * 1024; ldw = 1024; col0 = 0; K = 1024; ncols = 1024; WT = (bf16*)(F.ws + WS_WO) + (size_t)l * 1024 * 1024; }
        transpose_item(W, ldw, col0, K, ncols, WT, scr, r, F.lane);
    }
    const size_t gt = (size_t)F.bid * NTHREADS + F.tid, NGT = (size_t)F.G * NTHREADS;
    for (size_t e = gt; e < (size_t)2 * 512 * 1024; e += NGT) {
        const int l = (int)(e / (512 * 1024)), n = (int)((e / 1024) % 512), k = (int)(e % 1024);
        const float muw = F.in[7][(size_t)(l * 2 + 0) * 1024 + k], mua = F.in[7][(size_t)(l * 2 + 1) * 1024 + k];
        float v = 0.f;
        if (n < 64) v = F.in[9][((size_t)l * 1024 + k) * 64 + n] * (1.f - muw);
        else if (n < 128) v = F.in[9][((size_t)l * 1024 + k) * 64 + (n - 64)] * muw;
        else if (n < 192) v = F.in[12][((size_t)l * 1024 + k) * 64 + (n - 128)] * (1.f - mua);
        else if (n < 256) v = F.in[12][((size_t)l * 1024 + k) * 64 + (n - 192)] * mua;
        else if (n < 320 && l == 1) { const float muv = F.in[19][k]; const int m = (n - 256) & 31; const float w = F.in[21][(size_t)k * 32 + m]; v = (n < 288) ? w * (1.f - muv) : w * muv; }
        ((bf16*)(F.ws + WS_WA))[((size_t)l * NAG + 3072 + n) * 1024 + k] = (bf16)f2bf(v);
    }
}
__device__ __forceinline__ void phase_modnorm(Frame& F, int l, const float* xin) {
    const float* mod = (const float*)(F.ws + WS_MOD) + (size_t)l * 2 * 3072;
    const float* g = F.in[2] + l * 1024;
    bf16* XN = (bf16*)(F.ws + WS_XN);
    const int gw = F.bid * NWAVES + F.wave, NGW = F.G * NWAVES;
    for (int m = gw; m < MROWS; m += NGW) {
        const int b = m / SEQ; const f32x4* xr = (const f32x4*)(xin + (size_t)m * 1024) + F.lane;
        f32x4 v[4]; float s = 0.f;
#pragma unroll
        for (int j = 0; j < 4; ++j) { v[j] = xr[64 * j]; s += (v[j].x * v[j].x + v[j].y * v[j].y) + (v[j].z * v[j].z + v[j].w * v[j].w); }
        const float rs = 1.f / sqrtf(wave_sum(s) * (1.f / 1024.f) + 1e-6f);
        u32x2* o = (u32x2*)(XN + (size_t)m * 1024) + F.lane;
#pragma unroll
        for (int j = 0; j < 4; ++j) { const int c = 4 * F.lane + 256 * j;
            const f32x4 gg = *(const f32x4*)(g + c), sh = *(const f32x4*)(mod + b * 3072 + c), sc = *(const f32x4*)(mod + b * 3072 + 1024 + c);
            const f32x4 h = v[j] * rs * gg * (sc + 1.f) + sh; u32x2 w; w.x = pk2(h.x, h.y); w.y = pk2(h.z, h.w); o[64 * j] = w; }
    }
}
__device__ __forceinline__ void phase_final(Frame& F) {
    const float* g = F.in[27]; const int gw = F.bid * NWAVES + F.wave, NGW = F.G * NWAVES;
    for (int m = gw; m < MROWS; m += NGW) {
        f32x4* xr = (f32x4*)(F.out + (size_t)m * 1024) + F.lane; f32x4 v[4]; float s = 0.f;
#pragma unroll
        for (int j = 0; j < 4; ++j) { v[j] = xr[64 * j]; s += (v[j].x * v[j].x + v[j].y * v[j].y) + (v[j].z * v[j].z + v[j].w * v[j].w); }
        const float rs = 1.f / sqrtf(wave_sum(s) * (1.f / 1024.f) + 1e-6f);
#pragma unroll
        for (int j = 0; j < 4; ++j) { const f32x4 gg = *(const f32x4*)(g + 4 * F.lane + 256 * j); xr[64 * j] = v[j] * rs * gg; }
    }
}
#define LDSBAR() do { asm volatile("s_waitcnt lgkmcnt(0)" ::: "memory"); __builtin_amdgcn_s_barrier(); asm volatile("" ::: "memory"); } while (0)
typedef short bf16x8 __attribute__((ext_vector_type(8)));
typedef short s16x4 __attribute__((ext_vector_type(4)));
typedef short v4i16_t __attribute__((ext_vector_type(4)));
constexpr int RC = 32, RLS = 1024, RNSC = SEQ / RLS, RNCH = RLS / RC, RITEMS = BATCH * 16 * RNSC;
constexpr int AST = 72;
constexpr int MST = 40;
constexpr int OFF_RAWH = 0, OFF_RAWL = 12800, OFF_GCS = 12800, OFF_MK = 12800, OFF_QB = 15360, OFF_QK = 17920, OFF_YS = 20480, OFF_M = 28928, OFF_MMK = 31488;
constexpr int OFF_LW = 34048, OFF_LA = OFF_LW + 4608, OFF_LV = OFF_LA + 4608;
constexpr int OFF_W2T = 45824, OFF_A2T = OFF_W2T + 9216, OFF_V2T = OFF_A2T + 9216;
constexpr int OFF_CV = 69376, OFF_GAM = 72192, OFF_RK = 72448;
constexpr int OFF_PRE = 72576, OFF_U = 72576, OFF_T = OFF_U + 8704;
constexpr int OFF_LWG = 97664, OFF_ARR = 105856, OFF_VFS = 142720, OFF_GAS = OFF_ARR + 4 * (32 * AST * 2);
constexpr int PRE_ST = 196, U_ST = 68, T_ST = 36, YS_ST = 66;
enum { AR_RT = 0, AR_AT, AR_BT, AR_KT, AR_BH, AR_KH, AR_V, AR_W };
static_assert(OFF_VFS + 4096 <= LDS_BYTES - 64 && OFF_MMK + 2560 <= OFF_LW && OFF_YS + 32 * YS_ST * 4 <= OFF_M, "rwkv LDS map");
#define ARR(k) (F.lds + OFF_ARR + (k) * (32 * AST * 2))

__device__ __forceinline__ bf16x8 ld_b128(const LAS unsigned char* p) { return *(const LAS bf16x8*)p; }
__device__ __forceinline__ s16x4 ld_b64(const LAS unsigned char* p) { return *(const LAS s16x4*)p; }
__device__ __forceinline__ s16x4 ld_tr(const LAS unsigned char* p) { return __builtin_bit_cast(s16x4, __builtin_amdgcn_ds_read_tr16_b64_v4i16((LAS v4i16_t*)p)); }
__device__ __forceinline__ bf16x8 cat8(s16x4 a, s16x4 b) { return (bf16x8){a[0], a[1], a[2], a[3], b[0], b[1], b[2], b[3]}; }
__device__ __forceinline__ bf16x8 pack8(f32x4 a, f32x4 b) { u32x4 w; w.x = pk2(a[0], a[1]); w.y = pk2(a[2], a[3]); w.z = pk2(b[0], b[1]); w.w = pk2(b[2], b[3]); return __builtin_bit_cast(bf16x8, w); }
#define MFMA16(a, b, c) __builtin_amdgcn_mfma_f32_16x16x32_bf16((a), (b), (c), 0, 0, 0)
__device__ __forceinline__ void st_bf(LAS unsigned char* base, int idx, float v) { ((LAS bf16*)base)[idx] = (bf16)pg8::cvt_pk_bf16(v, v); }
__device__ __forceinline__ float fsig(float x) { return __builtin_amdgcn_rcpf(1.f + __expf(-x)); }
__device__ __forceinline__ float fast_tanh(float x) { return 1.f - 2.f * __builtin_amdgcn_rcpf(1.f + __expf(2.f * x)); }

__device__ __forceinline__ u32x4 rwkv_raw_load(const bf16* PA, const bf16* VF, int l, int b, int h, int t0, int i, int tid) {
    u32x4 v = (u32x4){0u, 0u, 0u, 0u};
    if (i == 5) { if (tid < 256) v = *(const u32x4*)(VF + (size_t)(b * SEQ + t0 + (tid >> 3)) * 1024 + h * 64 + (tid & 7) * 8); return v; }
    const int e = tid + NTHREADS * i, rr = (i < 4) ? (e >> 6) : 32, k = tid & 63, t = t0 - 1 + rr;
    const int col = (k < 24) ? ((k >> 3) * 1024 + h * 64 + (k & 7) * 8) : (3072 + (k - 24) * 8);
    if (i < 4 || tid < 64) { if (t >= 0) v = *(const u32x4*)(PA + (size_t)(b * SEQ + t) * NA + col); }
    else if (l == 1 && tid < 320) { const int q = tid - 64; v = *(const u32x4*)(VF + (size_t)(b * SEQ + t0 + (q >> 3)) * 1024 + h * 64 + (q & 7) * 8); }
    return v;
}
__device__ __forceinline__ void rwkv_raw_store(Frame& F, int i, int tid, u32x4 v) {
    if (i == 5) { if (tid < 256) *(LAS u32x4*)(F.lds + OFF_GAS + tid * 16) = v; return; }
    const int e = tid + NTHREADS * i, rr = (i < 4) ? (e >> 6) : 32, k = tid & 63;
    const int off = (k < 24) ? (OFF_RAWH + (rr * 192 + k * 8) * 2) : (OFF_RAWL + (rr * 320 + (k - 24) * 8) * 2);
    if (i < 4 || tid < 64) *(LAS u32x4*)(F.lds + off) = v;
    else if (tid < 320) *(LAS u32x4*)(F.lds + OFF_VFS + (tid - 64) * 16) = v;
}

__device__ __forceinline__ void rwkv_chain_scan(Frame& F, int chain, int sc_lo, int sc_hi);
template <int PASS> __device__ __forceinline__ void rwkv_pass(Frame& F, int l) {
    const int tid = F.tid, lane = F.lane, wave = F.wave, g = lane >> 4, c = lane & 15;
    const bf16* PA = (const bf16*)(F.ws + WS_PA); bf16* YA = (bf16*)(F.ws + WS_YA); bf16* VF = (bf16*)(F.ws + WS_VFIRST);
    float* PD = (float*)(F.ws + WS_SC); float* SST = (float*)(F.ws + WS_SC + 16 * MiB);
    LAS float* CV = (LAS float*)(F.lds + OFF_CV); LAS float* GAM = (LAS float*)(F.lds + OFF_GAM); LAS float* RK = (LAS float*)(F.lds + OFF_RK);
    LAS float* PRE = (LAS float*)(F.lds + OFF_PRE); LAS float* Us = (LAS float*)(F.lds + OFF_U); LAS float* Ts = (LAS float*)(F.lds + OFF_T);
    LAS float* LWG = (LAS float*)(F.lds + OFF_LWG); LAS float* GCS = (LAS float*)(F.lds + OFF_GCS); LAS float* YS = (LAS float*)(F.lds + OFF_YS);
    LAS bf16* RAWH = (LAS bf16*)(F.lds + OFF_RAWH); LAS bf16* RAWL = (LAS bf16*)(F.lds + OFF_RAWL); LAS bf16* VFS = (LAS bf16*)(F.lds + OFF_VFS);
    const int chain = F.bid >> 3, b = chain >> 4, h = chain & 15, NIT = RNSC / 8;
    if (F.G != 256) return;
    if (PASS == 3) rwkv_chain_scan(F, chain, (F.bid & 7) * NIT, (F.bid & 7) * NIT + NIT - 1);
    for (int e = tid; e < 4096; e += NTHREADS) { const int m = e >> 6, j = e & 63;
        st_bf(F.lds + OFF_W2T, j * AST + m, F.in[10][((size_t)l * 64 + m) * 1024 + h * 64 + j]);
        st_bf(F.lds + OFF_A2T, j * AST + m, F.in[13][((size_t)l * 64 + m) * 1024 + h * 64 + j]);
        if (m < 32) st_bf(F.lds + OFF_V2T, j * MST + m, (l == 1) ? F.in[22][(size_t)m * 1024 + h * 64 + j] : 0.f); }
    if (tid < 64) { const int cc = h * 64 + tid;
        CV[0 * 64 + tid] = F.in[8][l * 1024 + cc];  CV[1 * 64 + tid] = F.in[11][l * 1024 + cc]; CV[2 * 64 + tid] = (l == 1) ? F.in[20][cc] : 0.f;
        CV[3 * 64 + tid] = F.in[14][l * 1024 + cc]; CV[4 * 64 + tid] = F.in[15][l * 1024 + cc]; CV[5 * 64 + tid] = F.in[16][l * 1024 + cc];
        CV[6 * 64 + tid] = F.in[17][l * 1024 + cc]; CV[7 * 64 + tid] = F.in[18][l * 1024 + cc];
        CV[8 * 64 + tid] = F.in[6][(size_t)(l * 3 + 0) * 1024 + cc]; CV[9 * 64 + tid] = F.in[6][(size_t)(l * 3 + 1) * 1024 + cc]; CV[10 * 64 + tid] = F.in[6][(size_t)(l * 3 + 2) * 1024 + cc]; }
    const bf16* GAp = (const bf16*)(F.ws + WS_GA);
    u32x4 pre[5], preg = (u32x4){0u, 0u, 0u, 0u};
#pragma unroll
    for (int i = 0; i < 5; ++i) pre[i] = rwkv_raw_load(PA, VF, l, b, h, ((F.bid & 7) * NIT) * RLS, i, tid);
    if (PASS == 3) preg = rwkv_raw_load(PA, GAp, l, b, h, ((F.bid & 7) * NIT) * RLS, 5, tid);
    for (int ii = 0; ii < NIT; ++ii) {
        const int sc = (F.bid & 7) * NIT + ii, it = chain * RNSC + sc;
        f32x4 X[4];
#pragma unroll
        for (int jt = 0; jt < 4; ++jt) X[jt] = (f32x4){0.f, 0.f, 0.f, 0.f};
        if (PASS == 1) { if (wave >= 4) {
#pragma unroll
                for (int jt = 0; jt < 4; ++jt)
#pragma unroll
                    for (int r = 0; r < 4; ++r) X[jt][r] = (16 * jt + 4 * g + r == 16 * (wave - 4) + c) ? 1.f : 0.f; } }
        else if (wave < 4) { int lz = lane; asm volatile("" : "+v"(lz));
            const float* s0 = SST + (size_t)it * 4096 + (4 * (lz >> 4)) * 64 + 16 * wave + (lz & 15);
#pragma unroll
            for (int jt = 0; jt < 4; ++jt)
#pragma unroll
                for (int r = 0; r < 4; ++r) X[jt][r] = s0[(16 * jt + r) * 64]; }
        for (int ch = 0; ch < RNCH; ++ch) {
            const int t0 = sc * RLS + ch * RC;
            LDSBAR();
            {
            { int tz = tid; asm volatile("" : "+v"(tz));
#pragma unroll
              for (int i = 0; i < 5; ++i) rwkv_raw_store(F, i, tz, pre[i]);
              if (PASS == 3) rwkv_raw_store(F, 5, tz, preg);
              const bool last = (ch == RNCH - 1) && (ii == NIT - 1); const int t0n = last ? t0 : t0 + RC;
#pragma unroll
              for (int i = 0; i < 5; ++i) pre[i] = rwkv_raw_load(PA, VF, l, b, h, t0n, i, tz);
              if (PASS == 3) preg = rwkv_raw_load(PA, GAp, l, b, h, t0n, 5, tz); }
            LDSBAR();
            }
            {
            { const int tl = tid >> 4, mq = tid & 15; const LAS unsigned char* cur = F.lds + OFF_RAWL + (tl + 1) * 640 + mq * 8; const LAS unsigned char* prv = F.lds + OFF_RAWL + tl * 640 + mq * 8;
              const u32x2 cw = *(const LAS u32x2*)(cur), pw = *(const LAS u32x2*)(prv + 128), ca = *(const LAS u32x2*)(cur + 256), pa = *(const LAS u32x2*)(prv + 384);
              const unsigned cv2 = *(const LAS unsigned*)(F.lds + OFF_RAWL + (tl + 1) * 640 + 512 + mq * 4), pv2 = *(const LAS unsigned*)(F.lds + OFF_RAWL + tl * 640 + 576 + mq * 4);
              u32x2 lw, la;
              lw.x = pk2(fast_tanh(bflo(cw.x) + bflo(pw.x)), fast_tanh(bfhi(cw.x) + bfhi(pw.x))); lw.y = pk2(fast_tanh(bflo(cw.y) + bflo(pw.y)), fast_tanh(bfhi(cw.y) + bfhi(pw.y)));
              la.x = pk2(bflo(ca.x) + bflo(pa.x), bfhi(ca.x) + bfhi(pa.x)); la.y = pk2(bflo(ca.y) + bflo(pa.y), bfhi(ca.y) + bfhi(pa.y));
              const unsigned lv = pk2(bflo(cv2) + bflo(pv2), bfhi(cv2) + bfhi(pv2));
              *(LAS u32x2*)(F.lds + OFF_LW + (tl * AST + mq * 4) * 2) = lw; *(LAS u32x2*)(F.lds + OFF_LA + (tl * AST + mq * 4) * 2) = la; *(LAS unsigned*)(F.lds + OFF_LV + (tl * MST + mq * 2) * 2) = lv; }
            LDSBAR();
            }
            {
            { f32x4 acc3[3];
#pragma unroll
              for (int q = 0; q < 3; ++q) { const int o16 = 2 * wave + q - 1;
                const int tt = (q == 0) ? (wave >> 2) : (o16 >> 3), mat = (q == 0) ? 0 : 1 + ((o16 >> 2) & 1), jt = (q == 0) ? (wave & 3) : (o16 & 3);
                f32x4 acc = (f32x4){0.f, 0.f, 0.f, 0.f};
                if (mat < 2) { const LAS unsigned char* Ab = F.lds + (mat == 0 ? OFF_LW : OFF_LA) + ((16 * tt + c) * AST + 8 * g) * 2; const LAS unsigned char* Bb = F.lds + (mat == 0 ? OFF_W2T : OFF_A2T) + ((16 * jt + c) * AST + 8 * g) * 2;
                    acc = MFMA16(ld_b128(Ab), ld_b128(Bb), acc); acc = MFMA16(ld_b128(Ab + 64), ld_b128(Bb + 64), acc); }
                else { const LAS unsigned char* Ab = F.lds + OFF_LV + ((16 * tt + c) * MST + 8 * g) * 2; const LAS unsigned char* Bb = F.lds + OFF_V2T + ((16 * jt + c) * MST + 8 * g) * 2;
                    acc = MFMA16(ld_b128(Ab), ld_b128(Bb), acc); }
                acc3[q] = acc; }
              const float w0 = CV[16 * (wave & 3) + c];
#pragma unroll
              for (int q = 0; q < 3; ++q) { const int o16 = 2 * wave + q - 1;
                const int tt = (q == 0) ? (wave >> 2) : (o16 >> 3), mat = (q == 0) ? 0 : 1 + ((o16 >> 2) & 1), jt = (q == 0) ? (wave & 3) : (o16 & 3), nt = mat * 4 + jt;
                if (q == 0) {
#pragma unroll
                    for (int r = 0; r < 4; ++r) { const float x = -(acc3[0][r] + w0); const float sp = fmaxf(x, 0.f) + __logf(1.f + __expf(-fabsf(x))); LWG[(16 * tt + 4 * g + r) * 64 + 16 * jt + c] = -__expf(-sp - 0.5f); } }
                else {
#pragma unroll
                    for (int r = 0; r < 4; ++r) PRE[(16 * tt + 4 * g + r) * PRE_ST + 16 * nt + c] = acc3[q][r]; } } }
            LDSBAR();
            }
            {
            { const int tt = wave >> 2, jt = wave & 3; f32x4 acc = (f32x4){0.f, 0.f, 0.f, 0.f};
#pragma unroll
              for (int ks = 0; ks < 8; ++ks) { if (ks >= 4 && tt == 0) continue;
                  const float av = (4 * ks + g <= 16 * tt + c) ? 1.f : 0.f; const float bv = LWG[(4 * ks + g) * 64 + 16 * jt + c];
                  acc = __builtin_amdgcn_mfma_f32_16x16x4f32(av, bv, acc, 0, 0, 0); }
#pragma unroll
              for (int r = 0; r < 4; ++r) GCS[(16 * tt + 4 * g + r) * 64 + 16 * jt + c] = acc[r];
              if (tt == 1 && g == 3) GAM[16 * jt + c] = __expf(acc[3]); }
            LDSBAR();
            }
            {
            { typedef float f32x2 __attribute__((ext_vector_type(2)));
              const int hf = lane >> 5, j0 = 2 * (lane & 31); const bool up = hf != 0;
#define LD2(P_, IDX_) (*(const LAS f32x2*)((P_) + (IDX_)))
#define LDB2(P_, IDX_) (*(const LAS unsigned*)((P_) + (IDX_)))
#define BF2(W_) ((f32x2){bflo(W_), bfhi(W_)})
              const f32x2 c_a0 = LD2(CV, 64 + j0), c_v0 = LD2(CV, 128 + j0), c_kk = LD2(CV, 3 * 64 + j0), c_ka = LD2(CV, 4 * 64 + j0), c_rk = LD2(CV, 5 * 64 + j0), c_mr = LD2(CV, 8 * 64 + j0), c_mk = LD2(CV, 9 * 64 + j0), c_mv = LD2(CV, 10 * 64 + j0);
              f32x2 apre[2], vpre[2], gt[2], gp[2]; unsigned wr_[2], wrp[2], wk_[2], wkp[2], wv_[2], wvp[2], wvf[2];
#pragma unroll
              for (int k = 0; k < 2; ++k) { const int tl = wave + 8 * (2 * k + hf);
                  apre[k] = LD2(PRE, tl * PRE_ST + 64 + j0); vpre[k] = LD2(PRE, tl * PRE_ST + 128 + j0);
                  wr_[k] = LDB2(RAWH, (tl + 1) * 192 + j0); wrp[k] = LDB2(RAWH, tl * 192 + j0); wk_[k] = LDB2(RAWH, (tl + 1) * 192 + 64 + j0); wkp[k] = LDB2(RAWH, tl * 192 + 64 + j0);
                  wv_[k] = LDB2(RAWH, (tl + 1) * 192 + 128 + j0); wvp[k] = LDB2(RAWH, tl * 192 + 128 + j0); wvf[k] = LDB2(VFS, tl * 64 + j0);
                  gt[k] = LD2(GCS, tl * 64 + j0); gp[k] = LD2(GCS, (tl > 0 ? tl - 1 : 0) * 64 + j0); }
              unsigned o_at[2], o_bt[2], o_kt[2], o_v[2], o_rt[2]; float o_rk[2];
#pragma unroll
              for (int k = 0; k < 2; ++k) { const int tl = wave + 8 * (2 * k + hf);
                  const f32x2 pr = BF2(wr_[k]), prp = BF2(wrp[k]), pk = BF2(wk_[k]), pkp = BF2(wkp[k]), pv = BF2(wv_[k]), pvp = BF2(wvp[k]);
                  const f32x2 r = pr + (prp - pr) * c_mr, kx = pk + (pkp - pk) * c_mk; f32x2 v = pv + (pvp - pv) * c_mv;
                  const f32x2 ax = apre[k] + c_a0; const f32x2 asig = (f32x2){fsig(ax.x), fsig(ax.y)};
                  if (l == 1) { const f32x2 vx = vpre[k] + c_v0, vf = BF2(wvf[k]); v = v + (vf - v) * (f32x2){fsig(vx.x), fsig(vx.y)}; }
                  const f32x2 kk = kx * c_kk; const float ss = half_sum_dpp(kk.x * kk.x + kk.y * kk.y, up); const f32x2 kkn = kk * __builtin_amdgcn_rsqf(fmaxf(ss, 1e-24f));
                  const f32x2 k2 = kx * ((asig - 1.f) * c_ka + 1.f); const f32x2 bv = kkn * asig;
                  const f32x2 eg = (f32x2){__expf(gt[k].x), __expf(gt[k].y)}, einv = (f32x2){__expf(-gt[k].x), __expf(-gt[k].y)};
                  f32x2 egp = (f32x2){__expf(gp[k].x), __expf(gp[k].y)}; if (tl == 0) egp = (f32x2){1.f, 1.f};
                  const f32x2 at = -kkn * egp, bt = bv * einv, kt = k2 * einv, rt = r * eg;
                  o_at[k] = pk2(at.x, at.y); o_bt[k] = pk2(bt.x, bt.y); o_kt[k] = pk2(kt.x, kt.y); o_v[k] = pk2(v.x, v.y); o_rt[k] = pk2(rt.x, rt.y);
                  const f32x2 rkp = r * k2 * c_rk; o_rk[k] = (PASS == 3) ? half_sum_dpp(rkp.x + rkp.y, up) : 0.f; }
#pragma unroll
              for (int k = 0; k < 2; ++k) { const int tl = wave + 8 * (2 * k + hf), o = (tl * AST + j0) * 2;
                  *(LAS unsigned*)(ARR(AR_AT) + o) = o_at[k]; *(LAS unsigned*)(ARR(AR_BT) + o) = o_bt[k]; *(LAS unsigned*)(ARR(AR_KT) + o) = o_kt[k]; *(LAS unsigned*)(ARR(AR_V) + o) = o_v[k];
                  if (PASS == 3) { *(LAS unsigned*)(ARR(AR_RT) + o) = o_rt[k]; if ((lane & 31) == 0) RK[tl] = o_rk[k]; }
                  if (l == 0 && PASS == 1) *(unsigned*)(VF + (size_t)(b * SEQ + t0 + tl) * 1024 + h * 64 + j0) = o_v[k]; }
#undef LD2
#undef LDB2
#undef BF2
            }
            LDSBAR();
            }
            {
            { f32x4 acc7[2];
#pragma unroll
              for (int q = 0; q < 2; ++q) { const int tile = wave * 2 + q, rt = tile >> 2, ct = tile & 3, tt = rt & 1, st = ct & 1;
                f32x4 acc = (f32x4){0.f, 0.f, 0.f, 0.f};
                if (!(PASS == 1 && rt >= 2) && st <= tt) { const LAS unsigned char* Ab = ARR(rt < 2 ? AR_AT : AR_RT) + ((16 * tt + c) * AST + 8 * g) * 2; const LAS unsigned char* Bb = ARR(ct < 2 ? AR_BT : AR_KT) + ((16 * st + c) * AST + 8 * g) * 2;
                    acc = MFMA16(ld_b128(Ab), ld_b128(Bb), acc); acc = MFMA16(ld_b128(Ab + 64), ld_b128(Bb + 64), acc); }
                acc7[q] = acc; }
#pragma unroll
              for (int q = 0; q < 2; ++q) { const int tile = wave * 2 + q, rt = tile >> 2, ct = tile & 3, tt = rt & 1, st = ct & 1;
                if (PASS == 1 && rt >= 2) continue;
                const int s = 16 * st + c;
#pragma unroll
                for (int r = 0; r < 4; ++r) { const int t = 16 * tt + 4 * g + r; const bool keep = (rt < 2) ? (s < t) : (s <= t); const float v = keep ? acc7[q][r] : 0.f;
                    if (rt < 2 && ct < 2) { Ts[t * T_ST + s] = v; if (tt == 1 && st == 0) st_bf(F.lds + OFF_M, t * MST + s, v); } else st_bf(F.lds + (rt < 2 ? OFF_MK : (ct < 2 ? OFF_QB : OFF_QK)), t * MST + s, v); } } }
            LDSBAR();
            }
            f32x4 mkv[2], Ureg[2];
            {
            mkv[0] = (f32x4){0.f, 0.f, 0.f, 0.f}; mkv[1] = mkv[0];
            if (wave == 4 || wave == 5) { const int bb = 16 * (wave - 4), s = lane & 15; float x[16]; float trow[16];
#pragma unroll
                for (int t = 0; t < 16; ++t) trow[t] = Ts[(bb + t) * T_ST + bb + s];
#pragma unroll
                for (int t = 0; t < 16; ++t) { float a0 = (t == s) ? 1.f : 0.f, a1 = 0.f;
#pragma unroll
                    for (int u = 0; u < t; ++u) { const float tv = __int_as_float(__builtin_amdgcn_readlane(__float_as_int(trow[t]), u)); if (u & 1) a1 += tv * x[u]; else a0 += tv * x[u]; }
                    x[t] = a0 + a1; }
#pragma unroll
                for (int t = 0; t < 16; ++t) { if (lane < 16) st_bf(F.lds + OFF_M, (bb + t) * MST + bb + s, x[t]); } }
            else if (wave < 4) { const int q4 = c >> 2, p4 = c & 3;
                const LAS unsigned char* vb = ARR(AR_V) + ((8 * g + q4) * AST + 16 * wave + 4 * p4) * 2; const bf16x8 vfr = cat8(ld_tr(vb), ld_tr(vb + 4 * AST * 2));
#pragma unroll
                for (int st = 0; st < 2; ++st) mkv[st] = MFMA16(ld_b128(F.lds + OFF_MK + ((16 * st + c) * MST + 8 * g) * 2), vfr, mkv[st]); }
            LDSBAR();
            { const s16x4 z4 = (s16x4){0, 0, 0, 0};
              const bf16x8 m00 = cat8(ld_b64(F.lds + OFF_M + (c * MST + 4 * g) * 2), z4), t10 = cat8(ld_b64(F.lds + OFF_M + ((16 + c) * MST + 4 * g) * 2), z4), m11 = cat8(ld_b64(F.lds + OFF_M + ((16 + c) * MST + 16 + 4 * g) * 2), z4);
              bf16x8 r0; f32x4 r1;
              if (wave < 4) { r0 = pack8(mkv[0], (f32x4){0.f, 0.f, 0.f, 0.f}); r1 = mkv[1]; }
              else { const int jt = wave - 4, q4 = c >> 2, p4 = c & 3;
                  r0 = cat8(ld_tr(ARR(AR_AT) + ((4 * g + q4) * AST + 16 * jt + 4 * p4) * 2), z4);
#pragma unroll
                  for (int r = 0; r < 4; ++r) r1[r] = bf2f(((const LAS bf16*)ARR(AR_AT))[(16 + 4 * g + r) * AST + 16 * jt + c]); }
              const f32x4 zero4 = (f32x4){0.f, 0.f, 0.f, 0.f};
              const f32x4 x0 = MFMA16(m00, r0, zero4);
              const f32x4 yv = MFMA16(t10, pack8(x0, zero4), r1);
              const f32x4 x1 = MFMA16(m11, pack8(yv, zero4), zero4);
              Ureg[0] = x0; Ureg[1] = x1;
              if (wave >= 4) { const int jt = wave - 4;
#pragma unroll
                  for (int r = 0; r < 4; ++r) { st_bf(ARR(AR_W), (4 * g + r) * AST + 16 * jt + c, x0[r]); st_bf(ARR(AR_W), (16 + 4 * g + r) * AST + 16 * jt + c, x1[r]); } } }
            LDSBAR();
            }
            const bool active = (PASS == 1) ? true : (wave < 4);
            const bool inhom = (PASS == 1) ? (wave < 4) : true;
            const int cw = wave & 3;
            if (active) {
                bf16x8 xf[2];
                xf[0] = pack8(X[0], X[1]); xf[1] = pack8(X[2], X[3]);
                f32x4 Z[2];
#pragma unroll
                for (int tt = 0; tt < 2; ++tt) { f32x4 z = (f32x4){0.f, 0.f, 0.f, 0.f};
                    if (inhom) z = Ureg[tt];
#pragma unroll
                    for (int ks = 0; ks < 2; ++ks) { const LAS unsigned char* wb = ARR(AR_W) + ((16 * tt + c) * AST + 32 * ks + 4 * g) * 2;
                        z = MFMA16(cat8(ld_b64(wb), ld_b64(wb + 32)), xf[ks], z); }
                    Z[tt] = z; }
                const bf16x8 zf = pack8(Z[0], Z[1]);
                bf16x8 vf = zf;
                if (inhom) { const int q = c >> 2, p = c & 3; const LAS unsigned char* vb = ARR(AR_V) + ((4 * g + q) * AST + 16 * cw + 4 * p) * 2; vf = cat8(ld_tr(vb), ld_tr(vb + 16 * AST * 2)); }
                f32x4 Yt[2]; Yt[0] = (f32x4){0.f, 0.f, 0.f, 0.f}; Yt[1] = Yt[0];
                if (PASS == 3) {
#pragma unroll
                    for (int tt = 0; tt < 2; ++tt) { f32x4 y = (f32x4){0.f, 0.f, 0.f, 0.f};
#pragma unroll
                        for (int ks = 0; ks < 2; ++ks) { const LAS unsigned char* rb = ARR(AR_RT) + ((16 * tt + c) * AST + 32 * ks + 4 * g) * 2;
                            y = MFMA16(cat8(ld_b64(rb), ld_b64(rb + 32)), xf[ks], y); }
                        const LAS unsigned char* qb = F.lds + OFF_QB + ((16 * tt + c) * MST + 4 * g) * 2; const LAS unsigned char* qk = F.lds + OFF_QK + ((16 * tt + c) * MST + 4 * g) * 2;
                        y = MFMA16(cat8(ld_b64(qb), ld_b64(qb + 32)), zf, y);
                        y = MFMA16(cat8(ld_b64(qk), ld_b64(qk + 32)), vf, y);
                        Yt[tt] = y; } }
                { const int q = c >> 2, p = c & 3;
#pragma unroll
                  for (int jt = 0; jt < 4; ++jt) { f32x4 xn = X[jt];
                      const LAS unsigned char* bb = ARR(AR_BT) + ((4 * g + q) * AST + 16 * jt + 4 * p) * 2;
                      xn = MFMA16(cat8(ld_tr(bb), ld_tr(bb + 16 * AST * 2)), zf, xn);
                      if (inhom) { const LAS unsigned char* kb = ARR(AR_KT) + ((4 * g + q) * AST + 16 * jt + 4 * p) * 2; xn = MFMA16(cat8(ld_tr(kb), ld_tr(kb + 16 * AST * 2)), vf, xn); }
#pragma unroll
                      for (int r = 0; r < 4; ++r) xn[r] *= GAM[16 * jt + 4 * g + r];
                      X[jt] = xn; } }
                if (PASS == 3) {
#pragma unroll
                    for (int tt = 0; tt < 2; ++tt)
#pragma unroll
                        for (int r = 0; r < 4; ++r) YS[(16 * tt + 4 * g + r) * YS_ST + 16 * cw + c] = Yt[tt][r]; }
            }
            if (PASS == 3) {
                LDSBAR();
                { typedef float f32x2 __attribute__((ext_vector_type(2)));
                  const int hf = lane >> 5, i0_ = 2 * (lane & 31); const bool up = hf != 0;
                  f32x2 y[2]; float rk[2]; unsigned wv2[2], wg2[2];
#pragma unroll
                  for (int k = 0; k < 2; ++k) { const int tl = wave + 8 * (2 * k + hf); y[k] = *(const LAS f32x2*)(YS + tl * YS_ST + i0_); rk[k] = RK[tl];
                      wv2[k] = *(const LAS unsigned*)(ARR(AR_V) + (tl * AST + i0_) * 2); wg2[k] = *(const LAS unsigned*)(F.lds + OFF_GAS + (tl * 64 + i0_) * 2); }
                  const f32x2 c_g = *(const LAS f32x2*)(CV + 6 * 64 + i0_), c_b = *(const LAS f32x2*)(CV + 7 * 64 + i0_);
#pragma unroll
                  for (int k = 0; k < 2; ++k) { const int tl = wave + 8 * (2 * k + hf); const size_t row = (size_t)(b * SEQ + t0 + tl);
                      const float mean = half_sum_dpp(y[k].x + y[k].y, up) * (1.f / 64.f); const f32x2 dd = y[k] - mean; const float var = half_sum_dpp(dd.x * dd.x + dd.y * dd.y, up) * (1.f / 64.f);
                      const f32x2 vv = (f32x2){bflo(wv2[k]), bfhi(wv2[k])}, ga = (f32x2){bflo(wg2[k]), bfhi(wg2[k])};
                      const f32x2 o = (dd * __builtin_amdgcn_rsqf(var + 64e-5f) * c_g + c_b + vv * rk[k]) * ga;
                      *(unsigned*)(YA + row * 1024 + h * 64 + i0_) = pk2(o.x, o.y); } }
            }
        }
        if (PASS == 1) { int lz = lane; asm volatile("" : "+v"(lz));
            float* pd = PD + (size_t)it * 8192 + (4 * (lz >> 4)) * 128 + 16 * wave + (lz & 15);
#pragma unroll
            for (int jt = 0; jt < 4; ++jt)
#pragma unroll
                for (int r = 0; r < 4; ++r) pd[(16 * jt + r) * 128] = X[jt][r]; }
    }
}
#define R2_LOAD(SET_, ITEM) do { const f32x4* pd_ = (const f32x4*)(PD + (size_t)(ITEM) * 8192); _Pragma("unroll") for (int q = 0; q < 4; ++q) SET_[q] = pd_[F.tid + NTHREADS * q]; } while (0)
#define R2_STEP(SET_, SC) do { const size_t it_ = (size_t)F.bid * RNSC + (SC); \
    _Pragma("unroll") for (int q = 0; q < 4; ++q) { const int e = F.tid + NTHREADS * q; *(LAS f32x4*)(PL + (e >> 5) * 132 + (e & 31) * 4) = SET_[q]; } \
    if ((SC) + 2 < RNSC) R2_LOAD(SET_, it_ + 2); \
    LDSBAR(); \
    { float* so = SST + it_ * 4096; for (int e = F.tid; e < 1024; e += NTHREADS) { const int j = e >> 4, i4 = (e & 15) * 4; *(f32x4*)(so + j * 64 + i4) = *(const LAS f32x4*)(S + j * 68 + i4); } } \
    f32x4 acc[2]; float pc[16], sb[2][16]; \
    _Pragma("unroll") for (int q = 0; q < 2; ++q) _Pragma("unroll") for (int r = 0; r < 4; ++r) acc[q][r] = PL[(16 * jt + 4 * g + r) * 132 + 16 * (it0 + q) + c]; \
    _Pragma("unroll") for (int ks = 0; ks < 16; ++ks) { pc[ks] = PL[(16 * jt + c) * 132 + 64 + 4 * ks + g]; _Pragma("unroll") for (int q = 0; q < 2; ++q) sb[q][ks] = S[(4 * ks + g) * 68 + 16 * (it0 + q) + c]; } \
    _Pragma("unroll") for (int ks = 0; ks < 16; ++ks) { _Pragma("unroll") for (int q = 0; q < 2; ++q) acc[q] = __builtin_amdgcn_mfma_f32_16x16x4f32(pc[ks], sb[q][ks], acc[q], 0, 0, 0); } \
    LDSBAR(); \
    _Pragma("unroll") for (int q = 0; q < 2; ++q) _Pragma("unroll") for (int r = 0; r < 4; ++r) S[(16 * jt + 4 * g + r) * 68 + 16 * (it0 + q) + c] = acc[q][r]; \
    } while (0)
#define CS_LOAD(SET_, STEP_) do { const f32x4* pd_ = (const f32x4*)(PD + (item0 + (STEP_)) * 8192); _Pragma("unroll") for (int q = 0; q < 4; ++q) SET_[q] = pd_[F.tid + NTHREADS * q]; } while (0)
#define CS_STEP(SET_, SC) do { if (!done) { const int sc_ = (SC); \
    LDSBAR(); \
    if (sc_ >= sc_lo) { float* so = SST + (item0 + sc_) * 4096; for (int e = F.tid; e < 1024; e += NTHREADS) { const int j = e >> 4, i4 = (e & 15) * 4; *(f32x4*)(so + j * 64 + i4) = *(const LAS f32x4*)(S + j * 68 + i4); } } \
    if (sc_ >= sc_hi) done = true; else { \
    _Pragma("unroll") for (int q = 0; q < 4; ++q) { const int e = F.tid + NTHREADS * q; *(LAS f32x4*)(PL + (e >> 5) * 132 + (e & 31) * 4) = SET_[q]; } \
    if (sc_ + 2 < sc_hi) CS_LOAD(SET_, sc_ + 2); \
    LDSBAR(); \
    f32x4 acc[2]; float pc[16], sb[2][16]; \
    _Pragma("unroll") for (int q = 0; q < 2; ++q) _Pragma("unroll") for (int r = 0; r < 4; ++r) acc[q][r] = PL[(16 * jt + 4 * g + r) * 132 + 16 * (it0 + q) + c]; \
    _Pragma("unroll") for (int ks = 0; ks < 16; ++ks) { pc[ks] = PL[(16 * jt + c) * 132 + 64 + 4 * ks + g]; _Pragma("unroll") for (int q = 0; q < 2; ++q) sb[q][ks] = S[(4 * ks + g) * 68 + 16 * (it0 + q) + c]; } \
    _Pragma("unroll") for (int ks = 0; ks < 16; ++ks) { _Pragma("unroll") for (int q = 0; q < 2; ++q) acc[q] = __builtin_amdgcn_mfma_f32_16x16x4f32(pc[ks], sb[q][ks], acc[q], 0, 0, 0); } \
    LDSBAR(); \
    _Pragma("unroll") for (int q = 0; q < 2; ++q) _Pragma("unroll") for (int r = 0; r < 4; ++r) S[(16 * jt + 4 * g + r) * 68 + 16 * (it0 + q) + c] = acc[q][r]; } } } while (0)
__device__ __forceinline__ void rwkv_chain_scan(Frame& F, int chain, int sc_lo, int sc_hi) {
    const float* PD = (const float*)(F.ws + WS_SC); float* SST = (float*)(F.ws + WS_SC + 16 * MiB);
    LAS float* S = (LAS float*)F.lds; LAS float* PL = S + 64 * 68;
    const int lane = F.lane, wave = F.wave, g = lane >> 4, c = lane & 15, jt = wave >> 1, it0 = 2 * (wave & 1);
    for (int e = F.tid; e < 64 * 68; e += NTHREADS) S[e] = 0.f;
    f32x4 set0[4], set1[4];
    const size_t item0 = (size_t)chain * RNSC;
    if (0 < sc_hi) CS_LOAD(set0, 0);
    if (1 < sc_hi) CS_LOAD(set1, 1);
    bool done = false;
    for (int sc = 0; sc <= sc_hi; sc += 2) { CS_STEP(set0, sc); CS_STEP(set1, sc + 1); }
    asm volatile("s_waitcnt vmcnt(0)" ::: "memory"); __syncthreads();
}
constexpr size_t WS_LSE = 330 * MiB;
constexpr int AT_KS = 0, AT_VS = 36864, AT_BIAS = 76032, AT_OST = 76800, KVST = 72;
__device__ __forceinline__ void attn_decode_run(int ridx, int& b, int& gatt, int& h, int& dil, int& r, int& n0) {
    const int bgh = ridx >> 4, k16 = ridx & 15; h = bgh & 7; const int bg = bgh >> 3; gatt = bg % 3; b = bg / 3;
    dil = (gatt == 0) ? 1 : (gatt == 1 ? 4 : 16); const int rpr = 16 / dil; r = k16 / rpr; n0 = (k16 % rpr) * 4;
}
__device__ __forceinline__ u32x4 attn_kv_piece(const bf16* QKV, int b, int gatt, int h, int dil, int r, int which, int lk, int chn, bool wrap = false) {
    u32x4 v = (u32x4){0u, 0u, 0u, 0u};
    if (lk >= 0) v = *(const u32x4*)(QKV + (size_t)(b * SEQ + lk * dil + r) * NQKV + 1536 + which * 1536 + gatt * 512 + h * 64 + chn * 8);
    return v;
}
constexpr int AT_SLOT = 128 * KVST * 2;
template <bool STORE> __device__ __forceinline__ void phase_attn_mfma(Frame& F) {
    bf16* QKV = (bf16*)(F.ws + WS_QKV); float* LSE = (float*)(F.ws + WS_LSE); const float* rel_bias = F.in[26];
    const int tid = F.tid, lane = F.lane, w = F.wave, g = lane >> 4, c = lane & 15, q4 = c >> 2, p4 = c & 3;
    LAS float* BIAS = (LAS float*)(F.lds + AT_BIAS);
    LAS bf16* OST = (LAS bf16*)(F.lds + AT_OST) + w * 16 * 72;
    for (int e = tid; e < 16 * KVST / 2; e += NTHREADS) ((LAS unsigned*)(F.lds + AT_VS + 256 * KVST * 2))[e] = 0u;
    int b, gatt, h, dil, r, n0;
    u32x4 kv[8], qnext[2];
    { attn_decode_run(F.bid, b, gatt, h, dil, r, n0);
#pragma unroll
      for (int i = 0; i < 8; ++i) { const int e = tid + NTHREADS * i; kv[i] = attn_kv_piece(QKV, b, gatt, h, dil, r, e >> 11, 128 * n0 - 128 + ((e >> 3) & 255), e & 7, !STORE); }
#pragma unroll
      for (int ks = 0; ks < 2; ++ks) qnext[ks] = *(const u32x4*)(QKV + (size_t)(b * SEQ + (128 * n0 + 16 * w + c) * dil + r) * NQKV + gatt * 512 + h * 64 + 32 * ks + 8 * g); }
    for (int ridx = F.bid; ridx < 768; ridx += F.G) {
        attn_decode_run(ridx, b, gatt, h, dil, r, n0);
        for (int i = 0; i < 4; ++i) { const int n = n0 + i, par = i & 1;
            const int prevK = par ? AT_KS + AT_SLOT : AT_KS, curK = par ? AT_KS : AT_KS + AT_SLOT, prevV = par ? AT_VS + AT_SLOT : AT_VS, curV = par ? AT_VS : AT_VS + AT_SLOT;
            LDSBAR();
            if (i == 0 && tid < 129) BIAS[tid] = rel_bias[(int)T5BUCKET[gatt][tid] * 24 + gatt * 8 + h];
            { int tz = tid; asm volatile("" : "+v"(tz));
              if (i == 0) {
#pragma unroll
                  for (int q = 0; q < 8; ++q) { const int e = tz + NTHREADS * q, which = e >> 11, rowi = (e >> 3) & 255, chn = e & 7;
                      *(LAS u32x4*)(F.lds + (which ? AT_VS : AT_KS) + (rowi * KVST + chn * 8) * 2) = kv[q]; } }
              else {
#pragma unroll
                  for (int q = 0; q < 4; ++q) { const int e = tz + NTHREADS * q, which = e >> 10, rowi = (e >> 3) & 127, chn = e & 7;
                      *(LAS u32x4*)(F.lds + (which ? curV : curK) + (rowi * KVST + chn * 8) * 2) = kv[q]; } } }
            const size_t qrow = (size_t)(b * SEQ + (128 * n + 16 * w + c) * dil + r);
            u32x4 qraw[2]; qraw[0] = qnext[0]; qraw[1] = qnext[1];
            { int tz = tid; asm volatile("" : "+v"(tz)); const int lz = tz & 63;
              const bool same = (i < 3), more = same || (ridx + F.G < 768);
              int b2 = b, g2 = gatt, h2 = h, d2 = dil, r2 = r, m0 = n0;
              if (!same && more) attn_decode_run(ridx + F.G, b2, g2, h2, d2, r2, m0);
              const int nn = same ? n + 1 : m0, lb = same ? 128 * nn : 128 * nn - 128, sh = same ? 10 : 11, msk = same ? 127 : 255, npc = same ? 4 : 8;
              if (more) {
#pragma unroll
                  for (int ks = 0; ks < 2; ++ks) qnext[ks] = *(const u32x4*)(QKV + (size_t)(b2 * SEQ + (128 * nn + 16 * w + (lz & 15)) * d2 + r2) * NQKV + g2 * 512 + h2 * 64 + 32 * ks + 8 * (lz >> 4));
#pragma unroll
                  for (int q = 0; q < 8; ++q) { const int e = tz + NTHREADS * q; if (q < npc) kv[q] = attn_kv_piece(QKV, b2, g2, h2, d2, r2, e >> sh, lb + ((e >> 3) & msk), e & 7, !STORE); } } }
            bf16x8 qf[2];
#pragma unroll
            for (int ks = 0; ks < 2; ++ks) { const u32x4 v = qraw[ks]; u32x4 o;
                o.x = pk2(bflo(v.x) * 0.125f, bfhi(v.x) * 0.125f); o.y = pk2(bflo(v.y) * 0.125f, bfhi(v.y) * 0.125f); o.z = pk2(bflo(v.z) * 0.125f, bfhi(v.z) * 0.125f); o.w = pk2(bflo(v.w) * 0.125f, bfhi(v.w) * 0.125f);
                qf[ks] = __builtin_bit_cast(bf16x8, o); }
            LDSBAR();
            f32x4 S[9];
#pragma unroll
            for (int j = 0; j < 9; ++j) { const int tau = w + j; const LAS unsigned char* kb = F.lds + ((tau < 8) ? prevK + tau * 16 * KVST * 2 : curK + (tau - 8) * 16 * KVST * 2) + (c * KVST + 8 * g) * 2;
                f32x4 a = (f32x4){0.f, 0.f, 0.f, 0.f}; a = MFMA16(ld_b128(kb), qf[0], a); a = MFMA16(ld_b128(kb + 64), qf[1], a); S[j] = a; }
            float mx = -1e30f;
            { float bv[9][4];
#pragma unroll
              for (int j = 0; j < 9; ++j)
#pragma unroll
                  for (int rr = 0; rr < 4; ++rr) { const int delta = 128 - 16 * j + c - 4 * g - rr; bv[j][rr] = BIAS[min(max(delta, 0), 128)]; }
              asm volatile("s_waitcnt lgkmcnt(0)" ::: "memory");
#pragma unroll
              for (int j = 0; j < 9; ++j)
#pragma unroll
                  for (int rr = 0; rr < 4; ++rr) { const int delta = 128 - 16 * j + c - 4 * g - rr, ki = 16 * (w + j) + 4 * g + rr;
                      const bool valid = (delta >= 0) && (delta <= 128) && (n > 0 || ki >= 128);
                      const float s = valid ? S[j][rr] + bv[j][rr] : -1e30f; S[j][rr] = s; mx = fmaxf(mx, s); } }
            mx = fmaxf(mx, bperm_f(lane ^ 16, mx)); mx = fmaxf(mx, bperm_f(lane ^ 32, mx));
            float lsum = 0.f;
#pragma unroll
            for (int j = 0; j < 9; ++j)
#pragma unroll
                for (int rr = 0; rr < 4; ++rr) { const float p = (S[j][rr] > -1e29f) ? __expf(S[j][rr] - mx) : 0.f; S[j][rr] = p; lsum += p; }
            lsum += bperm_f(lane ^ 16, lsum); lsum += bperm_f(lane ^ 32, lsum);
            f32x4 O[4];
#pragma unroll
            for (int dt = 0; dt < 4; ++dt) O[dt] = (f32x4){0.f, 0.f, 0.f, 0.f};
#pragma unroll
            for (int m5 = 0; m5 < 5; ++m5) { const f32x4 z4 = (f32x4){0.f, 0.f, 0.f, 0.f};
                const bf16x8 pf = pack8(S[2 * m5], (2 * m5 + 1 < 9) ? S[(2 * m5 + 1 < 9) ? 2 * m5 + 1 : 0] : z4);
                const int t1 = w + 2 * m5, t2 = t1 + 1;
                const LAS unsigned char* v1 = F.lds + ((t1 < 8) ? prevV + t1 * 16 * KVST * 2 : curV + (t1 - 8) * 16 * KVST * 2) + ((4 * g + q4) * KVST + 4 * p4) * 2;
                const LAS unsigned char* v2 = F.lds + ((t2 < 8) ? prevV + t2 * 16 * KVST * 2 : curV + (t2 - 8) * 16 * KVST * 2) + ((4 * g + q4) * KVST + 4 * p4) * 2;
#pragma unroll
                for (int dt = 0; dt < 4; ++dt) O[dt] = MFMA16(pf, cat8(ld_tr(v1 + dt * 32), ld_tr(v2 + dt * 32)), O[dt]); }
            const float linv = __builtin_amdgcn_rcpf(lsum);
            if (STORE && g == 0) LSE[qrow * 24 + gatt * 8 + h] = mx + __logf(lsum);
#pragma unroll
            for (int rr = 0; rr < 4; ++rr) { const float li = bperm_f(4 * g + rr, linv);
#pragma unroll
                for (int dt = 0; dt < 4; ++dt) OST[(4 * g + rr) * 72 + 16 * dt + c] = (bf16)pk2(O[dt][rr] * li, 0.f); }
#pragma unroll
            for (int q = 0; q < 2; ++q) { const int row = q * 8 + (lane >> 3), ch = lane & 7; const u32x4 v = *(const LAS u32x4*)(OST + row * 72 + ch * 8);
                if (STORE) *(u32x4*)(QKV + (size_t)(b * SEQ + (128 * n + 16 * w + row) * dil + r) * NQKV + gatt * 512 + h * 64 + ch * 8) = v; else asm volatile("" :: "v"(v)); }
        }
    }
}
__device__ __forceinline__ void phase_attn_merge(Frame& F) {
    const bf16* QKV = (const bf16*)(F.ws + WS_QKV); const float* LSE = (const float*)(F.ws + WS_LSE); bf16* YB = (bf16*)(F.ws + WS_YB);
    const size_t gt = (size_t)F.bid * NTHREADS + F.tid, NGT = (size_t)F.G * NTHREADS;
    for (size_t e = gt; e < (size_t)MROWS * 64; e += NGT) { const size_t row = e >> 6; const int h = (int)(e >> 3) & 7, d8 = (int)e & 7;
        const float l0 = LSE[row * 24 + h], l1 = LSE[row * 24 + 8 + h], l2 = LSE[row * 24 + 16 + h]; const float m = fmaxf(l0, fmaxf(l1, l2));
        float w0 = __expf(l0 - m), w1 = __expf(l1 - m), w2 = __expf(l2 - m); const float inv = 1.f / (w0 + w1 + w2); w0 *= inv; w1 *= inv; w2 *= inv;
        const bf16* qp = QKV + row * NQKV + h * 64 + d8 * 8;
        const u32x4 a = *(const u32x4*)qp, bq = *(const u32x4*)(qp + 512), cq = *(const u32x4*)(qp + 1024); u32x4 o;
        o.x = pk2(w0 * bflo(a.x) + w1 * bflo(bq.x) + w2 * bflo(cq.x), w0 * bfhi(a.x) + w1 * bfhi(bq.x) + w2 * bfhi(cq.x));
        o.y = pk2(w0 * bflo(a.y) + w1 * bflo(bq.y) + w2 * bflo(cq.y), w0 * bfhi(a.y) + w1 * bfhi(bq.y) + w2 * bfhi(cq.y));
        o.z = pk2(w0 * bflo(a.z) + w1 * bflo(bq.z) + w2 * bflo(cq.z), w0 * bfhi(a.z) + w1 * bfhi(bq.z) + w2 * bfhi(cq.z));
        o.w = pk2(w0 * bflo(a.w) + w1 * bflo(bq.w) + w2 * bflo(cq.w), w0 * bfhi(a.w) + w1 * bfhi(bq.w) + w2 * bfhi(cq.w));
        *(u32x4*)(YB + row * 512 + h * 64 + d8 * 8) = o; }
}
#define GEMM_LDS ((PG8_LAS unsigned char*)F.lds)
template <class Epi> __device__ __forceinline__ void run_gemm(Frame& F, const bf16* A, const bf16* Bt, int N, int K, const Epi& E) {
    pg8::Gemm g{A, Bt, MROWS, N, K}; pg8::StaticOrder S; S.init(MROWS, N, F.G, F.bid);
    pg8::gemm_phase<Epi, pg8::StaticOrder, true, true>(GEMM_LDS, g, S, E, F.tid);
}
#define GSYNC(cls) do { xcd_barrier(xbar, cur_tid(wv)); } while (0)
struct PairOrder {
    pg8::StaticOrder base;
    __device__ bool next(int i, pg8::Unit& u) const { if (i >= 2) return false; pg8::Unit u0; if (!base.next(0, u0)) return false; u.pm = u0.pm; u.pn = u0.pn + 4 * i; return true; }
    __device__ __forceinline__ void a_ready(const pg8::Unit&) const {}
    __device__ __forceinline__ void done(const pg8::Unit&) const {}
};
__global__ void __launch_bounds__(NTHREADS, 2) fwd_kernel(Args a) {
    extern __shared__ __attribute__((aligned(16))) unsigned char lds[];
    cg::grid_group grid = cg::this_grid();
    const int wv = __builtin_amdgcn_readfirstlane((int)threadIdx.x >> 6);
    const KArgs ka = (KArgs)__builtin_amdgcn_kernarg_segment_ptr();
    { const int t0_ = cur_tid(wv); if (t0_ < 16) ((LAS unsigned*)lds)[(LDS_BYTES - 64) / 4 + t0_] = 0u; }
    __syncthreads();
    XcdBarrier xbar = xcd_barrier_post((unsigned*)(ka->ws + WS_CTL + 65536), (volatile LAS unsigned*)((LAS unsigned char*)lds + LDS_BYTES - 64), cur_tid(wv));
    { Frame F; make_frame(F, ka, lds, wv); p0_mod(F); p0_weights(F); }
    grid.sync();
    for (int l = 0; l < 2; ++l) {
        { Frame F; make_frame(F, ka, lds, wv); phase_modnorm(F, l, (l == 0) ? F.in[0] : F.out); }
        GSYNC(1);
        { Frame F; make_frame(F, ka, lds, wv); run_gemm(F, (const bf16*)(F.ws + WS_XN), (const bf16*)(F.ws + WS_WQKV) + (size_t)l * NQKV * 1024, NQKV, 1024, pg8::EpiStore{(bf16*)(F.ws + WS_QKV), NQKV}); }
        GSYNC(2);
        { Frame F; make_frame(F, ka, lds, wv); phase_attn_mfma<true>(F); }
        GSYNC(3);
        { Frame F; make_frame(F, ka, lds, wv); phase_attn_merge(F); }
        GSYNC(4);
        { Frame F; make_frame(F, ka, lds, wv); run_gemm(F, (const bf16*)(F.ws + WS_XN), (const bf16*)(F.ws + WS_WA) + (size_t)l * NAG * 1024, NAG, 1024, pg8::EpiD{(bf16*)(F.ws + WS_PA), (bf16*)(F.ws + WS_GA), (bf16*)(F.ws + WS_YB)}); }
        GSYNC(2);
        { Frame F; make_frame(F, ka, lds, wv); rwkv_pass<1>(F, l); }
        GSYNC(5);
        { Frame F; make_frame(F, ka, lds, wv); rwkv_pass<3>(F, l); }
        GSYNC(7);
        { Frame F; make_frame(F, ka, lds, wv); pg8::Gemm g{(const bf16*)(F.ws + WS_XN), (const bf16*)(F.ws + WS_WM) + (size_t)l * 2048 * 1024, MROWS, 2048, 1024}; PairOrder S; S.base.init(MROWS, 1024, F.G, F.bid);
          pg8::gemm_phase<pg8::EpiSig, PairOrder, true, true>(GEMM_LDS, g, S, pg8::EpiSig{(bf16*)(F.ws + WS_MG), 0}, F.tid); }
        { Frame F; make_frame(F, ka, lds, wv); run_gemm(F, (const bf16*)(F.ws + WS_YA), (const bf16*)(F.ws + WS_WBA) + (size_t)l * 1024 * 1024, 1024, 1024, pg8::EpiMerge<false>{(bf16*)(F.ws + WS_MERGED), (const bf16*)(F.ws + WS_MG)}); }
        { Frame F; make_frame(F, ka, lds, wv); run_gemm(F, (const bf16*)(F.ws + WS_YB), (const bf16*)(F.ws + WS_WBB) + (size_t)l * 1024 * 512, 1024, 512, pg8::EpiMerge<true>{(bf16*)(F.ws + WS_MERGED), (const bf16*)(F.ws + WS_MG)}); }
        GSYNC(2);
        { Frame F; make_frame(F, ka, lds, wv); run_gemm(F, (const bf16*)(F.ws + WS_MERGED), (const bf16*)(F.ws + WS_WO) + (size_t)l * 1024 * 1024, 1024, 1024,
              pg8::EpiResid{(l == 0) ? F.in[0] : F.out, F.out, (const float*)(F.ws + WS_MOD) + (size_t)l * 2 * 3072 + 2048}); }
        GSYNC(2);
    }
    { Frame F; make_frame(F, ka, lds, wv); phase_final(F); }
}
extern "C" void kernel_launch(void* const* d_in, const int* in_sizes, int n_in, void* d_out, int out_size, void* d_ws, size_t ws_size, hipStream_t stream) {
    static int grid = 0;
    if (grid == 0) {
        int dev = 0, cus = 0, per_cu = 0;
        (void)hipGetDevice(&dev); (void)hipDeviceGetAttribute(&cus, hipDeviceAttributeMultiprocessorCount, dev);
        (void)hipFuncSetAttribute((const void*)fwd_kernel, hipFuncAttributeMaxDynamicSharedMemorySize, LDS_BYTES);
        (void)hipOccupancyMaxActiveBlocksPerMultiprocessor(&per_cu, (const void*)fwd_kernel, NTHREADS, LDS_BYTES);
        if (n_in != 28 || out_size != MROWS * DM || ws_size < (size_t)352 * MiB || per_cu < 1) { fprintf(stderr, "kernel_launch: unexpected problem (n_in %d out %d ws %zu per_cu %d)\n", n_in, out_size, ws_size, per_cu); }
        grid = cus;
        (void)hipGetLastError();
    }
    (void)hipMemsetAsync((char*)d_ws + WS_CTL, 0, 1 * MiB, stream);
    Args a{};
    for (int i = 0; i < 28; ++i) a.in[i] = (const float*)d_in[i];
    a.out = (float*)d_out; a.ws = (unsigned char*)d_ws;
    void* args[] = {&a};
    hipError_t e = hipLaunchCooperativeKernel((void*)fwd_kernel, dim3(grid), dim3(NTHREADS), args, LDS_BYTES, stream);
    if (e != hipSuccess) fprintf(stderr, "cooperative launch failed: %s (grid %d)\n", hipGetErrorString(e), grid);
}
```
